# Optimizing an MI355X kernel written in HIP

```python
import math
import jax, jax.numpy as jnp
from jax import lax
import numpy as np

D_MODEL = 1024
BATCH = 2
SEQ = 8192
DEPTH = 4

N_A_LAYERS = DEPTH // 2
N_B_LAYERS = DEPTH - N_A_LAYERS
BLOCK = 128
EPS = 1e-6
ROPE_THETA = 10000.0

A_HEADS = 16
A_HEAD_DIM = D_MODEL // A_HEADS

B_HEAD_DIM = 128
B_HEADS = D_MODEL // B_HEAD_DIM
B_WINDOWS = (128, 512, 2048)
B_DILATIONS = (1, 4, 16)
B_GROUPS = len(B_WINDOWS)

MOE_GROUPS = 4
MOE_EXPERTS_PER_GROUP = 4
MOE_EXPERTS = MOE_GROUPS * MOE_EXPERTS_PER_GROUP
MOE_TOPK = 2
MOE_FF = D_MODEL // 4

kernel_name = "yoco_fox_dilated_hmoe_trunk"


def rms_norm(x, gain):
    xf = x.astype(jnp.float32)
    y = xf * lax.rsqrt(jnp.mean(xf * xf, axis=-1, keepdims=True) + EPS)
    return (y * gain.astype(jnp.float32)).astype(x.dtype)


def rope(x, positions):
    half = x.shape[-1] // 2
    inv_freq = ROPE_THETA ** (-jnp.arange(half, dtype=jnp.float32) / half)
    ang = positions.astype(jnp.float32)[..., None] * inv_freq
    cos = jnp.cos(ang)[:, :, None, :]
    sin = jnp.sin(ang)[:, :, None, :]
    xf = x.astype(jnp.float32)
    x1, x2 = xf[..., :half], xf[..., half:]
    out = jnp.concatenate([x1 * cos - x2 * sin, x2 * cos + x1 * sin], axis=-1)
    return out.astype(x.dtype)


def forgetting_attention(h, w_in, b_f, q_gain, k_gain, w_out):
    Bsz, S, D = h.shape
    proj = h @ w_in
    q = proj[..., :D].reshape(Bsz, S, A_HEADS, A_HEAD_DIM)
    k = proj[..., D:2 * D].reshape(Bsz, S, A_HEADS, A_HEAD_DIM)
    v = proj[..., 2 * D:3 * D].reshape(Bsz, S, A_HEADS, A_HEAD_DIM)
    f_logit = proj[..., 3 * D:]
    q = rms_norm(q, q_gain)
    k = rms_norm(k, k_gain)
    log_f = jax.nn.log_sigmoid(f_logit.astype(jnp.float32) + b_f.astype(jnp.float32))
    c = jnp.cumsum(log_f, axis=1)
    c_k = c.transpose(0, 2, 1)
    v32 = v.astype(jnp.float32)
    scale = A_HEAD_DIM ** -0.5
    nb = S // BLOCK
    q_blk = q.reshape(Bsz, nb, BLOCK, A_HEADS, A_HEAD_DIM).transpose(1, 0, 2, 3, 4)
    c_blk = c.reshape(Bsz, nb, BLOCK, A_HEADS).transpose(1, 0, 2, 3)
    starts = jnp.arange(nb, dtype=jnp.int32) * BLOCK
    k_pos = jnp.arange(S, dtype=jnp.int32)

    def one_block(args):
        qb, cb, start = args
        s = jnp.einsum('bqhd,bshd->bhqs', qb, k, preferred_element_type=jnp.float32) * scale
        s = s + cb.transpose(0, 2, 1)[..., None] - c_k[:, :, None, :]
        q_pos = start + jnp.arange(BLOCK, dtype=jnp.int32)
        causal = k_pos[None, :] <= q_pos[:, None]
        s = jnp.where(causal, s, -jnp.inf)
        p = jax.nn.softmax(s, axis=-1)
        return jnp.einsum('bhqs,bshd->bqhd', p, v32).astype(h.dtype)

    o = lax.map(one_block, (q_blk, c_blk, starts))
    o = o.transpose(1, 0, 2, 3, 4).reshape(Bsz, S, D)
    return o @ w_out


def shared_kv(h_stream, kv_norm, kv_w, k_gain, positions):
    Bsz, S, _ = h_stream.shape
    kv = rms_norm(h_stream, kv_norm) @ kv_w
    width = B_HEADS * B_HEAD_DIM
    k = kv[..., :width].reshape(Bsz, S, B_HEADS, B_HEAD_DIM)
    v = kv[..., width:].reshape(Bsz, S, B_HEADS, B_HEAD_DIM)
    k = rope(rms_norm(k, k_gain), positions)
    return k, v


def dilated_group(q, k, v, window, dilation):
    Bsz, S, H, Dh = q.shape
    band = window // dilation
    span = dilation * BLOCK
    s_pad = -(-S // span) * span
    L = s_pad // dilation
    nb = L // BLOCK

    def strided(t):
        X = t.shape[-1]
        t = jnp.pad(t, ((0, 0), (0, s_pad - S), (0, 0), (0, 0)))
        t = t.reshape(Bsz, L, dilation, H, X).transpose(0, 2, 1, 3, 4)
        return t.reshape(Bsz, dilation, nb, BLOCK, H, X)

    def with_prev(t):
        prev = jnp.pad(t, ((0, 0), (0, 0), (1, 0), (0, 0), (0, 0), (0, 0)))[:, :, :-1]
        return jnp.concatenate([prev, t], axis=3)

    qs = strided(q)
    kb = with_prev(strided(k))
    vb = with_prev(strided(v)).astype(jnp.float32)
    s = jnp.einsum('brnqhd,brnkhd->brnhqk', qs, kb,
                   preferred_element_type=jnp.float32) * (Dh ** -0.5)
    qi = jnp.arange(BLOCK)[:, None]
    kk = jnp.arange(2 * BLOCK)[None, :]
    dist = BLOCK + qi - kk
    in_band = (dist >= 0) & (dist <= band)
    before_start = (jnp.arange(nb)[:, None, None] == 0) & (kk[None] < BLOCK)
    valid = in_band[None] & ~before_start
    s = jnp.where(valid[None, None, :, None, :, :], s, -jnp.inf)
    m = jnp.max(s, axis=-1, keepdims=True)
    p = jnp.exp(s - m)
    l = jnp.sum(p, axis=-1, keepdims=True)
    o = jnp.einsum('brnhqk,brnkhd->brnqhd', p, vb) / l.transpose(0, 1, 2, 4, 3, 5)
    lse = (m + jnp.log(l))[..., 0].transpose(0, 1, 2, 4, 3)

    def unstride(t):
        X = t.shape[-1]
        t = t.reshape(Bsz, dilation, L, H, X).transpose(0, 2, 1, 3, 4)
        return t.reshape(Bsz, s_pad, H, X)[:, :S]

    return unstride(o), unstride(lse[..., None])[..., 0]


def dilated_attention(h, positions, k, v, w_q, q_gain, w_out):
    Bsz, S, D = h.shape
    q = (h @ w_q).reshape(Bsz, S, B_GROUPS, B_HEADS, B_HEAD_DIM)
    outs, lses = [], []
    for g in range(B_GROUPS):
        qg = rope(rms_norm(q[:, :, g], q_gain[g]), positions)
        o_g, lse_g = dilated_group(qg, k, v, B_WINDOWS[g], B_DILATIONS[g])
        outs.append(o_g)
        lses.append(lse_g)
    wgt = jax.nn.softmax(jnp.stack(lses, axis=0), axis=0)
    o = jnp.sum(wgt[..., None] * jnp.stack(outs, axis=0), axis=0)
    return o.reshape(Bsz, S, B_HEADS * B_HEAD_DIM).astype(h.dtype) @ w_out


def hier_moe(h, group_w, group_b, expert_w, expert_b, w_gate, w_up, w_down):
    Bsz, S, D = h.shape
    xt = h.reshape(Bsz * S, D)
    g_prob = jax.nn.softmax((xt @ group_w).astype(jnp.float32) + group_b.astype(jnp.float32), axis=-1)
    g_p, g_idx = lax.top_k(g_prob, 1)
    e_logits = ((xt @ expert_w).astype(jnp.float32) + expert_b.astype(jnp.float32))
    e_logits = e_logits.reshape(-1, MOE_GROUPS, MOE_EXPERTS_PER_GROUP)
    in_group = jnp.take_along_axis(e_logits, g_idx[:, :, None], axis=1)[:, 0]
    top_v, top_i = lax.top_k(in_group, MOE_TOPK)
    gate = g_p * jax.nn.softmax(top_v, axis=-1)
    eid = g_idx * MOE_EXPERTS_PER_GROUP + top_i
    comb = jnp.sum(jax.nn.one_hot(eid, MOE_EXPERTS, dtype=jnp.float32) * gate[..., None], axis=1)
    hid = jax.nn.silu(jnp.einsum('td,edf->tef', xt, w_gate)) * jnp.einsum('td,edf->tef', xt, w_up)
    y = jnp.einsum('tef,efd->td', hid * comb[..., None].astype(hid.dtype), w_down)
    return y.reshape(Bsz, S, D)


def setup_inputs(seed: int = 0) -> dict:
    key = jax.random.key(seed)
    ks = jax.random.split(key, 24)
    f32 = jnp.float32
    D = D_MODEL
    res_scale = (2.0 * DEPTH) ** -0.5
    bw = B_HEADS * B_HEAD_DIM

    def nrm(k, shape, scale):
        return jax.random.normal(k, shape, f32) * scale

    def gain(k, shape):
        return 1.0 + 0.02 * jax.random.normal(k, shape, f32)

    x = jax.random.normal(ks[0], (BATCH, SEQ, D), f32)
    positions = jnp.broadcast_to(jnp.arange(SEQ, dtype=jnp.int32), (BATCH, SEQ))
    return {
        "x": x,
        "positions": positions,
        "a_norm": gain(ks[1], (N_A_LAYERS, D)),
        "a_w_in": nrm(ks[2], (N_A_LAYERS, D, 3 * D + A_HEADS), D ** -0.5),
        "a_b_f": jax.random.uniform(ks[3], (N_A_LAYERS, A_HEADS), f32, 1.0, 5.0),
        "a_q_gain": gain(ks[4], (N_A_LAYERS, A_HEAD_DIM)),
        "a_k_gain": gain(ks[5], (N_A_LAYERS, A_HEAD_DIM)),
        "a_w_out": nrm(ks[6], (N_A_LAYERS, D, D), D ** -0.5 * res_scale),
        "kv_norm": gain(ks[7], (D,)),
        "kv_w": nrm(ks[8], (D, 2 * bw), D ** -0.5),
        "kv_k_gain": gain(ks[9], (B_HEAD_DIM,)),
        "b_norm": gain(ks[10], (N_B_LAYERS, D)),
        "b_w_q": nrm(ks[11], (N_B_LAYERS, D, B_GROUPS * bw), D ** -0.5),
        "b_q_gain": gain(ks[12], (N_B_LAYERS, B_GROUPS, B_HEAD_DIM)),
        "b_w_out": nrm(ks[13], (N_B_LAYERS, bw, D), bw ** -0.5 * res_scale),
        "ffn_norm": gain(ks[14], (DEPTH, D)),
        "moe_group_w": nrm(ks[15], (DEPTH, D, MOE_GROUPS), D ** -0.5),
        "moe_group_b": nrm(ks[16], (DEPTH, MOE_GROUPS), 0.01),
        "moe_expert_w": nrm(ks[17], (DEPTH, D, MOE_EXPERTS), D ** -0.5),
        "moe_expert_b": nrm(ks[18], (DEPTH, MOE_EXPERTS), 0.01),
        "moe_w_gate": nrm(ks[19], (DEPTH, MOE_EXPERTS, D, MOE_FF), D ** -0.5),
        "moe_w_up": nrm(ks[20], (DEPTH, MOE_EXPERTS, D, MOE_FF), D ** -0.5),
        "moe_w_down": nrm(ks[21], (DEPTH, MOE_EXPERTS, MOE_FF, D), MOE_FF ** -0.5 * res_scale),
    }


def reference(x, positions, a_norm, a_w_in, a_b_f, a_q_gain, a_k_gain, a_w_out,
              kv_norm, kv_w, kv_k_gain, b_norm, b_w_q, b_q_gain, b_w_out,
              ffn_norm, moe_group_w, moe_group_b, moe_expert_w, moe_expert_b,
              moe_w_gate, moe_w_up, moe_w_down):
    h = x
    k_sh = None
    v_sh = None
    for layer in range(DEPTH):
        if layer < N_A_LAYERS:
            i = layer
            h = h + forgetting_attention(rms_norm(h, a_norm[i]), a_w_in[i], a_b_f[i],
                                         a_q_gain[i], a_k_gain[i], a_w_out[i])
        else:
            if layer == N_A_LAYERS:
                k_sh, v_sh = shared_kv(h, kv_norm, kv_w, kv_k_gain, positions)
            j = layer - N_A_LAYERS
            h = h + dilated_attention(rms_norm(h, b_norm[j]), positions, k_sh, v_sh,
                                      b_w_q[j], b_q_gain[j], b_w_out[j])
        h = h + hier_moe(rms_norm(h, ffn_norm[layer]), moe_group_w[layer], moe_group_b[layer],
                         moe_expert_w[layer], moe_expert_b[layer],
                         moe_w_gate[layer], moe_w_up[layer], moe_w_down[layer])
    return h
```

```cpp
#include <hip/hip_runtime.h>
#include <hip/hip_bf16.h>
#include <cstdio>
#include <cstdint>
#include <cmath>
__device__ __forceinline__ int tid_fresh() { int t = (int)threadIdx.x; asm volatile("" : "+v"(t)); return t; }
__device__ __forceinline__ int bid_fresh() { int t = (int)blockIdx.x; asm volatile("" : "+s"(t)); return t; }
#if defined(__HIP_DEVICE_COMPILE__)
#define ASSUME_GLOBAL(p_) do { __builtin_assume(!__builtin_amdgcn_is_shared((const void*)(p_))); __builtin_assume(!__builtin_amdgcn_is_private((const void*)(p_))); } while (0)
#else
#define ASSUME_GLOBAL(p_) do { } while (0)
#endif
namespace pg8 {
#define PG8_LAS __attribute__((address_space(3)))
typedef unsigned short bf16_t;
typedef short bf16x8 __attribute__((ext_vector_type(8)));
typedef float f32x4 __attribute__((ext_vector_type(4)));
typedef unsigned u32x4 __attribute__((ext_vector_type(4)));
constexpr int BM = 256, BK = 64, HALF = 128, HTB = HALF * BK * 2  , STAGE_BYTES = 8 * HTB, NXCD = 8, WGM = 8;

__host__ __device__ __forceinline__ int lds_byte(int r, int c) { const int st = (r >> 4) * 2 + (c >> 5), rr = r & 15, cc = c & 31, ob = rr * 64 + cc * 2; return st * 1024 + (ob ^ (((ob >> 9) & 1) << 5)); }
__host__ __device__ __forceinline__ void stage_rc(int b, int& R, int& C) { const int st = b / 1024, sb = b % 1024, swz = sb ^ (((sb >> 9) & 1) << 5); R = (st >> 1) * 16 + swz / 64; C = (st & 1) * 32 + (swz % 64) / 2; }
__host__ __device__ __forceinline__ int perm32(int rho) { const int n = rho >> 4, i = rho & 15; return 8 * (i >> 2) + 4 * n + (i & 3); }

struct Unit { int pm, pn; };
struct Gemm { const bf16_t* A; const bf16_t* Bt; int M, N, K; };

struct StaticOrder {
    int nM, nN, nwg, G, c;
    __host__ __device__ void init(int M, int N, int G_, int c_) { nM = M / BM; nN = N / BM; nwg = nM * nN; G = G_; c = c_; }
    __host__ __device__ bool next(int i, Unit& u) const {
        const long L = (long)i * G + c; if (L >= nwg) return false;
        int wgid = (int)L; { const int q = nwg / NXCD, r = nwg % NXCD, xcd = wgid % NXCD, off = wgid / NXCD; wgid = (xcd < r ? xcd * (q + 1) : r * (q + 1) + (xcd - r) * q) + off; }
        const int nig = WGM * nN, gid = wgid / nig, fm = gid * WGM, gsz = (nM - fm) < WGM ? (nM - fm) : WGM;
        u.pm = fm + ((wgid % nig) % gsz); u.pn = (wgid % nig) / gsz; return true;
    }
    __device__ __forceinline__ void a_ready(const Unit&) const {}
    __device__ __forceinline__ void done(const Unit&) const {}
};

__device__ __forceinline__ unsigned cvt_pk_bf16(float lo, float hi) { unsigned r; asm volatile("v_cvt_pk_bf16_f32 %0, %1, %2" : "=v"(r) : "v"(lo), "v"(hi)); return r; }
typedef float f32x2 __attribute__((ext_vector_type(2)));
constexpr float RMS_EPS = 1e-6f;
#define PG8_GAS __attribute__((address_space(1)))
__device__ __forceinline__ void st16(bf16_t* p, const float (&o)[8]) { u32x4 w; w.x = cvt_pk_bf16(o[0], o[1]); w.y = cvt_pk_bf16(o[2], o[3]); w.z = cvt_pk_bf16(o[4], o[5]); w.w = cvt_pk_bf16(o[6], o[7]); *(PG8_GAS u32x4*)p = w; }
struct EpiAQkv {
    static constexpr bool PERM = true, AFTER_DRAIN = false;
    bf16_t* QKV; size_t sec_stride; const float* rstd; const float* gtab;
    __device__ __forceinline__ void operator()(const f32x4 (&acc)[2][2][4][2], const Unit& u, int wr, int wc, int fr, int fq) const {
        const int sec = u.pn >> 2, head = (u.pn & 3) * 4 + wc;
        bf16_t* dst = QKV + (size_t)sec * sec_stride + head * 64 + 8 * fq;
        const float* gp = gtab + sec * 64 + 8 * fq;
        const bool nrm = sec < 2;
        float rsv[2][4]; const float* rp = rstd + u.pm * BM + wr * 64 + fr;
#pragma unroll
        for (int ai = 0; ai < 2; ++ai)
#pragma unroll
            for (int m = 0; m < 4; ++m) rsv[ai][m] = *(const PG8_GAS float*)(rp + ai * HALF + m * 16);
        f32x4 g[2][2];
#pragma unroll
        for (int bj = 0; bj < 2; ++bj)
#pragma unroll
            for (int n = 0; n < 2; ++n) g[bj][n] = *(const PG8_GAS f32x4*)(gp + 32 * bj + 4 * n);
#pragma unroll
        for (int ai = 0; ai < 2; ++ai)
#pragma unroll
            for (int m = 0; m < 4; ++m) {
                const int row = u.pm * BM + ai * HALF + wr * 64 + m * 16 + fr;
                const float rs = rsv[ai][m];
                f32x4 v[2][2];
#pragma unroll
                for (int bj = 0; bj < 2; ++bj)
#pragma unroll
                    for (int n = 0; n < 2; ++n) v[bj][n] = acc[ai][bj][m][n] * rs;
                float s = 0.f;
#pragma unroll
                for (int bj = 0; bj < 2; ++bj)
#pragma unroll
                    for (int n = 0; n < 2; ++n) { const f32x4 x = v[bj][n]; s += (x[0] * x[0] + x[1] * x[1]) + (x[2] * x[2] + x[3] * x[3]); }
                s += __shfl_xor(s, 16); s += __shfl_xor(s, 32);
                const float sc = nrm ? __builtin_amdgcn_rsqf(s * (1.0f / 64.0f) + RMS_EPS) : 1.0f;
#pragma unroll
                for (int bj = 0; bj < 2; ++bj) { const f32x4 o0 = v[bj][0] * sc * g[bj][0], o1 = v[bj][1] * sc * g[bj][1];
                    u32x4 w; w.x = cvt_pk_bf16(o0[0], o0[1]); w.y = cvt_pk_bf16(o0[2], o0[3]); w.z = cvt_pk_bf16(o1[0], o1[1]); w.w = cvt_pk_bf16(o1[2], o1[3]);
                    *(PG8_GAS u32x4*)(dst + (size_t)row * 1024 + 32 * bj) = w; }
            }
    }
};
struct EpiBKvq {
    static constexpr bool PERM = true, AFTER_DRAIN = false;
    bf16_t *KB, *VB, *QB; const float* rstd; const float *kg, *qg  ; const unsigned* rcs  ; int tile_off; PG8_LAS float* xs;
    __device__ __forceinline__ void operator()(const f32x4 (&acc)[2][2][4][2], const Unit& u, int wr, int wc, int fr, int fq) const {
        const int T = u.pn + tile_off;
        float rsv[2][4]; const float* rp = rstd + u.pm * BM + wr * 64 + fr;
#pragma unroll
        for (int ai = 0; ai < 2; ++ai)
#pragma unroll
            for (int m = 0; m < 4; ++m) rsv[ai][m] = *(const PG8_GAS float*)(rp + ai * HALF + m * 16);
        if (T >= 4 && T < 8) {
            bf16_t* dst = VB + (T - 4) * 256 + 32 * wc + 8 * fq;
#pragma unroll
            for (int ai = 0; ai < 2; ++ai)
#pragma unroll
                for (int m = 0; m < 4; ++m) {
                    const int row = u.pm * BM + ai * HALF + wr * 64 + m * 16 + fr; const float rs = rsv[ai][m];
#pragma unroll
                    for (int bj = 0; bj < 2; ++bj) { float o[8];
#pragma unroll
                        for (int n = 0; n < 2; ++n)
#pragma unroll
                            for (int e = 0; e < 4; ++e) o[4 * n + e] = acc[ai][bj][m][n][e] * rs;
                        st16(dst + (size_t)row * 1024 + 128 * bj, o); }
                }
            return;
        }
        const bool isq = T >= 8; const int grp = isq ? ((T - 8) >> 2) : 0, head = (isq ? ((T - 8) & 3) : T) * 2 + (wc >> 1);
        const int d1 = 32 * (wc & 1) + 8 * fq;
        const float* gp = isq ? (qg + grp * 128) : kg;
        f32x4 g[2][2];
#pragma unroll
        for (int bj = 0; bj < 2; ++bj)
#pragma unroll
            for (int n = 0; n < 2; ++n) g[bj][n] = *(const PG8_GAS f32x4*)(gp + 64 * bj + d1 + 4 * n);
        const unsigned* rcp = rcs + (size_t)(u.pm * BM + wr * 64 + fr) * 64 + d1;
        u32x4 rn0 = *(const PG8_GAS u32x4*)(rcp), rn1 = *(const PG8_GAS u32x4*)(rcp + 4);
        float ss[2][4];
#pragma unroll
        for (int ai = 0; ai < 2; ++ai)
#pragma unroll
            for (int m = 0; m < 4; ++m) {
                const float rs = rsv[ai][m];
                float s = 0.f;
#pragma unroll
                for (int bj = 0; bj < 2; ++bj)
#pragma unroll
                    for (int n = 0; n < 2; ++n) { const f32x4 x = acc[ai][bj][m][n] * rs; s += (x[0] * x[0] + x[1] * x[1]) + (x[2] * x[2] + x[3] * x[3]); }
                s += __shfl_xor(s, 16); s += __shfl_xor(s, 32);
                ss[ai][m] = s;
                if (fq == 0) xs[(ai * HALF + wr * 64 + m * 16 + fr) * 4 + wc] = s;
            }
        asm volatile("s_waitcnt lgkmcnt(0)" ::: "memory"); __builtin_amdgcn_s_barrier(); asm volatile("" ::: "memory");
        bf16_t* dst = isq ? (QB + grp * 1024 + head * 128 + d1) : (KB + head * 128 + d1);
        const size_t pitch = isq ? 3072 : 1024;
#pragma unroll
        for (int ai = 0; ai < 2; ++ai)
#pragma unroll
            for (int m = 0; m < 4; ++m) {
                const int rl = ai * HALF + wr * 64 + m * 16 + fr, row = u.pm * BM + rl; const float rs = rsv[ai][m];
                const u32x4 rc0 = rn0, rc1 = rn1;
                { const int gi = ai * 4 + m + 1, an = (gi >> 2) & 1, mn = gi & 3; rn0 = *(const PG8_GAS u32x4*)(rcp + (size_t)(an * HALF + mn * 16) * 64); rn1 = *(const PG8_GAS u32x4*)(rcp + (size_t)(an * HALF + mn * 16) * 64 + 4); }
                const float tot = ss[ai][m] + xs[rl * 4 + (wc ^ 1)];
                const float sc = rs * __builtin_amdgcn_rsqf(tot * (1.0f / 128.0f) + RMS_EPS);
                float o1[8], o2[8];
#pragma unroll
                for (int n = 0; n < 2; ++n)
#pragma unroll
                    for (int e = 0; e < 4; ++e) { const int j = 4 * n + e;
                        const float y1 = acc[ai][0][m][n][e] * sc * g[0][n][e], y2 = acc[ai][1][m][n][e] * sc * g[1][n][e];
                        const unsigned cw = n ? rc1[e] : rc0[e];
                        const float c = (float)__builtin_bit_cast(_Float16, (unsigned short)(cw & 0xffffu)), sn = (float)__builtin_bit_cast(_Float16, (unsigned short)(cw >> 16));
                        o1[j] = y1 * c - y2 * sn; o2[j] = y2 * c + y1 * sn; }
                st16(dst + (size_t)row * pitch, o1); st16(dst + (size_t)row * pitch + 64, o2);
            }
        asm volatile("s_waitcnt lgkmcnt(0)" ::: "memory"); __builtin_amdgcn_s_barrier(); asm volatile("" ::: "memory");
    }
};
struct EpiResid {
    static constexpr bool PERM = true, AFTER_DRAIN = false;
    const float* B; float* H; float upd;
    __device__ __forceinline__ void operator()(const f32x4 (&acc)[2][2][4][2], const Unit& u, int wr, int wc, int fr, int fq) const {
        const size_t r0 = (size_t)(u.pm * BM + wr * 64 + fr) * 1024 + u.pn * BM + wc * 32 + 8 * fq;
        const float* bp = B + r0; float* hp = H + r0;
        f32x4 nx[2][2];
#pragma unroll
        for (int bj = 0; bj < 2; ++bj)
#pragma unroll
            for (int n = 0; n < 2; ++n) nx[bj][n] = *(const PG8_GAS f32x4*)(bp + bj * HALF + 4 * n);
#pragma unroll
        for (int ai = 0; ai < 2; ++ai)
#pragma unroll
            for (int m = 0; m < 4; ++m) { const size_t ro = (size_t)(ai * HALF + m * 16) * 1024;
                f32x4 cu[2][2];
#pragma unroll
                for (int bj = 0; bj < 2; ++bj)
#pragma unroll
                    for (int n = 0; n < 2; ++n) cu[bj][n] = nx[bj][n];
                { const int gi = ai * 4 + m + 1, an = (gi >> 2) & 1, mn = gi & 3; const size_t rn = (size_t)(an * HALF + mn * 16) * 1024;
#pragma unroll
                  for (int bj = 0; bj < 2; ++bj)
#pragma unroll
                      for (int n = 0; n < 2; ++n) nx[bj][n] = *(const PG8_GAS f32x4*)(bp + rn + bj * HALF + 4 * n); }
#pragma unroll
                for (int bj = 0; bj < 2; ++bj)
#pragma unroll
                    for (int n = 0; n < 2; ++n) *(PG8_GAS f32x4*)(hp + ro + bj * HALF + 4 * n) = cu[bj][n] + acc[ai][bj][m][n] * upd; }
    }
};

template <class Epi, class Sched, bool ALIGN_EPI = false, bool SP2 = false>
__device__ __forceinline__ void gemm_phase(PG8_LAS unsigned char* lds, const Gemm g, const Sched& S, const Epi& E) {
    const int tid = tid_fresh(), wid = __builtin_amdgcn_readfirstlane(tid >> 6), lane = tid & 63, wr = wid >> 2, wc = wid & 3, fr = lane & 15, fq = lane >> 4;
    const int K = g.K, nt = K / BK;
    unsigned voffA[2], voffB[2];
#pragma unroll
    for (int i = 0; i < 2; ++i) { int R, C; stage_rc(tid * 16 + i * 8192, R, C); const int Rb = Epi::PERM ? ((R & ~31) + perm32(R & 31)) : R;
        voffA[i] = (unsigned)(R * K + C) * 2u; voffB[i] = (unsigned)(Rb * K + C) * 2u; }
    const size_t kstep = (size_t)(BK * 2);
    const size_t hstep = (size_t)HALF * K * 2;
    const size_t tstep = 2 * hstep;
    const unsigned ldsw = (unsigned)wid * 1024u;
    const int aoff = lds_byte(wr * 64 + fr, fq * 8), boff = lds_byte(wc * 32 + fr, fq * 8);
#define PG8_SA(b, h) (((b) * 2 + (h)) * HTB)
#define PG8_SB(b, h) ((4 + (b) * 2 + (h)) * HTB)
#define PG8_STAGE(bufoff, gbase, voff) do { _Pragma("unroll") for (int _i = 0; _i < 2; ++_i) \
        __builtin_amdgcn_global_load_lds((const unsigned*)((const char*)(gbase) + (voff)[_i]), (PG8_LAS unsigned*)(lds + (bufoff) + ldsw + _i * 8192), 16, 0, 0); } while (0)
#define PG8_LDA(dst, b, h) do { _Pragma("unroll") for (int m = 0; m < 4; ++m) _Pragma("unroll") for (int k = 0; k < 2; ++k) dst[m][k] = *(const PG8_LAS bf16x8*)(lds + PG8_SA(b, h) + aoff + m * 2048 + k * 1024); } while (0)
#define PG8_LDB(dst, b, h) do { _Pragma("unroll") for (int n = 0; n < 2; ++n) _Pragma("unroll") for (int k = 0; k < 2; ++k) dst[n][k] = *(const PG8_LAS bf16x8*)(lds + PG8_SB(b, h) + boff + n * 2048 + k * 1024); } while (0)
#define PG8_MMA(ai, bj, At, Bt) do { __builtin_amdgcn_s_setprio(1); _Pragma("unroll") for (int m = 0; m < 4; ++m) _Pragma("unroll") for (int n = 0; n < 2; ++n) _Pragma("unroll") for (int k = 0; k < 2; ++k) \
        acc[ai][bj][m][n] = __builtin_amdgcn_mfma_f32_16x16x32_bf16(Bt[n][k], At[m][k], acc[ai][bj][m][n], 0, 0, 0); __builtin_amdgcn_s_setprio(0); } while (0)
#define PG8_WAIT_V(n) asm volatile("s_waitcnt vmcnt(" #n ")" ::: "memory")
#define PG8_WAIT_L(n) asm volatile("s_waitcnt lgkmcnt(" #n ")" ::: "memory")
#define PG8_BAR __builtin_amdgcn_s_barrier()
#define PG8_SCHED __builtin_amdgcn_sched_barrier(0)
    Unit cur, nxt; int ui = 0;
    if (!S.next(0, cur)) return;
    f32x4 acc[2][2][4][2];
#pragma unroll
    for (int a = 0; a < 2; ++a)
#pragma unroll
        for (int b = 0; b < 2; ++b)
#pragma unroll
            for (int m = 0; m < 4; ++m)
#pragma unroll
                for (int n = 0; n < 2; ++n) acc[a][b][m][n] = (f32x4){0.f, 0.f, 0.f, 0.f};
    bf16x8 At[4][2], B0[2][2], B1[2][2];
    const char* cA = (const char*)g.A + (size_t)cur.pm * tstep; const char* cB = (const char*)g.Bt + (size_t)cur.pn * tstep;
    S.a_ready(cur);
    if constexpr (SP2) {
        PG8_STAGE(PG8_SB(0, 0), cB, voffB); PG8_STAGE(PG8_SB(0, 1), cB + hstep, voffB); PG8_STAGE(PG8_SA(0, 0), cA, voffA); PG8_STAGE(PG8_SA(0, 1), cA + hstep, voffA);
        if (wr == 1) PG8_BAR;
        PG8_WAIT_V(2); PG8_BAR;
        PG8_STAGE(PG8_SB(1, 0), cB + kstep, voffB); PG8_STAGE(PG8_SA(1, 0), cA + kstep, voffA); PG8_STAGE(PG8_SB(1, 1), cB + hstep + kstep, voffB);
        PG8_WAIT_V(6); PG8_BAR;
    } else {
        PG8_STAGE(PG8_SB(0, 0), cB, voffB); PG8_STAGE(PG8_SA(0, 0), cA, voffA); PG8_STAGE(PG8_SB(0, 1), cB + hstep, voffB); PG8_STAGE(PG8_SA(0, 1), cA + hstep, voffA);
        if (wr == 1) PG8_BAR;
        PG8_WAIT_V(4); PG8_BAR;
        PG8_STAGE(PG8_SB(1, 0), cB + kstep, voffB); PG8_STAGE(PG8_SA(1, 0), cA + kstep, voffA); PG8_STAGE(PG8_SB(1, 1), cB + hstep + kstep, voffB);
        PG8_WAIT_V(6); PG8_BAR;
    }
    for (;;) {
        const bool has_next = S.next(ui + 1, nxt);
        const char* nA = has_next ? (const char*)g.A + (size_t)nxt.pm * tstep : cA; const char* nB = has_next ? (const char*)g.Bt + (size_t)nxt.pn * tstep : cB;
        for (int t = 0; t < nt; t += 2) {
            const bool last = (t == nt - 2);
            const char* a1 = cA + (size_t)(t + 1) * kstep;
            const char* a2 = last ? nA : cA + (size_t)(t + 2) * kstep; const char* b2 = last ? nB : cB + (size_t)(t + 2) * kstep;
            const char* a3 = a2 + kstep; const char* b3 = b2 + kstep;
            if (last && has_next) S.a_ready(nxt);
            if constexpr (SP2) {
            PG8_LDB(B0, 0, 0); PG8_LDB(B1, 0, 1); PG8_SCHED; PG8_LDA(At, 0, 0); PG8_STAGE(PG8_SA(1, 1), a1 + hstep, voffA);
            PG8_WAIT_V(8); PG8_WAIT_L(0); PG8_BAR; PG8_MMA(0, 0, At, B0); PG8_MMA(0, 1, At, B1); PG8_BAR; PG8_SCHED;
            PG8_LDA(At, 0, 1); PG8_STAGE(PG8_SB(0, 0), b2, voffB); PG8_STAGE(PG8_SB(0, 1), b2 + hstep, voffB); PG8_STAGE(PG8_SA(0, 0), a2, voffA);
            PG8_WAIT_V(8); PG8_WAIT_L(0); PG8_BAR; PG8_MMA(1, 0, At, B0); PG8_MMA(1, 1, At, B1); PG8_BAR; PG8_SCHED;
            PG8_LDB(B0, 1, 0); PG8_LDB(B1, 1, 1); PG8_SCHED; PG8_LDA(At, 1, 0); PG8_STAGE(PG8_SA(0, 1), a2 + hstep, voffA);
            PG8_WAIT_V(8); PG8_WAIT_L(0); PG8_BAR; PG8_MMA(0, 0, At, B0); PG8_MMA(0, 1, At, B1); PG8_BAR; PG8_SCHED;
            PG8_LDA(At, 1, 1); PG8_STAGE(PG8_SB(1, 0), b3, voffB); PG8_STAGE(PG8_SB(1, 1), b3 + hstep, voffB); PG8_STAGE(PG8_SA(1, 0), a3, voffA);
            PG8_WAIT_V(8); PG8_WAIT_L(0); PG8_BAR; PG8_MMA(1, 0, At, B0); PG8_MMA(1, 1, At, B1); PG8_BAR; PG8_SCHED;
            } else {
            PG8_LDB(B0, 0, 0); PG8_SCHED; PG8_LDA(At, 0, 0); PG8_STAGE(PG8_SA(1, 1), a1 + hstep, voffA);
            PG8_WAIT_L(8); PG8_BAR; PG8_WAIT_L(0); PG8_MMA(0, 0, At, B0); PG8_BAR; PG8_SCHED;
            PG8_LDB(B1, 0, 1); PG8_STAGE(PG8_SB(0, 0), b2, voffB);
            PG8_BAR; PG8_WAIT_L(0); PG8_MMA(0, 1, At, B1); PG8_BAR;
            PG8_LDA(At, 0, 1); PG8_STAGE(PG8_SA(0, 0), a2, voffA);
            PG8_BAR; PG8_WAIT_L(0); PG8_MMA(1, 0, At, B0); PG8_BAR; PG8_SCHED;
            PG8_STAGE(PG8_SB(0, 1), b2 + hstep, voffB);
            PG8_WAIT_V(6); PG8_BAR; PG8_MMA(1, 1, At, B1); PG8_BAR;
            PG8_LDB(B0, 1, 0); PG8_SCHED; PG8_LDA(At, 1, 0); PG8_STAGE(PG8_SA(0, 1), a2 + hstep, voffA);
            PG8_WAIT_L(8); PG8_BAR; PG8_WAIT_L(0); PG8_MMA(0, 0, At, B0); PG8_BAR; PG8_SCHED;
            PG8_LDB(B1, 1, 1); PG8_STAGE(PG8_SB(1, 0), b3, voffB);
            PG8_BAR; PG8_WAIT_L(0); PG8_MMA(0, 1, At, B1); PG8_BAR;
            PG8_LDA(At, 1, 1); PG8_STAGE(PG8_SA(1, 0), a3, voffA);
            PG8_BAR; PG8_WAIT_L(0); PG8_MMA(1, 0, At, B0); PG8_BAR; PG8_SCHED;
            PG8_STAGE(PG8_SB(1, 1), b3 + hstep, voffB);
            PG8_WAIT_V(6); PG8_BAR; PG8_MMA(1, 1, At, B1); PG8_BAR;
            }
        }
        if constexpr (ALIGN_EPI) { if (wr == 0) PG8_BAR; }
        if constexpr (!Epi::AFTER_DRAIN) { E(acc, cur, wr, wc, fr, fq); S.done(cur); }
        if (!has_next) break;
#pragma unroll
        for (int a = 0; a < 2; ++a)
#pragma unroll
            for (int b = 0; b < 2; ++b)
#pragma unroll
                for (int m = 0; m < 4; ++m)
#pragma unroll
                    for (int n = 0; n < 2; ++n) acc[a][b][m][n] = (f32x4){0.f, 0.f, 0.f, 0.f};
        cur = nxt; cA = nA; cB = nB; ++ui;
        if constexpr (ALIGN_EPI) { if (wr == 1) PG8_BAR; }
    }
    PG8_WAIT_V(0);
    if constexpr (!ALIGN_EPI) { if (wr == 0) PG8_BAR; }
    PG8_BAR;
    if constexpr (Epi::AFTER_DRAIN) { E.fused(acc, cur, wr, wc, fr, fq, lds, wid, lane); S.done(cur); }
#undef PG8_SA
#undef PG8_SB
#undef PG8_STAGE
#undef PG8_LDA
#undef PG8_LDB
#undef PG8_MMA
#undef PG8_WAIT_V
#undef PG8_WAIT_L
#undef PG8_BAR
#undef PG8_SCHED
}
}

#ifndef PG8_SP2
#define PG8_SP2 true
#endif
#ifndef PG8_ALIGN
#define PG8_ALIGN true
#endif

namespace attn_body {
using bf16=__hip_bfloat16;
using bf16x8=__attribute__((ext_vector_type(8)))short;
using s16x4=__attribute__((ext_vector_type(4)))short;
using f32x16=__attribute__((ext_vector_type(16)))float;
using u32x4=__attribute__((ext_vector_type(4)))unsigned;
constexpr int BATCH=2,NHEAD=16,SEQ=8192,D=64,DM=NHEAD*D;
constexpr int NW=8,QBLK=32,QB=QBLK*NW,KVBLK=64,NQB=SEQ/QB;
constexpr int ATTN_PITCH=DM, ATTN_UNIT_ROWS=QB;
__device__ __forceinline__ int crow(int r,int hi){return (r&3)+8*(r>>2)+4*hi;}
#define SBAR() __builtin_amdgcn_sched_barrier(0)
__device__ __forceinline__ void cmask(f32x16&p0,f32x16&p1,int jb,int qrel,int hi){
  const float NEG=-INFINITY; int kb=64*jb+4*hi;
  #pragma unroll
  for(int r=0;r<16;++r){int kv=kb+(r&3)+8*(r>>2); if(kv>qrel)p0[r]=NEG; if(kv+32>qrel)p1[r]=NEG;}
}

constexpr int NSLOT=3, SLOTB=8192;
constexpr int LDS_K=0, LDS_V=NSLOT*SLOTB, LDS_WS=2*NSLOT*SLOTB, LDS_OST=LDS_WS+NW*64*4, LDS_BYTES=LDS_OST+NW*4096;
constexpr float C2=0.125f*1.4426950408889634f;
__device__ __forceinline__ void glds16(const void*gsrc,unsigned lds_dst){unsigned keep;
  asm volatile("s_mov_b32 %0, m0\n\ts_mov_b32 m0, %2\n\ts_nop 0\n\tglobal_load_lds_dwordx4 %1, off\n\ts_mov_b32 m0, %0":"=&s"(keep):"v"(gsrc),"s"(lds_dst):"memory");}
__device__ __forceinline__ float max3f(float a,float b,float c){float r;asm("v_max3_f32 %0, %1, %2, %3":"=v"(r):"v"(a),"v"(b),"v"(c));return r;}
__device__ __forceinline__ float max2f(float a,float b){float r;asm("v_max_f32_e32 %0, %1, %2":"=v"(r):"v"(a),"v"(b));return r;}
__device__ __forceinline__ float fadd_s(float a,float b){float r;asm("v_add_f32_e32 %0, %1, %2":"=v"(r):"v"(a),"v"(b));return r;}
__device__ __forceinline__ float fsub_s(float a,float b){float r;asm("v_sub_f32_e32 %0, %1, %2":"=v"(r):"v"(a),"v"(b));return r;}
typedef float f32x2_t __attribute__((ext_vector_type(2))); typedef __bf16 bf16x2_t __attribute__((ext_vector_type(2)));
__device__ __forceinline__ unsigned cvtpk_s(float lo,float hi){f32x2_t v={lo,hi};bf16x2_t b=__builtin_convertvector(v,bf16x2_t);return __builtin_bit_cast(unsigned,b);}
#define WAIT_BAR(N) asm volatile("s_waitcnt vmcnt(" #N ") lgkmcnt(0)\n\ts_barrier":::"memory")

__device__ __forceinline__ void qkt(f32x16&p0,f32x16&p1,const char*Kslot,const bf16x8*qr,const f32x16&negm,int r32,int hi,s16x4 ka0,s16x4 ka1,s16x4 qa){
  const char*kb=Kslot+hi*1024+r32*16;
  #pragma unroll
  for(int d0=0;d0<4;++d0){
    const bf16x8 b0=*reinterpret_cast<const bf16x8*>(kb+d0*2048);
    const bf16x8 b1=*reinterpret_cast<const bf16x8*>(kb+d0*2048+512);
    if(d0==0){p0=__builtin_amdgcn_mfma_f32_32x32x16_bf16(b0,qr[0],negm,0,0,0);p1=__builtin_amdgcn_mfma_f32_32x32x16_bf16(b1,qr[0],negm,0,0,0);}
    else{p0=__builtin_amdgcn_mfma_f32_32x32x16_bf16(b0,qr[d0],p0,0,0,0);p1=__builtin_amdgcn_mfma_f32_32x32x16_bf16(b1,qr[d0],p1,0,0,0);}}
  p0=__builtin_amdgcn_mfma_f32_32x32x8bf16_1k(ka0,qa,p0,0,0,0);p1=__builtin_amdgcn_mfma_f32_32x32x8bf16_1k(ka1,qa,p1,0,0,0);
}
typedef __attribute__((address_space(3))) const char* lds_cptr;
typedef short v4i16_t __attribute__((ext_vector_type(4)));
__device__ __forceinline__ void kload8(bf16x8*kf,lds_cptr kp){
  kf[0]=*(const __attribute__((address_space(3))) bf16x8*)(kp);      kf[1]=*(const __attribute__((address_space(3))) bf16x8*)(kp+512);
  kf[2]=*(const __attribute__((address_space(3))) bf16x8*)(kp+2048); kf[3]=*(const __attribute__((address_space(3))) bf16x8*)(kp+2560);
  kf[4]=*(const __attribute__((address_space(3))) bf16x8*)(kp+4096); kf[5]=*(const __attribute__((address_space(3))) bf16x8*)(kp+4608);
  kf[6]=*(const __attribute__((address_space(3))) bf16x8*)(kp+6144); kf[7]=*(const __attribute__((address_space(3))) bf16x8*)(kp+6656);
}
__device__ __forceinline__ void kload2(bf16x8*kf,lds_cptr kp,int j){ kf[2*j]=*(const __attribute__((address_space(3))) bf16x8*)(kp+j*2048); kf[2*j+1]=*(const __attribute__((address_space(3))) bf16x8*)(kp+j*2048+512); }
__device__ __forceinline__ s16x4 vtr(lds_cptr p){ return __builtin_bit_cast(s16x4,__builtin_amdgcn_ds_read_tr16_b64_v4i16((__attribute__((address_space(3))) v4i16_t*)p)); }
__device__ __forceinline__ float rowmax(const f32x16&p0,const f32x16&p1){
  float a=max3f(p0[0],p0[1],p1[0]),b=max3f(p0[2],p0[3],p1[1]);a=max3f(a,p1[2],p1[3]);
  #pragma unroll
  for(int r=4;r<16;r+=4){a=max3f(a,p0[r],p0[r+1]);b=max3f(b,p0[r+2],p0[r+3]);a=max3f(a,p1[r],p1[r+1]);b=max3f(b,p1[r+2],p1[r+3]);}
  const float m=max2f(a,b);
  auto rr=__builtin_amdgcn_permlane32_swap(__float_as_uint(m),__float_as_uint(m),false,false);
  return max2f(__uint_as_float(rr[0]),__uint_as_float(rr[1]));
}
__device__ __forceinline__ void pv(f32x16*o,int vb,bf16x8 pa0,bf16x8 pa1,bf16x8 pa2,bf16x8 pa3){
  #pragma unroll
  for(int d0=0;d0<2;++d0){s16x4 lo[4],hi[4];
    #pragma unroll
    for(int ks=0;ks<4;++ks){
      asm volatile("ds_read_b64_tr_b16 %0,%1 offset:%c2":"=&v"(lo[ks]):"v"(vb),"i"(d0*4096+ks*1024):"memory");
      asm volatile("ds_read_b64_tr_b16 %0,%1 offset:%c2":"=&v"(hi[ks]):"v"(vb),"i"(d0*4096+ks*1024+512):"memory");}
    asm volatile("s_waitcnt lgkmcnt(0)":::"memory");SBAR();
    #define PK(k) (bf16x8){lo[k][0],lo[k][1],lo[k][2],lo[k][3],hi[k][0],hi[k][1],hi[k][2],hi[k][3]}
    o[d0]=__builtin_amdgcn_mfma_f32_32x32x16_bf16(pa0,PK(0),o[d0],0,0,0);
    o[d0]=__builtin_amdgcn_mfma_f32_32x32x16_bf16(pa1,PK(1),o[d0],0,0,0);
    o[d0]=__builtin_amdgcn_mfma_f32_32x32x16_bf16(pa2,PK(2),o[d0],0,0,0);
    o[d0]=__builtin_amdgcn_mfma_f32_32x32x16_bf16(pa3,PK(3),o[d0],0,0,0);
    #undef PK
  }
}

#ifndef ATTN_STORE16
#define ATTN_STORE16(p,v) (*(u32x4*)(p)=(v))
#endif
template<int THRL> __device__ __forceinline__ void attn_unit(int b,int h,int qb,int t0,const bf16*Q,const bf16*__restrict__ K,const bf16*__restrict__ V,bf16*O,char*shm){
  const int tid=tid_fresh(),lane=tid&63,r32=lane&31,hi=lane>>5; const int wid=__builtin_amdgcn_readfirstlane(tid>>6);
  const long rowbase=(long)b*SEQ; const int q0=qb*QB;
  const bf16*Qw=Q+(rowbase+q0+wid*QBLK)*DM+h*D;
  const bf16*Kh=K+(rowbase+(long)t0*KVBLK)*DM+h*D,*Vh=V+(rowbase+(long)t0*KVBLK)*DM+h*D;
  const unsigned lds0=(unsigned)(uintptr_t)shm;
  float*wsf=(float*)(shm+LDS_WS)+wid*64;
  const bf16*ksrc=Kh+(long)lane*DM+wid*8;
  const bf16*vsrc=Vh+(long)(16*(wid&3)+(lane>>2))*DM+(wid>>2)*32+(lane&3)*8;
  const unsigned kdst=lds0+LDS_K+wid*1024, vdst=lds0+LDS_V+wid*1024;
  #define DMA_K(t,slot) glds16(ksrc+(long)(t)*KVBLK*DM,(unsigned)__builtin_amdgcn_readfirstlane(kdst+(slot)))
  #define DMA_V(t,slot) glds16(vsrc+(long)(t)*KVBLK*DM,(unsigned)__builtin_amdgcn_readfirstlane(vdst+(slot)))
  const int vb0=(int)(lds0+LDS_V)+((lane>>4)&1)*32+(lane&3)*8+(4*hi+((lane&15)>>2))*64;
  const char*Kbase=shm+LDS_K; bf16x8 kf[8];
  const lds_cptr shm3=(lds_cptr)shm; const lds_cptr kp0=shm3+LDS_K+hi*1024+r32*16; const lds_cptr vp0=shm3+LDS_V+((lane>>4)&1)*32+(lane&3)*8+(4*hi+((lane&15)>>2))*64;
  const int NT=(q0+QB)/KVBLK-t0;
  DMA_K(0,0);DMA_V(0,0);DMA_K(1,SLOTB);
  bf16x8 qr[4];
  #pragma unroll
  for(int d0=0;d0<4;++d0)qr[d0]=*reinterpret_cast<const bf16x8*>(&Qw[(long)r32*DM+d0*16+hi*8]);
  typedef __attribute__((address_space(3))) unsigned long long lds_u64;
  const lds_u64* const ctab=(const lds_u64*)(__attribute__((address_space(3))) char*)(shm+LDS_BYTES);
  float mhat; { const float h1_=__uint_as_float((unsigned)ctab[q0-t0*KVBLK+wid*QBLK+r32]<<16), a0_=h1_+48.0f; mhat=__uint_as_float((__float_as_uint(a0_)+0x7fffu+((__float_as_uint(a0_)>>16)&1u))&0xffff0000u);
    if(h1_>=8192.0f) mhat=h1_; }
  float l_reg=0.f;f32x16 o[2];o[0]=f32x16{};o[1]=f32x16{};const f32x16 negm=f32x16{};
  typedef short s16x4k __attribute__((ext_vector_type(4))); typedef unsigned u32x2k __attribute__((ext_vector_type(2)));
  u32x2k qaw=(u32x2k){hi==0?0x3F803F80u:0u,0u};
  #define SETQA() do{ qaw[1]=(hi==0)?(0x3F80u|(((__float_as_uint(mhat)>>16)^0x8000u)<<16)):0u; }while(0)
  #define QAUG __builtin_bit_cast(s16x4k,qaw)
  #define MFA8(a_,b_,c_) __builtin_amdgcn_mfma_f32_32x32x8bf16_1k(a_,b_,c_,0,0,0)
  #define RNDBF(x_) __uint_as_float((__float_as_uint(x_)+0x7fffu+((__float_as_uint(x_)>>16)&1u))&0xffff0000u)
  SETQA();
  #define KAUG(t_,A0,A1) do{ const lds_u64* cp_=ctab+(t_)*KVBLK+r32; const unsigned long long w0_=cp_[0],w1_=cp_[32]; \
    A0=__builtin_bit_cast(s16x4k,w0_); A1=__builtin_bit_cast(s16x4k,w1_); }while(0)
  const int qrel=wid*QBLK+r32;
  #define CMASK(P0,P1,t) do{int jb_=(t)-(NT-4); if(jb_>=0)cmask(P0,P1,jb_,qrel,hi);}while(0)
  bool resc=false;
  #define START(P0,P1) do{ const float rm=rowmax(P0,P1); resc=false; \
    if(__builtin_expect(__any(rm>(float)THRL),0)){ const float rn_=mhat+__builtin_fmaxf(rm,0.f); const float mn_=RNDBF(rn_); const float dl=mn_-mhat; mhat=mn_; SETQA(); \
      _Pragma("unroll") for(int r=0;r<16;++r){P0[r]-=dl;P1[r]-=dl;} \
      } \
    _Pragma("unroll") for(int r=0;r<16;++r)P0[r]=__builtin_amdgcn_exp2f(P0[r]); }while(0)
  #define RESC() do{ if(resc){ asm volatile("s_waitcnt lgkmcnt(0)":::"memory"); \
      _Pragma("unroll") for(int d_=0;d_<2;++d_) _Pragma("unroll") for(int r=0;r<16;++r)o[d_][r]*=wsf[crow(r,hi)]; } }while(0)
  f32x16 pA0,pA1,pB0,pB1;
  int sl_prev=0,sl_cur=0,sl_next=SLOTB;
  #define ROT() do{sl_prev=sl_cur;sl_cur=sl_next;sl_next=(sl_next==(NSLOT-1)*SLOTB)?0:sl_next+SLOTB;}while(0)
  DMA_K(2,2*SLOTB);
  WAIT_BAR(3);
  { s16x4k ka0_,ka1_; KAUG(0,ka0_,ka1_); qkt(pA0,pA1,Kbase,qr,negm,r32,hi,ka0_,ka1_,QAUG); } asm volatile("s_nop 15\n\ts_nop 7":"+v"(pA0),"+v"(pA1));CMASK(pA0,pA1,0);
  START(pA0,pA1);
  _Pragma("unroll") for(int r=0;r<16;++r)pA1[r]=__builtin_amdgcn_exp2f(pA1[r]);
  WAIT_BAR(0);
  DMA_K(3,0);DMA_V(1,SLOTB);
  ROT();
  kload8(kf,kp0+sl_cur);
  WAIT_BAR(2);
  s16x4 vlo[8],vhi[8]; u32x4 pw0,pw1,pw2,pw3;
  #define PKW(P,B) cvtpk_s(P[B],P[B+1])
  #define PAF(k) __builtin_bit_cast(bf16x8,pw##k)
  #define VFR(i) (bf16x8){vlo[i][0],vlo[i][1],vlo[i][2],vlo[i][3],vhi[i][0],vhi[i][1],vhi[i][2],vhi[i][3]}
  #define PIN(x) asm volatile("":"+v"(x))
  #define MX3(a,b,c) __builtin_fmaxf(__builtin_fmaxf((a),(b)),(c))
  #define GAPA(MF,A0,A1,A2,A3,W0,W1,PW) do{ MF; sacc+=A0; sacc+=A1; sacc+=A2; sacc+=A3; PIN(sacc); W0; W1; PIN(PW); SBAR(); }while(0)
  #define EX(v) __builtin_amdgcn_exp2f(v)
  #define GAPB(MF,X,B) do{ MF; X[B]=EX(X[B]); X[B+1]=EX(X[B+1]); X[B+2]=EX(X[B+2]); X[B+3]=EX(X[B+3]); PIN(X); SBAR(); }while(0)
  #define VRD(i) do{ vlo[i]=vtr(vp_+(((i)>>2)*4096+((i)&3)*1024)); vhi[i]=vtr(vp_+(((i)>>2)*4096+((i)&3)*1024+512)); }while(0)
  #define KRD(G,j) do{ if(G){ kload2(kf,kp0+sl_next,j); SBAR(); } }while(0)
  #define STEP(C0,C1,P0,P1,t,GK,GV,GL) do{ SBAR(); \
    const lds_cptr vp_=vp0+sl_prev; s16x4k ka0_,ka1_; \
    VRD(0); SBAR(); float sacc=(P0[0]+P0[1]); \
    GAPA(C0=__builtin_amdgcn_mfma_f32_32x32x16_bf16(kf[0],qr[0],negm,0,0,0), P0[2],P0[3],P0[4],P0[5],     pw0[0]=PKW(P0,0), pw0[1]=PKW(P0,2), pw0); \
    VRD(4); SBAR(); GAPA(C1=__builtin_amdgcn_mfma_f32_32x32x16_bf16(kf[1],qr[0],negm,0,0,0), P0[6],P0[7],P0[8],P0[9],     pw0[2]=PKW(P0,4), pw0[3]=PKW(P0,6), pw0); \
    VRD(1); SBAR(); GAPA(C0=__builtin_amdgcn_mfma_f32_32x32x16_bf16(kf[2],qr[1],C0,0,0,0),   P0[10],P0[11],P0[12],P0[13], pw1[0]=PKW(P0,8), pw1[1]=PKW(P0,10), pw1); \
    VRD(5); SBAR(); GAPA(C1=__builtin_amdgcn_mfma_f32_32x32x16_bf16(kf[3],qr[1],C1,0,0,0),   P0[14],P0[15],P1[0],P1[1],   pw1[2]=PKW(P0,12),pw1[3]=PKW(P0,14), pw1); \
    VRD(2); SBAR(); GAPA(C0=__builtin_amdgcn_mfma_f32_32x32x16_bf16(kf[4],qr[2],C0,0,0,0),   P1[2],P1[3],P1[4],P1[5],     pw2[0]=PKW(P1,0), pw2[1]=PKW(P1,2), pw2); \
    VRD(6); SBAR(); GAPA(C1=__builtin_amdgcn_mfma_f32_32x32x16_bf16(kf[5],qr[2],C1,0,0,0),   P1[6],P1[7],P1[8],P1[9],     pw2[2]=PKW(P1,4), pw2[3]=PKW(P1,6), pw2); \
    VRD(3); SBAR(); GAPA(C0=__builtin_amdgcn_mfma_f32_32x32x16_bf16(kf[6],qr[3],C0,0,0,0),   P1[10],P1[11],P1[12],P1[13], pw3[0]=PKW(P1,8), pw3[1]=PKW(P1,10), pw3); \
    VRD(7); KAUG(t,ka0_,ka1_); SBAR(); GAPA(C1=__builtin_amdgcn_mfma_f32_32x32x16_bf16(kf[7],qr[3],C1,0,0,0),   P1[14],P1[15],0.f,0.f,       pw3[2]=PKW(P1,12),pw3[3]=PKW(P1,14), pw3); \
    C0=MFA8(ka0_,QAUG,C0); C1=MFA8(ka1_,QAUG,C1); \
    l_reg+=sacc; \
    if(GK){DMA_K((t)+3,sl_cur);} if(GV){DMA_V((t)+1,sl_next);} \
    CMASK(C0,C1,t); \
    { float a=MX3(C0[0],C0[1],C1[0]),b=MX3(C0[2],C0[3],C1[1]); a=MX3(a,C1[2],C1[3]); \
      _Pragma("unroll") for(int r=4;r<16;r+=4){a=MX3(a,C0[r],C0[r+1]);b=MX3(b,C0[r+2],C0[r+3]);a=MX3(a,C1[r],C1[r+1]);b=MX3(b,C1[r+2],C1[r+3]);} \
      float rm=__builtin_fmaxf(a,b); { auto rr=__builtin_amdgcn_permlane32_swap(__float_as_uint(rm),__float_as_uint(rm),false,false); rm=__builtin_fmaxf(__uint_as_float(rr[0]),__uint_as_float(rr[1])); } \
      resc=false; \
      if(__builtin_expect(__any(rm>(float)THRL),0)){ const float rn_=mhat+__builtin_fmaxf(rm,0.f); const float mn_=RNDBF(rn_); const float dl=mn_-mhat; mhat=mn_; SETQA(); \
        _Pragma("unroll") for(int r=0;r<16;++r){C0[r]-=dl;C1[r]-=dl;} \
        const float f=__builtin_amdgcn_exp2f(-dl); l_reg*=f; if(hi==0)wsf[r32]=f; resc=true; } } \
    SBAR(); \
    GAPB(o[0]=__builtin_amdgcn_mfma_f32_32x32x16_bf16(PAF(0),VFR(0),o[0],0,0,0), C0,0); \
    GAPB(o[1]=__builtin_amdgcn_mfma_f32_32x32x16_bf16(PAF(0),VFR(4),o[1],0,0,0), C0,4); \
    KRD(GL,0); GAPB(o[0]=__builtin_amdgcn_mfma_f32_32x32x16_bf16(PAF(1),VFR(1),o[0],0,0,0), C0,8); \
    KRD(GL,1); GAPB(o[1]=__builtin_amdgcn_mfma_f32_32x32x16_bf16(PAF(1),VFR(5),o[1],0,0,0), C0,12); \
    KRD(GL,2); GAPB(o[0]=__builtin_amdgcn_mfma_f32_32x32x16_bf16(PAF(2),VFR(2),o[0],0,0,0), C1,0); \
    KRD(GL,3); GAPB(o[1]=__builtin_amdgcn_mfma_f32_32x32x16_bf16(PAF(2),VFR(6),o[1],0,0,0), C1,4); \
    GAPB(o[0]=__builtin_amdgcn_mfma_f32_32x32x16_bf16(PAF(3),VFR(3),o[0],0,0,0), C1,8); \
    GAPB(o[1]=__builtin_amdgcn_mfma_f32_32x32x16_bf16(PAF(3),VFR(7),o[1],0,0,0), C1,12); \
    }while(0)
  int t=1;
  #undef CMASK
  #define CMASK(P0,P1,t) do{}while(0)
  for(;t+5<NT;t+=2){
    STEP(pB0,pB1,pA0,pA1,t,true,true,true);     WAIT_BAR(2); RESC(); ROT();
    STEP(pA0,pA1,pB0,pB1,t+1,true,true,true);   WAIT_BAR(2); RESC(); ROT();
  }
  #undef CMASK
  #define CMASK(P0,P1,t) do{int jb_=(t)-(NT-4); if(jb_>=0)cmask(P0,P1,jb_,qrel,hi);}while(0)
  #define ENDW(tt) do{ if((tt)+3<NT){WAIT_BAR(2);} else if((tt)+2<NT){WAIT_BAR(1);} else {WAIT_BAR(0);} }while(0)
  for(;t+1<NT;t+=2){
    STEP(pB0,pB1,pA0,pA1,t,(t+3<NT),(t+1<NT),(t+1<NT));       ENDW(t);   RESC(); ROT();
    STEP(pA0,pA1,pB0,pB1,t+1,(t+4<NT),(t+2<NT),(t+2<NT));     ENDW(t+1); RESC(); ROT();
  }
  STEP(pB0,pB1,pA0,pA1,NT-1,false,false,false); RESC();
  { float sacc=pB0[0]+pB0[1]; _Pragma("unroll") for(int r=2;r<16;++r)sacc+=pB0[r]; _Pragma("unroll") for(int r=0;r<16;++r)sacc+=pB1[r]; l_reg+=sacc;
    pw0=(u32x4){PKW(pB0,0),PKW(pB0,2),PKW(pB0,4),PKW(pB0,6)};pw1=(u32x4){PKW(pB0,8),PKW(pB0,10),PKW(pB0,12),PKW(pB0,14)};pw2=(u32x4){PKW(pB1,0),PKW(pB1,2),PKW(pB1,4),PKW(pB1,6)};pw3=(u32x4){PKW(pB1,8),PKW(pB1,10),PKW(pB1,12),PKW(pB1,14)};
    SBAR(); pv(o,vb0+sl_cur,PAF(0),PAF(1),PAF(2),PAF(3)); }
  #undef PKW
  #undef PAF
  #undef VFR
  #undef PIN
  #undef MX3
  #undef GAPA
  #undef GAPB
  #undef EX
  #undef VRD
  #undef KRD
  #undef STEP
  #undef ENDW
  {auto rr=__builtin_amdgcn_permlane32_swap(__float_as_uint(l_reg),__float_as_uint(l_reg),false,false);l_reg=__uint_as_float(rr[0])+__uint_as_float(rr[1]);}
  if(hi==0)wsf[32+r32]=l_reg;asm volatile("s_waitcnt lgkmcnt(0)":::"memory");
  float rli[16];
  #pragma unroll
  for(int r=0;r<16;++r)rli[r]=__builtin_amdgcn_rcpf(wsf[32+crow(r,hi)]);
  bf16*Ow=O+(rowbase+q0+wid*QBLK)*DM+h*D;
  { bf16*stg=(bf16*)(shm+LDS_OST)+wid*2048;
    #pragma unroll
    for(int r=0;r<16;++r){const int orow=crow(r,hi);
      #pragma unroll
      for(int d0=0;d0<2;++d0)stg[orow*64+d0*32+r32]=__float2bfloat16(o[d0][r]*rli[r]);}
    asm volatile("s_waitcnt lgkmcnt(0)":::"memory");
    #pragma unroll
    for(int i=0;i<4;++i){const int row=i*8+(lane>>3),ch=lane&7; const u32x4 v=*(const u32x4*)(stg+row*64+ch*8); ATTN_STORE16(Ow+(long)row*DM+ch*8,v);} }
  asm volatile("s_waitcnt lgkmcnt(0)\n\ts_barrier":::"memory");
  #undef KAUG
  #undef SETQA
  #undef QAUG
  #undef RNDBF
  #undef MFA8
  #undef DMA_K
  #undef DMA_V
  #undef CMASK
  #undef START
  #undef RESC
  #undef ROT
}
constexpr int ATTN_LDS_BYTES=LDS_BYTES+SEQ*8+16;
struct AttnTensors { const bf16* Q; const bf16* K; const bf16* V; bf16* O; const unsigned long long* CAUG; };
struct AttnUnit { int bh; int qb; };
struct StaticOrder {
  int vcu;
  __device__ __forceinline__ explicit StaticOrder(int grid,int block):vcu((block%8)*(grid/8)+block/8){}
  __device__ __forceinline__ bool next(int i,AttnUnit&u)const{ if(i>=4)return false; const int s=vcu&7; u.bh=vcu>>3; u.qb=(i==0)?s:(i==1)?15-s:(i==2)?16+s:31-s; return true; }
  __device__ __forceinline__ void a_ready(const AttnUnit&)const{}
  __device__ __forceinline__ void done(const AttnUnit&)const{}
};
__device__ __forceinline__ unsigned f2bf_rne(float f){unsigned u=__float_as_uint(f);return (u+0x7fffu+((u>>16)&1u))>>16;}
__device__ __forceinline__ void fox_scan(char*lds,const float*__restrict__ lf,unsigned long long*__restrict__ tab){
  typedef __attribute__((address_space(3))) double lds_f64;
  lds_f64* sums=(lds_f64*)(__attribute__((address_space(3))) char*)lds;
  const int tid=tid_fresh(); double acc=0.0;
  #pragma unroll
  for(int i=0;i<16;++i)acc+=(double)lf[tid*16+i];
  sums[tid]=acc; __syncthreads();
  double run=0.0; for(int i=0;i<tid;++i)run+=sums[i];
  #pragma unroll 1
  for(int i=0;i<16;++i){ run+=(double)lf[tid*16+i]; const float nv=(float)(run*-1.4426950408889634);
    const unsigned h1=f2bf_rne(nv); const float r1=nv-__uint_as_float(h1<<16); const unsigned h2=f2bf_rne(r1); const float r2=r1-__uint_as_float(h2<<16); const unsigned h3=f2bf_rne(r2);
    tab[tid*16+i]=(unsigned long long)(h1|(h2<<16))|((unsigned long long)(h3|0x3F800000u)<<32); }
  __syncthreads();
}
__device__ __forceinline__ float caug_val(unsigned long long w){ return (__uint_as_float((unsigned)w<<16)+__uint_as_float((unsigned)w&0xffff0000u))+__uint_as_float((unsigned)(w>>32)<<16); }
constexpr float SKIP_TH=72.0f;
template<int THRL=8> __device__ __forceinline__ void attn_phase_dyn(char*lds,const AttnTensors&T,unsigned*ctr){
  typedef __attribute__((address_space(3))) unsigned long long lds_u64; typedef __attribute__((address_space(3))) int lds_i32;
  lds_i32* slotw=(lds_i32*)(__attribute__((address_space(3))) char*)(lds+LDS_BYTES+SEQ*8);
  lds_u64* tab=(lds_u64*)(__attribute__((address_space(3))) char*)(lds+LDS_BYTES);
  for(;;){
    const int tid=tid_fresh();
    if(tid==0){ slotw[0]=(int)__hip_atomic_fetch_add(ctr,1u,__ATOMIC_RELAXED,__HIP_MEMORY_SCOPE_AGENT); slotw[1]=0; }
    __syncthreads();
    const int slot=__builtin_amdgcn_readfirstlane(slotw[0]);
    if(slot>=BATCH*NHEAD*NQB) break;
    const int qb=NQB-1-(slot>>5), bh=slot&31, q0=qb*QB, NTF=(q0+QB)/KVBLK;
    const unsigned long long* cg=T.CAUG+(long)bh*SEQ;
    const float lim=caug_val(cg[q0])-SKIP_TH;
    if(tid<NTF-4){ const bool p0_=caug_val(cg[tid*KVBLK+KVBLK-1])<lim, p1_=(tid+1<NTF-4)&&(caug_val(cg[(tid+1)*KVBLK+KVBLK-1])<lim);
      if(p0_&&!p1_) slotw[1]=tid+1; }
    __syncthreads();
    const int nskip=__builtin_amdgcn_readfirstlane(slotw[1]);
    const int t0=nskip&~1;
    for(int i=tid;i<(NTF-t0)*KVBLK;i+=NW*64) tab[i]=cg[t0*KVBLK+i];
    __syncthreads();
    attn_unit<THRL>(bh/NHEAD,bh%NHEAD,qb,t0,T.Q,T.K,T.V,T.O,lds);
  }
}
#undef SBAR
#undef WAIT_BAR
}

namespace swa {
constexpr int D = 128; constexpr float THR = 8.f; constexpr bool WSKIP = true;
constexpr float SCALE = 0.08838834764831845f;
constexpr int NW = 8, QBLK = 32, KVBLK = 64, QB = NW * QBLK;
constexpr int SHM_V = KVBLK * D * 2, SHM_K = KVBLK * D * 2;
constexpr int LDS_BYTES = 2 * SHM_V + 2 * SHM_K + NW * 64 * 4;

using bf16 = __hip_bfloat16;
typedef short bf16x8 __attribute__((ext_vector_type(8)));
typedef short s16x4 __attribute__((ext_vector_type(4)));
typedef float f32x16 __attribute__((ext_vector_type(16)));
typedef float f32x4 __attribute__((ext_vector_type(4)));
typedef unsigned u32x4 __attribute__((ext_vector_type(4)));
template <class A, class Bt> struct same_t { static constexpr bool v = false; };
template <class A> struct same_t<A, A> { static constexpr bool v = true; };

#define KSWZ(row, colB) ((row) * 256 + ((colB) ^ (((row) & 7) << 4)))
#define SBAR() __builtin_amdgcn_sched_barrier(0)
__device__ __forceinline__ int v_st(int k, int c) { const int kk = (k & ~0xC) | ((k & 4) << 1) | ((k & 8) >> 1); return ((kk >> 3) * 4 + (c >> 5)) * 512 + ((kk & 7) * 32 + (c & 31)) * 2; }
__device__ __forceinline__ int v_rd_base(int lane) { return ((lane & 3) << 3) | (((lane >> 2) & 3) << 6) | (((lane >> 4) & 1) << 5) | (((lane >> 5) & 1) << 8); }
constexpr int v_rd_off(int d0, int ks, int half) { return d0 * 512 + ks * 4096 + half * 2048; }
__device__ __forceinline__ int crow(int r, int hi) { return (r & 3) + 8 * (r >> 2) + 4 * hi; }
__device__ __forceinline__ unsigned cvtpk(float lo, float hi) {
    unsigned r; asm volatile("v_cvt_pk_bf16_f32 %0, %1, %2" : "=v"(r) : "v"(lo), "v"(hi)); return r;
}
__device__ __forceinline__ bf16x8 pack8(f32x4 a, f32x4 b) {
    u32x4 w = {cvtpk(a[0], a[1]), cvtpk(a[2], a[3]), cvtpk(b[0], b[1]), cvtpk(b[2], b[3])};
    return *reinterpret_cast<bf16x8*>(&w);
}
template <class T> __device__ __forceinline__ bf16x8 load8(const T* p) {
    if constexpr (same_t<T, float>::v) { return pack8(*(const f32x4*)p, *(const f32x4*)(p + 4)); }
    else { return *reinterpret_cast<const bf16x8*>(p); }
}
__device__ __forceinline__ void mask_tile(f32x16& p0, f32x16& p1, int dq, unsigned W) {
    const float NEG = -__builtin_inff();
#pragma unroll
    for (int r = 0; r < 16; ++r) {
        const int c = (r & 3) + 8 * (r >> 2);
        if ((unsigned)(dq - c) >= W) p0[r] = NEG;
        if ((unsigned)(dq - c - 32) >= W) p1[r] = NEG;
    }
}
__device__ __forceinline__ void partialSM(f32x16& p0, f32x16& p1, float& m_reg, float& mn, float& alpha) {
    float pmax = p0[0]; for (int r = 1; r < 16; ++r) pmax = fmaxf(pmax, p0[r]); for (int r = 0; r < 16; ++r) pmax = fmaxf(pmax, p1[r]);
    { auto rr = __builtin_amdgcn_permlane32_swap(__float_as_uint(pmax), __float_as_uint(pmax), false, false);
      pmax = fmaxf(__uint_as_float(rr[0]), __uint_as_float(rr[1])); }
    constexpr float C2 = 1.4426950408889634f * SCALE;
    if (__builtin_expect(__all((pmax - m_reg) * SCALE <= THR), 1)) { mn = m_reg; alpha = 1.f; }
    else { mn = fmaxf(m_reg, pmax); alpha = __builtin_amdgcn_exp2f((m_reg - mn) * C2); m_reg = mn; }
    const float mnL = -mn * C2;
    for (int r = 0; r < 16; ++r) p0[r] = fmaf(p0[r], C2, mnL); for (int r = 0; r < 16; ++r) p1[r] = fmaf(p1[r], C2, mnL);
    for (int r = 0; r < 16; ++r) p0[r] = __builtin_amdgcn_exp2f(p0[r]);
}
__device__ __forceinline__ void finishSM(f32x16& p0, f32x16& p1, float alpha, float& l_reg, bf16x8& pa0, bf16x8& pa1, bf16x8& pa2, bf16x8& pa3) {
    for (int r = 0; r < 16; ++r) p1[r] = __builtin_amdgcn_exp2f(p1[r]);
    float ps = 0; for (int r = 0; r < 16; ++r) ps += p0[r]; for (int r = 0; r < 16; ++r) ps += p1[r];
    { auto rr = __builtin_amdgcn_permlane32_swap(__float_as_uint(ps), __float_as_uint(ps), false, false);
      ps = __uint_as_float(rr[0]) + __uint_as_float(rr[1]); }
    l_reg = l_reg * alpha + ps;
#define PK4(P, B_, OUT) do { unsigned a0 = cvtpk(P[B_+0], P[B_+1]), a1 = cvtpk(P[B_+2], P[B_+3]);                          \
        unsigned b0 = cvtpk(P[B_+4], P[B_+5]), b1 = cvtpk(P[B_+6], P[B_+7]);                                             \
        auto r0 = __builtin_amdgcn_permlane32_swap(a0, b0, false, false); auto r1 = __builtin_amdgcn_permlane32_swap(a1, b1, false, false); \
        u32x4 w = {r0[0], r1[0], r0[1], r1[1]}; OUT = *reinterpret_cast<bf16x8*>(&w); } while (0)
    PK4(p0, 0, pa0); PK4(p0, 8, pa1); PK4(p1, 0, pa2); PK4(p1, 8, pa3);
#undef PK4
}
template <int KB, bool SK>
__device__ __forceinline__ void qkt(f32x16& p0, f32x16& p1, const char* K_lds, int r32, int hi, const bf16x8* qr, bool act) {
    if (SK && !act) { const float NEG = -__builtin_inff();
#pragma unroll
        for (int r = 0; r < 16; ++r) { p0[r] = NEG; p1[r] = NEG; } return; }
    p0 = f32x16{}; p1 = f32x16{};
    const char* kb[4];
#pragma unroll
    for (int dd = 0; dd < 4; ++dd) kb[dd] = K_lds + KB * SHM_K + KSWZ(r32, (dd * 16 + hi * 8) * 2);
#pragma unroll
    for (int d0 = 0; d0 < 8; ++d0) { const char* a = kb[d0 & 3] + (d0 >> 2) * 128;
        bf16x8 b0 = *reinterpret_cast<const bf16x8*>(a);
        bf16x8 b1 = *reinterpret_cast<const bf16x8*>(a + 32 * 256);
        p0 = __builtin_amdgcn_mfma_f32_32x32x16_bf16(b0, qr[d0], p0, 0, 0, 0);
        p1 = __builtin_amdgcn_mfma_f32_32x32x16_bf16(b1, qr[d0], p1, 0, 0, 0); }
}
template <int VB, bool SK>
__device__ __forceinline__ void pv_tile(f32x16* o, int vb0, bf16x8 pa0, bf16x8 pa1, bf16x8 pa2, bf16x8 pa3, bool act) {
    if (SK && !act) return;
#define TRRD(dst, off) asm volatile("ds_read_b64_tr_b16 %0, %1 offset:%2" : "=&v"(dst) : "v"(vb0), "i"(off) : "memory")
#define PV_D0(d0) do { s16x4 l0, l1, l2, l3, h0, h1, h2, h3; constexpr int b_ = VB * SHM_V + v_rd_off(d0, 0, 0);     \
        TRRD(l0, b_); TRRD(h0, b_ + 2048); TRRD(l1, b_ + 4096); TRRD(h1, b_ + 6144); TRRD(l2, b_ + 8192); TRRD(h2, b_ + 10240); TRRD(l3, b_ + 12288); TRRD(h3, b_ + 14336); \
        asm volatile("s_waitcnt lgkmcnt(0)" ::: "memory"); SBAR();                 \
        o[d0] = __builtin_amdgcn_mfma_f32_32x32x16_bf16(pa0, (bf16x8){l0[0], l0[1], l0[2], l0[3], h0[0], h0[1], h0[2], h0[3]}, o[d0], 0, 0, 0);   \
        o[d0] = __builtin_amdgcn_mfma_f32_32x32x16_bf16(pa1, (bf16x8){l1[0], l1[1], l1[2], l1[3], h1[0], h1[1], h1[2], h1[3]}, o[d0], 0, 0, 0);   \
        o[d0] = __builtin_amdgcn_mfma_f32_32x32x16_bf16(pa2, (bf16x8){l2[0], l2[1], l2[2], l2[3], h2[0], h2[1], h2[2], h2[3]}, o[d0], 0, 0, 0);   \
        o[d0] = __builtin_amdgcn_mfma_f32_32x32x16_bf16(pa3, (bf16x8){l3[0], l3[1], l3[2], l3[3], h3[0], h3[1], h3[2], h3[3]}, o[d0], 0, 0, 0); } while (0)
    PV_D0(0); PV_D0(1); PV_D0(2); PV_D0(3);
#undef PV_D0
#undef TRRD
}

template <class TIn, class TOut> struct BlockRef { const TIn* Q; const TIn* K; const TIn* V; TOut* O; int P0; int qp, kp, op; float* L; int lp; };
template <class TIn> struct Seam {
    bf16x8 qr[8];
    bf16x8 st_v0, st_v1, st_k0, st_k1; f32x4 sf0, sf1, sf2, sf3;
    f32x4 tq[16];
};
__device__ __forceinline__ int swa_jlo(int P0, int W) { const int lowk = P0 - W + 1; return lowk > 0 ? lowk / KVBLK : 0; }
#define ROW(p, k0, rr) ((p) + (size_t)((k0) + (rr)) * D + sc)
#define VMW() asm volatile("s_waitcnt vmcnt(0)" ::: "memory")
#define VMWN(n) asm volatile("s_waitcnt vmcnt(%0)" :: "i"(n) : "memory")
#define ROWP(p, k0, rr, pt) ((const TIn*)((const char*)(p) + (unsigned)((((k0) + (rr)) * (pt) + sc) * 2)))
#define SLOAD_H(Kp, Vp, k0, pt) do { S.st_v0 = load8<TIn>(ROWP(Vp, k0, sr, pt)); S.st_v1 = load8<TIn>(ROWP(Vp, k0, 32 + sr, pt));              \
                         S.st_k0 = load8<TIn>(ROWP(Kp, k0, sr, pt)); S.st_k1 = load8<TIn>(ROWP(Kp, k0, 32 + sr, pt)); } while (0)
#define SWRITE_HK(bf) do { *(bf16x8*)(K_lds + (bf) * SHM_K + kws) = S.st_k0; *(bf16x8*)(K_lds + (bf) * SHM_K + kws + 32 * 256) = S.st_k1; } while (0)
#define SWRITE_HV(bf) do { *(bf16x8*)(V_lds + (bf) * SHM_V + vst0) = S.st_v0; *(bf16x8*)(V_lds + (bf) * SHM_V + vst1) = S.st_v1; } while (0)
#define SWRITE_H(bf) do { SWRITE_HV(bf); SWRITE_HK(bf); } while (0)
#define SLOAD_F(p, k0) do { S.sf0 = *(const f32x4*)ROW(p, k0, sr); S.sf1 = *(const f32x4*)(ROW(p, k0, sr) + 4);                \
                            S.sf2 = *(const f32x4*)ROW(p, k0, 32 + sr); S.sf3 = *(const f32x4*)(ROW(p, k0, 32 + sr) + 4); } while (0)
#define SWRITE_KF(bf) do { *(bf16x8*)(K_lds + (bf) * SHM_K + kws) = pack8(S.sf0, S.sf1); *(bf16x8*)(K_lds + (bf) * SHM_K + kws + 32 * 256) = pack8(S.sf2, S.sf3); } while (0)
#define SWRITE_VF(bf) do { *(bf16x8*)(V_lds + (bf) * SHM_V + vst0) = pack8(S.sf0, S.sf1); *(bf16x8*)(V_lds + (bf) * SHM_V + vst1) = pack8(S.sf2, S.sf3); } while (0)
template <class TIn, class TOut>
__device__ __forceinline__ void causal_swa_prime(const BlockRef<TIn, TOut>& cur, int W, char* lds, Seam<TIn>& S) {
    constexpr bool F32 = same_t<TIn, float>::v;
    const int tid = tid_fresh(), wid = __builtin_amdgcn_readfirstlane(tid >> 6), lane = tid & 63, r32 = lane & 31, hi = lane >> 5;
    const int sr = tid >> 4, sc = (tid & 15) * 8, kws = KSWZ(sr, sc * 2); char* K_lds = lds + 2 * SHM_V;
    const int kb0 = swa_jlo(cur.P0, W) * KVBLK;
    for (int d0 = 0; d0 < 8; ++d0) S.qr[d0] = load8<TIn>((const TIn*)((const char*)cur.Q + (unsigned)(((wid * QBLK + r32) * cur.qp + hi * 8) * 2) + d0 * 32));
    if constexpr (F32) { SLOAD_F((const float*)cur.K, kb0); VMW(); SWRITE_KF(0); SBAR(); SLOAD_F((const float*)cur.V, kb0); }
    else { SLOAD_H(cur.K, cur.V, kb0, cur.kp); VMW(); SWRITE_HK(0); }
    __syncthreads();
}
template <class TIn, class TOut>
__device__ __forceinline__ void causal_swa_block(const BlockRef<TIn, TOut>& cur, const BlockRef<TIn, TOut>& nxt, int skv, int W, char* lds, Seam<TIn>& S) {
    constexpr bool F32 = same_t<TIn, float>::v;
    const int tid = tid_fresh(), wid = __builtin_amdgcn_readfirstlane(tid >> 6), lane = tid & 63, r32 = lane & 31, hi = lane >> 5;
    const int j_lo = swa_jlo(cur.P0, W);
    int j_hi = (cur.P0 + QB - 1) / KVBLK + 1; if (j_hi > skv / KVBLK) j_hi = skv / KVBLK;
    const int NT = j_hi - j_lo;
    const int kbn = swa_jlo(nxt.P0, W) * KVBLK;
    const int qlo = cur.P0 + wid * QBLK, qm = qlo + r32 - 4 * hi;
    char* V_lds = lds; char* K_lds = lds + 2 * SHM_V;
    float* ws = (float*)(lds + 2 * SHM_V + 2 * SHM_K) + wid * 64; float* li_l = ws, * al_l = ws + 32;
    float m_reg = -1e30f, l_reg = 0; f32x16 o[4] = {};
    const int sr = tid >> 4, sc = (tid & 15) * 8, vst0 = v_st(sr, sc), vst1 = v_st(32 + sr, sc), kws = KSWZ(sr, sc * 2);
    const int vb0 = (int)(uintptr_t)V_lds + v_rd_base(lane);
    const TIn* Kh = cur.K; const TIn* Vh = cur.V;
#define RESC(a) do { if (__any((a) < 1.f)) { if (hi == 0) al_l[r32] = (a); asm volatile("s_waitcnt lgkmcnt(0)" ::: "memory");              \
                     for (int d_ = 0; d_ < 4; ++d_) for (int r = 0; r < 16; ++r) o[d_][r] *= al_l[crow(r, hi)]; } } while (0)
#define KBASE(t) ((j_lo + (t)) * KVBLK)
#define ACT(t) (KBASE(t) <= qlo + QBLK - 1 && KBASE(t) + KVBLK - 1 >= qlo - W + 1)
#define MASKT(P0_, P1_, t) do { const int kb_ = KBASE(t); if ((!SK || ACT(t)) && (kb_ + KVBLK - 1 > qlo || kb_ <= qlo + QBLK - 1 - W)) mask_tile(P0_, P1_, qm - kb_, (unsigned)W); } while (0)
    constexpr int NQL = F32 ? 16 : 8;
    constexpr bool SK = WSKIP && !F32;
#define SEAM_K0() do { VMWN(NQL); if constexpr (F32) { SWRITE_KF(0); SBAR(); SLOAD_F((const float*)nxt.V, kbn); } else { SWRITE_HK(0); } SBAR(); } while (0)
    f32x16 pA0, pA1, pB0, pB1; float mnA, mnB, alA, alB; bf16x8 pa0, pa1, pa2, pa3;
    if constexpr (F32) { VMW(); SWRITE_VF(0); SBAR(); } else { SWRITE_HV(0); SBAR(); }
    if (NT > 1) { if constexpr (F32) SLOAD_F((const float*)Kh, KBASE(1)); else SLOAD_H(Kh, Vh, KBASE(1), cur.kp); }
    SBAR(); qkt<0, SK>(pA0, pA1, K_lds, r32, hi, S.qr, ACT(0));
    if constexpr (F32) { if (NT > 1) { VMW(); SWRITE_KF(1); SBAR(); SLOAD_F((const float*)Vh, KBASE(1)); } }
    MASKT(pA0, pA1, 0); partialSM(pA0, pA1, m_reg, mnA, alA);
    if (NT > 1) { VMW(); if constexpr (F32) { SWRITE_VF(1); SBAR(); if (NT > 2) SLOAD_F((const float*)Kh, KBASE(2)); } else SWRITE_H(1); }
    __syncthreads();
#define HALF_STEP(PX0, PX1, mnX, alX, PY0, PY1, alY, t, KB, VB, SB) do {                                                      \
        SBAR(); qkt<KB, SK>(PX0, PX1, K_lds, r32, hi, S.qr, ACT(t));                                             \
        finishSM(PY0, PY1, alY, l_reg, pa0, pa1, pa2, pa3); SBAR();                                                           \
        if ((t) + 1 < NT) { if constexpr (F32) { VMW(); SWRITE_KF(SB); SBAR(); SLOAD_F((const float*)Vh, KBASE((t) + 1)); }  \
                            else { SLOAD_H(Kh, Vh, KBASE((t) + 1), cur.kp); } SBAR(); }                                               \
        pv_tile<VB, SK>(o, vb0, pa0, pa1, pa2, pa3, ACT((t) - 1)); MASKT(PX0, PX1, (t)); partialSM(PX0, PX1, m_reg, mnX, alX);                                        \
        __syncthreads();                                                                                                      \
        if ((t) + 1 < NT) { VMW(); if constexpr (F32) { SWRITE_VF(SB); SBAR(); if ((t) + 2 < NT) SLOAD_F((const float*)Kh, KBASE((t) + 2)); } \
                            else { SWRITE_H(SB); } }                                                                          \
        RESC(alX); __syncthreads(); } while (0)
    for (int t = 1; t + 1 < NT; t += 2) {
        HALF_STEP(pB0, pB1, mnB, alB, pA0, pA1, alA, t, 1, 0, 0);
        HALF_STEP(pA0, pA1, mnA, alA, pB0, pB1, alB, t + 1, 0, 1, 1);
    }
    const bool even = (NT & 1) == 0;
    if (even) { SBAR(); qkt<1, SK>(pB0, pB1, K_lds, r32, hi, S.qr, ACT(NT - 1)); SBAR(); }
#define QROW(e) (nxt.Q + (size_t)(wid * QBLK + r32) * D + ((e) >> 1) * 16 + hi * 8 + ((e) & 1) * 4)
    if constexpr (F32) { SLOAD_F((const float*)nxt.K, kbn); SBAR();
#pragma unroll
        for (int e = 0; e < 8; ++e) S.tq[e] = *(const f32x4*)QROW(e); }
    else { SLOAD_H(nxt.K, nxt.V, kbn, nxt.kp); SBAR();
#pragma unroll
        for (int d0 = 0; d0 < 8; ++d0) S.qr[d0] = load8<TIn>((const TIn*)((const char*)nxt.Q + (unsigned)(((wid * QBLK + r32) * nxt.qp + hi * 8) * 2) + d0 * 32)); }
    SBAR();
    finishSM(pA0, pA1, alA, l_reg, pa0, pa1, pa2, pa3); SBAR();
    if constexpr (F32) {
#pragma unroll
        for (int e = 8; e < 16; ++e) S.tq[e] = *(const f32x4*)QROW(e); SBAR(); }
#undef QROW
    pv_tile<0, SK>(o, vb0, pa0, pa1, pa2, pa3, ACT(even ? NT - 2 : NT - 1));
    if (even) { MASKT(pB0, pB1, NT - 1); partialSM(pB0, pB1, m_reg, mnB, alB); __syncthreads(); RESC(alB);
        finishSM(pB0, pB1, alB, l_reg, pa0, pa1, pa2, pa3); SBAR(); pv_tile<1, SK>(o, vb0, pa0, pa1, pa2, pa3, ACT(NT - 1)); }
    SBAR(); SEAM_K0();
    if (hi == 0) { li_l[r32] = l_reg; if (cur.L) cur.L[(unsigned)((wid * QBLK + r32) * cur.lp)] = m_reg * SCALE + logf(l_reg); }
    asm volatile("s_waitcnt lgkmcnt(0)" ::: "memory");
    float rli[16];
#pragma unroll
    for (int r = 0; r < 16; ++r) rli[r] = __builtin_amdgcn_rcpf(li_l[crow(r, hi)]);
    TOut* Ow = cur.O + (unsigned)(wid * QBLK * cur.op); const int opitch = cur.op;
#pragma unroll
    for (int r = 0; r < 16; ++r) { const int orow = crow(r, hi);
#pragma unroll
        for (int d0 = 0; d0 < 4; ++d0) { const float v = o[d0][r] * rli[r];
            if constexpr (same_t<TOut, float>::v) { Ow[(unsigned)(orow * opitch + d0 * 32 + r32)] = v; }
            else { const float vn = __shfl_xor(v, 1);
                   if ((r32 & 1) == 0) *(unsigned*)(Ow + (unsigned)(orow * opitch + d0 * 32 + r32)) = cvtpk(v, vn); } } }
    if constexpr (F32) {
#pragma unroll
        for (int d0 = 0; d0 < 8; ++d0) S.qr[d0] = pack8(S.tq[2 * d0], S.tq[2 * d0 + 1]); }
    __syncthreads();
#undef RESC
#undef KBASE
#undef ACT
#undef MASKT
#undef SEAM_K0
#undef HALF_STEP
}
#undef ROW
#undef VMW
#undef VMWN
#undef SLOAD_H
#undef SWRITE_HK
#undef SWRITE_HV
#undef SWRITE_H
#undef SLOAD_F
#undef SWRITE_KF
#undef SWRITE_VF

#undef ROWP
#undef KSWZ
#undef SBAR
}

constexpr int NWAVES = 8;
constexpr int BATCH = 2, SEQ = 8192, DM = 1024, TOK = BATCH * SEQ;
constexpr int AH = 16, AHD = 64;
constexpr int BH = 8, BHD = 128, BG = 3;
constexpr int NE = 16, FF = 256, NCLS = 24, MROWS = 80;
constexpr int NA = 2, NB = 2, NL = 4;
constexpr int WIN_LD = 3 * DM + AH;
constexpr float LOG2E = 1.4426950408889634f;

constexpr size_t MiB = 1u << 20;
constexpr size_t WS_CTL = 0, CTL_ZERO_BYTES = 1 * MiB;
constexpr size_t WS_RSTD = 1 * MiB;
constexpr size_t WS_GA = 1 * MiB + 256 * 1024, WS_GB = 1 * MiB + 512 * 1024;
constexpr size_t WS_LOGF = 2 * MiB;
constexpr size_t WS_CL = 3 * MiB;
constexpr size_t WS_CAUG = 4 * MiB;
constexpr size_t WS_ROPEC = 6 * MiB, WS_ROPES = 10 * MiB;
constexpr size_t WS_WF = 14 * MiB;
constexpr size_t WS_WR = 14 * MiB + 512 * 1024;
constexpr size_t WS_GTAB = 15 * MiB;
constexpr size_t WS_LSE = 16 * MiB;
constexpr size_t WS_LIST = 18 * MiB;
constexpr size_t WS_WIN = 20 * MiB;
constexpr size_t WS_WOA = 32 * MiB;
constexpr size_t WS_WKVQ0 = 36 * MiB;
constexpr size_t WS_WQ1 = 46 * MiB;
constexpr size_t WS_WOB = 52 * MiB;
constexpr size_t WS_WGU = 56 * MiB;
constexpr size_t WS_WD = 88 * MiB;
constexpr size_t WS_HB = 104 * MiB;
constexpr size_t WS_KB = 136 * MiB, WS_VB = 168 * MiB;
constexpr size_t WS_QB = 200 * MiB;
constexpr size_t WS_END = 296 * MiB;
constexpr int CW_BAR = 4096, CW_CNT = 16384, CW_AQ = 20480;

constexpr int RING_OFF = 0, RING_BYTES = 131072;
constexpr int XS_OFF = 131072;
constexpr int LDS_BYTES = 155648;
constexpr int MISC_OFF = LDS_BYTES - 256;
static_assert(attn_body::ATTN_LDS_BYTES <= MISC_OFF, "attention LDS");

#define GAS __attribute__((address_space(1)))
#define LAS __attribute__((address_space(3)))
typedef unsigned short bf16;
typedef unsigned v4u __attribute__((ext_vector_type(4)));
typedef float f32x4 __attribute__((ext_vector_type(4)));
typedef short bf16x8 __attribute__((ext_vector_type(8)));
typedef GAS unsigned gu32;
#define RLX_AGENT __ATOMIC_RELAXED, __HIP_MEMORY_SCOPE_AGENT
#define LDS_WAIT() asm volatile("s_waitcnt lgkmcnt(0)" ::: "memory")
__device__ __forceinline__ unsigned f2bf(float f) { unsigned u = __builtin_bit_cast(unsigned, f); return (u + 0x7fffu + ((u >> 16) & 1u)) >> 16; }
__device__ __forceinline__ unsigned pk2(float lo, float hi) { return f2bf(lo) | (f2bf(hi) << 16); }
__device__ __forceinline__ float bf2f(unsigned b) { return __builtin_bit_cast(float, b << 16); }

#define XB_TMO      128
#define XB_XCNT(j)  (256  + 64 * (j))
#define XB_XSUB(j)  (1280 + 64 * (j))
#define XB_XGEN(j)  (2304 + 64 * (j))
#define XB_TOP      3328
#define XB_TOPGEN   3392
#define XCD_BAR_WORDS 3456
#define XB_SPIN_CAP (1u << 18)

__device__ __forceinline__ unsigned xb_ld(unsigned* p)              { return __hip_atomic_load(p, __ATOMIC_RELAXED, __HIP_MEMORY_SCOPE_AGENT); }
__device__ __forceinline__ unsigned xb_add(unsigned* p, unsigned v) { return __hip_atomic_fetch_add(p, v, __ATOMIC_RELAXED, __HIP_MEMORY_SCOPE_AGENT); }
__device__ __forceinline__ unsigned xb_xcc_id() { return (unsigned)__builtin_amdgcn_s_getreg((3 << 11) | 20) & 0xFu; }
#define XB_SPIN(cond, bar) do { unsigned _sp = 0; while (cond) { __builtin_amdgcn_s_sleep(1); \
    if ((++_sp & 255u) == 0u) { if (xb_ld(&(bar)[XB_TMO])) break; if (_sp > XB_SPIN_CAP) { atomicAdd(&(bar)[XB_TMO], 1u); break; } } } } while (0)

struct XcdBarrier {
    unsigned* bar; unsigned x;
    volatile LAS unsigned* st;
};

__device__ __forceinline__ XcdBarrier xcd_barrier_post(unsigned* bar, volatile LAS unsigned* st) {
    XcdBarrier b; b.bar = bar; b.x = xb_xcc_id(); b.st = st;
    if (threadIdx.x == 0) (void)xb_add(&bar[XB_XCNT(b.x)], 1u);
    return b;
}
__device__ __forceinline__ void xcd_barrier_complete(unsigned* bar, unsigned x, unsigned& nloc, unsigned& nx) {
    const unsigned G = gridDim.x * gridDim.y * gridDim.z;
    unsigned sum, cnt, mine, sp = 0u;
    for (;;) {
        sum = 0u; cnt = 0u; mine = 0u;
#pragma unroll
        for (unsigned j = 0; j < 16; ++j) { const unsigned c = xb_ld(&bar[XB_XCNT(j)]); sum += c; cnt += (c > 0u) ? 1u : 0u; mine = (j == x) ? c : mine; }
        if (sum == G) break;
        __builtin_amdgcn_s_sleep(1);
        if ((++sp & 255u) == 0u) { if (xb_ld(&bar[XB_TMO])) break; if (sp > XB_SPIN_CAP) { atomicAdd(&bar[XB_TMO], 1u); break; } }
    }
    nloc = mine > 0u ? mine : 1u; nx = cnt > 0u ? cnt : 1u;
}

__device__ __forceinline__ void xcd_barrier(const XcdBarrier& b) {
    asm volatile("s_waitcnt vmcnt(0)" ::: "memory");
    __syncthreads();
    if (threadIdx.x == 0) {
        unsigned* bar = b.bar;
        __builtin_amdgcn_s_waitcnt(0);
        unsigned nloc = b.st[0], nx = b.st[1];
        if (nloc == 0u) { xcd_barrier_complete(bar, b.x, nloc, nx); b.st[0] = nloc; b.st[1] = nx; }
        const unsigned old = xb_add(&bar[XB_XSUB(b.x)], 1u);
        const unsigned gen = old / nloc;
        if (old + 1u == (gen + 1u) * nloc) {
            __builtin_amdgcn_fence(__ATOMIC_RELEASE, "agent");
            asm volatile("s_waitcnt vmcnt(0)" ::: "memory");
            const unsigned og = xb_add(&bar[XB_TOP], 1u);
            const unsigned tg = og / nx;
            if (og + 1u == (tg + 1u) * nx) xb_add(&bar[XB_TOPGEN], 1u);
            else XB_SPIN(xb_ld(&bar[XB_TOPGEN]) == tg, bar);
            __builtin_amdgcn_fence(__ATOMIC_ACQUIRE, "agent");
            xb_add(&bar[XB_XGEN(b.x)], 1u);
            asm volatile("s_waitcnt vmcnt(0)" ::: "memory");
        } else {
            XB_SPIN(xb_ld(&bar[XB_XGEN(b.x)]) == gen, bar);
            __builtin_amdgcn_fence(__ATOMIC_ACQUIRE, "agent");
            asm volatile("s_waitcnt vmcnt(0)" ::: "memory");
        }
    }
    __syncthreads();
}

struct Args { const float* in[24]; float* out; unsigned char* ws; int ph_lo, ph_hi; };
typedef const __attribute__((address_space(4))) char* kptr_t;
struct KA { kptr_t k;
    __device__ __forceinline__ const float* in(int i) const { return (const float*)(const GAS float*)*(const float* const __attribute__((address_space(4)))*)(k + 8 * i); }
    __device__ __forceinline__ float* out() const { return (float*)(GAS float*)*(float* const __attribute__((address_space(4)))*)(k + 192); }
    __device__ __forceinline__ unsigned char* ws() const { return (unsigned char*)(GAS unsigned char*)*(unsigned char* const __attribute__((address_space(4)))*)(k + 200); } };
static_assert(sizeof(Args) == 216 && __builtin_offsetof(Args, out) == 192 && __builtin_offsetof(Args, ws) == 200, "Args layout");
struct Frame { LAS unsigned char* lds; int tid, lane, wave, vcu, G; };

__device__ __forceinline__ float wave_sum(float v) {
#pragma unroll
    for (int o = 1; o < 64; o <<= 1) v += __shfl_xor(v, o);
    return v;
}
struct TrD { const float* src; const float* gain; bf16* dst; int ld, mode, dK, n0, drow0, k0, up; };
__device__ __forceinline__ int map64(int n)  { return (n & ~255) + 128 * ((n >> 5) & 1) + 32 * ((n >> 6) & 3) + (n & 31); }
__device__ __forceinline__ int map128(int n) { return (n & ~255) + 128 * ((n >> 6) & 1) + 64 * ((n >> 7) & 1) + (n & 63); }
__device__ __forceinline__ void tr_load(const TrD& d, f32x4 (&rg)[8], int lane) {
    const int r = lane >> 3, c4 = lane & 7;
#pragma unroll
    for (int i = 0; i < 8; ++i) { const int kk = 8 * i + r; f32x4 v = *(const GAS f32x4*)(d.src + (size_t)(d.k0 + kk) * d.ld + d.n0 + 4 * c4);
        const float g = d.gain ? *(const GAS float*)(d.gain + d.k0 + kk) : 1.0f; rg[i] = v * g; }
}
__device__ __forceinline__ void tr_store(const TrD& d, const f32x4 (&rg)[8], LAS float* scr, int lane) {
    { const int r = lane >> 3, c4 = lane & 7;
#pragma unroll
      for (int i = 0; i < 8; ++i) { LAS float* p = scr + (8 * i + r) * 33 + 4 * c4; p[0] = rg[i].x; p[1] = rg[i].y; p[2] = rg[i].z; p[3] = rg[i].w; } }
    LDS_WAIT(); asm volatile("" ::: "memory");
    const int c = lane & 7;
#pragma unroll
    for (int j = 0; j < 4; ++j) { const int n = (lane >> 3) + 8 * j; const LAS float* s = scr + (8 * c) * 33 + n;
        v4u o; o.x = pk2(s[0 * 33], s[1 * 33]); o.y = pk2(s[2 * 33], s[3 * 33]); o.z = pk2(s[4 * 33], s[5 * 33]); o.w = pk2(s[6 * 33], s[7 * 33]);
        size_t pos;
        if (d.mode == 0) pos = (size_t)(d.drow0 + n) * d.dK + d.k0 + 8 * c;
        else { const int f = d.n0 + n, k8 = (d.k0 >> 3) + c, ks = k8 >> 2, fq = k8 & 3, fr = f & 15;
            if (d.mode == 1) { const int w = f >> 5, cb = 2 * d.up + ((f >> 4) & 1); pos = ((size_t)((w * 32 + ks) * 4 + cb) * 64 + fq * 16 + fr) * 8; }
            else { const int p = f >> 9, w = (f >> 6) & 7, cb = (f >> 4) & 3, KS = d.mode == 2 ? 8 : 32; pos = ((size_t)(((p * 8 + w) * KS + ks) * 4 + cb) * 64 + fq * 16 + fr) * 8; } }
        *(GAS v4u*)(d.dst + pos) = o; }
    LDS_WAIT(); asm volatile("" ::: "memory");
}
__device__ __forceinline__ TrD tr_decode_moe(const KA a, unsigned char* ws, int l, int it);
__device__ __forceinline__ TrD tr_decode_moe(const KA a, unsigned char* ws, int l, int it) {
    TrD d; const int slot = l & 1; d.dK = 0; d.drow0 = 0;
    if (it < 4096) {
        const int e = it >> 8, r = it & 255, up = r >> 7, q = r & 127, kb = q >> 3, nb = q & 7;
        d.src = a.in(up ? 21 : 20) + ((size_t)(l * NE + e)) * DM * FF; d.ld = FF; d.gain = a.in(15) + (size_t)l * DM;
        d.dst = (bf16*)(ws + WS_WGU) + ((size_t)(slot * NE + e)) * 512 * DM; d.mode = 1; d.n0 = 32 * nb; d.up = up; d.k0 = 64 * kb;
    } else {
        const int r0 = it - 4096, e = r0 >> 7, q = r0 & 127, kb = q >> 5, nb = q & 31;
        d.src = a.in(22) + ((size_t)(l * NE + e)) * FF * DM; d.ld = DM; d.gain = nullptr;
        d.dst = (bf16*)(ws + WS_WD) + ((size_t)(slot * NE + e)) * DM * FF; d.mode = 2; d.n0 = 32 * nb; d.up = 0; d.k0 = 64 * kb;
    }
    return d;
}
constexpr int TR_I_WIN = 16 * 96, TR_I_WO = 16 * 32, TR_I_KV = 16 * 64, TR_I_Q = 16 * 96, TR_I_MOE = 6144;
constexpr int TR_NITEMS = 2 * TR_I_WIN + 2 * TR_I_WO + TR_I_KV + 2 * TR_I_Q + 2 * TR_I_WO + 2 * TR_I_MOE;
__device__ __forceinline__ TrD tr_decode_main(const KA a, unsigned char* ws, int it) {
    TrD d; d.mode = 0; d.dK = DM; d.up = 0; int r = it;
    if (r < 2 * TR_I_WIN) { const int l = r / TR_I_WIN; r -= l * TR_I_WIN; const int kb = r / 96, nb = r % 96, n0 = 32 * nb;
        d.src = a.in(3) + (size_t)l * DM * WIN_LD; d.ld = WIN_LD; d.gain = a.in(2) + l * DM; d.dst = (bf16*)(ws + WS_WIN) + (size_t)l * 3072 * DM; d.n0 = n0; d.drow0 = map64(n0); d.k0 = 64 * kb; return d; }
    r -= 2 * TR_I_WIN;
    if (r < 2 * TR_I_WO) { const int l = r / TR_I_WO; r -= l * TR_I_WO; const int kb = r / 32, nb = r % 32;
        d.src = a.in(7) + (size_t)l * DM * DM; d.ld = DM; d.gain = nullptr; d.dst = (bf16*)(ws + WS_WOA) + (size_t)l * DM * DM; d.n0 = 32 * nb; d.drow0 = 32 * nb; d.k0 = 64 * kb; d.mode = 3; return d; }
    r -= 2 * TR_I_WO;
    if (r < TR_I_KV) { const int kb = r / 64, nb = r % 64, n0 = 32 * nb;
        d.src = a.in(9); d.ld = 2 * DM; d.gain = a.in(8); d.dst = (bf16*)(ws + WS_WKVQ0); d.n0 = n0; d.drow0 = n0 < DM ? map128(n0) : n0; d.k0 = 64 * kb; return d; }
    r -= TR_I_KV;
    if (r < 2 * TR_I_Q) { const int j = r / TR_I_Q; r -= j * TR_I_Q; const int kb = r / 96, nb = r % 96, n0 = 32 * nb;
        d.src = a.in(12) + (size_t)j * DM * 3072; d.ld = 3072; d.gain = a.in(11) + j * DM; d.dst = j == 0 ? (bf16*)(ws + WS_WKVQ0) + (size_t)2048 * DM : (bf16*)(ws + WS_WQ1); d.n0 = n0; d.drow0 = map128(n0); d.k0 = 64 * kb; return d; }
    r -= 2 * TR_I_Q;
    if (r < 2 * TR_I_WO) { const int j = r / TR_I_WO; r -= j * TR_I_WO; const int kb = r / 32, nb = r % 32;
        d.src = a.in(14) + (size_t)j * DM * DM; d.ld = DM; d.gain = nullptr; d.dst = (bf16*)(ws + WS_WOB) + (size_t)j * DM * DM; d.n0 = 32 * nb; d.drow0 = 32 * nb; d.k0 = 64 * kb; d.mode = 3; return d; }
    r -= 2 * TR_I_WO;
    { const int l = r / TR_I_MOE; return tr_decode_moe(a, ws, l, r - l * TR_I_MOE); }
}
template <bool MAIN> __device__ __forceinline__ void tr_run(const KA a, unsigned char* ws, int layer, int nitems, int gw, int NGW, LAS float* scr, int lane) {
    int it = gw; if (it >= nitems) return;
    TrD d = MAIN ? tr_decode_main(a, ws, it) : tr_decode_moe(a, ws, layer, it);
    f32x4 rg[8]; tr_load(d, rg, lane);
    for (;;) {
        const int itn = it + NGW; const bool more = itn < nitems;
        TrD dn = d; f32x4 rn[8];
        if (more) { dn = MAIN ? tr_decode_main(a, ws, itn) : tr_decode_moe(a, ws, layer, itn); tr_load(dn, rn, lane); }
        tr_store(d, rg, scr, lane);
        if (!more) break;
        d = dn; it = itn;
#pragma unroll
        for (int i = 0; i < 8; ++i) rg[i] = rn[i];
    }
}
constexpr int CW_CQ = 24576;
__device__ __forceinline__ void conv_drain(const KA a, unsigned char* ws, Frame& F, unsigned* cctr, bool main, int layer, int lo, int hi) {
    volatile LAS int* cw = (volatile LAS int*)(F.lds + MISC_OFF) + 16;
    LAS float* scr = (LAS float*)(F.lds + RING_OFF + F.wave * 16384);
    const int nb = (hi - lo + 63) >> 6;
    for (;;) {
        __syncthreads();
        if (F.tid == 0) cw[0] = (int)__hip_atomic_fetch_add(cctr, 1u, RLX_AGENT);
        __syncthreads();
        const int b = __builtin_amdgcn_readfirstlane(cw[0]);
        if (b >= nb) break;
        const int base = lo + b * 64, end = (base + 64 < hi) ? base + 64 : hi;
        int it = base + F.wave; if (it >= end) continue;
        TrD d = main ? tr_decode_main(a, ws, it) : tr_decode_moe(a, ws, layer, it);
        f32x4 rg[8]; tr_load(d, rg, F.lane);
        for (;;) {
            const int itn = it + 8; const bool more = itn < end;
            TrD dn = d; f32x4 rn[8];
            if (more) { dn = main ? tr_decode_main(a, ws, itn) : tr_decode_moe(a, ws, layer, itn); tr_load(dn, rn, F.lane); }
            tr_store(d, rg, scr, F.lane);
            if (!more) break;
            d = dn; it = itn;
#pragma unroll
            for (int i = 0; i < 8; ++i) rg[i] = rn[i];
        }
    }
    __syncthreads();
}
__device__ __forceinline__ void sincos_f64(double a, float& c, float& s) {
    const double q = __builtin_rint(a * 0.63661977236758134308);
    const double r = __builtin_fma(-q, 6.123233995736766036e-17, __builtin_fma(-q, 1.5707963267948966192, a));
    const double r2 = r * r;
    double sp = -1.0 / 39916800.0; sp = sp * r2 + 1.0 / 362880.0; sp = sp * r2 - 1.0 / 5040.0; sp = sp * r2 + 1.0 / 120.0; sp = sp * r2 - 1.0 / 6.0; sp = sp * r2 * r + r;
    double cp = 1.0 / 479001600.0; cp = cp * r2 - 1.0 / 3628800.0; cp = cp * r2 + 1.0 / 40320.0; cp = cp * r2 - 1.0 / 720.0; cp = cp * r2 + 1.0 / 24.0; cp = cp * r2 - 0.5; cp = cp * r2 + 1.0;
    const int qi = (int)((long long)q & 3);
    const double cs = (qi == 0) ? cp : (qi == 1) ? -sp : (qi == 2) ? -cp : sp;
    const double sn = (qi == 0) ? sp : (qi == 1) ? cp : (qi == 2) ? -sp : -cp;
    c = (float)cs; s = (float)sn;
}
__device__ __forceinline__ void p_prologue(const KA a, Frame& F) {
    unsigned char* ws = a.ws(); asm volatile("" : "+s"(ws)); ASSUME_GLOBAL(ws);
    LAS float* scr = (LAS float*)(F.lds + RING_OFF + F.wave * 16384);
    const int gw = F.vcu * NWAVES + F.wave, NGW = F.G * NWAVES;
    tr_run<true>(a, ws, 0, TR_I_WIN, gw, NGW, scr, F.lane);
    const int gt = (F.vcu * NWAVES + F.wave) * 64 + F.lane, NGT = NGW * 64;
    for (int i = gt; i < 2 * 16 * DM; i += NGT) { const int l = i / (16 * DM), v = (i / DM) % 16, k = i % DM;
        ((float*)(ws + WS_WF))[i] = a.in(3)[(size_t)l * DM * WIN_LD + (size_t)k * WIN_LD + 3 * DM + v] * a.in(2)[l * DM + k]; }
    for (int i = gt; i < 4 * 20 * DM; i += NGT) { const int l = i / (20 * DM), v = (i / DM) % 20, k = i % DM;
        const float w = v < 4 ? a.in(16)[(size_t)l * DM * 4 + k * 4 + v] : a.in(18)[(size_t)l * DM * 16 + k * 16 + (v - 4)];
        ((float*)(ws + WS_WR))[i] = w * a.in(15)[l * DM + k]; }
    for (int i = gt; i < 2 * 192; i += NGT) { const int l = i / 192, sec = (i / 64) % 3, dd = i % 64;
        ((float*)(ws + WS_GTAB))[i] = sec == 0 ? a.in(5)[l * AHD + dd] * (0.125f * LOG2E) : (sec == 1 ? a.in(6)[l * AHD + dd] : 1.0f); }
    const int* pos = (const int*)a.in(1);
    for (int i = gt; i < TOK * 64; i += NGT) { const int m = i >> 6, f = i & 63;
        const float invf = powf(10000.0f, -(float)f / 64.0f);
        const float ang = (float)pos[m] * invf;
        float c, s; sincos_f64((double)ang, c, s);
        ((unsigned*)(ws + WS_ROPEC))[i] = (unsigned)__builtin_bit_cast(unsigned short, (_Float16)c) | ((unsigned)__builtin_bit_cast(unsigned short, (_Float16)s) << 16); }
}

template <int N, int O> struct RedTree {
    static __device__ __forceinline__ void run(float (&v)[80], int lane, int& base) {
        if constexpr (O >= 1) {
            if constexpr (N % 2 == 0) {
                const bool up = (lane & O) != 0;
#pragma unroll
                for (int i = 0; i < N / 2; ++i) { const float keep = up ? v[i + N / 2] : v[i], send = up ? v[i] : v[i + N / 2]; v[i] = keep + __shfl_xor(send, O); }
                if (up) base += N / 2;
                RedTree<N / 2, O / 2>::run(v, lane, base);
            } else {
#pragma unroll
                for (int i = 0; i < N; ++i) v[i] += __shfl_xor(v[i], O);
                RedTree<N, O / 2>::run(v, lane, base);
            }
        }
    }
};
template <int MODE> __device__ __forceinline__ void p_rowpass(const KA a, Frame& F, int layer, bool dry = false, const float* Hsrc = nullptr, bool raw_wf = false) {
    unsigned char* ws = a.ws(); asm volatile("" : "+s"(ws)); ASSUME_GLOBAL(ws);
    constexpr int NV = MODE == 1 ? 16 : (MODE == 2 ? 20 : 0), NT = MODE == 2 ? 2 : 4, NVAL = NT * NV;
    constexpr int NFIN = MODE == 2 ? 5 : 1;
    LAS float* wl = (LAS float*)(F.lds + RING_OFF);
    LAS float* red = (LAS float*)(F.lds + RING_OFF + 96 * 1024) + F.wave * 96;
    if (NV) {
        if (MODE == 1 && raw_wf) {
            const float* win = a.in(3) + (size_t)layer * DM * WIN_LD + 3 * DM; const float* gn = a.in(2) + layer * DM;
            for (int i = F.tid; i < 16 * DM; i += NWAVES * 64) { const int k = i >> 4, v = i & 15; wl[v * DM + k] = *(const GAS float*)(win + (size_t)k * WIN_LD + v) * *(const GAS float*)(gn + k); }
        } else {
        const float* wsrc = MODE == 1 ? (const float*)(ws + WS_WF) + (size_t)layer * 16 * DM : (const float*)(ws + WS_WR) + (size_t)layer * 20 * DM;
        for (int i = F.tid; i < NV * DM / 4; i += NWAVES * 64) ((LAS f32x4*)wl)[i] = ((const f32x4*)wsrc)[i];
        }
        __syncthreads();
    }
    const int gw = F.vcu * NWAVES + F.wave, NGW = F.G * NWAVES;
    const float* H = Hsrc ? Hsrc : a.out(); float* rstd = (float*)(ws + WS_RSTD); bf16* hb = (bf16*)(ws + WS_HB);
    for (int m0 = NT * gw; m0 < TOK; m0 += NT * NGW) {
        f32x4 v[NT][4]; float rs[4] = {0.f, 0.f, 0.f, 0.f};
#pragma unroll
        for (int r = 0; r < NT; ++r) { const f32x4* xr = (const f32x4*)(H + (size_t)(m0 + r) * DM) + F.lane;
#pragma unroll
            for (int j = 0; j < 4; ++j) v[r][j] = xr[64 * j]; }
#pragma unroll
        for (int r = 0; r < NT; ++r) { float s = 0.f;
#pragma unroll
            for (int j = 0; j < 4; ++j) s += (v[r][j].x * v[r][j].x + v[r][j].y * v[r][j].y) + (v[r][j].z * v[r][j].z + v[r][j].w * v[r][j].w);
            rs[r] = 1.0f / sqrtf(wave_sum(s) * (1.0f / DM) + 1e-6f);
            unsigned long long* o8 = (unsigned long long*)(hb + (size_t)(m0 + r) * DM) + F.lane;
#pragma unroll
            for (int j = 0; j < 4; ++j) o8[64 * j] = (unsigned long long)pk2(v[r][j].x, v[r][j].y) | ((unsigned long long)pk2(v[r][j].z, v[r][j].w) << 32); }
        if (F.lane < NT) rstd[m0 + F.lane] = F.lane == 0 ? rs[0] : (F.lane == 1 ? rs[1] : (F.lane == 2 ? rs[2] : rs[3]));
        if (NV) {
            float pv[80];
#pragma unroll
            for (int q = 0; q < NV; ++q) {
                f32x4 w[4];
#pragma unroll
                for (int j = 0; j < 4; ++j) w[j] = ((const LAS f32x4*)(wl + q * DM))[F.lane + 64 * j];
#pragma unroll
                for (int r = 0; r < NT; ++r) { float p = 0.f;
#pragma unroll
                    for (int j = 0; j < 4; ++j) p += (v[r][j].x * w[j].x + v[r][j].y * w[j].y) + (v[r][j].z * w[j].z + v[r][j].w * w[j].w);
                    pv[r * NV + q] = p; }
            }
            int base = 0;
            RedTree<NVAL, 32>::run(pv, F.lane, base);
            if (MODE == 1) {
                const int r = base >> 4, hh = base & 15; const float rsr = r == 0 ? rs[0] : (r == 1 ? rs[1] : (r == 2 ? rs[2] : rs[3]));
                const float z = pv[0] * rsr + a.in(4)[layer * AH + hh]; const float ls = fminf(z, 0.f) - log1pf(expf(-fabsf(z)));
                const int m = m0 + r, b = m / SEQ, sidx = m % SEQ; ((float*)(ws + WS_LOGF))[(size_t)(b * AH + hh) * SEQ + sidx] = ls;
            } else if (MODE == 2) {
#pragma unroll
                for (int i = 0; i < NFIN; ++i) red[base + i] = pv[i];
                LDS_WAIT(); asm volatile("" ::: "memory");
                if (F.lane < NT) {
                    const int m = m0 + F.lane; const float rsr = F.lane == 0 ? rs[0] : (F.lane == 1 ? rs[1] : (F.lane == 2 ? rs[2] : rs[3]));
                    float d[20];
#pragma unroll
                    for (int q = 0; q < 20; ++q) d[q] = red[F.lane * 20 + q] * rsr;
                    const float* gb = a.in(17) + layer * 4;
                    float lg[4];
#pragma unroll
                    for (int q = 0; q < 4; ++q) lg[q] = d[q] + gb[q];
                    int gi = 0; float gm = lg[0];
#pragma unroll
                    for (int q = 1; q < 4; ++q) if (lg[q] > gm) { gm = lg[q]; gi = q; }
                    float gs = 0.f;
#pragma unroll
                    for (int q = 0; q < 4; ++q) gs += expf(lg[q] - gm);
                    const float gp = 1.0f / gs;
                    const float* ebp = a.in(19) + layer * 16;
                    float el[4];
#pragma unroll
                    for (int q = 0; q < 4; ++q) { float t = 0.f;
#pragma unroll
                        for (int g2 = 0; g2 < 4; ++g2) if (g2 == gi) t = d[4 + 4 * g2 + q] + ebp[4 * g2 + q];
                        el[q] = t; }
                    int i1 = 0; float v1 = el[0];
#pragma unroll
                    for (int q = 1; q < 4; ++q) if (el[q] > v1) { v1 = el[q]; i1 = q; }
                    int i2 = -1; float v2 = 0.f;
#pragma unroll
                    for (int q = 0; q < 4; ++q) if (q != i1 && (i2 < 0 || el[q] > v2)) { v2 = el[q]; i2 = q; }
                    const float e2 = expf(v2 - v1), g1 = gp / (1.0f + e2), g2v = gp * e2 / (1.0f + e2);
                    const int lo = i1 < i2 ? i1 : i2, hi = i1 < i2 ? i2 : i1;
                    const int pidx = (lo == 0) ? (hi - 1) : (lo == 1 ? hi + 1 : 5);
                    const int cls = gi * 6 + pidx;
                    if (!dry) {
                        const unsigned p = __hip_atomic_fetch_add((unsigned*)(ws + WS_CTL) + CW_CNT + layer * 64 + cls, 1u, RLX_AGENT);
                        ((int*)(ws + WS_LIST))[(size_t)cls * TOK + p] = m;
                        ((float*)(ws + WS_GA))[m] = (i1 < i2) ? g1 : g2v;
                        ((float*)(ws + WS_GB))[m] = (i1 < i2) ? g2v : g1;
                    }
                }
                LDS_WAIT(); asm volatile("" ::: "memory");
            }
        }
    }
    __syncthreads();
}

__device__ __forceinline__ swa::BlockRef<swa::bf16, swa::bf16> b_unit_ref(unsigned char* ws, int id, bool dry) {
    const int g = id >> 9, r0 = id & 511, bh = r0 >> 5, r1 = r0 & 31;
    const int dl = (g == 0) ? 1 : (g == 1 ? 4 : 16), nq = 32 / dl, res = r1 / nq, qb = r1 % nq;
    const int b = bh >> 3, h = bh & 7;
    const size_t tok0 = (size_t)b * SEQ + res;
    swa::BlockRef<swa::bf16, swa::bf16> R;
    swa::bf16* qbase = (swa::bf16*)(ws + WS_QB) + tok0 * 3072 + g * 1024 + h * 128;
    R.Q = qbase + (size_t)qb * 256 * dl * 3072; R.O = qbase + (size_t)qb * 256 * dl * 3072; R.qp = dl * 3072; R.op = dl * 3072;
    R.K = (const swa::bf16*)(ws + WS_KB) + tok0 * 1024 + h * 128; R.V = (const swa::bf16*)(ws + WS_VB) + tok0 * 1024 + h * 128; R.kp = dl * 1024;
    R.L = (float*)(ws + WS_LSE) + (tok0 + (size_t)qb * 256 * dl) * 24 + g * 8 + h; R.lp = dl * 24;
    R.P0 = qb * 256;
    if (dry) { R.O = (swa::bf16*)(ws + WS_HB) + tok0 * 1024 + h * 128 + (size_t)qb * 256 * dl * 1024; R.op = dl * 1024; R.L = nullptr; }
    return R;
}
__device__ __forceinline__ void p_battn(const KA a, Frame& F, bool dry) {
    unsigned char* ws = a.ws(); asm volatile("" : "+s"(ws)); ASSUME_GLOBAL(ws); char* lds = (char*)(F.lds + RING_OFF);
    constexpr int NUNITS = 3 * 512;
    const int bid0 = bid_fresh();
    const bool xdeal = gridDim.x == 256; const int vc = (bid0 & 7) * 32 + (bid0 >> 3), xj = vc & 31, xb = (vc >> 5) * 2; int it = 0;
#define B_PAIR(it_) (xj + 32 * ((it_) >> 1))
#define B_UNIT_ID(it_) (xdeal ? ((((B_PAIR(it_)) / 16) % 3) * 512 + (xb + (B_PAIR(it_)) / 48) * 32 + 2 * ((B_PAIR(it_)) % 16) + ((it_) & 1)) : (bid0 + (it_) * (int)gridDim.x))
    int id = B_UNIT_ID(0);
    if (id >= NUNITS) return;
    typedef swa::BlockRef<swa::bf16, swa::bf16> Ref;
    Ref cur = b_unit_ref(ws, id, dry);
    swa::Seam<swa::bf16> S;
    swa::causal_swa_prime<swa::bf16, swa::bf16>(cur, 129, lds, S);
    for (;;) {
        ++it; const int idn = (xdeal && it >= 6) ? NUNITS : B_UNIT_ID(it); const bool last = idn >= NUNITS;
        const Ref nxt = last ? cur : b_unit_ref(ws, idn, dry);
        const int dl = (id >> 9) == 0 ? 1 : ((id >> 9) == 1 ? 4 : 16);
        swa::causal_swa_block<swa::bf16, swa::bf16>(cur, nxt, SEQ / dl, 129, lds, S);
        if (last) break;
        cur = nxt; id = idn;
    }
#undef B_UNIT_ID
#undef B_PAIR
}
__device__ __forceinline__ void p_bmerge(const KA a, Frame& F) {
    unsigned char* ws = a.ws(); asm volatile("" : "+s"(ws)); ASSUME_GLOBAL(ws);
    const int gw = F.vcu * NWAVES + F.wave, NGW = F.G * NWAVES;
    const bf16* og = (const bf16*)(ws + WS_QB); const float* lse = (const float*)(ws + WS_LSE); bf16* o = (bf16*)(ws + WS_HB);
    for (int m = gw; m < TOK; m += NGW) {
        const int h = F.lane >> 3;
        const float l0 = lse[(size_t)m * 24 + h], l1 = lse[(size_t)m * 24 + 8 + h], l2 = lse[(size_t)m * 24 + 16 + h];
        const float mx = fmaxf(l0, fmaxf(l1, l2));
        const float e0 = expf(l0 - mx), e1 = expf(l1 - mx), e2 = expf(l2 - mx), inv = 1.0f / (e0 + e1 + e2);
        const float w0 = e0 * inv, w1 = e1 * inv, w2 = e2 * inv;
        float accv[16];
#pragma unroll
        for (int i = 0; i < 16; ++i) accv[i] = 0.f;
#pragma unroll
        for (int g = 0; g < 3; ++g) { const float w = g == 0 ? w0 : (g == 1 ? w1 : w2);
            const v4u* p = (const v4u*)(og + (size_t)m * 3072 + g * 1024 + F.lane * 16);
#pragma unroll
            for (int q = 0; q < 2; ++q) { const v4u x = p[q];
                const unsigned xs[4] = {x.x, x.y, x.z, x.w};
#pragma unroll
                for (int e = 0; e < 4; ++e) { accv[q * 8 + 2 * e] += w * bf2f(xs[e] & 0xffffu); accv[q * 8 + 2 * e + 1] += w * bf2f(xs[e] >> 16); } } }
        v4u* po = (v4u*)(o + (size_t)m * DM + F.lane * 16);
#pragma unroll
        for (int q = 0; q < 2; ++q) { v4u w; w.x = pk2(accv[q * 8 + 0], accv[q * 8 + 1]); w.y = pk2(accv[q * 8 + 2], accv[q * 8 + 3]); w.z = pk2(accv[q * 8 + 4], accv[q * 8 + 5]); w.w = pk2(accv[q * 8 + 6], accv[q * 8 + 7]); po[q] = w; }
    }
}

constexpr int MOE_AP = 128 + 8;
constexpr int MOE_HP = 512 + 8;
constexpr int MOE_A_BYTES = MROWS * MOE_AP * 2;
constexpr int MOE_A_OFF = 0, MOE_H_OFF = 2 * MOE_A_BYTES, MOE_T_OFF = MOE_H_OFF + MROWS * MOE_HP * 2;
static_assert(MOE_T_OFF + 3 * MROWS * 4 <= RING_BYTES, "MoE LDS");
typedef float f32x4m __attribute__((ext_vector_type(4)));
__device__ __forceinline__ void p_moe(const KA a, Frame& F, int layer, float upd) {
    unsigned char* ws = a.ws(); asm volatile("" : "+s"(ws)); ASSUME_GLOBAL(ws);
    const unsigned* cnt = (const unsigned*)(ws + WS_CTL) + CW_CNT + layer * 64;
    for (int u = F.vcu; ; u += (int)gridDim.x) {
    int cls = -1, tile = 0, n_c = 0;
    { int accu = 0;
      for (int c = 0; c < NCLS; ++c) { const int n = (int)__hip_atomic_load(cnt + c, RLX_AGENT); const int nt = (n + MROWS - 1) / MROWS;
          if (cls < 0 && u < accu + nt) { cls = c; tile = u - accu; n_c = n; } accu += nt; } }
    if (cls < 0) break;
    const int nrow = (n_c - tile * MROWS) < MROWS ? (n_c - tile * MROWS) : MROWS;
    const int grp = cls / 6, pidx = cls % 6;
    const int elo = pidx < 3 ? 0 : (pidx < 5 ? 1 : 2), ehi = pidx < 3 ? pidx + 1 : (pidx < 5 ? pidx - 1 : 3);
    const int slot = layer & 1;
    const int ea = grp * 4 + elo, eb = grp * 4 + ehi;
    LAS bf16* Al = (LAS bf16*)(F.lds + RING_OFF + MOE_A_OFF); LAS bf16* Hl = (LAS bf16*)(F.lds + RING_OFF + MOE_H_OFF);
    LAS int* tokl = (LAS int*)(F.lds + RING_OFF + MOE_T_OFF); LAS float* gal = (LAS float*)(tokl + MROWS); LAS float* gbl = gal + MROWS;
    if (F.tid < MROWS) { const bool ok = F.tid < nrow; const int t = ok ? ((const int*)(ws + WS_LIST))[(size_t)cls * TOK + tile * MROWS + F.tid] : 0;
        tokl[F.tid] = ok ? t : -1; gal[F.tid] = ok ? ((const float*)(ws + WS_GA))[t] : 0.f; gbl[F.tid] = ok ? ((const float*)(ws + WS_GB))[t] : 0.f; }
    __syncthreads();
    const bf16* hb = (const bf16*)(ws + WS_HB);
    const int fr = F.lane & 15, fq = F.lane >> 4, w = F.wave; const unsigned lb = (unsigned)F.lane * 16u;
    int grow[3]; unsigned gsrc[3]; bool gld[3];
#pragma unroll
    for (int i = 0; i < 3; ++i) { const int idx = F.tid + 512 * i; const int r = idx >> 4; const int t = (idx < MROWS * 16) ? tokl[r] : -1; grow[i] = (idx < MROWS * 16) ? (r * MOE_AP + (idx & 15) * 8) : -1;
        gsrc[i] = (unsigned)((t >= 0 ? t : 0) * DM + (idx & 15) * 8); gld[i] = t >= 0; }
#define MOE_GLOAD(kc_) do { _Pragma("unroll") for (int i = 0; i < 3; ++i) { const v4u t_ = *(const GAS v4u*)((const char*)hb + (gsrc[i] + (unsigned)((kc_) * 128)) * 2u); \
        greg[i].x = gld[i] ? t_.x : 0u; greg[i].y = gld[i] ? t_.y : 0u; greg[i].z = gld[i] ? t_.z : 0u; greg[i].w = gld[i] ? t_.w : 0u; } } while (0)
#define MOE_GSTORE(buf_) do { _Pragma("unroll") for (int i = 0; i < 3; ++i) { if (grow[i] >= 0) *(LAS v4u*)(Al + (buf_) * (MOE_A_BYTES / 2) + grow[i]) = greg[i]; } } while (0)
#pragma unroll 1
    for (int x = 0; x < 2; ++x) {
        const bf16* Wt = (const bf16*)(ws + WS_WGU) + ((size_t)(slot * NE + (x ? eb : ea))) * 512 * DM + (size_t)w * (32 * 4 * 64 * 8);
        f32x4m acc[5][4];
#pragma unroll
        for (int rb = 0; rb < 5; ++rb)
#pragma unroll
            for (int cb = 0; cb < 4; ++cb) acc[rb][cb] = (f32x4m){0.f, 0.f, 0.f, 0.f};
        v4u greg[3]; bf16x8 bfr[4][4];
#pragma unroll
        for (int i = 0; i < 3; ++i) { greg[i].x = 0u; greg[i].y = 0u; greg[i].z = 0u; greg[i].w = 0u; }
        MOE_GLOAD(0);
#pragma unroll
        for (int r = 0; r < 3; ++r)
#pragma unroll
            for (int cb = 0; cb < 4; ++cb) bfr[r][cb] = *(const GAS bf16x8*)((const char*)(Wt + (r * 4 + cb) * 512) + lb);
        MOE_GSTORE(0);
        LDS_WAIT(); __builtin_amdgcn_s_barrier(); asm volatile("" ::: "memory");
#pragma unroll 1
        for (int kc = 0; kc < 8; ++kc) {
            MOE_GLOAD(kc < 7 ? kc + 1 : 7);
            const LAS bf16* Ab = Al + (kc & 1) * (MOE_A_BYTES / 2);
            bf16x8 afn = *(const LAS bf16x8*)(Ab + fr * MOE_AP + fq * 8);
#pragma unroll
            for (int j = 0; j < 4; ++j) {
                const int ks = kc * 4 + j, kn = (ks + 3 < 32) ? ks + 3 : 31;
#pragma unroll
                for (int cb = 0; cb < 4; ++cb) bfr[(j + 3) & 3][cb] = *(const GAS bf16x8*)((const char*)(Wt + (kn * 4 + cb) * 512) + lb);
#pragma unroll
                for (int rb = 0; rb < 5; ++rb) { const bf16x8 af = afn; const int tn = j * 5 + rb + 1, jn = tn / 5, rn = tn % 5;
                    if (tn < 20) afn = *(const LAS bf16x8*)(Ab + (rn * 16 + fr) * MOE_AP + jn * 32 + fq * 8);
                    __builtin_amdgcn_sched_barrier(0);
#pragma unroll
                    for (int cb = 0; cb < 4; ++cb) acc[rb][cb] = __builtin_amdgcn_mfma_f32_16x16x32_bf16(bfr[j][cb], af, acc[rb][cb], 0, 0, 0);
                    __builtin_amdgcn_sched_barrier(0); }
            }
            if (kc < 7) MOE_GSTORE((kc + 1) & 1);
            LDS_WAIT(); __builtin_amdgcn_s_barrier(); asm volatile("" ::: "memory");
        }
        { const int l2 = tid_fresh() & 63, fr = l2 & 15, fq = l2 >> 4;
#pragma unroll
        for (int rb = 0; rb < 5; ++rb) { const int row = rb * 16 + fr; const float gt = x ? gbl[row] : gal[row];
#pragma unroll
            for (int cb = 0; cb < 2; ++cb) { float hv[4];
#pragma unroll
                for (int j = 0; j < 4; ++j) { const float gv = acc[rb][cb][j], uv = acc[rb][cb + 2][j]; hv[j] = gv / (1.0f + __expf(-gv)) * uv * gt; }
                *(LAS unsigned long long*)(Hl + row * MOE_HP + x * 256 + 32 * w + 16 * cb + 4 * fq) = (unsigned long long)pk2(hv[0], hv[1]) | ((unsigned long long)pk2(hv[2], hv[3]) << 32); } }
        }
    }
    __syncthreads();
    float* H = a.out(); LAS float* ssl = (LAS float*)(F.lds + RING_OFF + MOE_A_OFF);
#pragma unroll 1
    for (int p = 0; p < 2; ++p) {
        const bf16* WtA = (const bf16*)(ws + WS_WD) + ((size_t)(slot * NE + ea)) * DM * FF + (size_t)(p * 8 + w) * (8 * 4 * 64 * 8);
        const bf16* WtB = (const bf16*)(ws + WS_WD) + ((size_t)(slot * NE + eb)) * DM * FF + (size_t)(p * 8 + w) * (8 * 4 * 64 * 8);
        f32x4m acc[5][4];
#pragma unroll
        for (int rb = 0; rb < 5; ++rb)
#pragma unroll
            for (int cb = 0; cb < 4; ++cb) acc[rb][cb] = (f32x4m){0.f, 0.f, 0.f, 0.f};
        bf16x8 bfr[4][4];
#pragma unroll
        for (int r = 0; r < 3; ++r)
#pragma unroll
            for (int cb = 0; cb < 4; ++cb) bfr[r][cb] = *(const GAS bf16x8*)((const char*)(WtA + (r * 4 + cb) * 512) + lb);
        bf16x8 afn = *(const LAS bf16x8*)(Hl + fr * MOE_HP + fq * 8);
#pragma unroll 1
        for (int kc = 0; kc < 4; ++kc) {
#pragma unroll
            for (int j = 0; j < 4; ++j) {
                const int ks = kc * 4 + j, kn = (ks + 3 < 16) ? ks + 3 : 15;
                { const bf16* Wn = (kn < 8 ? WtA : WtB) + ((kn & 7) * 4) * 512;
#pragma unroll
                    for (int cb = 0; cb < 4; ++cb) bfr[(j + 3) & 3][cb] = *(const GAS bf16x8*)((const char*)(Wn + cb * 512) + lb); }
#pragma unroll
                for (int rb = 0; rb < 5; ++rb) { const bf16x8 af = afn; const int rn = (rb + 1) % 5, kq = ks + (rb == 4 ? 1 : 0);
                    afn = *(const LAS bf16x8*)(Hl + (rn * 16 + fr) * MOE_HP + (kq < 16 ? kq : 15) * 32 + fq * 8);
                    __builtin_amdgcn_sched_barrier(0);
#pragma unroll
                    for (int cb = 0; cb < 4; ++cb) acc[rb][cb] = __builtin_amdgcn_mfma_f32_16x16x32_bf16(bfr[j][cb], af, acc[rb][cb], 0, 0, 0);
                    __builtin_amdgcn_sched_barrier(0); }
            }
        }
        const int l3 = tid_fresh() & 63, fr3 = l3 & 15, fq3 = l3 >> 4;
        bf16* hbw = (bf16*)(ws + WS_HB);
#pragma unroll
        for (int rb = 0; rb < 5; ++rb) { const int t = tokl[rb * 16 + fr3]; float ssq = 0.f;
            if (t >= 0) { GAS f32x4* hp = (GAS f32x4*)(H + (size_t)t * DM + 512 * p + 64 * w + 4 * fq3); GAS unsigned long long* bp = (GAS unsigned long long*)(hbw + (size_t)t * DM + 512 * p + 64 * w + 4 * fq3);
#pragma unroll
                for (int cb = 0; cb < 4; ++cb) { const f32x4 hn = hp[4 * cb] + acc[rb][cb] * upd; hp[4 * cb] = hn; ssq += (hn.x * hn.x + hn.y * hn.y) + (hn.z * hn.z + hn.w * hn.w);
                    bp[4 * cb] = (unsigned long long)pk2(hn.x, hn.y) | ((unsigned long long)pk2(hn.z, hn.w) << 32); } }
            ssq += __shfl_xor(ssq, 16); ssq += __shfl_xor(ssq, 32);
            if (fq3 == 0) ssl[(rb * 16 + fr3) * 16 + p * 8 + w] = ssq; }
    }
    __syncthreads();
    if (F.tid < MROWS) { const int t = tokl[F.tid]; float tot = 0.f;
#pragma unroll
        for (int i = 0; i < 16; ++i) tot += ssl[F.tid * 16 + i];
        if (t >= 0) ((float*)(ws + WS_RSTD))[t] = 1.0f / sqrtf(tot * (1.0f / DM) + 1e-6f); }
    __syncthreads();
#undef MOE_GLOAD
#undef MOE_GSTORE
    }
}

constexpr int OPR_ROWS = 64, OPR_AP = 128 + 8;
constexpr int OPR_WR_OFF = 0;
constexpr int OPR_A_OFF = 81920, OPR_A_BYTES = OPR_ROWS * OPR_AP * 2;
constexpr int OPR_PART_OFF = OPR_A_OFF + 2 * OPR_A_BYTES;
constexpr int OPR_SUM_OFF = OPR_PART_OFF + 20480;
constexpr int OPR_SSQ_OFF = OPR_SUM_OFF + 5120;
constexpr int OPR_WQ_OFF = OPR_SSQ_OFF + 4096;
static_assert(OPR_WQ_OFF + 8192 <= MISC_OFF, "OPR LDS");
template <bool MERGE> __device__ __forceinline__ void p_opr(const KA a, Frame& F, int layer, const bf16* Wt_all, const float* base, bool dry) {
    unsigned char* ws = a.ws(); asm volatile("" : "+s"(ws)); ASSUME_GLOBAL(ws);
    LAS float* wrl = (LAS float*)(F.lds + OPR_WR_OFF); LAS bf16* Al = (LAS bf16*)(F.lds + OPR_A_OFF);
    LAS float* part = (LAS float*)(F.lds + OPR_PART_OFF); LAS float* sums = (LAS float*)(F.lds + OPR_SUM_OFF); LAS float* ssl = (LAS float*)(F.lds + OPR_SSQ_OFF); LAS float* wql = (LAS float*)(F.lds + OPR_WQ_OFF);
    { const float* wsrc = (const float*)(ws + WS_WR) + (size_t)layer * 20 * DM;
      for (int i = F.tid; i < 20 * DM / 4; i += NWAVES * 64) ((LAS f32x4*)wrl)[i] = *(const GAS f32x4*)(wsrc + 4 * i); }
    float* H = a.out(); bf16* hbw = (bf16*)(ws + WS_HB);
    const int fr = F.lane & 15, fq = F.lane >> 4, w = F.wave; const unsigned lb = (unsigned)F.lane * 16u;
    for (int u = bid_fresh(); u < TOK / OPR_ROWS; u += (int)gridDim.x) {
    const int row0 = u * OPR_ROWS;
    if (MERGE) {
        const int r = F.tid >> 3, hh = F.tid & 7; const float* lp = (const float*)(ws + WS_LSE) + (size_t)(row0 + r) * 24 + hh;
        const float l0 = *(const GAS float*)lp, l1 = *(const GAS float*)(lp + 8), l2 = *(const GAS float*)(lp + 16);
        const float mx = fmaxf(l0, fmaxf(l1, l2)); const float e0 = expf(l0 - mx), e1 = expf(l1 - mx), e2 = expf(l2 - mx), inv = 1.0f / (e0 + e1 + e2);
        *(LAS f32x4*)(wql + (r * 8 + hh) * 4) = (f32x4){e0 * inv, e1 * inv, e2 * inv, 0.f};
    }
    __syncthreads();
    const bf16* asrc = MERGE ? (const bf16*)(ws + WS_QB) : (const bf16*)(ws + WS_QB);
    unsigned gsrc[2]; int grow[2];
#pragma unroll
    for (int i = 0; i < 2; ++i) { const int idx = F.tid + 512 * i, r = idx >> 4, c = idx & 15; grow[i] = r * OPR_AP + c * 8; gsrc[i] = (unsigned)((row0 + r) * (MERGE ? 3072 : 1024) + c * 8); }
    constexpr int NG = MERGE ? 3 : 1;
#define OPR_GLOAD(kc_) do { _Pragma("unroll") for (int i = 0; i < 2; ++i) _Pragma("unroll") for (int g = 0; g < NG; ++g) \
        greg[i][g] = *(const GAS v4u*)((const char*)asrc + (gsrc[i] + (unsigned)(g * 1024 + (kc_) * 128)) * 2u); } while (0)
#define OPR_GSTORE(buf_, kc_) do { _Pragma("unroll") for (int i = 0; i < 2; ++i) { v4u o_; \
        if (MERGE) { const int r_ = (F.tid + 512 * i) >> 4; const f32x4 wq_ = *(const LAS f32x4*)(wql + (r_ * 8 + (kc_)) * 4); \
            const unsigned x0_[4] = {greg[i][0].x, greg[i][0].y, greg[i][0].z, greg[i][0].w}, x1_[4] = {greg[i][NG > 1 ? 1 : 0].x, greg[i][NG > 1 ? 1 : 0].y, greg[i][NG > 1 ? 1 : 0].z, greg[i][NG > 1 ? 1 : 0].w}, \
                           x2_[4] = {greg[i][NG > 2 ? 2 : 0].x, greg[i][NG > 2 ? 2 : 0].y, greg[i][NG > 2 ? 2 : 0].z, greg[i][NG > 2 ? 2 : 0].w}; unsigned y_[4]; \
            _Pragma("unroll") for (int e = 0; e < 4; ++e) { const float lo_ = wq_.x * bf2f(x0_[e] & 0xffffu) + wq_.y * bf2f(x1_[e] & 0xffffu) + wq_.z * bf2f(x2_[e] & 0xffffu), \
                                                                     hi_ = wq_.x * bf2f(x0_[e] >> 16) + wq_.y * bf2f(x1_[e] >> 16) + wq_.z * bf2f(x2_[e] >> 16); y_[e] = pk2(lo_, hi_); } \
            o_ = (v4u){y_[0], y_[1], y_[2], y_[3]}; } else o_ = greg[i][0]; \
        *(LAS v4u*)(Al + (buf_) * (OPR_A_BYTES / 2) + grow[i]) = o_; } } while (0)
#pragma unroll 1
    for (int p = 0; p < 2; ++p) {
        const bf16* Wt = Wt_all + (size_t)(p * 8 + w) * (32 * 4 * 64 * 8);
        f32x4m acc[4][4];
#pragma unroll
        for (int rb = 0; rb < 4; ++rb)
#pragma unroll
            for (int cb = 0; cb < 4; ++cb) acc[rb][cb] = *(const GAS f32x4*)(base + (size_t)(row0 + rb * 16 + fr) * DM + 512 * p + 64 * w + 4 * fq + 16 * cb);
        v4u greg[2][NG]; bf16x8 bfr[4][4];
        OPR_GLOAD(0);
#pragma unroll
        for (int r = 0; r < 3; ++r)
#pragma unroll
            for (int cb = 0; cb < 4; ++cb) bfr[r][cb] = *(const GAS bf16x8*)((const char*)(Wt + (r * 4 + cb) * 512) + lb);
        OPR_GSTORE(0, 0);
        LDS_WAIT(); __builtin_amdgcn_s_barrier(); asm volatile("" ::: "memory");
#pragma unroll 1
        for (int kc = 0; kc < 8; ++kc) {
            const int kcn = kc < 7 ? kc + 1 : 7;
            OPR_GLOAD(kcn);
            const LAS bf16* Ab = Al + (kc & 1) * (OPR_A_BYTES / 2);
            bf16x8 afn = *(const LAS bf16x8*)(Ab + fr * OPR_AP + fq * 8);
#pragma unroll
            for (int j = 0; j < 4; ++j) {
                const int ks = kc * 4 + j, kn = (ks + 3 < 32) ? ks + 3 : 31;
#pragma unroll
                for (int cb = 0; cb < 4; ++cb) bfr[(j + 3) & 3][cb] = *(const GAS bf16x8*)((const char*)(Wt + (kn * 4 + cb) * 512) + lb);
#pragma unroll
                for (int rb = 0; rb < 4; ++rb) { const bf16x8 af = afn; const int tn = j * 4 + rb + 1, jn = tn >> 2, rn = tn & 3;
                    if (tn < 16) afn = *(const LAS bf16x8*)(Ab + (rn * 16 + fr) * OPR_AP + jn * 32 + fq * 8);
                    __builtin_amdgcn_sched_barrier(0);
#pragma unroll
                    for (int cb = 0; cb < 4; ++cb) acc[rb][cb] = __builtin_amdgcn_mfma_f32_16x16x32_bf16(bfr[j][cb], af, acc[rb][cb], 0, 0, 0);
                    __builtin_amdgcn_sched_barrier(0); }
            }
            if (kc < 7) OPR_GSTORE((kc + 1) & 1, kcn);
            LDS_WAIT(); __builtin_amdgcn_s_barrier(); asm volatile("" ::: "memory");
        }
        { const int l3 = tid_fresh() & 63, fr3 = l3 & 15, fq3 = l3 >> 4;
#pragma unroll
          for (int rb = 0; rb < 4; ++rb) { const size_t off = (size_t)(row0 + rb * 16 + fr3) * DM + 512 * p + 64 * w + 4 * fq3; float ssq = 0.f;
              GAS f32x4* hp = (GAS f32x4*)(H + off); GAS unsigned long long* cp = (GAS unsigned long long*)(hbw + off);
#pragma unroll
              for (int cb = 0; cb < 4; ++cb) { const f32x4 hn = acc[rb][cb]; if (!dry) hp[4 * cb] = hn; ssq += (hn.x * hn.x + hn.y * hn.y) + (hn.z * hn.z + hn.w * hn.w);
                  if (!dry) cp[4 * cb] = (unsigned long long)pk2(hn.x, hn.y) | ((unsigned long long)pk2(hn.z, hn.w) << 32); }
              ssq += __shfl_xor(ssq, 16); ssq += __shfl_xor(ssq, 32);
              if (fq3 == 0) ssl[(rb * 16 + fr3) * 16 + p * 8 + w] = ssq; }
#pragma unroll 1
          for (int half = 0; half < 2; ++half) {
#pragma unroll 1
              for (int v5 = 0; v5 < 2; ++v5) { const LAS float* wv = wrl + (half * 10 + v5 * 5) * DM + 512 * p + 64 * w + 4 * fq3; float pd[5][4];
#pragma unroll
                  for (int q = 0; q < 5; ++q) {
#pragma unroll
                      for (int rb = 0; rb < 4; ++rb) pd[q][rb] = 0.f;
#pragma unroll
                      for (int cb = 0; cb < 4; ++cb) { const f32x4 w4 = *(const LAS f32x4*)(wv + q * DM + 16 * cb);
#pragma unroll
                          for (int rb = 0; rb < 4; ++rb) pd[q][rb] += (acc[rb][cb].x * w4.x + acc[rb][cb].y * w4.y) + (acc[rb][cb].z * w4.z + acc[rb][cb].w * w4.w); } }
#pragma unroll
                  for (int q = 0; q < 5; ++q)
#pragma unroll
                      for (int rb = 0; rb < 4; ++rb) pd[q][rb] += __shfl_xor(pd[q][rb], 16);
#pragma unroll
                  for (int q = 0; q < 5; ++q)
#pragma unroll
                      for (int rb = 0; rb < 4; ++rb) pd[q][rb] += __shfl_xor(pd[q][rb], 32);
                  if (fq3 == 0) {
#pragma unroll
                      for (int q = 0; q < 5; ++q)
#pragma unroll
                          for (int rb = 0; rb < 4; ++rb) part[(rb * 16 + fr3) * 80 + (v5 * 5 + q) * 8 + w] = pd[q][rb]; } }
              LDS_WAIT(); __builtin_amdgcn_s_barrier(); asm volatile("" ::: "memory");
              for (int i = F.tid; i < OPR_ROWS * 10; i += NWAVES * 64) { const int r = i / 10, vv = i - r * 10; const LAS float* pp = part + r * 80 + vv * 8;
                  const float t = ((pp[0] + pp[1]) + (pp[2] + pp[3])) + ((pp[4] + pp[5]) + (pp[6] + pp[7]));
                  LAS float* sp = sums + r * 20 + half * 10 + vv; *sp = (p == 0) ? t : (*sp + t); }
              LDS_WAIT(); __builtin_amdgcn_s_barrier(); asm volatile("" ::: "memory");
          } }
    }
    if (F.tid < OPR_ROWS) { const int m = row0 + F.tid; float tot = 0.f;
#pragma unroll
        for (int i = 0; i < 16; ++i) tot += ssl[F.tid * 16 + i];
        const float rsr = 1.0f / sqrtf(tot * (1.0f / DM) + 1e-6f);
        ((float*)(ws + WS_RSTD))[m] = rsr;
        float d[20];
#pragma unroll
        for (int q = 0; q < 20; ++q) d[q] = sums[F.tid * 20 + q] * rsr;
        const float* gb = a.in(17) + layer * 4;
        float lg[4];
#pragma unroll
        for (int q = 0; q < 4; ++q) lg[q] = d[q] + gb[q];
        int gi = 0; float gm = lg[0];
#pragma unroll
        for (int q = 1; q < 4; ++q) if (lg[q] > gm) { gm = lg[q]; gi = q; }
        float gs = 0.f;
#pragma unroll
        for (int q = 0; q < 4; ++q) gs += expf(lg[q] - gm);
        const float gp = 1.0f / gs;
        const float* ebp = a.in(19) + layer * 16;
        float el[4];
#pragma unroll
        for (int q = 0; q < 4; ++q) { float t = 0.f;
#pragma unroll
            for (int g2 = 0; g2 < 4; ++g2) if (g2 == gi) t = d[4 + 4 * g2 + q] + ebp[4 * g2 + q];
            el[q] = t; }
        int i1 = 0; float v1 = el[0];
#pragma unroll
        for (int q = 1; q < 4; ++q) if (el[q] > v1) { v1 = el[q]; i1 = q; }
        int i2 = -1; float v2 = 0.f;
#pragma unroll
        for (int q = 0; q < 4; ++q) if (q != i1 && (i2 < 0 || el[q] > v2)) { v2 = el[q]; i2 = q; }
        const float e2 = expf(v2 - v1), g1 = gp / (1.0f + e2), g2v = gp * e2 / (1.0f + e2);
        const int lo = i1 < i2 ? i1 : i2, hi = i1 < i2 ? i2 : i1;
        const int pidx = (lo == 0) ? (hi - 1) : (lo == 1 ? hi + 1 : 5);
        const int cls = gi * 6 + pidx;
        if (!dry) {
            const unsigned pp = __hip_atomic_fetch_add((unsigned*)(ws + WS_CTL) + CW_CNT + layer * 64 + cls, 1u, RLX_AGENT);
            ((int*)(ws + WS_LIST))[(size_t)cls * TOK + pp] = m;
            ((float*)(ws + WS_GA))[m] = (i1 < i2) ? g1 : g2v;
            ((float*)(ws + WS_GB))[m] = (i1 < i2) ? g2v : g1;
        }
    }
    __syncthreads();
    }
#undef OPR_GLOAD
#undef OPR_GSTORE
}

__global__ void __launch_bounds__(NWAVES * 64, 2) fwd_kernel(Args args_unused_directly) {
    extern __shared__ __attribute__((aligned(16))) unsigned char lds[];
    Frame F;
    F.lds = (LAS unsigned char*)lds;
    F.tid = threadIdx.x; F.lane = F.tid & 63; F.wave = __builtin_amdgcn_readfirstlane(F.tid >> 6);
    F.G = gridDim.x; { const int bx = blockIdx.x; F.vcu = (F.G % 8 == 0) ? (bx % 8) * (F.G / 8) + bx / 8 : bx; }
    const kptr_t kbase = (kptr_t)__builtin_amdgcn_kernarg_segment_ptr();
    unsigned char* const ws0 = KA{kbase}.ws();
    volatile LAS unsigned* MISC = (volatile LAS unsigned*)(F.lds + MISC_OFF);
    if (F.tid < 64) MISC[F.tid] = 0u;
    __syncthreads();
    const int lo = *(const int __attribute__((address_space(4)))*)(kbase + 208), hi = *(const int __attribute__((address_space(4)))*)(kbase + 212);
    XcdBarrier bar; bar.bar = (unsigned*)(ws0 + WS_CTL) + CW_BAR; bar.x = 0; bar.st = nullptr;
    if (hi - lo > 1) bar = xcd_barrier_post((unsigned*)(ws0 + WS_CTL) + CW_BAR, MISC + 8);
    int pc = 0;
#ifndef PH_EN
#define PH_EN 0xFFFF
#endif
#ifndef REP_MASK
#define REP_MASK 0
#endif
#define RUN(id, ...) RUN_(id, 1, __VA_ARGS__)
#define RUN_(id, bar_, ...) do { if (((PH_EN >> (id)) & 1) && pc >= lo && pc < hi) { \
      for (int rep_ = ((REP_MASK >> (id)) & 1); rep_ >= 0; --rep_) { const bool dry = rep_ > 0; (void)dry; kptr_t kl_ = kbase; asm volatile("" : "+s"(kl_)); const KA args{kl_}; unsigned char* ws = args.ws(); asm volatile("" : "+s"(ws)); ASSUME_GLOBAL(ws); \
        F.tid = tid_fresh(); F.lane = F.tid & 63; F.wave = __builtin_amdgcn_readfirstlane(F.tid >> 6); { const int bx = bid_fresh(); F.vcu = (F.G % 8 == 0) ? (bx % 8) * (F.G / 8) + bx / 8 : bx; } \
        __VA_ARGS__; } } if ((bar_) && pc >= lo && pc + 1 < hi) xcd_barrier(bar); ++pc; } while (0)

    RUN_(0, 0, { p_prologue(args, F); __syncthreads(); });
    for (int l = 0; l < NL; ++l) {
        if (l < NA) {
            RUN(1, p_rowpass<1>(args, F, l, false, l == 0 ? args.in(0) : args.out(), l == 0));
            RUN(2, {

                { const int bx = bid_fresh(); if (bx < BATCH * AH) attn_body::fox_scan((char*)lds + RING_OFF, (const float*)(ws + WS_LOGF) + (size_t)bx * SEQ, (unsigned long long*)(ws + WS_CAUG) + (size_t)bx * SEQ); }
                pg8::Gemm g{(const pg8::bf16_t*)(ws + WS_HB), (const pg8::bf16_t*)(ws + WS_WIN) + (size_t)l * 3072 * DM, TOK, 3072, DM};
                pg8::StaticOrder S; S.init(TOK, 3072, F.G, bid_fresh());
                pg8::EpiAQkv E{(pg8::bf16_t*)(ws + WS_QB), (size_t)(16 * MiB), (const float*)(ws + WS_RSTD), (const float*)(ws + WS_GTAB) + l * 192};
                pg8::gemm_phase<pg8::EpiAQkv, pg8::StaticOrder, true, true>(F.lds + RING_OFF, g, S, E);
            });
            RUN(3, {
                const attn_body::AttnTensors AT{(const attn_body::bf16*)(ws + WS_QB), (const attn_body::bf16*)(ws + WS_QB + 32 * MiB), (const attn_body::bf16*)(ws + WS_QB + 64 * MiB),
                                                (attn_body::bf16*)(ws + (dry ? WS_KB : WS_QB)), (const unsigned long long*)(ws + WS_CAUG)};
                unsigned* cq = (unsigned*)(ws + WS_CTL) + CW_CQ + (l * 2 + (dry ? 1 : 0)) * 64;
                const bool cmain = l == 0; const int clo = cmain ? TR_I_WIN : 0, chi = cmain ? TR_NITEMS : 6144;
                _Pragma("unroll 1") for (int pass = 0; pass < 2; ++pass) {
                    if (pass == 1 || (F.vcu & 3) == 0) conv_drain(args, ws, F, cq, cmain, 2, clo, chi);
                    if (pass == 0) { attn_body::attn_phase_dyn<8>((char*)lds + RING_OFF, AT, (unsigned*)(ws + WS_CTL) + CW_AQ + (l * 2 + (dry ? 1 : 0)) * 64); __syncthreads(); }
                }
            });
            RUN(4, {
                p_opr<false>(args, F, l, (const bf16*)(ws + WS_WOA) + (size_t)l * DM * DM, l == 0 ? args.in(0) : args.out(), dry);
            });
        } else {
            const int j = l - NA;
            RUN(6, {
                const int N = j == 0 ? 5120 : 3072;
                pg8::Gemm g{(const pg8::bf16_t*)(ws + WS_HB), j == 0 ? (const pg8::bf16_t*)(ws + WS_WKVQ0) : (const pg8::bf16_t*)(ws + WS_WQ1), TOK, N, DM};
                pg8::StaticOrder S; S.init(TOK, N, F.G, bid_fresh());
                pg8::EpiBKvq E{(pg8::bf16_t*)(ws + WS_KB), (pg8::bf16_t*)(ws + WS_VB), (pg8::bf16_t*)(ws + WS_QB), (const float*)(ws + WS_RSTD), args.in(10), args.in(13) + j * BG * BHD,
                               (const unsigned*)(ws + WS_ROPEC), j == 0 ? 0 : 8, (PG8_LAS float*)(F.lds + XS_OFF)};
                pg8::gemm_phase<pg8::EpiBKvq, pg8::StaticOrder, true, true>(F.lds + RING_OFF, g, S, E);
            });
            RUN(7, p_battn(args, F, dry));
            RUN(9, {
                if (l == 2) {
                    LAS float* scr = (LAS float*)(F.lds + RING_OFF + F.wave * 16384);
                    tr_run<false>(args, ws, 3, 6144, F.vcu * NWAVES + F.wave, F.G * NWAVES, scr, F.lane);
                    __syncthreads();
                }
                p_opr<true>(args, F, l, (const bf16*)(ws + WS_WOB) + (size_t)j * DM * DM, args.out(), dry);
            });
        }
        RUN(11, p_moe(args, F, l, dry ? 0.f : 1.f));
    }
#undef RUN
}
constexpr int N_PHASES = 1 + NA * 5 + NB * 4;

#ifndef MK_ONE_LAUNCH
#define MK_ONE_LAUNCH 1
#endif
extern "C" void kernel_launch(void* const* d_in, const int* in_sizes, int n_in, void* d_out, int out_size, void* d_ws, size_t ws_size, hipStream_t stream) {
    static int grid = 0;
    if (grid == 0) {
        if (n_in != 23 || out_size != TOK * DM || ws_size < WS_END) { fprintf(stderr, "kernel_launch: unexpected shapes (n_in %d, out %d, ws %zu)\n", n_in, out_size, ws_size); grid = -1; return; }
        int dev = 0, cus = 0;
        if (hipGetDevice(&dev) != hipSuccess || hipDeviceGetAttribute(&cus, hipDeviceAttributeMultiprocessorCount, dev) != hipSuccess) { grid = -1; return; }
        if (hipFuncSetAttribute((const void*)fwd_kernel, hipFuncAttributeMaxDynamicSharedMemorySize, LDS_BYTES) != hipSuccess) { fprintf(stderr, "kernel_launch: hipFuncSetAttribute failed\n"); grid = -1; return; }
        int per_cu = 0;
        if (hipOccupancyMaxActiveBlocksPerMultiprocessor(&per_cu, (const void*)fwd_kernel, NWAVES * 64, LDS_BYTES) != hipSuccess || per_cu < 1) fprintf(stderr, "kernel_launch: occupancy query says %d\n", per_cu);
        (void)hipGetLastError();
        grid = cus;
    }
    if (grid < 0) return;
    if (hipMemsetAsync((char*)d_ws + WS_CTL, 0, CTL_ZERO_BYTES, stream) != hipSuccess) return;
    Args a{};
    for (int i = 0; i < 23; ++i) a.in[i] = (const float*)d_in[i];
    a.in[23] = nullptr;
    a.out = (float*)d_out; a.ws = (unsigned char*)d_ws;
#if MK_ONE_LAUNCH
    a.ph_lo = 0; a.ph_hi = N_PHASES;
    hipLaunchKernelGGL(fwd_kernel, dim3(grid), dim3(NWAVES * 64), LDS_BYTES, stream, a);
#else
    for (int p = 0; p < N_PHASES; ++p) { a.ph_lo = p; a.ph_hi = p + 1;
        hipLaunchKernelGGL(fwd_kernel, dim3(grid), dim3(NWAVES * 64), LDS_BYTES, stream, a); }
#endif
}
```

```cpp
#include <hip/hip_runtime.h>
#include <hip/hip_bf16.h>
#include <cstdio>
#include <cstdint>
#include <cmath>
__device__ __forceinline__ int tid_fresh() { int t = (int)threadIdx.x; asm volatile("" : "+v"(t)); return t; }
__device__ __forceinline__ int bid_fresh() { int t = (int)blockIdx.x; asm volatile("" : "+s"(t)); return t; }
#if defined(__HIP_DEVICE_COMPILE__)
#define ASSUME_GLOBAL(p_) do { __builtin_assume(!__builtin_amdgcn_is_shared((const void*)(p_))); __builtin_assume(!__builtin_amdgcn_is_private((const void*)(p_))); } while (0)
#else
#define ASSUME_GLOBAL(p_) do { } while (0)
#endif
namespace pg8 {
#define PG8_LAS __attribute__((address_space(3)))
typedef unsigned short bf16_t;
typedef short bf16x8 __attribute__((ext_vector_type(8)));
typedef float f32x4 __attribute__((ext_vector_type(4)));
typedef unsigned u32x4 __attribute__((ext_vector_type(4)));
constexpr int BM = 256, BK = 64, HALF = 128, HTB = HALF * BK * 2  , STAGE_BYTES = 8 * HTB, NXCD = 8, WGM = 8;

__host__ __device__ __forceinline__ int lds_byte(int r, int c) { const int st = (r >> 4) * 2 + (c >> 5), rr = r & 15, cc = c & 31, ob = rr * 64 + cc * 2; return st * 1024 + (ob ^ (((ob >> 9) & 1) << 5)); }
__host__ __device__ __forceinline__ void stage_rc(int b, int& R, int& C) { const int st = b / 1024, sb = b % 1024, swz = sb ^ (((sb >> 9) & 1) << 5); R = (st >> 1) * 16 + swz / 64; C = (st & 1) * 32 + (swz % 64) / 2; }
__host__ __device__ __forceinline__ int perm32(int rho) { const int n = rho >> 4, i = rho & 15; return 8 * (i >> 2) + 4 * n + (i & 3); }

struct Unit { int pm, pn; };
struct Gemm { const bf16_t* A; const bf16_t* Bt; int M, N, K; };

struct StaticOrder {
    int nM, nN, nwg, G, c;
    __host__ __device__ void init(int M, int N, int G_, int c_) { nM = M / BM; nN = N / BM; nwg = nM * nN; G = G_; c = c_; }
    __host__ __device__ bool next(int i, Unit& u) const {
        const long L = (long)i * G + c; if (L >= nwg) return false;
        int wgid = (int)L; { const int q = nwg / NXCD, r = nwg % NXCD, xcd = wgid % NXCD, off = wgid / NXCD; wgid = (xcd < r ? xcd * (q + 1) : r * (q + 1) + (xcd - r) * q) + off; }
        const int nig = WGM * nN, gid = wgid / nig, fm = gid * WGM, gsz = (nM - fm) < WGM ? (nM - fm) : WGM;
        u.pm = fm + ((wgid % nig) % gsz); u.pn = (wgid % nig) / gsz; return true;
    }
    __device__ __forceinline__ void a_ready(const Unit&) const {}
    __device__ __forceinline__ void done(const Unit&) const {}
};

__device__ __forceinline__ unsigned cvt_pk_bf16(float lo, float hi) { unsigned r; asm volatile("v_cvt_pk_bf16_f32 %0, %1, %2" : "=v"(r) : "v"(lo), "v"(hi)); return r; }
typedef float f32x2 __attribute__((ext_vector_type(2)));
constexpr float RMS_EPS = 1e-6f;
#define PG8_GAS __attribute__((address_space(1)))
__device__ __forceinline__ void st16(bf16_t* p, const float (&o)[8]) { u32x4 w; w.x = cvt_pk_bf16(o[0], o[1]); w.y = cvt_pk_bf16(o[2], o[3]); w.z = cvt_pk_bf16(o[4], o[5]); w.w = cvt_pk_bf16(o[6], o[7]); *(PG8_GAS u32x4*)p = w; }
struct EpiAQkv {
    static constexpr bool PERM = true, AFTER_DRAIN = false;
    bf16_t* QKV; size_t sec_stride; const float* rstd; const float* gtab;
    __device__ __forceinline__ void operator()(const f32x4 (&acc)[2][2][4][2], const Unit& u, int wr, int wc, int fr, int fq) const {
        const int sec = u.pn >> 2, head = (u.pn & 3) * 4 + wc;
        bf16_t* dst = QKV + (size_t)sec * sec_stride + head * 64 + 8 * fq;
        const float* gp = gtab + sec * 64 + 8 * fq;
        const bool nrm = sec < 2;
        float rsv[2][4]; const float* rp = rstd + u.pm * BM + wr * 64 + fr;
#pragma unroll
        for (int ai = 0; ai < 2; ++ai)
#pragma unroll
            for (int m = 0; m < 4; ++m) rsv[ai][m] = *(const PG8_GAS float*)(rp + ai * HALF + m * 16);
        f32x4 g[2][2];
#pragma unroll
        for (int bj = 0; bj < 2; ++bj)
#pragma unroll
            for (int n = 0; n < 2; ++n) g[bj][n] = *(const PG8_GAS f32x4*)(gp + 32 * bj + 4 * n);
#pragma unroll
        for (int ai = 0; ai < 2; ++ai)
#pragma unroll
            for (int m = 0; m < 4; ++m) {
                const int row = u.pm * BM + ai * HALF + wr * 64 + m * 16 + fr;
                const float rs = rsv[ai][m];
                f32x4 v[2][2];
#pragma unroll
                for (int bj = 0; bj < 2; ++bj)
#pragma unroll
                    for (int n = 0; n < 2; ++n) v[bj][n] = acc[ai][bj][m][n] * rs;
                float s = 0.f;
#pragma unroll
                for (int bj = 0; bj < 2; ++bj)
#pragma unroll
                    for (int n = 0; n < 2; ++n) { const f32x4 x = v[bj][n]; s += (x[0] * x[0] + x[1] * x[1]) + (x[2] * x[2] + x[3] * x[3]); }
                s += __shfl_xor(s, 16); s += __shfl_xor(s, 32);
                const float sc = nrm ? __builtin_amdgcn_rsqf(s * (1.0f / 64.0f) + RMS_EPS) : 1.0f;
#pragma unroll
                for (int bj = 0; bj < 2; ++bj) { const f32x4 o0 = v[bj][0] * sc * g[bj][0], o1 = v[bj][1] * sc * g[bj][1];
                    u32x4 w; w.x = cvt_pk_bf16(o0[0], o0[1]); w.y = cvt_pk_bf16(o0[2], o0[3]); w.z = cvt_pk_bf16(o1[0], o1[1]); w.w = cvt_pk_bf16(o1[2], o1[3]);
                    *(PG8_GAS u32x4*)(dst + (size_t)row * 1024 + 32 * bj) = w; }
            }
    }
};
struct EpiBKvq {
    static constexpr bool PERM = true, AFTER_DRAIN = false;
    bf16_t *KB, *VB, *QB; const float* rstd; const float *kg, *qg  ; const unsigned* rcs  ; int tile_off; PG8_LAS float* xs;
    __device__ __forceinline__ void operator()(const f32x4 (&acc)[2][2][4][2], const Unit& u, int wr, int wc, int fr, int fq) const {
        const int T = u.pn + tile_off;
        float rsv[2][4]; const float* rp = rstd + u.pm * BM + wr * 64 + fr;
#pragma unroll
        for (int ai = 0; ai < 2; ++ai)
#pragma unroll
            for (int m = 0; m < 4; ++m) rsv[ai][m] = *(const PG8_GAS float*)(rp + ai * HALF + m * 16);
        if (T >= 4 && T < 8) {
            bf16_t* dst = VB + (T - 4) * 256 + 32 * wc + 8 * fq;
#pragma unroll
            for (int ai = 0; ai < 2; ++ai)
#pragma unroll
                for (int m = 0; m < 4; ++m) {
                    const int row = u.pm * BM + ai * HALF + wr * 64 + m * 16 + fr; const float rs = rsv[ai][m];
#pragma unroll
                    for (int bj = 0; bj < 2; ++bj) { float o[8];
#pragma unroll
                        for (int n = 0; n < 2; ++n)
#pragma unroll
                            for (int e = 0; e < 4; ++e) o[4 * n + e] = acc[ai][bj][m][n][e] * rs;
                        st16(dst + (size_t)row * 1024 + 128 * bj, o); }
                }
            return;
        }
        const bool isq = T >= 8; const int grp = isq ? ((T - 8) >> 2) : 0, head = (isq ? ((T - 8) & 3) : T) * 2 + (wc >> 1);
        const int d1 = 32 * (wc & 1) + 8 * fq;
        const float* gp = isq ? (qg + grp * 128) : kg;
        f32x4 g[2][2];
#pragma unroll
        for (int bj = 0; bj < 2; ++bj)
#pragma unroll
            for (int n = 0; n < 2; ++n) g[bj][n] = *(const PG8_GAS f32x4*)(gp + 64 * bj + d1 + 4 * n);
        const unsigned* rcp = rcs + (size_t)(u.pm * BM + wr * 64 + fr) * 64 + d1;
        u32x4 rn0 = *(const PG8_GAS u32x4*)(rcp), rn1 = *(const PG8_GAS u32x4*)(rcp + 4);
        float ss[2][4];
#pragma unroll
        for (int ai = 0; ai < 2; ++ai)
#pragma unroll
            for (int m = 0; m < 4; ++m) {
                const float rs = rsv[ai][m];
                float s = 0.f;
#pragma unroll
                for (int bj = 0; bj < 2; ++bj)
#pragma unroll
                    for (int n = 0; n < 2; ++n) { const f32x4 x = acc[ai][bj][m][n] * rs; s += (x[0] * x[0] + x[1] * x[1]) + (x[2] * x[2] + x[3] * x[3]); }
                s += __shfl_xor(s, 16); s += __shfl_xor(s, 32);
                ss[ai][m] = s;
                if (fq == 0) xs[(ai * HALF + wr * 64 + m * 16 + fr) * 4 + wc] = s;
            }
        asm volatile("s_waitcnt lgkmcnt(0)" ::: "memory"); __builtin_amdgcn_s_barrier(); asm volatile("" ::: "memory");
        bf16_t* dst = isq ? (QB + grp * 1024 + head * 128 + d1) : (KB + head * 128 + d1);
        const size_t pitch = isq ? 3072 : 1024;
#pragma unroll
        for (int ai = 0; ai < 2; ++ai)
#pragma unroll
            for (int m = 0; m < 4; ++m) {
                const int rl = ai * HALF + wr * 64 + m * 16 + fr, row = u.pm * BM + rl; const float rs = rsv[ai][m];
                const u32x4 rc0 = rn0, rc1 = rn1;
                { const int gi = ai * 4 + m + 1, an = (gi >> 2) & 1, mn = gi & 3; rn0 = *(const PG8_GAS u32x4*)(rcp + (size_t)(an * HALF + mn * 16) * 64); rn1 = *(const PG8_GAS u32x4*)(rcp + (size_t)(an * HALF + mn * 16) * 64 + 4); }
                const float tot = ss[ai][m] + xs[rl * 4 + (wc ^ 1)];
                const float sc = rs * __builtin_amdgcn_rsqf(tot * (1.0f / 128.0f) + RMS_EPS);
                float o1[8], o2[8];
#pragma unroll
                for (int n = 0; n < 2; ++n)
#pragma unroll
                    for (int e = 0; e < 4; ++e) { const int j = 4 * n + e;
                        const float y1 = acc[ai][0][m][n][e] * sc * g[0][n][e], y2 = acc[ai][1][m][n][e] * sc * g[1][n][e];
                        const unsigned cw = n ? rc1[e] : rc0[e];
                        const float c = (float)__builtin_bit_cast(_Float16, (unsigned short)(cw & 0xffffu)), sn = (float)__builtin_bit_cast(_Float16, (unsigned short)(cw >> 16));
                        o1[j] = y1 * c - y2 * sn; o2[j] = y2 * c + y1 * sn; }
                st16(dst + (size_t)row * pitch, o1); st16(dst + (size_t)row * pitch + 64, o2);
            }
        asm volatile("s_waitcnt lgkmcnt(0)" ::: "memory"); __builtin_amdgcn_s_barrier(); asm volatile("" ::: "memory");
    }
};
struct EpiResid {
    static constexpr bool PERM = true, AFTER_DRAIN = false;
    const float* B; float* H; float upd;
    __device__ __forceinline__ void operator()(const f32x4 (&acc)[2][2][4][2], const Unit& u, int wr, int wc, int fr, int fq) const {
        const size_t r0 = (size_t)(u.pm * BM + wr * 64 + fr) * 1024 + u.pn * BM + wc * 32 + 8 * fq;
        const float* bp = B + r0; float* hp = H + r0;
        f32x4 nx[2][2];
#pragma unroll
        for (int bj = 0; bj < 2; ++bj)
#pragma unroll
            for (int n = 0; n < 2; ++n) nx[bj][n] = *(const PG8_GAS f32x4*)(bp + bj * HALF + 4 * n);
#pragma unroll
        for (int ai = 0; ai < 2; ++ai)
#pragma unroll
            for (int m = 0; m < 4; ++m) { const size_t ro = (size_t)(ai * HALF + m * 16) * 1024;
                f32x4 cu[2][2];
#pragma unroll
                for (int bj = 0; bj < 2; ++bj)
#pragma unroll
                    for (int n = 0; n < 2; ++n) cu[bj][n] = nx[bj][n];
                { const int gi = ai * 4 + m + 1, an = (gi >> 2) & 1, mn = gi & 3; const size_t rn = (size_t)(an * HALF + mn * 16) * 1024;
#pragma unroll
                  for (int bj = 0; bj < 2; ++bj)
#pragma unroll
                      for (int n = 0; n < 2; ++n) nx[bj][n] = *(const PG8_GAS f32x4*)(bp + rn + bj * HALF + 4 * n); }
#pragma unroll
                for (int bj = 0; bj < 2; ++bj)
#pragma unroll
                    for (int n = 0; n < 2; ++n) *(PG8_GAS f32x4*)(hp + ro + bj * HALF + 4 * n) = cu[bj][n] + acc[ai][bj][m][n] * upd; }
    }
};

template <class Epi, class Sched, bool ALIGN_EPI = false, bool SP2 = false>
__device__ __forceinline__ void gemm_phase(PG8_LAS unsigned char* lds, const Gemm g, const Sched& S, const Epi& E) {
    const int tid = tid_fresh(), wid = __builtin_amdgcn_readfirstlane(tid >> 6), lane = tid & 63, wr = wid >> 2, wc = wid & 3, fr = lane & 15, fq = lane >> 4;
    const int K = g.K, nt = K / BK;
    unsigned voffA[2], voffB[2];
#pragma unroll
    for (int i = 0; i < 2; ++i) { int R, C; stage_rc(tid * 16 + i * 8192, R, C); const int Rb = Epi::PERM ? ((R & ~31) + perm32(R & 31)) : R;
        voffA[i] = (unsigned)(R * K + C) * 2u; voffB[i] = (unsigned)(Rb * K + C) * 2u; }
    const size_t kstep = (size_t)(BK * 2);
    const size_t hstep = (size_t)HALF * K * 2;
    const size_t tstep = 2 * hstep;
    const unsigned ldsw = (unsigned)wid * 1024u;
    const int aoff = lds_byte(wr * 64 + fr, fq * 8), boff = lds_byte(wc * 32 + fr, fq * 8);
#define PG8_SA(b, h) (((b) * 2 + (h)) * HTB)
#define PG8_SB(b, h) ((4 + (b) * 2 + (h)) * HTB)
#define PG8_STAGE(bufoff, gbase, voff) do { _Pragma("unroll") for (int _i = 0; _i < 2; ++_i) \
        __builtin_amdgcn_global_load_lds((const unsigned*)((const char*)(gbase) + (voff)[_i]), (PG8_LAS unsigned*)(lds + (bufoff) + ldsw + _i * 8192), 16, 0, 0); } while (0)
#define PG8_LDA(dst, b, h) do { _Pragma("unroll") for (int m = 0; m < 4; ++m) _Pragma("unroll") for (int k = 0; k < 2; ++k) dst[m][k] = *(const PG8_LAS bf16x8*)(lds + PG8_SA(b, h) + aoff + m * 2048 + k * 1024); } while (0)
#define PG8_LDB(dst, b, h) do { _Pragma("unroll") for (int n = 0; n < 2; ++n) _Pragma("unroll") for (int k = 0; k < 2; ++k) dst[n][k] = *(const PG8_LAS bf16x8*)(lds + PG8_SB(b, h) + boff + n * 2048 + k * 1024); } while (0)
#define PG8_MMA(ai, bj, At, Bt) do { __builtin_amdgcn_s_setprio(1); _Pragma("unroll") for (int m = 0; m < 4; ++m) _Pragma("unroll") for (int n = 0; n < 2; ++n) _Pragma("unroll") for (int k = 0; k < 2; ++k) \
        acc[ai][bj][m][n] = __builtin_amdgcn_mfma_f32_16x16x32_bf16(Bt[n][k], At[m][k], acc[ai][bj][m][n], 0, 0, 0); __builtin_amdgcn_s_setprio(0); } while (0)
#define PG8_WAIT_V(n) asm volatile("s_waitcnt vmcnt(" #n ")" ::: "memory")
#define PG8_WAIT_L(n) asm volatile("s_waitcnt lgkmcnt(" #n ")" ::: "memory")
#define PG8_BAR __builtin_amdgcn_s_barrier()
#define PG8_SCHED __builtin_amdgcn_sched_barrier(0)
    Unit cur, nxt; int ui = 0;
    if (!S.next(0, cur)) return;
    f32x4 acc[2][2][4][2];
#pragma unroll
    for (int a = 0; a < 2; ++a)
#pragma unroll
        for (int b = 0; b < 2; ++b)
#pragma unroll
            for (int m = 0; m < 4; ++m)
#pragma unroll
                for (int n = 0; n < 2; ++n) acc[a][b][m][n] = (f32x4){0.f, 0.f, 0.f, 0.f};
    bf16x8 At[4][2], B0[2][2], B1[2][2];
    const char* cA = (const char*)g.A + (size_t)cur.pm * tstep; const char* cB = (const char*)g.Bt + (size_t)cur.pn * tstep;
    S.a_ready(cur);
    if constexpr (SP2) {
        PG8_STAGE(PG8_SB(0, 0), cB, voffB); PG8_STAGE(PG8_SB(0, 1), cB + hstep, voffB); PG8_STAGE(PG8_SA(0, 0), cA, voffA); PG8_STAGE(PG8_SA(0, 1), cA + hstep, voffA);
        if (wr == 1) PG8_BAR;
        PG8_WAIT_V(2); PG8_BAR;
        PG8_STAGE(PG8_SB(1, 0), cB + kstep, voffB); PG8_STAGE(PG8_SA(1, 0), cA + kstep, voffA); PG8_STAGE(PG8_SB(1, 1), cB + hstep + kstep, voffB);
        PG8_WAIT_V(6); PG8_BAR;
    } else {
        PG8_STAGE(PG8_SB(0, 0), cB, voffB); PG8_STAGE(PG8_SA(0, 0), cA, voffA); PG8_STAGE(PG8_SB(0, 1), cB + hstep, voffB); PG8_STAGE(PG8_SA(0, 1), cA + hstep, voffA);
        if (wr == 1) PG8_BAR;
        PG8_WAIT_V(4); PG8_BAR;
        PG8_STAGE(PG8_SB(1, 0), cB + kstep, voffB); PG8_STAGE(PG8_SA(1, 0), cA + kstep, voffA); PG8_STAGE(PG8_SB(1, 1), cB + hstep + kstep, voffB);
        PG8_WAIT_V(6); PG8_BAR;
    }
    for (;;) {
        const bool has_next = S.next(ui + 1, nxt);
        const char* nA = has_next ? (const char*)g.A + (size_t)nxt.pm * tstep : cA; const char* nB = has_next ? (const char*)g.Bt + (size_t)nxt.pn * tstep : cB;
        for (int t = 0; t < nt; t += 2) {
            const bool last = (t == nt - 2);
            const char* a1 = cA + (size_t)(t + 1) * kstep;
            const char* a2 = last ? nA : cA + (size_t)(t + 2) * kstep; const char* b2 = last ? nB : cB + (size_t)(t + 2) * kstep;
            const char* a3 = a2 + kstep; const char* b3 = b2 + kstep;
            if (last && has_next) S.a_ready(nxt);
            if constexpr (SP2) {
            PG8_LDB(B0, 0, 0); PG8_LDB(B1, 0, 1); PG8_SCHED; PG8_LDA(At, 0, 0); PG8_STAGE(PG8_SA(1, 1), a1 + hstep, voffA);
            PG8_WAIT_V(8); PG8_WAIT_L(0); PG8_BAR; PG8_MMA(0, 0, At, B0); PG8_MMA(0, 1, At, B1); PG8_BAR; PG8_SCHED;
            PG8_LDA(At, 0, 1); PG8_STAGE(PG8_SB(0, 0), b2, voffB); PG8_STAGE(PG8_SB(0, 1), b2 + hstep, voffB); PG8_STAGE(PG8_SA(0, 0), a2, voffA);
            PG8_WAIT_V(8); PG8_WAIT_L(0); PG8_BAR; PG8_MMA(1, 0, At, B0); PG8_MMA(1, 1, At, B1); PG8_BAR; PG8_SCHED;
            PG8_LDB(B0, 1, 0); PG8_LDB(B1, 1, 1); PG8_SCHED; PG8_LDA(At, 1, 0); PG8_STAGE(PG8_SA(0, 1), a2 + hstep, voffA);
            PG8_WAIT_V(8); PG8_WAIT_L(0); PG8_BAR; PG8_MMA(0, 0, At, B0); PG8_MMA(0, 1, At, B1); PG8_BAR; PG8_SCHED;
            PG8_LDA(At, 1, 1); PG8_STAGE(PG8_SB(1, 0), b3, voffB); PG8_STAGE(PG8_SB(1, 1), b3 + hstep, voffB); PG8_STAGE(PG8_SA(1, 0), a3, voffA);
            PG8_WAIT_V(8); PG8_WAIT_L(0); PG8_BAR; PG8_MMA(1, 0, At, B0); PG8_MMA(1, 1, At, B1); PG8_BAR; PG8_SCHED;
            } else {
            PG8_LDB(B0, 0, 0); PG8_SCHED; PG8_LDA(At, 0, 0); PG8_STAGE(PG8_SA(1, 1), a1 + hstep, voffA);
            PG8_WAIT_L(8); PG8_BAR; PG8_WAIT_L(0); PG8_MMA(0, 0, At, B0); PG8_BAR; PG8_SCHED;
            PG8_LDB(B1, 0, 1); PG8_STAGE(PG8_SB(0, 0), b2, voffB);
            PG8_BAR; PG8_WAIT_L(0); PG8_MMA(0, 1, At, B1); PG8_BAR;
            PG8_LDA(At, 0, 1); PG8_STAGE(PG8_SA(0, 0), a2, voffA);
            PG8_BAR; PG8_WAIT_L(0); PG8_MMA(1, 0, At, B0); PG8_BAR; PG8_SCHED;
            PG8_STAGE(PG8_SB(0, 1), b2 + hstep, voffB);
            PG8_WAIT_V(6); PG8_BAR; PG8_MMA(1, 1, At, B1); PG8_BAR;
            PG8_LDB(B0, 1, 0); PG8_SCHED; PG8_LDA(At, 1, 0); PG8_STAGE(PG8_SA(0, 1), a2 + hstep, voffA);
            PG8_WAIT_L(8); PG8_BAR; PG8_WAIT_L(0); PG8_MMA(0, 0, At, B0); PG8_BAR; PG8_SCHED;
            PG8_LDB(B1, 1, 1); PG8_STAGE(PG8_SB(1, 0), b3, voffB);
            PG8_BAR; PG8_WAIT_L(0); PG8_MMA(0, 1, At, B1); PG8_BAR;
            PG8_LDA(At, 1, 1); PG8_STAGE(PG8_SA(1, 0), a3, voffA);
            PG8_BAR; PG8_WAIT_L(0); PG8_MMA(1, 0, At, B0); PG8_BAR; PG8_SCHED;
            PG8_STAGE(PG8_SB(1, 1), b3 + hstep, voffB);
            PG8_WAIT_V(6); PG8_BAR; PG8_MMA(1, 1, At, B1); PG8_BAR;
            }
        }
        if constexpr (ALIGN_EPI) { if (wr == 0) PG8_BAR; }
        if constexpr (!Epi::AFTER_DRAIN) { E(acc, cur, wr, wc, fr, fq); S.done(cur); }
        if (!has_next) break;
#pragma unroll
        for (int a = 0; a < 2; ++a)
#pragma unroll
            for (int b = 0; b < 2; ++b)
#pragma unroll
                for (int m = 0; m < 4; ++m)
#pragma unroll
                    for (int n = 0; n < 2; ++n) acc[a][b][m][n] = (f32x4){0.f, 0.f, 0.f, 0.f};
        cur = nxt; cA = nA; cB = nB; ++ui;
        if constexpr (ALIGN_EPI) { if (wr == 1) PG8_BAR; }
    }
    PG8_WAIT_V(0);
    if constexpr (!ALIGN_EPI) { if (wr == 0) PG8_BAR; }
    PG8_BAR;
    if constexpr (Epi::AFTER_DRAIN) { E.fused(acc, cur, wr, wc, fr, fq, lds, wid, lane); S.done(cur); }
#undef PG8_SA
#undef PG8_SB
#undef PG8_STAGE
#undef PG8_LDA
#undef PG8_LDB
#undef PG8_MMA
#undef PG8_WAIT_V
#undef PG8_WAIT_L
#undef PG8_BAR
#undef PG8_SCHED
}
}

#ifndef PG8_SP2
#define PG8_SP2 true
#endif
#ifndef PG8_ALIGN
#define PG8_ALIGN true
#endif

namespace attn_body {
using bf16=__hip_bfloat16;
using bf16x8=__attribute__((ext_vector_type(8)))short;
using s16x4=__attribute__((ext_vector_type(4)))short;
using f32x16=__attribute__((ext_vector_type(16)))float;
using u32x4=__attribute__((ext_vector_type(4)))unsigned;
constexpr int BATCH=2,NHEAD=16,SEQ=8192,D=64,DM=NHEAD*D;
constexpr int NW=8,QBLK=32,QB=QBLK*NW,KVBLK=64,NQB=SEQ/QB;
constexpr int ATTN_PITCH=DM, ATTN_UNIT_ROWS=QB;
__device__ __forceinline__ int crow(int r,int hi){return (r&3)+8*(r>>2)+4*hi;}
#define SBAR() __builtin_amdgcn_sched_barrier(0)
__device__ __forceinline__ void cmask(f32x16&p0,f32x16&p1,int jb,int qrel,int hi){
  const float NEG=-INFINITY; int kb=64*jb+4*hi;
  #pragma unroll
  for(int r=0;r<16;++r){int kv=kb+(r&3)+8*(r>>2); if(kv>qrel)p0[r]=NEG; if(kv+32>qrel)p1[r]=NEG;}
}

constexpr int NSLOT=3, SLOTB=8192;
constexpr int LDS_K=0, LDS_V=NSLOT*SLOTB, LDS_WS=2*NSLOT*SLOTB, LDS_OST=LDS_WS+NW*64*4, LDS_BYTES=LDS_OST+NW*4096;
constexpr float C2=0.125f*1.4426950408889634f;
__device__ __forceinline__ void glds16(const void*gsrc,unsigned lds_dst){unsigned keep;
  asm volatile("s_mov_b32 %0, m0\n\ts_mov_b32 m0, %2\n\ts_nop 0\n\tglobal_load_lds_dwordx4 %1, off\n\ts_mov_b32 m0, %0":"=&s"(keep):"v"(gsrc),"s"(lds_dst):"memory");}
__device__ __forceinline__ float max3f(float a,float b,float c){float r;asm("v_max3_f32 %0, %1, %2, %3":"=v"(r):"v"(a),"v"(b),"v"(c));return r;}
__device__ __forceinline__ float max2f(float a,float b){float r;asm("v_max_f32_e32 %0, %1, %2":"=v"(r):"v"(a),"v"(b));return r;}
__device__ __forceinline__ float fadd_s(float a,float b){float r;asm("v_add_f32_e32 %0, %1, %2":"=v"(r):"v"(a),"v"(b));return r;}
__device__ __forceinline__ float fsub_s(float a,float b){float r;asm("v_sub_f32_e32 %0, %1, %2":"=v"(r):"v"(a),"v"(b));return r;}
typedef float f32x2_t __attribute__((ext_vector_type(2))); typedef __bf16 bf16x2_t __attribute__((ext_vector_type(2)));
__device__ __forceinline__ unsigned cvtpk_s(float lo,float hi){f32x2_t v={lo,hi};bf16x2_t b=__builtin_convertvector(v,bf16x2_t);return __builtin_bit_cast(unsigned,b);}
#define WAIT_BAR(N) asm volatile("s_waitcnt vmcnt(" #N ") lgkmcnt(0)\n\ts_barrier":::"memory")

__device__ __forceinline__ void qkt(f32x16&p0,f32x16&p1,const char*Kslot,const bf16x8*qr,const f32x16&negm,int r32,int hi,s16x4 ka0,s16x4 ka1,s16x4 qa){
  const char*kb=Kslot+hi*1024+r32*16;
  #pragma unroll
  for(int d0=0;d0<4;++d0){
    const bf16x8 b0=*reinterpret_cast<const bf16x8*>(kb+d0*2048);
    const bf16x8 b1=*reinterpret_cast<const bf16x8*>(kb+d0*2048+512);
    if(d0==0){p0=__builtin_amdgcn_mfma_f32_32x32x16_bf16(b0,qr[0],negm,0,0,0);p1=__builtin_amdgcn_mfma_f32_32x32x16_bf16(b1,qr[0],negm,0,0,0);}
    else{p0=__builtin_amdgcn_mfma_f32_32x32x16_bf16(b0,qr[d0],p0,0,0,0);p1=__builtin_amdgcn_mfma_f32_32x32x16_bf16(b1,qr[d0],p1,0,0,0);}}
  p0=__builtin_amdgcn_mfma_f32_32x32x8bf16_1k(ka0,qa,p0,0,0,0);p1=__builtin_amdgcn_mfma_f32_32x32x8bf16_1k(ka1,qa,p1,0,0,0);
}
typedef __attribute__((address_space(3))) const char* lds_cptr;
typedef short v4i16_t __attribute__((ext_vector_type(4)));
__device__ __forceinline__ void kload8(bf16x8*kf,lds_cptr kp){
  kf[0]=*(const __attribute__((address_space(3))) bf16x8*)(kp);      kf[1]=*(const __attribute__((address_space(3))) bf16x8*)(kp+512);
  kf[2]=*(const __attribute__((address_space(3))) bf16x8*)(kp+2048); kf[3]=*(const __attribute__((address_space(3))) bf16x8*)(kp+2560);
  kf[4]=*(const __attribute__((address_space(3))) bf16x8*)(kp+4096); kf[5]=*(const __attribute__((address_space(3))) bf16x8*)(kp+4608);
  kf[6]=*(const __attribute__((address_space(3))) bf16x8*)(kp+6144); kf[7]=*(const __attribute__((address_space(3))) bf16x8*)(kp+6656);
}
__device__ __forceinline__ void kload2(bf16x8*kf,lds_cptr kp,int j){ kf[2*j]=*(const __attribute__((address_space(3))) bf16x8*)(kp+j*2048); kf[2*j+1]=*(const __attribute__((address_space(3))) bf16x8*)(kp+j*2048+512); }
__device__ __forceinline__ s16x4 vtr(lds_cptr p){ return __builtin_bit_cast(s16x4,__builtin_amdgcn_ds_read_tr16_b64_v4i16((__attribute__((address_space(3))) v4i16_t*)p)); }
__device__ __forceinline__ float rowmax(const f32x16&p0,const f32x16&p1){
  float a=max3f(p0[0],p0[1],p1[0]),b=max3f(p0[2],p0[3],p1[1]);a=max3f(a,p1[2],p1[3]);
  #pragma unroll
  for(int r=4;r<16;r+=4){a=max3f(a,p0[r],p0[r+1]);b=max3f(b,p0[r+2],p0[r+3]);a=max3f(a,p1[r],p1[r+1]);b=max3f(b,p1[r+2],p1[r+3]);}
  const float m=max2f(a,b);
  auto rr=__builtin_amdgcn_permlane32_swap(__float_as_uint(m),__float_as_uint(m),false,false);
  return max2f(__uint_as_float(rr[0]),__uint_as_float(rr[1]));
}
__device__ __forceinline__ void pv(f32x16*o,int vb,bf16x8 pa0,bf16x8 pa1,bf16x8 pa2,bf16x8 pa3){
  #pragma unroll
  for(int d0=0;d0<2;++d0){s16x4 lo[4],hi[4];
    #pragma unroll
    for(int ks=0;ks<4;++ks){
      asm volatile("ds_read_b64_tr_b16 %0,%1 offset:%c2":"=&v"(lo[ks]):"v"(vb),"i"(d0*4096+ks*1024):"memory");
      asm volatile("ds_read_b64_tr_b16 %0,%1 offset:%c2":"=&v"(hi[ks]):"v"(vb),"i"(d0*4096+ks*1024+512):"memory");}
    asm volatile("s_waitcnt lgkmcnt(0)":::"memory");SBAR();
    #define PK(k) (bf16x8){lo[k][0],lo[k][1],lo[k][2],lo[k][3],hi[k][0],hi[k][1],hi[k][2],hi[k][3]}
    o[d0]=__builtin_amdgcn_mfma_f32_32x32x16_bf16(pa0,PK(0),o[d0],0,0,0);
    o[d0]=__builtin_amdgcn_mfma_f32_32x32x16_bf16(pa1,PK(1),o[d0],0,0,0);
    o[d0]=__builtin_amdgcn_mfma_f32_32x32x16_bf16(pa2,PK(2),o[d0],0,0,0);
    o[d0]=__builtin_amdgcn_mfma_f32_32x32x16_bf16(pa3,PK(3),o[d0],0,0,0);
    #undef PK
  }
}

#ifndef ATTN_STORE16
#define ATTN_STORE16(p,v) (*(u32x4*)(p)=(v))
#endif
template<int THRL> __device__ __forceinline__ void attn_unit(int b,int h,int qb,int t0,const bf16*Q,const bf16*__restrict__ K,const bf16*__restrict__ V,bf16*O,char*shm){
  const int tid=tid_fresh(),lane=tid&63,r32=lane&31,hi=lane>>5; const int wid=__builtin_amdgcn_readfirstlane(tid>>6);
  const long rowbase=(long)b*SEQ; const int q0=qb*QB;
  const bf16*Qw=Q+(rowbase+q0+wid*QBLK)*DM+h*D;
  const bf16*Kh=K+(rowbase+(long)t0*KVBLK)*DM+h*D,*Vh=V+(rowbase+(long)t0*KVBLK)*DM+h*D;
  const unsigned lds0=(unsigned)(uintptr_t)shm;
  float*wsf=(float*)(shm+LDS_WS)+wid*64;
  const bf16*ksrc=Kh+(long)lane*DM+wid*8;
  const bf16*vsrc=Vh+(long)(16*(wid&3)+(lane>>2))*DM+(wid>>2)*32+(lane&3)*8;
  const unsigned kdst=lds0+LDS_K+wid*1024, vdst=lds0+LDS_V+wid*1024;
  #define DMA_K(t,slot) glds16(ksrc+(long)(t)*KVBLK*DM,(unsigned)__builtin_amdgcn_readfirstlane(kdst+(slot)))
  #define DMA_V(t,slot) glds16(vsrc+(long)(t)*KVBLK*DM,(unsigned)__builtin_amdgcn_readfirstlane(vdst+(slot)))
  const int vb0=(int)(lds0+LDS_V)+((lane>>4)&1)*32+(lane&3)*8+(4*hi+((lane&15)>>2))*64;
  const char*Kbase=shm+LDS_K; bf16x8 kf[8];
  const lds_cptr shm3=(lds_cptr)shm; const lds_cptr kp0=shm3+LDS_K+hi*1024+r32*16; const lds_cptr vp0=shm3+LDS_V+((lane>>4)&1)*32+(lane&3)*8+(4*hi+((lane&15)>>2))*64;
  const int NT=(q0+QB)/KVBLK-t0;
  DMA_K(0,0);DMA_V(0,0);DMA_K(1,SLOTB);
  bf16x8 qr[4];
  #pragma unroll
  for(int d0=0;d0<4;++d0)qr[d0]=*reinterpret_cast<const bf16x8*>(&Qw[(long)r32*DM+d0*16+hi*8]);
  typedef __attribute__((address_space(3))) unsigned long long lds_u64;
  const lds_u64* const ctab=(const lds_u64*)(__attribute__((address_space(3))) char*)(shm+LDS_BYTES);
  float mhat; { const float h1_=__uint_as_float((unsigned)ctab[q0-t0*KVBLK+wid*QBLK+r32]<<16), a0_=h1_+48.0f; mhat=__uint_as_float((__float_as_uint(a0_)+0x7fffu+((__float_as_uint(a0_)>>16)&1u))&0xffff0000u);
    if(h1_>=8192.0f) mhat=h1_; }
  float l_reg=0.f;f32x16 o[2];o[0]=f32x16{};o[1]=f32x16{};const f32x16 negm=f32x16{};
  typedef short s16x4k __attribute__((ext_vector_type(4))); typedef unsigned u32x2k __attribute__((ext_vector_type(2)));
  u32x2k qaw=(u32x2k){hi==0?0x3F803F80u:0u,0u};
  #define SETQA() do{ qaw[1]=(hi==0)?(0x3F80u|(((__float_as_uint(mhat)>>16)^0x8000u)<<16)):0u; }while(0)
  #define QAUG __builtin_bit_cast(s16x4k,qaw)
  #define MFA8(a_,b_,c_) __builtin_amdgcn_mfma_f32_32x32x8bf16_1k(a_,b_,c_,0,0,0)
  #define RNDBF(x_) __uint_as_float((__float_as_uint(x_)+0x7fffu+((__float_as_uint(x_)>>16)&1u))&0xffff0000u)
  SETQA();
  #define KAUG(t_,A0,A1) do{ const lds_u64* cp_=ctab+(t_)*KVBLK+r32; const unsigned long long w0_=cp_[0],w1_=cp_[32]; \
    A0=__builtin_bit_cast(s16x4k,w0_); A1=__builtin_bit_cast(s16x4k,w1_); }while(0)
  const int qrel=wid*QBLK+r32;
  #define CMASK(P0,P1,t) do{int jb_=(t)-(NT-4); if(jb_>=0)cmask(P0,P1,jb_,qrel,hi);}while(0)
  bool resc=false;
  #define START(P0,P1) do{ const float rm=rowmax(P0,P1); resc=false; \
    if(__builtin_expect(__any(rm>(float)THRL),0)){ const float rn_=mhat+__builtin_fmaxf(rm,0.f); const float mn_=RNDBF(rn_); const float dl=mn_-mhat; mhat=mn_; SETQA(); \
      _Pragma("unroll") for(int r=0;r<16;++r){P0[r]-=dl;P1[r]-=dl;} \
      } \
    _Pragma("unroll") for(int r=0;r<16;++r)P0[r]=__builtin_amdgcn_exp2f(P0[r]); }while(0)
  #define RESC() do{ if(resc){ asm volatile("s_waitcnt lgkmcnt(0)":::"memory"); \
      _Pragma("unroll") for(int d_=0;d_<2;++d_) _Pragma("unroll") for(int r=0;r<16;++r)o[d_][r]*=wsf[crow(r,hi)]; } }while(0)
  f32x16 pA0,pA1,pB0,pB1;
  int sl_prev=0,sl_cur=0,sl_next=SLOTB;
  #define ROT() do{sl_prev=sl_cur;sl_cur=sl_next;sl_next=(sl_next==(NSLOT-1)*SLOTB)?0:sl_next+SLOTB;}while(0)
  DMA_K(2,2*SLOTB);
  WAIT_BAR(3);
  { s16x4k ka0_,ka1_; KAUG(0,ka0_,ka1_); qkt(pA0,pA1,Kbase,qr,negm,r32,hi,ka0_,ka1_,QAUG); } asm volatile("s_nop 15\n\ts_nop 7":"+v"(pA0),"+v"(pA1));CMASK(pA0,pA1,0);
  START(pA0,pA1);
  _Pragma("unroll") for(int r=0;r<16;++r)pA1[r]=__builtin_amdgcn_exp2f(pA1[r]);
  WAIT_BAR(0);
  DMA_K(3,0);DMA_V(1,SLOTB);
  ROT();
  kload8(kf,kp0+sl_cur);
  WAIT_BAR(2);
  s16x4 vlo[8],vhi[8]; u32x4 pw0,pw1,pw2,pw3;
  #define PKW(P,B) cvtpk_s(P[B],P[B+1])
  #define PAF(k) __builtin_bit_cast(bf16x8,pw##k)
  #define VFR(i) (bf16x8){vlo[i][0],vlo[i][1],vlo[i][2],vlo[i][3],vhi[i][0],vhi[i][1],vhi[i][2],vhi[i][3]}
  #define PIN(x) asm volatile("":"+v"(x))
  #define MX3(a,b,c) __builtin_fmaxf(__builtin_fmaxf((a),(b)),(c))
  #define GAPA(MF,A0,A1,A2,A3,W0,W1,PW) do{ MF; sacc+=A0; sacc+=A1; sacc+=A2; sacc+=A3; PIN(sacc); W0; W1; PIN(PW); SBAR(); }while(0)
  #define EX(v) __builtin_amdgcn_exp2f(v)
  #define GAPB(MF,X,B) do{ MF; X[B]=EX(X[B]); X[B+1]=EX(X[B+1]); X[B+2]=EX(X[B+2]); X[B+3]=EX(X[B+3]); PIN(X); SBAR(); }while(0)
  #define VRD(i) do{ vlo[i]=vtr(vp_+(((i)>>2)*4096+((i)&3)*1024)); vhi[i]=vtr(vp_+(((i)>>2)*4096+((i)&3)*1024+512)); }while(0)
  #define KRD(G,j) do{ if(G){ kload2(kf,kp0+sl_next,j); SBAR(); } }while(0)
  #define STEP(C0,C1,P0,P1,t,GK,GV,GL) do{ SBAR(); \
    const lds_cptr vp_=vp0+sl_prev; s16x4k ka0_,ka1_; \
    VRD(0); SBAR(); float sacc=(P0[0]+P0[1]); \
    GAPA(C0=__builtin_amdgcn_mfma_f32_32x32x16_bf16(kf[0],qr[0],negm,0,0,0), P0[2],P0[3],P0[4],P0[5],     pw0[0]=PKW(P0,0), pw0[1]=PKW(P0,2), pw0); \
    VRD(4); SBAR(); GAPA(C1=__builtin_amdgcn_mfma_f32_32x32x16_bf16(kf[1],qr[0],negm,0,0,0), P0[6],P0[7],P0[8],P0[9],     pw0[2]=PKW(P0,4), pw0[3]=PKW(P0,6), pw0); \
    VRD(1); SBAR(); GAPA(C0=__builtin_amdgcn_mfma_f32_32x32x16_bf16(kf[2],qr[1],C0,0,0,0),   P0[10],P0[11],P0[12],P0[13], pw1[0]=PKW(P0,8), pw1[1]=PKW(P0,10), pw1); \
    VRD(5); SBAR(); GAPA(C1=__builtin_amdgcn_mfma_f32_32x32x16_bf16(kf[3],qr[1],C1,0,0,0),   P0[14],P0[15],P1[0],P1[1],   pw1[2]=PKW(P0,12),pw1[3]=PKW(P0,14), pw1); \
    VRD(2); SBAR(); GAPA(C0=__builtin_amdgcn_mfma_f32_32x32x16_bf16(kf[4],qr[2],C0,0,0,0),   P1[2],P1[3],P1[4],P1[5],     pw2[0]=PKW(P1,0), pw2[1]=PKW(P1,2), pw2); \
    VRD(6); SBAR(); GAPA(C1=__builtin_amdgcn_mfma_f32_32x32x16_bf16(kf[5],qr[2],C1,0,0,0),   P1[6],P1[7],P1[8],P1[9],     pw2[2]=PKW(P1,4), pw2[3]=PKW(P1,6), pw2); \
    VRD(3); SBAR(); GAPA(C0=__builtin_amdgcn_mfma_f32_32x32x16_bf16(kf[6],qr[3],C0,0,0,0),   P1[10],P1[11],P1[12],P1[13], pw3[0]=PKW(P1,8), pw3[1]=PKW(P1,10), pw3); \
    VRD(7); KAUG(t,ka0_,ka1_); SBAR(); GAPA(C1=__builtin_amdgcn_mfma_f32_32x32x16_bf16(kf[7],qr[3],C1,0,0,0),   P1[14],P1[15],0.f,0.f,       pw3[2]=PKW(P1,12),pw3[3]=PKW(P1,14), pw3); \
    C0=MFA8(ka0_,QAUG,C0); C1=MFA8(ka1_,QAUG,C1); \
    l_reg+=sacc; \
    if(GK){DMA_K((t)+3,sl_cur);} if(GV){DMA_V((t)+1,sl_next);} \
    CMASK(C0,C1,t); \
    { float a=MX3(C0[0],C0[1],C1[0]),b=MX3(C0[2],C0[3],C1[1]); a=MX3(a,C1[2],C1[3]); \
      _Pragma("unroll") for(int r=4;r<16;r+=4){a=MX3(a,C0[r],C0[r+1]);b=MX3(b,C0[r+2],C0[r+3]);a=MX3(a,C1[r],C1[r+1]);b=MX3(b,C1[r+2],C1[r+3]);} \
      float rm=__builtin_fmaxf(a,b); { auto rr=__builtin_amdgcn_permlane32_swap(__float_as_uint(rm),__float_as_uint(rm),false,false); rm=__builtin_fmaxf(__uint_as_float(rr[0]),__uint_as_float(rr[1])); } \
      resc=false; \
      if(__builtin_expect(__any(rm>(float)THRL),0)){ const float rn_=mhat+__builtin_fmaxf(rm,0.f); const float mn_=RNDBF(rn_); const float dl=mn_-mhat; mhat=mn_; SETQA(); \
        _Pragma("unroll") for(int r=0;r<16;++r){C0[r]-=dl;C1[r]-=dl;} \
        const float f=__builtin_amdgcn_exp2f(-dl); l_reg*=f; if(hi==0)wsf[r32]=f; resc=true; } } \
    SBAR(); \
    GAPB(o[0]=__builtin_amdgcn_mfma_f32_32x32x16_bf16(PAF(0),VFR(0),o[0],0,0,0), C0,0); \
    GAPB(o[1]=__builtin_amdgcn_mfma_f32_32x32x16_bf16(PAF(0),VFR(4),o[1],0,0,0), C0,4); \
    KRD(GL,0); GAPB(o[0]=__builtin_amdgcn_mfma_f32_32x32x16_bf16(PAF(1),VFR(1),o[0],0,0,0), C0,8); \
    KRD(GL,1); GAPB(o[1]=__builtin_amdgcn_mfma_f32_32x32x16_bf16(PAF(1),VFR(5),o[1],0,0,0), C0,12); \
    KRD(GL,2); GAPB(o[0]=__builtin_amdgcn_mfma_f32_32x32x16_bf16(PAF(2),VFR(2),o[0],0,0,0), C1,0); \
    KRD(GL,3); GAPB(o[1]=__builtin_amdgcn_mfma_f32_32x32x16_bf16(PAF(2),VFR(6),o[1],0,0,0), C1,4); \
    GAPB(o[0]=__builtin_amdgcn_mfma_f32_32x32x16_bf16(PAF(3),VFR(3),o[0],0,0,0), C1,8); \
    GAPB(o[1]=__builtin_amdgcn_mfma_f32_32x32x16_bf16(PAF(3),VFR(7),o[1],0,0,0), C1,12); \
    }while(0)
  int t=1;
  #undef CMASK
  #define CMASK(P0,P1,t) do{}while(0)
  for(;t+5<NT;t+=2){
    STEP(pB0,pB1,pA0,pA1,t,true,true,true);     WAIT_BAR(2); RESC(); ROT();
    STEP(pA0,pA1,pB0,pB1,t+1,true,true,true);   WAIT_BAR(2); RESC(); ROT();
  }
  #undef CMASK
  #define CMASK(P0,P1,t) do{int jb_=(t)-(NT-4); if(jb_>=0)cmask(P0,P1,jb_,qrel,hi);}while(0)
  #define ENDW(tt) do{ if((tt)+3<NT){WAIT_BAR(2);} else if((tt)+2<NT){WAIT_BAR(1);} else {WAIT_BAR(0);} }while(0)
  for(;t+1<NT;t+=2){
    STEP(pB0,pB1,pA0,pA1,t,(t+3<NT),(t+1<NT),(t+1<NT));       ENDW(t);   RESC(); ROT();
    STEP(pA0,pA1,pB0,pB1,t+1,(t+4<NT),(t+2<NT),(t+2<NT));     ENDW(t+1); RESC(); ROT();
  }
  STEP(pB0,pB1,pA0,pA1,NT-1,false,false,false); RESC();
  { float sacc=pB0[0]+pB0[1]; _Pragma("unroll") for(int r=2;r<16;++r)sacc+=pB0[r]; _Pragma("unroll") for(int r=0;r<16;++r)sacc+=pB1[r]; l_reg+=sacc;
    pw0=(u32x4){PKW(pB0,0),PKW(pB0,2),PKW(pB0,4),PKW(pB0,6)};pw1=(u32x4){PKW(pB0,8),PKW(pB0,10),PKW(pB0,12),PKW(pB0,14)};pw2=(u32x4){PKW(pB1,0),PKW(pB1,2),PKW(pB1,4),PKW(pB1,6)};pw3=(u32x4){PKW(pB1,8),PKW(pB1,10),PKW(pB1,12),PKW(pB1,14)};
    SBAR(); pv(o,vb0+sl_cur,PAF(0),PAF(1),PAF(2),PAF(3)); }
  #undef PKW
  #undef PAF
  #undef VFR
  #undef PIN
  #undef MX3
  #undef GAPA
  #undef GAPB
  #undef EX
  #undef VRD
  #undef KRD
  #undef STEP
  #undef ENDW
  {auto rr=__builtin_amdgcn_permlane32_swap(__float_as_uint(l_reg),__float_as_uint(l_reg),false,false);l_reg=__uint_as_float(rr[0])+__uint_as_float(rr[1]);}
  if(hi==0)wsf[32+r32]=l_reg;asm volatile("s_waitcnt lgkmcnt(0)":::"memory");
  float rli[16];
  #pragma unroll
  for(int r=0;r<16;++r)rli[r]=__builtin_amdgcn_rcpf(wsf[32+crow(r,hi)]);
  bf16*Ow=O+(rowbase+q0+wid*QBLK)*DM+h*D;
  { bf16*stg=(bf16*)(shm+LDS_OST)+wid*2048;
    #pragma unroll
    for(int r=0;r<16;++r){const int orow=crow(r,hi);
      #pragma unroll
      for(int d0=0;d0<2;++d0)stg[orow*64+d0*32+r32]=__float2bfloat16(o[d0][r]*rli[r]);}
    asm volatile("s_waitcnt lgkmcnt(0)":::"memory");
    #pragma unroll
    for(int i=0;i<4;++i){const int row=i*8+(lane>>3),ch=lane&7; const u32x4 v=*(const u32x4*)(stg+row*64+ch*8); ATTN_STORE16(Ow+(long)row*DM+ch*8,v);} }
  asm volatile("s_waitcnt lgkmcnt(0)\n\ts_barrier":::"memory");
  #undef KAUG
  #undef SETQA
  #undef QAUG
  #undef RNDBF
  #undef MFA8
  #undef DMA_K
  #undef DMA_V
  #undef CMASK
  #undef START
  #undef RESC
  #undef ROT
}
constexpr int ATTN_LDS_BYTES=LDS_BYTES+SEQ*8+16;
struct AttnTensors { const bf16* Q; const bf16* K; const bf16* V; bf16* O; const unsigned long long* CAUG; };
struct AttnUnit { int bh; int qb; };
struct StaticOrder {
  int vcu;
  __device__ __forceinline__ explicit StaticOrder(int grid,int block):vcu((block%8)*(grid/8)+block/8){}
  __device__ __forceinline__ bool next(int i,AttnUnit&u)const{ if(i>=4)return false; const int s=vcu&7; u.bh=vcu>>3; u.qb=(i==0)?s:(i==1)?15-s:(i==2)?16+s:31-s; return true; }
  __device__ __forceinline__ void a_ready(const AttnUnit&)const{}
  __device__ __forceinline__ void done(const AttnUnit&)const{}
};
__device__ __forceinline__ unsigned f2bf_rne(float f){unsigned u=__float_as_uint(f);return (u+0x7fffu+((u>>16)&1u))>>16;}
__device__ __forceinline__ void fox_scan(char*lds,const float*__restrict__ lf,unsigned long long*__restrict__ tab){
  typedef __attribute__((address_space(3))) double lds_f64;
  lds_f64* sums=(lds_f64*)(__attribute__((address_space(3))) char*)lds;
  const int tid=tid_fresh(); double acc=0.0;
  #pragma unroll
  for(int i=0;i<16;++i)acc+=(double)lf[tid*16+i];
  sums[tid]=acc; __syncthreads();
  double run=0.0; for(int i=0;i<tid;++i)run+=sums[i];
  #pragma unroll 1
  for(int i=0;i<16;++i){ run+=(double)lf[tid*16+i]; const float nv=(float)(run*-1.4426950408889634);
    const unsigned h1=f2bf_rne(nv); const float r1=nv-__uint_as_float(h1<<16); const unsigned h2=f2bf_rne(r1); const float r2=r1-__uint_as_float(h2<<16); const unsigned h3=f2bf_rne(r2);
    tab[tid*16+i]=(unsigned long long)(h1|(h2<<16))|((unsigned long long)(h3|0x3F800000u)<<32); }
  __syncthreads();
}
__device__ __forceinline__ float caug_val(unsigned long long w){ return (__uint_as_float((unsigned)w<<16)+__uint_as_float((unsigned)w&0xffff0000u))+__uint_as_float((unsigned)(w>>32)<<16); }
constexpr float SKIP_TH=72.0f;
template<int THRL=8> __device__ __forceinline__ void attn_phase_dyn(char*lds,const AttnTensors&T,unsigned*ctr){
  typedef __attribute__((address_space(3))) unsigned long long lds_u64; typedef __attribute__((address_space(3))) int lds_i32;
  lds_i32* slotw=(lds_i32*)(__attribute__((address_space(3))) char*)(lds+LDS_BYTES+SEQ*8);
  lds_u64* tab=(lds_u64*)(__attribute__((address_space(3))) char*)(lds+LDS_BYTES);
  for(;;){
    const int tid=tid_fresh();
    if(tid==0){ slotw[0]=(int)__hip_atomic_fetch_add(ctr,1u,__ATOMIC_RELAXED,__HIP_MEMORY_SCOPE_AGENT); slotw[1]=0; }
    __syncthreads();
    const int slot=__builtin_amdgcn_readfirstlane(slotw[0]);
    if(slot>=BATCH*NHEAD*NQB) break;
    const int qb=NQB-1-(slot>>5), bh=slot&31, q0=qb*QB, NTF=(q0+QB)/KVBLK;
    const unsigned long long* cg=T.CAUG+(long)bh*SEQ;
    const float lim=caug_val(cg[q0])-SKIP_TH;
    if(tid<NTF-4){ const bool p0_=caug_val(cg[tid*KVBLK+KVBLK-1])<lim, p1_=(tid+1<NTF-4)&&(caug_val(cg[(tid+1)*KVBLK+KVBLK-1])<lim);
      if(p0_&&!p1_) slotw[1]=tid+1; }
    __syncthreads();
    const int nskip=__builtin_amdgcn_readfirstlane(slotw[1]);
    const int t0=nskip&~1;
    for(int i=tid;i<(NTF-t0)*KVBLK;i+=NW*64) tab[i]=cg[t0*KVBLK+i];
    __syncthreads();
    attn_unit<THRL>(bh/NHEAD,bh%NHEAD,qb,t0,T.Q,T.K,T.V,T.O,lds);
  }
}
#undef SBAR
#undef WAIT_BAR
}

namespace swa {
constexpr int D = 128; constexpr float THR = 8.f; constexpr bool WSKIP = true;
constexpr float SCALE = 0.08838834764831845f;
constexpr int NW = 8, QBLK = 32, KVBLK = 64, QB = NW * QBLK;
constexpr int SHM_V = KVBLK * D * 2, SHM_K = KVBLK * D * 2;
constexpr int LDS_BYTES = 2 * SHM_V + 2 * SHM_K + NW * 64 * 4;

using bf16 = __hip_bfloat16;
typedef short bf16x8 __attribute__((ext_vector_type(8)));
typedef short s16x4 __attribute__((ext_vector_type(4)));
typedef float f32x16 __attribute__((ext_vector_type(16)));
typedef float f32x4 __attribute__((ext_vector_type(4)));
typedef unsigned u32x4 __attribute__((ext_vector_type(4)));
template <class A, class Bt> struct same_t { static constexpr bool v = false; };
template <class A> struct same_t<A, A> { static constexpr bool v = true; };

#define KSWZ(row, colB) ((row) * 256 + ((colB) ^ (((row) & 7) << 4)))
#define SBAR() __builtin_amdgcn_sched_barrier(0)
__device__ __forceinline__ int v_st(int k, int c) { const int kk = (k & ~0xC) | ((k & 4) << 1) | ((k & 8) >> 1); return ((kk >> 3) * 4 + (c >> 5)) * 512 + ((kk & 7) * 32 + (c & 31)) * 2; }
__device__ __forceinline__ int v_rd_base(int lane) { return ((lane & 3) << 3) | (((lane >> 2) & 3) << 6) | (((lane >> 4) & 1) << 5) | (((lane >> 5) & 1) << 8); }
constexpr int v_rd_off(int d0, int ks, int half) { return d0 * 512 + ks * 4096 + half * 2048; }
__device__ __forceinline__ int crow(int r, int hi) { return (r & 3) + 8 * (r >> 2) + 4 * hi; }
__device__ __forceinline__ unsigned cvtpk(float lo, float hi) {
    unsigned r; asm volatile("v_cvt_pk_bf16_f32 %0, %1, %2" : "=v"(r) : "v"(lo), "v"(hi)); return r;
}
__device__ __forceinline__ bf16x8 pack8(f32x4 a, f32x4 b) {
    u32x4 w = {cvtpk(a[0], a[1]), cvtpk(a[2], a[3]), cvtpk(b[0], b[1]), cvtpk(b[2], b[3])};
    return *reinterpret_cast<bf16x8*>(&w);
}
template <class T> __device__ __forceinline__ bf16x8 load8(const T* p) {
    if constexpr (same_t<T, float>::v) { return pack8(*(const f32x4*)p, *(const f32x4*)(p + 4)); }
    else { return *reinterpret_cast<const bf16x8*>(p); }
}
__device__ __forceinline__ void mask_tile(f32x16& p0, f32x16& p1, int dq, unsigned W) {
    const float NEG = -__builtin_inff();
#pragma unroll
    for (int r = 0; r < 16; ++r) {
        const int c = (r & 3) + 8 * (r >> 2);
        if ((unsigned)(dq - c) >= W) p0[r] = NEG;
        if ((unsigned)(dq - c - 32) >= W) p1[r] = NEG;
    }
}
__device__ __forceinline__ void partialSM(f32x16& p0, f32x16& p1, float& m_reg, float& mn, float& alpha) {
    float pmax = p0[0]; for (int r = 1; r < 16; ++r) pmax = fmaxf(pmax, p0[r]); for (int r = 0; r < 16; ++r) pmax = fmaxf(pmax, p1[r]);
    { auto rr = __builtin_amdgcn_permlane32_swap(__float_as_uint(pmax), __float_as_uint(pmax), false, false);
      pmax = fmaxf(__uint_as_float(rr[0]), __uint_as_float(rr[1])); }
    constexpr float C2 = 1.4426950408889634f * SCALE;
    if (__builtin_expect(__all((pmax - m_reg) * SCALE <= THR), 1)) { mn = m_reg; alpha = 1.f; }
    else { mn = fmaxf(m_reg, pmax); alpha = __builtin_amdgcn_exp2f((m_reg - mn) * C2); m_reg = mn; }
    const float mnL = -mn * C2;
    for (int r = 0; r < 16; ++r) p0[r] = fmaf(p0[r], C2, mnL); for (int r = 0; r < 16; ++r) p1[r] = fmaf(p1[r], C2, mnL);
    for (int r = 0; r < 16; ++r) p0[r] = __builtin_amdgcn_exp2f(p0[r]);
}
__device__ __forceinline__ void finishSM(f32x16& p0, f32x16& p1, float alpha, float& l_reg, bf16x8& pa0, bf16x8& pa1, bf16x8& pa2, bf16x8& pa3) {
    for (int r = 0; r < 16; ++r) p1[r] = __builtin_amdgcn_exp2f(p1[r]);
    float ps = 0; for (int r = 0; r < 16; ++r) ps += p0[r]; for (int r = 0; r < 16; ++r) ps += p1[r];
    { auto rr = __builtin_amdgcn_permlane32_swap(__float_as_uint(ps), __float_as_uint(ps), false, false);
      ps = __uint_as_float(rr[0]) + __uint_as_float(rr[1]); }
    l_reg = l_reg * alpha + ps;
#define PK4(P, B_, OUT) do { unsigned a0 = cvtpk(P[B_+0], P[B_+1]), a1 = cvtpk(P[B_+2], P[B_+3]);                          \
        unsigned b0 = cvtpk(P[B_+4], P[B_+5]), b1 = cvtpk(P[B_+6], P[B_+7]);                                             \
        auto r0 = __builtin_amdgcn_permlane32_swap(a0, b0, false, false); auto r1 = __builtin_amdgcn_permlane32_swap(a1, b1, false, false); \
        u32x4 w = {r0[0], r1[0], r0[1], r1[1]}; OUT = *reinterpret_cast<bf16x8*>(&w); } while (0)
    PK4(p0, 0, pa0); PK4(p0, 8, pa1); PK4(p1, 0, pa2); PK4(p1, 8, pa3);
#undef PK4
}
template <int KB, bool SK>
__device__ __forceinline__ void qkt(f32x16& p0, f32x16& p1, const char* K_lds, int r32, int hi, const bf16x8* qr, bool act) {
    if (SK && !act) { const float NEG = -__builtin_inff();
#pragma unroll
        for (int r = 0; r < 16; ++r) { p0[r] = NEG; p1[r] = NEG; } return; }
    p0 = f32x16{}; p1 = f32x16{};
    const char* kb[4];
#pragma unroll
    for (int dd = 0; dd < 4; ++dd) kb[dd] = K_lds + KB * SHM_K + KSWZ(r32, (dd * 16 + hi * 8) * 2);
#pragma unroll
    for (int d0 = 0; d0 < 8; ++d0) { const char* a = kb[d0 & 3] + (d0 >> 2) * 128;
        bf16x8 b0 = *reinterpret_cast<const bf16x8*>(a);
        bf16x8 b1 = *reinterpret_cast<const bf16x8*>(a + 32 * 256);
        p0 = __builtin_amdgcn_mfma_f32_32x32x16_bf16(b0, qr[d0], p0, 0, 0, 0);
        p1 = __builtin_amdgcn_mfma_f32_32x32x16_bf16(b1, qr[d0], p1, 0, 0, 0); }
}
template <int VB, bool SK>
__device__ __forceinline__ void pv_tile(f32x16* o, int vb0, bf16x8 pa0, bf16x8 pa1, bf16x8 pa2, bf16x8 pa3, bool act) {
    if (SK && !act) return;
#define TRRD(dst, off) asm volatile("ds_read_b64_tr_b16 %0, %1 offset:%2" : "=&v"(dst) : "v"(vb0), "i"(off) : "memory")
#define PV_D0(d0) do { s16x4 l0, l1, l2, l3, h0, h1, h2, h3; constexpr int b_ = VB * SHM_V + v_rd_off(d0, 0, 0);     \
        TRRD(l0, b_); TRRD(h0, b_ + 2048); TRRD(l1, b_ + 4096); TRRD(h1, b_ + 6144); TRRD(l2, b_ + 8192); TRRD(h2, b_ + 10240); TRRD(l3, b_ + 12288); TRRD(h3, b_ + 14336); \
        asm volatile("s_waitcnt lgkmcnt(0)" ::: "memory"); SBAR();                 \
        o[d0] = __builtin_amdgcn_mfma_f32_32x32x16_bf16(pa0, (bf16x8){l0[0], l0[1], l0[2], l0[3], h0[0], h0[1], h0[2], h0[3]}, o[d0], 0, 0, 0);   \
        o[d0] = __builtin_amdgcn_mfma_f32_32x32x16_bf16(pa1, (bf16x8){l1[0], l1[1], l1[2], l1[3], h1[0], h1[1], h1[2], h1[3]}, o[d0], 0, 0, 0);   \
        o[d0] = __builtin_amdgcn_mfma_f32_32x32x16_bf16(pa2, (bf16x8){l2[0], l2[1], l2[2], l2[3], h2[0], h2[1], h2[2], h2[3]}, o[d0], 0, 0, 0);   \
        o[d0] = __builtin_amdgcn_mfma_f32_32x32x16_bf16(pa3, (bf16x8){l3[0], l3[1], l3[2], l3[3], h3[0], h3[1], h3[2], h3[3]}, o[d0], 0, 0, 0); } while (0)
    PV_D0(0); PV_D0(1); PV_D0(2); PV_D0(3);
#undef PV_D0
#undef TRRD
}

template <class TIn, class TOut> struct BlockRef { const TIn* Q; const TIn* K; const TIn* V; TOut* O; int P0; int qp, kp, op; float* L; int lp; };
template <class TIn> struct Seam {
    bf16x8 qr[8];
    bf16x8 st_v0, st_v1, st_k0, st_k1; f32x4 sf0, sf1, sf2, sf3;
    f32x4 tq[16];
};
__device__ __forceinline__ int swa_jlo(int P0, int W) { const int lowk = P0 - W + 1; return lowk > 0 ? lowk / KVBLK : 0; }
#define ROW(p, k0, rr) ((p) + (size_t)((k0) + (rr)) * D + sc)
#define VMW() asm volatile("s_waitcnt vmcnt(0)" ::: "memory")
#define VMWN(n) asm volatile("s_waitcnt vmcnt(%0)" :: "i"(n) : "memory")
#define ROWP(p, k0, rr, pt) ((const TIn*)((const char*)(p) + (unsigned)((((k0) + (rr)) * (pt) + sc) * 2)))
#define SLOAD_H(Kp, Vp, k0, pt) do { S.st_v0 = load8<TIn>(ROWP(Vp, k0, sr, pt)); S.st_v1 = load8<TIn>(ROWP(Vp, k0, 32 + sr, pt));              \
                         S.st_k0 = load8<TIn>(ROWP(Kp, k0, sr, pt)); S.st_k1 = load8<TIn>(ROWP(Kp, k0, 32 + sr, pt)); } while (0)
#define SWRITE_HK(bf) do { *(bf16x8*)(K_lds + (bf) * SHM_K + kws) = S.st_k0; *(bf16x8*)(K_lds + (bf) * SHM_K + kws + 32 * 256) = S.st_k1; } while (0)
#define SWRITE_HV(bf) do { *(bf16x8*)(V_lds + (bf) * SHM_V + vst0) = S.st_v0; *(bf16x8*)(V_lds + (bf) * SHM_V + vst1) = S.st_v1; } while (0)
#define SWRITE_H(bf) do { SWRITE_HV(bf); SWRITE_HK(bf); } while (0)
#define SLOAD_F(p, k0) do { S.sf0 = *(const f32x4*)ROW(p, k0, sr); S.sf1 = *(const f32x4*)(ROW(p, k0, sr) + 4);                \
                            S.sf2 = *(const f32x4*)ROW(p, k0, 32 + sr); S.sf3 = *(const f32x4*)(ROW(p, k0, 32 + sr) + 4); } while (0)
#define SWRITE_KF(bf) do { *(bf16x8*)(K_lds + (bf) * SHM_K + kws) = pack8(S.sf0, S.sf1); *(bf16x8*)(K_lds + (bf) * SHM_K + kws + 32 * 256) = pack8(S.sf2, S.sf3); } while (0)
#define SWRITE_VF(bf) do { *(bf16x8*)(V_lds + (bf) * SHM_V + vst0) = pack8(S.sf0, S.sf1); *(bf16x8*)(V_lds + (bf) * SHM_V + vst1) = pack8(S.sf2, S.sf3); } while (0)
template <class TIn, class TOut>
__device__ __forceinline__ void causal_swa_prime(const BlockRef<TIn, TOut>& cur, int W, char* lds, Seam<TIn>& S) {
    constexpr bool F32 = same_t<TIn, float>::v;
    const int tid = tid_fresh(), wid = __builtin_amdgcn_readfirstlane(tid >> 6), lane = tid & 63, r32 = lane & 31, hi = lane >> 5;
    const int sr = tid >> 4, sc = (tid & 15) * 8, kws = KSWZ(sr, sc * 2); char* K_lds = lds + 2 * SHM_V;
    const int kb0 = swa_jlo(cur.P0, W) * KVBLK;
    for (int d0 = 0; d0 < 8; ++d0) S.qr[d0] = load8<TIn>((const TIn*)((const char*)cur.Q + (unsigned)(((wid * QBLK + r32) * cur.qp + hi * 8) * 2) + d0 * 32));
    if constexpr (F32) { SLOAD_F((const float*)cur.K, kb0); VMW(); SWRITE_KF(0); SBAR(); SLOAD_F((const float*)cur.V, kb0); }
    else { SLOAD_H(cur.K, cur.V, kb0, cur.kp); VMW(); SWRITE_HK(0); }
    __syncthreads();
}
template <class TIn, class TOut>
__device__ __forceinline__ void causal_swa_block(const BlockRef<TIn, TOut>& cur, const BlockRef<TIn, TOut>& nxt, int skv, int W, char* lds, Seam<TIn>& S) {
    constexpr bool F32 = same_t<TIn, float>::v;
    const int tid = tid_fresh(), wid = __builtin_amdgcn_readfirstlane(tid >> 6), lane = tid & 63, r32 = lane & 31, hi = lane >> 5;
    const int j_lo = swa_jlo(cur.P0, W);
    int j_hi = (cur.P0 + QB - 1) / KVBLK + 1; if (j_hi > skv / KVBLK) j_hi = skv / KVBLK;
    const int NT = j_hi - j_lo;
    const int kbn = swa_jlo(nxt.P0, W) * KVBLK;
    const int qlo = cur.P0 + wid * QBLK, qm = qlo + r32 - 4 * hi;
    char* V_lds = lds; char* K_lds = lds + 2 * SHM_V;
    float* ws = (float*)(lds + 2 * SHM_V + 2 * SHM_K) + wid * 64; float* li_l = ws, * al_l = ws + 32;
    float m_reg = -1e30f, l_reg = 0; f32x16 o[4] = {};
    const int sr = tid >> 4, sc = (tid & 15) * 8, vst0 = v_st(sr, sc), vst1 = v_st(32 + sr, sc), kws = KSWZ(sr, sc * 2);
    const int vb0 = (int)(uintptr_t)V_lds + v_rd_base(lane);
    const TIn* Kh = cur.K; const TIn* Vh = cur.V;
#define RESC(a) do { if (__any((a) < 1.f)) { if (hi == 0) al_l[r32] = (a); asm volatile("s_waitcnt lgkmcnt(0)" ::: "memory");              \
                     for (int d_ = 0; d_ < 4; ++d_) for (int r = 0; r < 16; ++r) o[d_][r] *= al_l[crow(r, hi)]; } } while (0)
#define KBASE(t) ((j_lo + (t)) * KVBLK)
#define ACT(t) (KBASE(t) <= qlo + QBLK - 1 && KBASE(t) + KVBLK - 1 >= qlo - W + 1)
#define MASKT(P0_, P1_, t) do { const int kb_ = KBASE(t); if ((!SK || ACT(t)) && (kb_ + KVBLK - 1 > qlo || kb_ <= qlo + QBLK - 1 - W)) mask_tile(P0_, P1_, qm - kb_, (unsigned)W); } while (0)
    constexpr int NQL = F32 ? 16 : 8;
    constexpr bool SK = WSKIP && !F32;
#define SEAM_K0() do { VMWN(NQL); if constexpr (F32) { SWRITE_KF(0); SBAR(); SLOAD_F((const float*)nxt.V, kbn); } else { SWRITE_HK(0); } SBAR(); } while (0)
    f32x16 pA0, pA1, pB0, pB1; float mnA, mnB, alA, alB; bf16x8 pa0, pa1, pa2, pa3;
    if constexpr (F32) { VMW(); SWRITE_VF(0); SBAR(); } else { SWRITE_HV(0); SBAR(); }
    if (NT > 1) { if constexpr (F32) SLOAD_F((const float*)Kh, KBASE(1)); else SLOAD_H(Kh, Vh, KBASE(1), cur.kp); }
    SBAR(); qkt<0, SK>(pA0, pA1, K_lds, r32, hi, S.qr, ACT(0));
    if constexpr (F32) { if (NT > 1) { VMW(); SWRITE_KF(1); SBAR(); SLOAD_F((const float*)Vh, KBASE(1)); } }
    MASKT(pA0, pA1, 0); partialSM(pA0, pA1, m_reg, mnA, alA);
    if (NT > 1) { VMW(); if constexpr (F32) { SWRITE_VF(1); SBAR(); if (NT > 2) SLOAD_F((const float*)Kh, KBASE(2)); } else SWRITE_H(1); }
    __syncthreads();
#define HALF_STEP(PX0, PX1, mnX, alX, PY0, PY1, alY, t, KB, VB, SB) do {                                                      \
        SBAR(); qkt<KB, SK>(PX0, PX1, K_lds, r32, hi, S.qr, ACT(t));                                             \
        finishSM(PY0, PY1, alY, l_reg, pa0, pa1, pa2, pa3); SBAR();                                                           \
        if ((t) + 1 < NT) { if constexpr (F32) { VMW(); SWRITE_KF(SB); SBAR(); SLOAD_F((const float*)Vh, KBASE((t) + 1)); }  \
                            else { SLOAD_H(Kh, Vh, KBASE((t) + 1), cur.kp); } SBAR(); }                                               \
        pv_tile<VB, SK>(o, vb0, pa0, pa1, pa2, pa3, ACT((t) - 1)); MASKT(PX0, PX1, (t)); partialSM(PX0, PX1, m_reg, mnX, alX);                                        \
        __syncthreads();                                                                                                      \
        if ((t) + 1 < NT) { VMW(); if constexpr (F32) { SWRITE_VF(SB); SBAR(); if ((t) + 2 < NT) SLOAD_F((const float*)Kh, KBASE((t) + 2)); } \
                            else { SWRITE_H(SB); } }                                                                          \
        RESC(alX); __syncthreads(); } while (0)
    for (int t = 1; t + 1 < NT; t += 2) {
        HALF_STEP(pB0, pB1, mnB, alB, pA0, pA1, alA, t, 1, 0, 0);
        HALF_STEP(pA0, pA1, mnA, alA, pB0, pB1, alB, t + 1, 0, 1, 1);
    }
    const bool even = (NT & 1) == 0;
    if (even) { SBAR(); qkt<1, SK>(pB0, pB1, K_lds, r32, hi, S.qr, ACT(NT - 1)); SBAR(); }
#define QROW(e) (nxt.Q + (size_t)(wid * QBLK + r32) * D + ((e) >> 1) * 16 + hi * 8 + ((e) & 1) * 4)
    if constexpr (F32) { SLOAD_F((const float*)nxt.K, kbn); SBAR();
#pragma unroll
        for (int e = 0; e < 8; ++e) S.tq[e] = *(const f32x4*)QROW(e); }
    else { SLOAD_H(nxt.K, nxt.V, kbn, nxt.kp); SBAR();
#pragma unroll
        for (int d0 = 0; d0 < 8; ++d0) S.qr[d0] = load8<TIn>((const TIn*)((const char*)nxt.Q + (unsigned)(((wid * QBLK + r32) * nxt.qp + hi * 8) * 2) + d0 * 32)); }
    SBAR();
    finishSM(pA0, pA1, alA, l_reg, pa0, pa1, pa2, pa3); SBAR();
    if constexpr (F32) {
#pragma unroll
        for (int e = 8; e < 16; ++e) S.tq[e] = *(const f32x4*)QROW(e); SBAR(); }
#undef QROW
    pv_tile<0, SK>(o, vb0, pa0, pa1, pa2, pa3, ACT(even ? NT - 2 : NT - 1));
    if (even) { MASKT(pB0, pB1, NT - 1); partialSM(pB0, pB1, m_reg, mnB, alB); __syncthreads(); RESC(alB);
        finishSM(pB0, pB1, alB, l_reg, pa0, pa1, pa2, pa3); SBAR(); pv_tile<1, SK>(o, vb0, pa0, pa1, pa2, pa3, ACT(NT - 1)); }
    SBAR(); SEAM_K0();
    if (hi == 0) { li_l[r32] = l_reg; if (cur.L) cur.L[(unsigned)((wid * QBLK + r32) * cur.lp)] = m_reg * SCALE + logf(l_reg); }
    asm volatile("s_waitcnt lgkmcnt(0)" ::: "memory");
    float rli[16];
#pragma unroll
    for (int r = 0; r < 16; ++r) rli[r] = __builtin_amdgcn_rcpf(li_l[crow(r, hi)]);
    TOut* Ow = cur.O + (unsigned)(wid * QBLK * cur.op); const int opitch = cur.op;
#pragma unroll
    for (int r = 0; r < 16; ++r) { const int orow = crow(r, hi);
#pragma unroll
        for (int d0 = 0; d0 < 4; ++d0) { const float v = o[d0][r] * rli[r];
            if constexpr (same_t<TOut, float>::v) { Ow[(unsigned)(orow * opitch + d0 * 32 + r32)] = v; }
            else { const float vn = __shfl_xor(v, 1);
                   if ((r32 & 1) == 0) *(unsigned*)(Ow + (unsigned)(orow * opitch + d0 * 32 + r32)) = cvtpk(v, vn); } } }
    if constexpr (F32) {
#pragma unroll
        for (int d0 = 0; d0 < 8; ++d0) S.qr[d0] = pack8(S.tq[2 * d0], S.tq[2 * d0 + 1]); }
    __syncthreads();
#undef RESC
#undef KBASE
#undef ACT
#undef MASKT
#undef SEAM_K0
#undef HALF_STEP
}
#undef ROW
#undef VMW
#undef VMWN
#undef SLOAD_H
#undef SWRITE_HK
#undef SWRITE_HV
#undef SWRITE_H
#undef SLOAD_F
#undef SWRITE_KF
#undef SWRITE_VF

#undef ROWP
#undef KSWZ
#undef SBAR
}

constexpr int NWAVES = 8;
constexpr int BATCH = 2, SEQ = 8192, DM = 1024, TOK = BATCH * SEQ;
constexpr int AH = 16, AHD = 64;
constexpr int BH = 8, BHD = 128, BG = 3;
constexpr int NE = 16, FF = 256, NCLS = 24, MROWS = 80;
constexpr int NA = 2, NB = 2, NL = 4;
constexpr int WIN_LD = 3 * DM + AH;
constexpr float LOG2E = 1.4426950408889634f;

constexpr size_t MiB = 1u << 20;
constexpr size_t WS_CTL = 0, CTL_ZERO_BYTES = 1 * MiB;
constexpr size_t WS_RSTD = 1 * MiB;
constexpr size_t WS_GA = 1 * MiB + 256 * 1024, WS_GB = 1 * MiB + 512 * 1024;
constexpr size_t WS_LOGF = 2 * MiB;
constexpr size_t WS_CL = 3 * MiB;
constexpr size_t WS_CAUG = 4 * MiB;
constexpr size_t WS_ROPEC = 6 * MiB, WS_ROPES = 10 * MiB;
constexpr size_t WS_WF = 14 * MiB;
constexpr size_t WS_WR = 14 * MiB + 512 * 1024;
constexpr size_t WS_GTAB = 15 * MiB;
constexpr size_t WS_LSE = 16 * MiB;
constexpr size_t WS_LIST = 18 * MiB;
constexpr size_t WS_WIN = 20 * MiB;
constexpr size_t WS_WOA = 32 * MiB;
constexpr size_t WS_WKVQ0 = 36 * MiB;
constexpr size_t WS_WQ1 = 46 * MiB;
constexpr size_t WS_WOB = 52 * MiB;
constexpr size_t WS_WGU = 56 * MiB;
constexpr size_t WS_WD = 88 * MiB;
constexpr size_t WS_HB = 104 * MiB;
constexpr size_t WS_KB = 136 * MiB, WS_VB = 168 * MiB;
constexpr size_t WS_QB = 200 * MiB;
constexpr size_t WS_END = 296 * MiB;
constexpr int CW_BAR = 4096, CW_CNT = 16384, CW_AQ = 20480;

constexpr int RING_OFF = 0, RING_BYTES = 131072;
constexpr int XS_OFF = 131072;
constexpr int LDS_BYTES = 155648;
constexpr int MISC_OFF = LDS_BYTES - 256;
static_assert(attn_body::ATTN_LDS_BYTES <= MISC_OFF, "attention LDS");

#define GAS __attribute__((address_space(1)))
#define LAS __attribute__((address_space(3)))
typedef unsigned short bf16;
typedef unsigned v4u __attribute__((ext_vector_type(4)));
typedef float f32x4 __attribute__((ext_vector_type(4)));
typedef short bf16x8 __attribute__((ext_vector_type(8)));
typedef GAS unsigned gu32;
#define RLX_AGENT __ATOMIC_RELAXED, __HIP_MEMORY_SCOPE_AGENT
#define LDS_WAIT() asm volatile("s_waitcnt lgkmcnt(0)" ::: "memory")
__device__ __forceinline__ unsigned f2bf(float f) { unsigned u = __builtin_bit_cast(unsigned, f); return (u + 0x7fffu + ((u >> 16) & 1u)) >> 16; }
__device__ __forceinline__ unsigned pk2(float lo, float hi) { return f2bf(lo) | (f2bf(hi) << 16); }
__device__ __forceinline__ float bf2f(unsigned b) { return __builtin_bit_cast(float, b << 16); }

#define XB_TMO      128
#define XB_XCNT(j)  (256  + 64 * (j))
#define XB_XSUB(j)  (1280 + 64 * (j))
#define XB_XGEN(j)  (2304 + 64 * (j))
#define XB_TOP      3328
#define XB_TOPGEN   3392
#define XCD_BAR_WORDS 3456
#define XB_SPIN_CAP (1u << 18)

__device__ __forceinline__ unsigned xb_ld(unsigned* p)              { return __hip_atomic_load(p, __ATOMIC_RELAXED, __HIP_MEMORY_SCOPE_AGENT); }
__device__ __forceinline__ unsigned xb_add(unsigned* p, unsigned v) { return __hip_atomic_fetch_add(p, v, __ATOMIC_RELAXED, __HIP_MEMORY_SCOPE_AGENT); }
__device__ __forceinline__ unsigned xb_xcc_id() { return (unsigned)__builtin_amdgcn_s_getreg((3 << 11) | 20) & 0xFu; }
#define XB_SPIN(cond, bar) do { unsigned _sp = 0; while (cond) { __builtin_amdgcn_s_sleep(1); \
    if ((++_sp & 255u) == 0u) { if (xb_ld(&(bar)[XB_TMO])) break; if (_sp > XB_SPIN_CAP) { atomicAdd(&(bar)[XB_TMO], 1u); break; } } } } while (0)

struct XcdBarrier {
    unsigned* bar; unsigned x;
    volatile LAS unsigned* st;
};

__device__ __forceinline__ XcdBarrier xcd_barrier_post(unsigned* bar, volatile LAS unsigned* st) {
    XcdBarrier b; b.bar = bar; b.x = xb_xcc_id(); b.st = st;
    if (threadIdx.x == 0) (void)xb_add(&bar[XB_XCNT(b.x)], 1u);
    return b;
}
__device__ __forceinline__ void xcd_barrier_complete(unsigned* bar, unsigned x, unsigned& nloc, unsigned& nx) {
    const unsigned G = gridDim.x * gridDim.y * gridDim.z;
    unsigned sum, cnt, mine, sp = 0u;
    for (;;) {
        sum = 0u; cnt = 0u; mine = 0u;
#pragma unroll
        for (unsigned j = 0; j < 16; ++j) { const unsigned c = xb_ld(&bar[XB_XCNT(j)]); sum += c; cnt += (c > 0u) ? 1u : 0u; mine = (j == x) ? c : mine; }
        if (sum == G) break;
        __builtin_amdgcn_s_sleep(1);
        if ((++sp & 255u) == 0u) { if (xb_ld(&bar[XB_TMO])) break; if (sp > XB_SPIN_CAP) { atomicAdd(&bar[XB_TMO], 1u); break; } }
    }
    nloc = mine > 0u ? mine : 1u; nx = cnt > 0u ? cnt : 1u;
}

__device__ __forceinline__ void xcd_barrier(const XcdBarrier& b) {
    asm volatile("s_waitcnt vmcnt(0)" ::: "memory");
    __syncthreads();
    if (threadIdx.x == 0) {
        unsigned* bar = b.bar;
        __builtin_amdgcn_s_waitcnt(0);
        unsigned nloc = b.st[0], nx = b.st[1];
        if (nloc == 0u) { xcd_barrier_complete(bar, b.x, nloc, nx); b.st[0] = nloc; b.st[1] = nx; }
        const unsigned old = xb_add(&bar[XB_XSUB(b.x)], 1u);
        const unsigned gen = old / nloc;
        if (old + 1u == (gen + 1u) * nloc) {
            __builtin_amdgcn_fence(__ATOMIC_RELEASE, "agent");
            asm volatile("s_waitcnt vmcnt(0)" ::: "memory");
            const unsigned og = xb_add(&bar[XB_TOP], 1u);
            const unsigned tg = og / nx;
            if (og + 1u == (tg + 1u) * nx) xb_add(&bar[XB_TOPGEN], 1u);
            else XB_SPIN(xb_ld(&bar[XB_TOPGEN]) == tg, bar);
            __builtin_amdgcn_fence(__ATOMIC_ACQUIRE, "agent");
            xb_add(&bar[XB_XGEN(b.x)], 1u);
            asm volatile("s_waitcnt vmcnt(0)" ::: "memory");
        } else {
            XB_SPIN(xb_ld(&bar[XB_XGEN(b.x)]) == gen, bar);
            __builtin_amdgcn_fence(__ATOMIC_ACQUIRE, "agent");
            asm volatile("s_waitcnt vmcnt(0)" ::: "memory");
        }
    }
    __syncthreads();
}

struct Args { const float* in[24]; float* out; unsigned char* ws; int ph_lo, ph_hi; };
typedef const __attribute__((address_space(4))) char* kptr_t;
struct KA { kptr_t k;
    __device__ __forceinline__ const float* in(int i) const { return (const float*)(const GAS float*)*(const float* const __attribute__((address_space(4)))*)(k + 8 * i); }
    __device__ __forceinline__ float* out() const { return (float*)(GAS float*)*(float* const __attribute__((address_space(4)))*)(k + 192); }
    __device__ __forceinline__ unsigned char* ws() const { return (unsigned char*)(GAS unsigned char*)*(unsigned char* const __attribute__((address_space(4)))*)(k + 200); } };
static_assert(sizeof(Args) == 216 && __builtin_offsetof(Args, out) == 192 && __builtin_offsetof(Args, ws) == 200, "Args layout");
struct Frame { LAS unsigned char* lds; int tid, lane, wave, vcu, G; };

__device__ __forceinline__ float wave_sum(float v) {
#pragma unroll
    for (int o = 1; o < 64; o <<= 1) v += __shfl_xor(v, o);
    return v;
}
struct TrD { const float* src; const float* gain; bf16* dst; int ld, mode, dK, n0, drow0, k0, up; };
__device__ __forceinline__ int map64(int n)  { return (n & ~255) + 128 * ((n >> 5) & 1) + 32 * ((n >> 6) & 3) + (n & 31); }
__device__ __forceinline__ int map128(int n) { return (n & ~255) + 128 * ((n >> 6) & 1) + 64 * ((n >> 7) & 1) + (n & 63); }
__device__ __forceinline__ void tr_load(const TrD& d, f32x4 (&rg)[8], int lane) {
    const int r = lane >> 3, c4 = lane & 7;
#pragma unroll
    for (int i = 0; i < 8; ++i) { const int kk = 8 * i + r; f32x4 v = *(const GAS f32x4*)(d.src + (size_t)(d.k0 + kk) * d.ld + d.n0 + 4 * c4);
        const float g = d.gain ? *(const GAS float*)(d.gain + d.k0 + kk) : 1.0f; rg[i] = v * g; }
}
__device__ __forceinline__ void tr_store(const TrD& d, const f32x4 (&rg)[8], LAS float* scr, int lane) {
    { const int r = lane >> 3, c4 = lane & 7;
#pragma unroll
      for (int i = 0; i < 8; ++i) { LAS float* p = scr + (8 * i + r) * 33 + 4 * c4; p[0] = rg[i].x; p[1] = rg[i].y; p[2] = rg[i].z; p[3] = rg[i].w; } }
    LDS_WAIT(); asm volatile("" ::: "memory");
    const int c = lane & 7;
#pragma unroll
    for (int j = 0; j < 4; ++j) { const int n = (lane >> 3) + 8 * j; const LAS float* s = scr + (8 * c) * 33 + n;
        v4u o; o.x = pk2(s[0 * 33], s[1 * 33]); o.y = pk2(s[2 * 33], s[3 * 33]); o.z = pk2(s[4 * 33], s[5 * 33]); o.w = pk2(s[6 * 33], s[7 * 33]);
        size_t pos;
        if (d.mode == 0) pos = (size_t)(d.drow0 + n) * d.dK + d.k0 + 8 * c;
        else { const int f = d.n0 + n, k8 = (d.k0 >> 3) + c, ks = k8 >> 2, fq = k8 & 3, fr = f & 15;
            if (d.mode == 1) { const int w = f >> 5, cb = 2 * d.up + ((f >> 4) & 1); pos = ((size_t)((w * 32 + ks) * 4 + cb) * 64 + fq * 16 + fr) * 8; }
            else { const int p = f >> 9, w = (f >> 6) & 7, cb = (f >> 4) & 3, KS = d.mode == 2 ? 8 : 32; pos = ((size_t)(((p * 8 + w) * KS + ks) * 4 + cb) * 64 + fq * 16 + fr) * 8; } }
        *(GAS v4u*)(d.dst + pos) = o; }
    LDS_WAIT(); asm volatile("" ::: "memory");
}
__device__ __forceinline__ TrD tr_decode_moe(const KA a, unsigned char* ws, int l, int it);
__device__ __forceinline__ TrD tr_decode_moe(const KA a, unsigned char* ws, int l, int it) {
    TrD d; const int slot = l & 1; d.dK = 0; d.drow0 = 0;
    if (it < 4096) {
        const int e = it >> 8, r = it & 255, up = r >> 7, q = r & 127, kb = q >> 3, nb = q & 7;
        d.src = a.in(up ? 21 : 20) + ((size_t)(l * NE + e)) * DM * FF; d.ld = FF; d.gain = a.in(15) + (size_t)l * DM;
        d.dst = (bf16*)(ws + WS_WGU) + ((size_t)(slot * NE + e)) * 512 * DM; d.mode = 1; d.n0 = 32 * nb; d.up = up; d.k0 = 64 * kb;
    } else {
        const int r0 = it - 4096, e = r0 >> 7, q = r0 & 127, kb = q >> 5, nb = q & 31;
        d.src = a.in(22) + ((size_t)(l * NE + e)) * FF * DM; d.ld = DM; d.gain = nullptr;
        d.dst = (bf16*)(ws + WS_WD) + ((size_t)(slot * NE + e)) * DM * FF; d.mode = 2; d.n0 = 32 * nb; d.up = 0; d.k0 = 64 * kb;
    }
    return d;
}
constexpr int TR_I_WIN = 16 * 96, TR_I_WO = 16 * 32, TR_I_KV = 16 * 64, TR_I_Q = 16 * 96, TR_I_MOE = 6144;
constexpr int TR_NITEMS = 2 * TR_I_WIN + 2 * TR_I_WO + TR_I_KV + 2 * TR_I_Q + 2 * TR_I_WO + 2 * TR_I_MOE;
__device__ __forceinline__ TrD tr_decode_main(const KA a, unsigned char* ws, int it) {
    TrD d; d.mode = 0; d.dK = DM; d.up = 0; int r = it;
    if (r < 2 * TR_I_WIN) { const int l = r / TR_I_WIN; r -= l * TR_I_WIN; const int kb = r / 96, nb = r % 96, n0 = 32 * nb;
        d.src = a.in(3) + (size_t)l * DM * WIN_LD; d.ld = WIN_LD; d.gain = a.in(2) + l * DM; d.dst = (bf16*)(ws + WS_WIN) + (size_t)l * 3072 * DM; d.n0 = n0; d.drow0 = map64(n0); d.k0 = 64 * kb; return d; }
    r -= 2 * TR_I_WIN;
    if (r < 2 * TR_I_WO) { const int l = r / TR_I_WO; r -= l * TR_I_WO; const int kb = r / 32, nb = r % 32;
        d.src = a.in(7) + (size_t)l * DM * DM; d.ld = DM; d.gain = nullptr; d.dst = (bf16*)(ws + WS_WOA) + (size_t)l * DM * DM; d.n0 = 32 * nb; d.drow0 = 32 * nb; d.k0 = 64 * kb; d.mode = 3; return d; }
    r -= 2 * TR_I_WO;
    if (r < TR_I_KV) { const int kb = r / 64, nb = r % 64, n0 = 32 * nb;
        d.src = a.in(9); d.ld = 2 * DM; d.gain = a.in(8); d.dst = (bf16*)(ws + WS_WKVQ0); d.n0 = n0; d.drow0 = n0 < DM ? map128(n0) : n0; d.k0 = 64 * kb; return d; }
    r -= TR_I_KV;
    if (r < 2 * TR_I_Q) { const int j = r / TR_I_Q; r -= j * TR_I_Q; const int kb = r / 96, nb = r % 96, n0 = 32 * nb;
        d.src = a.in(12) + (size_t)j * DM * 3072; d.ld = 3072; d.gain = a.in(11) + j * DM; d.dst = j == 0 ? (bf16*)(ws + WS_WKVQ0) + (size_t)2048 * DM : (bf16*)(ws + WS_WQ1); d.n0 = n0; d.drow0 = map128(n0); d.k0 = 64 * kb; return d; }
    r -= 2 * TR_I_Q;
    if (r < 2 * TR_I_WO) { const int j = r / TR_I_WO; r -= j * TR_I_WO; const int kb = r / 32, nb = r % 32;
        d.src = a.in(14) + (size_t)j * DM * DM; d.ld = DM; d.gain = nullptr; d.dst = (bf16*)(ws + WS_WOB) + (size_t)j * DM * DM; d.n0 = 32 * nb; d.drow0 = 32 * nb; d.k0 = 64 * kb; d.mode = 3; return d; }
    r -= 2 * TR_I_WO;
    { const int l = r / TR_I_MOE; return tr_decode_moe(a, ws, l, r - l * TR_I_MOE); }
}
template <bool MAIN> __device__ __forceinline__ void tr_run(const KA a, unsigned char* ws, int layer, int nitems, int gw, int NGW, LAS float* scr, int lane) {
    int it = gw; if (it >= nitems) return;
    TrD d = MAIN ? tr_decode_main(a, ws, it) : tr_decode_moe(a, ws, layer, it);
    f32x4 rg[8]; tr_load(d, rg, lane);
    for (;;) {
        const int itn = it + NGW; const bool more = itn < nitems;
        TrD dn = d; f32x4 rn[8];
        if (more) { dn = MAIN ? tr_decode_main(a, ws, itn) : tr_decode_moe(a, ws, layer, itn); tr_load(dn, rn, lane); }
        tr_store(d, rg, scr, lane);
        if (!more) break;
        d = dn; it = itn;
#pragma unroll
        for (int i = 0; i < 8; ++i) rg[i] = rn[i];
    }
}
constexpr int CW_CQ = 24576;
__device__ __forceinline__ void conv_drain(const KA a, unsigned char* ws, Frame& F, unsigned* cctr, bool main, int layer, int lo, int hi) {
    volatile LAS int* cw = (volatile LAS int*)(F.lds + MISC_OFF) + 16;
    LAS float* scr = (LAS float*)(F.lds + RING_OFF + F.wave * 16384);
    const int nb = (hi - lo + 63) >> 6;
    for (;;) {
        __syncthreads();
        if (F.tid == 0) cw[0] = (int)__hip_atomic_fetch_add(cctr, 1u, RLX_AGENT);
        __syncthreads();
        const int b = __builtin_amdgcn_readfirstlane(cw[0]);
        if (b >= nb) break;
        const int base = lo + b * 64, end = (base + 64 < hi) ? base + 64 : hi;
        int it = base + F.wave; if (it >= end) continue;
        TrD d = main ? tr_decode_main(a, ws, it) : tr_decode_moe(a, ws, layer, it);
        f32x4 rg[8]; tr_load(d, rg, F.lane);
        for (;;) {
            const int itn = it + 8; const bool more = itn < end;
            TrD dn = d; f32x4 rn[8];
            if (more) { dn = main ? tr_decode_main(a, ws, itn) : tr_decode_moe(a, ws, layer, itn); tr_load(dn, rn, F.lane); }
            tr_store(d, rg, scr, F.lane);
            if (!more) break;
            d = dn; it = itn;
#pragma unroll
            for (int i = 0; i < 8; ++i) rg[i] = rn[i];
        }
    }
    __syncthreads();
}
__device__ __forceinline__ void sincos_f64(double a, float& c, float& s) {
    const double q = __builtin_rint(a * 0.63661977236758134308);
    const double r = __builtin_fma(-q, 6.123233995736766036e-17, __builtin_fma(-q, 1.5707963267948966192, a));
    const double r2 = r * r;
    double sp = -1.0 / 39916800.0; sp = sp * r2 + 1.0 / 362880.0; sp = sp * r2 - 1.0 / 5040.0; sp = sp * r2 + 1.0 / 120.0; sp = sp * r2 - 1.0 / 6.0; sp = sp * r2 * r + r;
    double cp = 1.0 / 479001600.0; cp = cp * r2 - 1.0 / 3628800.0; cp = cp * r2 + 1.0 / 40320.0; cp = cp * r2 - 1.0 / 720.0; cp = cp * r2 + 1.0 / 24.0; cp = cp * r2 - 0.5; cp = cp * r2 + 1.0;
    const int qi = (int)((long long)q & 3);
    const double cs = (qi == 0) ? cp : (qi == 1) ? -sp : (qi == 2) ? -cp : sp;
    const double sn = (qi == 0) ? sp : (qi == 1) ? cp : (qi == 2) ? -sp : -cp;
    c = (float)cs; s = (float)sn;
}
__device__ __forceinline__ void p_prologue(const KA a, Frame& F) {
    unsigned char* ws = a.ws(); asm volatile("" : "+s"(ws)); ASSUME_GLOBAL(ws);
    LAS float* scr = (LAS float*)(F.lds + RING_OFF + F.wave * 16384);
    const int gw = F.vcu * NWAVES + F.wave, NGW = F.G * NWAVES;
    tr_run<true>(a, ws, 0, TR_I_WIN, gw, NGW, scr, F.lane);
    const int gt = (F.vcu * NWAVES + F.wave) * 64 + F.lane, NGT = NGW * 64;
    for (int i = gt; i < 2 * 16 * DM; i += NGT) { const int l = i / (16 * DM), v = (i / DM) % 16, k = i % DM;
        ((float*)(ws + WS_WF))[i] = a.in(3)[(size_t)l * DM * WIN_LD + (size_t)k * WIN_LD + 3 * DM + v] * a.in(2)[l * DM + k]; }
    for (int i = gt; i < 4 * 20 * DM; i += NGT) { const int l = i / (20 * DM), v = (i / DM) % 20, k = i % DM;
        const float w = v < 4 ? a.in(16)[(size_t)l * DM * 4 + k * 4 + v] : a.in(18)[(size_t)l * DM * 16 + k * 16 + (v - 4)];
        ((float*)(ws + WS_WR))[i] = w * a.in(15)[l * DM + k]; }
    for (int i = gt; i < 2 * 192; i += NGT) { const int l = i / 192, sec = (i / 64) % 3, dd = i % 64;
        ((float*)(ws + WS_GTAB))[i] = sec == 0 ? a.in(5)[l * AHD + dd] * (0.125f * LOG2E) : (sec == 1 ? a.in(6)[l * AHD + dd] : 1.0f); }
    const int* pos = (const int*)a.in(1);
    for (int i = gt; i < TOK * 64; i += NGT) { const int m = i >> 6, f = i & 63;
        const float invf = powf(10000.0f, -(float)f / 64.0f);
        const float ang = (float)pos[m] * invf;
        float c, s; sincos_f64((double)ang, c, s);
        ((unsigned*)(ws + WS_ROPEC))[i] = (unsigned)__builtin_bit_cast(unsigned short, (_Float16)c) | ((unsigned)__builtin_bit_cast(unsigned short, (_Float16)s) << 16); }
}

template <int N, int O> struct RedTree {
    static __device__ __forceinline__ void run(float (&v)[80], int lane, int& base) {
        if constexpr (O >= 1) {
            if constexpr (N % 2 == 0) {
                const bool up = (lane & O) != 0;
#pragma unroll
                for (int i = 0; i < N / 2; ++i) { const float keep = up ? v[i + N / 2] : v[i], send = up ? v[i] : v[i + N / 2]; v[i] = keep + __shfl_xor(send, O); }
                if (up) base += N / 2;
                RedTree<N / 2, O / 2>::run(v, lane, base);
            } else {
#pragma unroll
                for (int i = 0; i < N; ++i) v[i] += __shfl_xor(v[i], O);
                RedTree<N, O / 2>::run(v, lane, base);
            }
        }
    }
};
template <int MODE> __device__ __forceinline__ void p_rowpass(const KA a, Frame& F, int layer, bool dry = false, const float* Hsrc = nullptr, bool raw_wf = false) {
    unsigned char* ws = a.ws(); asm volatile("" : "+s"(ws)); ASSUME_GLOBAL(ws);
    constexpr int NV = MODE == 1 ? 16 : (MODE == 2 ? 20 : 0), NT = MODE == 2 ? 2 : 4, NVAL = NT * NV;
    constexpr int NFIN = MODE == 2 ? 5 : 1;
    LAS float* wl = (LAS float*)(F.lds + RING_OFF);
    LAS float* red = (LAS float*)(F.lds + RING_OFF + 96 * 1024) + F.wave * 96;
    if (NV) {
        if (MODE == 1 && raw_wf) {
            const float* win = a.in(3) + (size_t)layer * DM * WIN_LD + 3 * DM; const float* gn = a.in(2) + layer * DM;
            for (int i = F.tid; i < 16 * DM; i += NWAVES * 64) { const int k = i >> 4, v = i & 15; wl[v * DM + k] = *(const GAS float*)(win + (size_t)k * WIN_LD + v) * *(const GAS float*)(gn + k); }
        } else {
        const float* wsrc = MODE == 1 ? (const float*)(ws + WS_WF) + (size_t)layer * 16 * DM : (const float*)(ws + WS_WR) + (size_t)layer * 20 * DM;
        for (int i = F.tid; i < NV * DM / 4; i += NWAVES * 64) ((LAS f32x4*)wl)[i] = ((const f32x4*)wsrc)[i];
        }
        __syncthreads();
    }
    const int gw = F.vcu * NWAVES + F.wave, NGW = F.G * NWAVES;
    const float* H = Hsrc ? Hsrc : a.out(); float* rstd = (float*)(ws + WS_RSTD); bf16* hb = (bf16*)(ws + WS_HB);
    for (int m0 = NT * gw; m0 < TOK; m0 += NT * NGW) {
        f32x4 v[NT][4]; float rs[4] = {0.f, 0.f, 0.f, 0.f};
#pragma unroll
        for (int r = 0; r < NT; ++r) { const f32x4* xr = (const f32x4*)(H + (size_t)(m0 + r) * DM) + F.lane;
#pragma unroll
            for (int j = 0; j < 4; ++j) v[r][j] = xr[64 * j]; }
#pragma unroll
        for (int r = 0; r < NT; ++r) { float s = 0.f;
#pragma unroll
            for (int j = 0; j < 4; ++j) s += (v[r][j].x * v[r][j].x + v[r][j].y * v[r][j].y) + (v[r][j].z * v[r][j].z + v[r][j].w * v[r][j].w);
            rs[r] = 1.0f / sqrtf(wave_sum(s) * (1.0f / DM) + 1e-6f);
            unsigned long long* o8 = (unsigned long long*)(hb + (size_t)(m0 + r) * DM) + F.lane;
#pragma unroll
            for (int j = 0; j < 4; ++j) o8[64 * j] = (unsigned long long)pk2(v[r][j].x, v[r][j].y) | ((unsigned long long)pk2(v[r][j].z, v[r][j].w) << 32); }
        if (F.lane < NT) rstd[m0 + F.lane] = F.lane == 0 ? rs[0] : (F.lane == 1 ? rs[1] : (F.lane == 2 ? rs[2] : rs[3]));
        if (NV) {
            float pv[80];
#pragma unroll
            for (int q = 0; q < NV; ++q) {
                f32x4 w[4];
#pragma unroll
                for (int j = 0; j < 4; ++j) w[j] = ((const LAS f32x4*)(wl + q * DM))[F.lane + 64 * j];
#pragma unroll
                for (int r = 0; r < NT; ++r) { float p = 0.f;
#pragma unroll
                    for (int j = 0; j < 4; ++j) p += (v[r][j].x * w[j].x + v[r][j].y * w[j].y) + (v[r][j].z * w[j].z + v[r][j].w * w[j].w);
                    pv[r * NV + q] = p; }
            }
            int base = 0;
            RedTree<NVAL, 32>::run(pv, F.lane, base);
            if (MODE == 1) {
                const int r = base >> 4, hh = base & 15; const float rsr = r == 0 ? rs[0] : (r == 1 ? rs[1] : (r == 2 ? rs[2] : rs[3]));
                const float z = pv[0] * rsr + a.in(4)[layer * AH + hh]; const float ls = fminf(z, 0.f) - __logf(1.0f + __expf(-fabsf(z)));
                const int m = m0 + r, b = m / SEQ, sidx = m % SEQ; ((float*)(ws + WS_LOGF))[(size_t)(b * AH + hh) * SEQ + sidx] = ls;
            } else if (MODE == 2) {
#pragma unroll
                for (int i = 0; i < NFIN; ++i) red[base + i] = pv[i];
                LDS_WAIT(); asm volatile("" ::: "memory");
                if (F.lane < NT) {
                    const int m = m0 + F.lane; const float rsr = F.lane == 0 ? rs[0] : (F.lane == 1 ? rs[1] : (F.lane == 2 ? rs[2] : rs[3]));
                    float d[20];
#pragma unroll
                    for (int q = 0; q < 20; ++q) d[q] = red[F.lane * 20 + q] * rsr;
                    const float* gb = a.in(17) + layer * 4;
                    float lg[4];
#pragma unroll
                    for (int q = 0; q < 4; ++q) lg[q] = d[q] + gb[q];
                    int gi = 0; float gm = lg[0];
#pragma unroll
                    for (int q = 1; q < 4; ++q) if (lg[q] > gm) { gm = lg[q]; gi = q; }
                    float gs = 0.f;
#pragma unroll
                    for (int q = 0; q < 4; ++q) gs += expf(lg[q] - gm);
                    const float gp = 1.0f / gs;
                    const float* ebp = a.in(19) + layer * 16;
                    float el[4];
#pragma unroll
                    for (int q = 0; q < 4; ++q) { float t = 0.f;
#pragma unroll
                        for (int g2 = 0; g2 < 4; ++g2) if (g2 == gi) t = d[4 + 4 * g2 + q] + ebp[4 * g2 + q];
                        el[q] = t; }
                    int i1 = 0; float v1 = el[0];
#pragma unroll
                    for (int q = 1; q < 4; ++q) if (el[q] > v1) { v1 = el[q]; i1 = q; }
                    int i2 = -1; float v2 = 0.f;
#pragma unroll
                    for (int q = 0; q < 4; ++q) if (q != i1 && (i2 < 0 || el[q] > v2)) { v2 = el[q]; i2 = q; }
                    const float e2 = expf(v2 - v1), g1 = gp / (1.0f + e2), g2v = gp * e2 / (1.0f + e2);
                    const int lo = i1 < i2 ? i1 : i2, hi = i1 < i2 ? i2 : i1;
                    const int pidx = (lo == 0) ? (hi - 1) : (lo == 1 ? hi + 1 : 5);
                    const int cls = gi * 6 + pidx;
                    if (!dry) {
                        const unsigned p = __hip_atomic_fetch_add((unsigned*)(ws + WS_CTL) + CW_CNT + layer * 64 + cls, 1u, RLX_AGENT);
                        ((int*)(ws + WS_LIST))[(size_t)cls * TOK + p] = m;
                        ((float*)(ws + WS_GA))[m] = (i1 < i2) ? g1 : g2v;
                        ((float*)(ws + WS_GB))[m] = (i1 < i2) ? g2v : g1;
                    }
                }
                LDS_WAIT(); asm volatile("" ::: "memory");
            }
        }
    }
    __syncthreads();
}

__device__ __forceinline__ swa::BlockRef<swa::bf16, swa::bf16> b_unit_ref(unsigned char* ws, int id, bool dry) {
    const int g = id >> 9, r0 = id & 511, bh = r0 >> 5, r1 = r0 & 31;
    const int dl = (g == 0) ? 1 : (g == 1 ? 4 : 16), nq = 32 / dl, res = r1 / nq, qb = r1 % nq;
    const int b = bh >> 3, h = bh & 7;
    const size_t tok0 = (size_t)b * SEQ + res;
    swa::BlockRef<swa::bf16, swa::bf16> R;
    swa::bf16* qbase = (swa::bf16*)(ws + WS_QB) + tok0 * 3072 + g * 1024 + h * 128;
    R.Q = qbase + (size_t)qb * 256 * dl * 3072; R.O = qbase + (size_t)qb * 256 * dl * 3072; R.qp = dl * 3072; R.op = dl * 3072;
    R.K = (const swa::bf16*)(ws + WS_KB) + tok0 * 1024 + h * 128; R.V = (const swa::bf16*)(ws + WS_VB) + tok0 * 1024 + h * 128; R.kp = dl * 1024;
    R.L = (float*)(ws + WS_LSE) + (tok0 + (size_t)qb * 256 * dl) * 24 + g * 8 + h; R.lp = dl * 24;
    R.P0 = qb * 256;
    if (dry) { R.O = (swa::bf16*)(ws + WS_HB) + tok0 * 1024 + h * 128 + (size_t)qb * 256 * dl * 1024; R.op = dl * 1024; R.L = nullptr; }
    return R;
}
__device__ __forceinline__ void p_battn(const KA a, Frame& F, bool dry) {
    unsigned char* ws = a.ws(); asm volatile("" : "+s"(ws)); ASSUME_GLOBAL(ws); char* lds = (char*)(F.lds + RING_OFF);
    constexpr int NUNITS = 3 * 512;
    const int bid0 = bid_fresh();
    const bool xdeal = gridDim.x == 256; const int vc = (bid0 & 7) * 32 + (bid0 >> 3), xj = vc & 31, xb = (vc >> 5) * 2; int it = 0;
#define B_PAIR(it_) (xj + 32 * ((it_) >> 1))
#define B_UNIT_ID(it_) (xdeal ? ((((B_PAIR(it_)) / 16) % 3) * 512 + (xb + (B_PAIR(it_)) / 48) * 32 + 2 * ((B_PAIR(it_)) % 16) + ((it_) & 1)) : (bid0 + (it_) * (int)gridDim.x))
    int id = B_UNIT_ID(0);
    if (id >= NUNITS) return;
    typedef swa::BlockRef<swa::bf16, swa::bf16> Ref;
    Ref cur = b_unit_ref(ws, id, dry);
    swa::Seam<swa::bf16> S;
    swa::causal_swa_prime<swa::bf16, swa::bf16>(cur, 129, lds, S);
    for (;;) {
        ++it; const int idn = (xdeal && it >= 6) ? NUNITS : B_UNIT_ID(it); const bool last = idn >= NUNITS;
        const Ref nxt = last ? cur : b_unit_ref(ws, idn, dry);
        const int dl = (id >> 9) == 0 ? 1 : ((id >> 9) == 1 ? 4 : 16);
        swa::causal_swa_block<swa::bf16, swa::bf16>(cur, nxt, SEQ / dl, 129, lds, S);
        if (last) break;
        cur = nxt; id = idn;
    }
#undef B_UNIT_ID
#undef B_PAIR
}
__device__ __forceinline__ void p_bmerge(const KA a, Frame& F) {
    unsigned char* ws = a.ws(); asm volatile("" : "+s"(ws)); ASSUME_GLOBAL(ws);
    const int gw = F.vcu * NWAVES + F.wave, NGW = F.G * NWAVES;
    const bf16* og = (const bf16*)(ws + WS_QB); const float* lse = (const float*)(ws + WS_LSE); bf16* o = (bf16*)(ws + WS_HB);
    for (int m = gw; m < TOK; m += NGW) {
        const int h = F.lane >> 3;
        const float l0 = lse[(size_t)m * 24 + h], l1 = lse[(size_t)m * 24 + 8 + h], l2 = lse[(size_t)m * 24 + 16 + h];
        const float mx = fmaxf(l0, fmaxf(l1, l2));
        const float e0 = expf(l0 - mx), e1 = expf(l1 - mx), e2 = expf(l2 - mx), inv = 1.0f / (e0 + e1 + e2);
        const float w0 = e0 * inv, w1 = e1 * inv, w2 = e2 * inv;
        float accv[16];
#pragma unroll
        for (int i = 0; i < 16; ++i) accv[i] = 0.f;
#pragma unroll
        for (int g = 0; g < 3; ++g) { const float w = g == 0 ? w0 : (g == 1 ? w1 : w2);
            const v4u* p = (const v4u*)(og + (size_t)m * 3072 + g * 1024 + F.lane * 16);
#pragma unroll
            for (int q = 0; q < 2; ++q) { const v4u x = p[q];
                const unsigned xs[4] = {x.x, x.y, x.z, x.w};
#pragma unroll
                for (int e = 0; e < 4; ++e) { accv[q * 8 + 2 * e] += w * bf2f(xs[e] & 0xffffu); accv[q * 8 + 2 * e + 1] += w * bf2f(xs[e] >> 16); } } }
        v4u* po = (v4u*)(o + (size_t)m * DM + F.lane * 16);
#pragma unroll
        for (int q = 0; q < 2; ++q) { v4u w; w.x = pk2(accv[q * 8 + 0], accv[q * 8 + 1]); w.y = pk2(accv[q * 8 + 2], accv[q * 8 + 3]); w.z = pk2(accv[q * 8 + 4], accv[q * 8 + 5]); w.w = pk2(accv[q * 8 + 6], accv[q * 8 + 7]); po[q] = w; }
    }
}

constexpr int MOE_AP = 128 + 8;
constexpr int MOE_HP = 512 + 8;
constexpr int MOE_A_BYTES = MROWS * MOE_AP * 2;
constexpr int MOE_A_OFF = 0, MOE_H_OFF = 2 * MOE_A_BYTES, MOE_T_OFF = MOE_H_OFF + MROWS * MOE_HP * 2;
static_assert(MOE_T_OFF + 3 * MROWS * 4 <= RING_BYTES, "MoE LDS");
typedef float f32x4m __attribute__((ext_vector_type(4)));
__device__ __forceinline__ void p_moe(const KA a, Frame& F, int layer, float upd) {
    unsigned char* ws = a.ws(); asm volatile("" : "+s"(ws)); ASSUME_GLOBAL(ws);
    const unsigned* cnt = (const unsigned*)(ws + WS_CTL) + CW_CNT + layer * 64;
    for (int u = F.vcu; ; u += (int)gridDim.x) {
    int cls = -1, tile = 0, n_c = 0;
    { int accu = 0;
      for (int c = 0; c < NCLS; ++c) { const int n = (int)__hip_atomic_load(cnt + c, RLX_AGENT); const int nt = (n + MROWS - 1) / MROWS;
          if (cls < 0 && u < accu + nt) { cls = c; tile = u - accu; n_c = n; } accu += nt; } }
    if (cls < 0) break;
    const int nrow = (n_c - tile * MROWS) < MROWS ? (n_c - tile * MROWS) : MROWS;
    const int grp = cls / 6, pidx = cls % 6;
    const int elo = pidx < 3 ? 0 : (pidx < 5 ? 1 : 2), ehi = pidx < 3 ? pidx + 1 : (pidx < 5 ? pidx - 1 : 3);
    const int slot = layer & 1;
    const int ea = grp * 4 + elo, eb = grp * 4 + ehi;
    LAS bf16* Al = (LAS bf16*)(F.lds + RING_OFF + MOE_A_OFF); LAS bf16* Hl = (LAS bf16*)(F.lds + RING_OFF + MOE_H_OFF);
    LAS int* tokl = (LAS int*)(F.lds + RING_OFF + MOE_T_OFF); LAS float* gal = (LAS float*)(tokl + MROWS); LAS float* gbl = gal + MROWS;
    if (F.tid < MROWS) { const bool ok = F.tid < nrow; const int t = ok ? ((const int*)(ws + WS_LIST))[(size_t)cls * TOK + tile * MROWS + F.tid] : 0;
        tokl[F.tid] = ok ? t : -1; gal[F.tid] = ok ? ((const float*)(ws + WS_GA))[t] : 0.f; gbl[F.tid] = ok ? ((const float*)(ws + WS_GB))[t] : 0.f; }
    __syncthreads();
    const bf16* hb = (const bf16*)(ws + WS_HB);
    const int fr = F.lane & 15, fq = F.lane >> 4, w = F.wave; const unsigned lb = (unsigned)F.lane * 16u;
    int grow[3]; unsigned gsrc[3]; bool gld[3];
#pragma unroll
    for (int i = 0; i < 3; ++i) { const int idx = F.tid + 512 * i; const int r = idx >> 4; const int t = (idx < MROWS * 16) ? tokl[r] : -1; grow[i] = (idx < MROWS * 16) ? (r * MOE_AP + (idx & 15) * 8) : -1;
        gsrc[i] = (unsigned)((t >= 0 ? t : 0) * DM + (idx & 15) * 8); gld[i] = t >= 0; }
#define MOE_GLOAD(kc_) do { _Pragma("unroll") for (int i = 0; i < 3; ++i) { const v4u t_ = *(const GAS v4u*)((const char*)hb + (gsrc[i] + (unsigned)((kc_) * 128)) * 2u); \
        greg[i].x = gld[i] ? t_.x : 0u; greg[i].y = gld[i] ? t_.y : 0u; greg[i].z = gld[i] ? t_.z : 0u; greg[i].w = gld[i] ? t_.w : 0u; } } while (0)
#define MOE_GSTORE(buf_) do { _Pragma("unroll") for (int i = 0; i < 3; ++i) { if (grow[i] >= 0) *(LAS v4u*)(Al + (buf_) * (MOE_A_BYTES / 2) + grow[i]) = greg[i]; } } while (0)
#pragma unroll 1
    for (int xi = 0; xi < 2; ++xi) { const int x = xi ^ (tile & 1);
        const bf16* Wt = (const bf16*)(ws + WS_WGU) + ((size_t)(slot * NE + (x ? eb : ea))) * 512 * DM + (size_t)w * (32 * 4 * 64 * 8);
        f32x4m acc[5][4];
#pragma unroll
        for (int rb = 0; rb < 5; ++rb)
#pragma unroll
            for (int cb = 0; cb < 4; ++cb) acc[rb][cb] = (f32x4m){0.f, 0.f, 0.f, 0.f};
        v4u greg[3]; bf16x8 bfr[4][4];
#pragma unroll
        for (int i = 0; i < 3; ++i) { greg[i].x = 0u; greg[i].y = 0u; greg[i].z = 0u; greg[i].w = 0u; }
        MOE_GLOAD(0);
#pragma unroll
        for (int r = 0; r < 3; ++r)
#pragma unroll
            for (int cb = 0; cb < 4; ++cb) bfr[r][cb] = *(const GAS bf16x8*)((const char*)(Wt + (r * 4 + cb) * 512) + lb);
        MOE_GSTORE(0);
        LDS_WAIT(); __builtin_amdgcn_s_barrier(); asm volatile("" ::: "memory");
#pragma unroll 1
        for (int kc = 0; kc < 8; ++kc) {
            MOE_GLOAD(kc < 7 ? kc + 1 : 7);
            const LAS bf16* Ab = Al + (kc & 1) * (MOE_A_BYTES / 2);
            bf16x8 afn = *(const LAS bf16x8*)(Ab + fr * MOE_AP + fq * 8);
#pragma unroll
            for (int j = 0; j < 4; ++j) {
                const int ks = kc * 4 + j, kn = (ks + 3 < 32) ? ks + 3 : 31;
#pragma unroll
                for (int cb = 0; cb < 4; ++cb) bfr[(j + 3) & 3][cb] = *(const GAS bf16x8*)((const char*)(Wt + (kn * 4 + cb) * 512) + lb);
#pragma unroll
                for (int rb = 0; rb < 5; ++rb) { const bf16x8 af = afn; const int tn = j * 5 + rb + 1, jn = tn / 5, rn = tn % 5;
                    if (tn < 20) afn = *(const LAS bf16x8*)(Ab + (rn * 16 + fr) * MOE_AP + jn * 32 + fq * 8);
                    __builtin_amdgcn_sched_barrier(0);
#pragma unroll
                    for (int cb = 0; cb < 4; ++cb) acc[rb][cb] = __builtin_amdgcn_mfma_f32_16x16x32_bf16(bfr[j][cb], af, acc[rb][cb], 0, 0, 0);
                    __builtin_amdgcn_sched_barrier(0); }
            }
            if (kc < 7) MOE_GSTORE((kc + 1) & 1);
            LDS_WAIT(); __builtin_amdgcn_s_barrier(); asm volatile("" ::: "memory");
        }
        { const int l2 = tid_fresh() & 63, fr = l2 & 15, fq = l2 >> 4;
#pragma unroll
        for (int rb = 0; rb < 5; ++rb) { const int row = rb * 16 + fr; const float gt = x ? gbl[row] : gal[row];
#pragma unroll
            for (int cb = 0; cb < 2; ++cb) { float hv[4];
#pragma unroll
                for (int j = 0; j < 4; ++j) { const float gv = acc[rb][cb][j], uv = acc[rb][cb + 2][j]; hv[j] = gv / (1.0f + __expf(-gv)) * uv * gt; }
                *(LAS unsigned long long*)(Hl + row * MOE_HP + x * 256 + 32 * w + 16 * cb + 4 * fq) = (unsigned long long)pk2(hv[0], hv[1]) | ((unsigned long long)pk2(hv[2], hv[3]) << 32); } }
        }
    }
    __syncthreads();
    float* H = a.out(); LAS float* ssl = (LAS float*)(F.lds + RING_OFF + MOE_A_OFF);
#pragma unroll 1
    for (int pi = 0; pi < 2; ++pi) { const int p = pi ^ ((tile >> 1) & 1);
        const bf16* WtA = (const bf16*)(ws + WS_WD) + ((size_t)(slot * NE + ea)) * DM * FF + (size_t)(p * 8 + w) * (8 * 4 * 64 * 8);
        const bf16* WtB = (const bf16*)(ws + WS_WD) + ((size_t)(slot * NE + eb)) * DM * FF + (size_t)(p * 8 + w) * (8 * 4 * 64 * 8);
        f32x4m acc[5][4];
#pragma unroll
        for (int rb = 0; rb < 5; ++rb)
#pragma unroll
            for (int cb = 0; cb < 4; ++cb) acc[rb][cb] = (f32x4m){0.f, 0.f, 0.f, 0.f};
        bf16x8 bfr[4][4];
#pragma unroll
        for (int r = 0; r < 3; ++r)
#pragma unroll
            for (int cb = 0; cb < 4; ++cb) bfr[r][cb] = *(const GAS bf16x8*)((const char*)(WtA + (r * 4 + cb) * 512) + lb);
        bf16x8 afn = *(const LAS bf16x8*)(Hl + fr * MOE_HP + fq * 8);
#pragma unroll 1
        for (int kc = 0; kc < 4; ++kc) {
#pragma unroll
            for (int j = 0; j < 4; ++j) {
                const int ks = kc * 4 + j, kn = (ks + 3 < 16) ? ks + 3 : 15;
                { const bf16* Wn = (kn < 8 ? WtA : WtB) + ((kn & 7) * 4) * 512;
#pragma unroll
                    for (int cb = 0; cb < 4; ++cb) bfr[(j + 3) & 3][cb] = *(const GAS bf16x8*)((const char*)(Wn + cb * 512) + lb); }
#pragma unroll
                for (int rb = 0; rb < 5; ++rb) { const bf16x8 af = afn; const int rn = (rb + 1) % 5, kq = ks + (rb == 4 ? 1 : 0);
                    afn = *(const LAS bf16x8*)(Hl + (rn * 16 + fr) * MOE_HP + (kq < 16 ? kq : 15) * 32 + fq * 8);
                    __builtin_amdgcn_sched_barrier(0);
#pragma unroll
                    for (int cb = 0; cb < 4; ++cb) acc[rb][cb] = __builtin_amdgcn_mfma_f32_16x16x32_bf16(bfr[j][cb], af, acc[rb][cb], 0, 0, 0);
                    __builtin_amdgcn_sched_barrier(0); }
            }
        }
        const int l3 = tid_fresh() & 63, fr3 = l3 & 15, fq3 = l3 >> 4;
        bf16* hbw = (bf16*)(ws + WS_HB);
#pragma unroll
        for (int rb = 0; rb < 5; ++rb) { const int t = tokl[rb * 16 + fr3]; float ssq = 0.f;
            if (t >= 0) { GAS f32x4* hp = (GAS f32x4*)(H + (size_t)t * DM + 512 * p + 64 * w + 4 * fq3); GAS unsigned long long* bp = (GAS unsigned long long*)(hbw + (size_t)t * DM + 512 * p + 64 * w + 4 * fq3);
#pragma unroll
                for (int cb = 0; cb < 4; ++cb) { const f32x4 hn = hp[4 * cb] + acc[rb][cb] * upd; hp[4 * cb] = hn; ssq += (hn.x * hn.x + hn.y * hn.y) + (hn.z * hn.z + hn.w * hn.w);
                    bp[4 * cb] = (unsigned long long)pk2(hn.x, hn.y) | ((unsigned long long)pk2(hn.z, hn.w) << 32); } }
            ssq += __shfl_xor(ssq, 16); ssq += __shfl_xor(ssq, 32);
            if (fq3 == 0) ssl[(rb * 16 + fr3) * 16 + p * 8 + w] = ssq; }
    }
    __syncthreads();
    if (F.tid < MROWS) { const int t = tokl[F.tid]; float tot = 0.f;
#pragma unroll
        for (int i = 0; i < 16; ++i) tot += ssl[F.tid * 16 + i];
        if (t >= 0) ((float*)(ws + WS_RSTD))[t] = 1.0f / sqrtf(tot * (1.0f / DM) + 1e-6f); }
    __syncthreads();
#undef MOE_GLOAD
#undef MOE_GSTORE
    }
}

constexpr int OPR_ROWS = 64, OPR_AP = 128 + 8;
constexpr int OPR_WR_OFF = 0;
constexpr int OPR_A_OFF = 81920, OPR_A_BYTES = OPR_ROWS * OPR_AP * 2;
constexpr int OPR_PART_OFF = OPR_A_OFF + 2 * OPR_A_BYTES;
constexpr int OPR_SUM_OFF = OPR_PART_OFF + 20480;
constexpr int OPR_SSQ_OFF = OPR_SUM_OFF + 5120;
constexpr int OPR_WQ_OFF = OPR_SSQ_OFF + 4096;
static_assert(OPR_WQ_OFF + 8192 <= MISC_OFF, "OPR LDS");
template <bool MERGE> __device__ __forceinline__ void p_opr(const KA a, Frame& F, int layer, const bf16* Wt_all, const float* base, bool dry) {
    unsigned char* ws = a.ws(); asm volatile("" : "+s"(ws)); ASSUME_GLOBAL(ws);
    LAS float* wrl = (LAS float*)(F.lds + OPR_WR_OFF); LAS bf16* Al = (LAS bf16*)(F.lds + OPR_A_OFF);
    LAS float* part = (LAS float*)(F.lds + OPR_PART_OFF); LAS float* sums = (LAS float*)(F.lds + OPR_SUM_OFF); LAS float* ssl = (LAS float*)(F.lds + OPR_SSQ_OFF); LAS float* wql = (LAS float*)(F.lds + OPR_WQ_OFF);
    { const float* wsrc = (const float*)(ws + WS_WR) + (size_t)layer * 20 * DM;
      for (int i = F.tid; i < 20 * DM / 4; i += NWAVES * 64) ((LAS f32x4*)wrl)[i] = *(const GAS f32x4*)(wsrc + 4 * i); }
    float* H = a.out(); bf16* hbw = (bf16*)(ws + WS_HB);
    const int fr = F.lane & 15, fq = F.lane >> 4, w = F.wave; const unsigned lb = (unsigned)F.lane * 16u;
    for (int u = bid_fresh(); u < TOK / OPR_ROWS; u += (int)gridDim.x) {
    const int row0 = u * OPR_ROWS; const int rot = (u * 3) & 7;
#define OPR_KC(kc_) (((kc_) + rot) & 7)
#define OPR_KS(s_) (OPR_KC((s_) >> 2) * 4 + ((s_) & 3))
    if (MERGE) {
        const int r = F.tid >> 3, hh = F.tid & 7; const float* lp = (const float*)(ws + WS_LSE) + (size_t)(row0 + r) * 24 + hh;
        const float l0 = *(const GAS float*)lp, l1 = *(const GAS float*)(lp + 8), l2 = *(const GAS float*)(lp + 16);
        const float mx = fmaxf(l0, fmaxf(l1, l2)); const float e0 = expf(l0 - mx), e1 = expf(l1 - mx), e2 = expf(l2 - mx), inv = 1.0f / (e0 + e1 + e2);
        *(LAS f32x4*)(wql + (r * 8 + hh) * 4) = (f32x4){e0 * inv, e1 * inv, e2 * inv, 0.f};
    }
    __syncthreads();
    const bf16* asrc = MERGE ? (const bf16*)(ws + WS_QB) : (const bf16*)(ws + WS_QB);
    unsigned gsrc[2]; int grow[2];
#pragma unroll
    for (int i = 0; i < 2; ++i) { const int idx = F.tid + 512 * i, r = idx >> 4, c = idx & 15; grow[i] = r * OPR_AP + c * 8; gsrc[i] = (unsigned)((row0 + r) * (MERGE ? 3072 : 1024) + c * 8); }
    constexpr int NG = MERGE ? 3 : 1;
#define OPR_GLOAD(kc_) do { _Pragma("unroll") for (int i = 0; i < 2; ++i) _Pragma("unroll") for (int g = 0; g < NG; ++g) \
        greg[i][g] = *(const GAS v4u*)((const char*)asrc + (gsrc[i] + (unsigned)(g * 1024 + OPR_KC(kc_) * 128)) * 2u); } while (0)
#define OPR_GSTORE(buf_, kc_) do { _Pragma("unroll") for (int i = 0; i < 2; ++i) { v4u o_; \
        if (MERGE) { const int r_ = (F.tid + 512 * i) >> 4; const f32x4 wq_ = *(const LAS f32x4*)(wql + (r_ * 8 + OPR_KC(kc_)) * 4); \
            const unsigned x0_[4] = {greg[i][0].x, greg[i][0].y, greg[i][0].z, greg[i][0].w}, x1_[4] = {greg[i][NG > 1 ? 1 : 0].x, greg[i][NG > 1 ? 1 : 0].y, greg[i][NG > 1 ? 1 : 0].z, greg[i][NG > 1 ? 1 : 0].w}, \
                           x2_[4] = {greg[i][NG > 2 ? 2 : 0].x, greg[i][NG > 2 ? 2 : 0].y, greg[i][NG > 2 ? 2 : 0].z, greg[i][NG > 2 ? 2 : 0].w}; unsigned y_[4]; \
            _Pragma("unroll") for (int e = 0; e < 4; ++e) { const float lo_ = wq_.x * bf2f(x0_[e] & 0xffffu) + wq_.y * bf2f(x1_[e] & 0xffffu) + wq_.z * bf2f(x2_[e] & 0xffffu), \
                                                                     hi_ = wq_.x * bf2f(x0_[e] >> 16) + wq_.y * bf2f(x1_[e] >> 16) + wq_.z * bf2f(x2_[e] >> 16); y_[e] = pk2(lo_, hi_); } \
            o_ = (v4u){y_[0], y_[1], y_[2], y_[3]}; } else o_ = greg[i][0]; \
        *(LAS v4u*)(Al + (buf_) * (OPR_A_BYTES / 2) + grow[i]) = o_; } } while (0)
#pragma unroll 1
    for (int p = 0; p < 2; ++p) {
        const bf16* Wt = Wt_all + (size_t)(p * 8 + w) * (32 * 4 * 64 * 8);
        f32x4m acc[4][4];
#pragma unroll
        for (int rb = 0; rb < 4; ++rb)
#pragma unroll
            for (int cb = 0; cb < 4; ++cb) acc[rb][cb] = *(const GAS f32x4*)(base + (size_t)(row0 + rb * 16 + fr) * DM + 512 * p + 64 * w + 4 * fq + 16 * cb);
        v4u greg[2][NG]; bf16x8 bfr[4][4];
        OPR_GLOAD(0);
#pragma unroll
        for (int r = 0; r < 3; ++r)
#pragma unroll
            for (int cb = 0; cb < 4; ++cb) bfr[r][cb] = *(const GAS bf16x8*)((const char*)(Wt + (OPR_KS(r) * 4 + cb) * 512) + lb);
        OPR_GSTORE(0, 0);
        LDS_WAIT(); __builtin_amdgcn_s_barrier(); asm volatile("" ::: "memory");
#pragma unroll 1
        for (int kc = 0; kc < 8; ++kc) {
            const int kcn = kc < 7 ? kc + 1 : 7;
            OPR_GLOAD(kcn);
            const LAS bf16* Ab = Al + (kc & 1) * (OPR_A_BYTES / 2);
            bf16x8 afn = *(const LAS bf16x8*)(Ab + fr * OPR_AP + fq * 8);
#pragma unroll
            for (int j = 0; j < 4; ++j) {
                const int ks = kc * 4 + j, kn = (ks + 3 < 32) ? ks + 3 : 31;
#pragma unroll
                for (int cb = 0; cb < 4; ++cb) bfr[(j + 3) & 3][cb] = *(const GAS bf16x8*)((const char*)(Wt + (OPR_KS(kn) * 4 + cb) * 512) + lb);
#pragma unroll
                for (int rb = 0; rb < 4; ++rb) { const bf16x8 af = afn; const int tn = j * 4 + rb + 1, jn = tn >> 2, rn = tn & 3;
                    if (tn < 16) afn = *(const LAS bf16x8*)(Ab + (rn * 16 + fr) * OPR_AP + jn * 32 + fq * 8);
                    __builtin_amdgcn_sched_barrier(0);
#pragma unroll
                    for (int cb = 0; cb < 4; ++cb) acc[rb][cb] = __builtin_amdgcn_mfma_f32_16x16x32_bf16(bfr[j][cb], af, acc[rb][cb], 0, 0, 0);
                    __builtin_amdgcn_sched_barrier(0); }
            }
            if (kc < 7) OPR_GSTORE((kc + 1) & 1, kcn);
            LDS_WAIT(); __builtin_amdgcn_s_barrier(); asm volatile("" ::: "memory");
        }
        { const int l3 = tid_fresh() & 63, fr3 = l3 & 15, fq3 = l3 >> 4;
#pragma unroll
          for (int rb = 0; rb < 4; ++rb) { const size_t off = (size_t)(row0 + rb * 16 + fr3) * DM + 512 * p + 64 * w + 4 * fq3; float ssq = 0.f;
              GAS f32x4* hp = (GAS f32x4*)(H + off); GAS unsigned long long* cp = (GAS unsigned long long*)(hbw + off);
#pragma unroll
              for (int cb = 0; cb < 4; ++cb) { const f32x4 hn = acc[rb][cb]; if (!dry) hp[4 * cb] = hn; ssq += (hn.x * hn.x + hn.y * hn.y) + (hn.z * hn.z + hn.w * hn.w);
                  if (!dry) cp[4 * cb] = (unsigned long long)pk2(hn.x, hn.y) | ((unsigned long long)pk2(hn.z, hn.w) << 32); }
              ssq += __shfl_xor(ssq, 16); ssq += __shfl_xor(ssq, 32);
              if (fq3 == 0) ssl[(rb * 16 + fr3) * 16 + p * 8 + w] = ssq; }
#pragma unroll 1
          for (int half = 0; half < 2; ++half) {
#pragma unroll 1
              for (int v5 = 0; v5 < 2; ++v5) { const LAS float* wv = wrl + (half * 10 + v5 * 5) * DM + 512 * p + 64 * w + 4 * fq3; float pd[5][4];
#pragma unroll
                  for (int q = 0; q < 5; ++q) {
#pragma unroll
                      for (int rb = 0; rb < 4; ++rb) pd[q][rb] = 0.f;
#pragma unroll
                      for (int cb = 0; cb < 4; ++cb) { const f32x4 w4 = *(const LAS f32x4*)(wv + q * DM + 16 * cb);
#pragma unroll
                          for (int rb = 0; rb < 4; ++rb) pd[q][rb] += (acc[rb][cb].x * w4.x + acc[rb][cb].y * w4.y) + (acc[rb][cb].z * w4.z + acc[rb][cb].w * w4.w); } }
#pragma unroll
                  for (int q = 0; q < 5; ++q)
#pragma unroll
                      for (int rb = 0; rb < 4; ++rb) pd[q][rb] += __shfl_xor(pd[q][rb], 16);
#pragma unroll
                  for (int q = 0; q < 5; ++q)
#pragma unroll
                      for (int rb = 0; rb < 4; ++rb) pd[q][rb] += __shfl_xor(pd[q][rb], 32);
                  if (fq3 == 0) {
#pragma unroll
                      for (int q = 0; q < 5; ++q)
#pragma unroll
                          for (int rb = 0; rb < 4; ++rb) part[(rb * 16 + fr3) * 80 + (v5 * 5 + q) * 8 + w] = pd[q][rb]; } }
              LDS_WAIT(); __builtin_amdgcn_s_barrier(); asm volatile("" ::: "memory");
              for (int i = F.tid; i < OPR_ROWS * 10; i += NWAVES * 64) { const int r = i / 10, vv = i - r * 10; const LAS float* pp = part + r * 80 + vv * 8;
                  const float t = ((pp[0] + pp[1]) + (pp[2] + pp[3])) + ((pp[4] + pp[5]) + (pp[6] + pp[7]));
                  LAS float* sp = sums + r * 20 + half * 10 + vv; *sp = (p == 0) ? t : (*sp + t); }
              LDS_WAIT(); __builtin_amdgcn_s_barrier(); asm volatile("" ::: "memory");
          } }
    }
    if (F.tid < OPR_ROWS) { const int m = row0 + F.tid; float tot = 0.f;
#pragma unroll
        for (int i = 0; i < 16; ++i) tot += ssl[F.tid * 16 + i];
        const float rsr = 1.0f / sqrtf(tot * (1.0f / DM) + 1e-6f);
        ((float*)(ws + WS_RSTD))[m] = rsr;
        float d[20];
#pragma unroll
        for (int q = 0; q < 20; ++q) d[q] = sums[F.tid * 20 + q] * rsr;
        const float* gb = a.in(17) + layer * 4;
        float lg[4];
#pragma unroll
        for (int q = 0; q < 4; ++q) lg[q] = d[q] + gb[q];
        int gi = 0; float gm = lg[0];
#pragma unroll
        for (int q = 1; q < 4; ++q) if (lg[q] > gm) { gm = lg[q]; gi = q; }
        float gs = 0.f;
#pragma unroll
        for (int q = 0; q < 4; ++q) gs += expf(lg[q] - gm);
        const float gp = 1.0f / gs;
        const float* ebp = a.in(19) + layer * 16;
        float el[4];
#pragma unroll
        for (int q = 0; q < 4; ++q) { float t = 0.f;
#pragma unroll
            for (int g2 = 0; g2 < 4; ++g2) if (g2 == gi) t = d[4 + 4 * g2 + q] + ebp[4 * g2 + q];
            el[q] = t; }
        int i1 = 0; float v1 = el[0];
#pragma unroll
        for (int q = 1; q < 4; ++q) if (el[q] > v1) { v1 = el[q]; i1 = q; }
        int i2 = -1; float v2 = 0.f;
#pragma unroll
        for (int q = 0; q < 4; ++q) if (q != i1 && (i2 < 0 || el[q] > v2)) { v2 = el[q]; i2 = q; }
        const float e2 = expf(v2 - v1), g1 = gp / (1.0f + e2), g2v = gp * e2 / (1.0f + e2);
        const int lo = i1 < i2 ? i1 : i2, hi = i1 < i2 ? i2 : i1;
        const int pidx = (lo == 0) ? (hi - 1) : (lo == 1 ? hi + 1 : 5);
        const int cls = gi * 6 + pidx;
        if (!dry) {
            const unsigned pp = __hip_atomic_fetch_add((unsigned*)(ws + WS_CTL) + CW_CNT + layer * 64 + cls, 1u, RLX_AGENT);
            ((int*)(ws + WS_LIST))[(size_t)cls * TOK + pp] = m;
            ((float*)(ws + WS_GA))[m] = (i1 < i2) ? g1 : g2v;
            ((float*)(ws + WS_GB))[m] = (i1 < i2) ? g2v : g1;
        }
    }
    __syncthreads();
    }
#undef OPR_KC
#undef OPR_KS
#undef OPR_GLOAD
#undef OPR_GSTORE
}

__global__ void __launch_bounds__(NWAVES * 64, 2) fwd_kernel(Args args_unused_directly) {
    extern __shared__ __attribute__((aligned(16))) unsigned char lds[];
    Frame F;
    F.lds = (LAS unsigned char*)lds;
    F.tid = threadIdx.x; F.lane = F.tid & 63; F.wave = __builtin_amdgcn_readfirstlane(F.tid >> 6);
    F.G = gridDim.x; { const int bx = blockIdx.x; F.vcu = (F.G % 8 == 0) ? (bx % 8) * (F.G / 8) + bx / 8 : bx; }
    const kptr_t kbase = (kptr_t)__builtin_amdgcn_kernarg_segment_ptr();
    unsigned char* const ws0 = KA{kbase}.ws();
    volatile LAS unsigned* MISC = (volatile LAS unsigned*)(F.lds + MISC_OFF);
    if (F.tid < 64) MISC[F.tid] = 0u;
    __syncthreads();
    const int lo = *(const int __attribute__((address_space(4)))*)(kbase + 208), hi = *(const int __attribute__((address_space(4)))*)(kbase + 212);
    XcdBarrier bar; bar.bar = (unsigned*)(ws0 + WS_CTL) + CW_BAR; bar.x = 0; bar.st = nullptr;
    if (hi - lo > 1) bar = xcd_barrier_post((unsigned*)(ws0 + WS_CTL) + CW_BAR, MISC + 8);
    int pc = 0;
#ifndef PH_EN
#define PH_EN 0xFFFF
#endif
#ifndef REP_MASK
#define REP_MASK 0
#endif
#define RUN(id, ...) RUN_(id, 1, __VA_ARGS__)
#define RUN_(id, bar_, ...) do { if (((PH_EN >> (id)) & 1) && pc >= lo && pc < hi) { \
      for (int rep_ = ((REP_MASK >> (id)) & 1); rep_ >= 0; --rep_) { const bool dry = rep_ > 0; (void)dry; kptr_t kl_ = kbase; asm volatile("" : "+s"(kl_)); const KA args{kl_}; unsigned char* ws = args.ws(); asm volatile("" : "+s"(ws)); ASSUME_GLOBAL(ws); \
        F.tid = tid_fresh(); F.lane = F.tid & 63; F.wave = __builtin_amdgcn_readfirstlane(F.tid >> 6); { const int bx = bid_fresh(); F.vcu = (F.G % 8 == 0) ? (bx % 8) * (F.G / 8) + bx / 8 : bx; } \
        __VA_ARGS__; } } if ((bar_) && pc >= lo && pc + 1 < hi) xcd_barrier(bar); ++pc; } while (0)

    RUN_(0, 0, { p_prologue(args, F); __syncthreads(); });
    for (int l = 0; l < NL; ++l) {
        if (l < NA) {
            RUN(1, p_rowpass<1>(args, F, l, false, l == 0 ? args.in(0) : args.out(), l == 0));
            RUN(2, {

                { const int bx = bid_fresh(); if (bx < BATCH * AH) attn_body::fox_scan((char*)lds + RING_OFF, (const float*)(ws + WS_LOGF) + (size_t)bx * SEQ, (unsigned long long*)(ws + WS_CAUG) + (size_t)bx * SEQ); }
                pg8::Gemm g{(const pg8::bf16_t*)(ws + WS_HB), (const pg8::bf16_t*)(ws + WS_WIN) + (size_t)l * 3072 * DM, TOK, 3072, DM};
                pg8::StaticOrder S; S.init(TOK, 3072, F.G, bid_fresh());
                pg8::EpiAQkv E{(pg8::bf16_t*)(ws + WS_QB), (size_t)(16 * MiB), (const float*)(ws + WS_RSTD), (const float*)(ws + WS_GTAB) + l * 192};
                pg8::gemm_phase<pg8::EpiAQkv, pg8::StaticOrder, true, true>(F.lds + RING_OFF, g, S, E);
            });
            RUN(3, {
                const attn_body::AttnTensors AT{(const attn_body::bf16*)(ws + WS_QB), (const attn_body::bf16*)(ws + WS_QB + 32 * MiB), (const attn_body::bf16*)(ws + WS_QB + 64 * MiB),
                                                (attn_body::bf16*)(ws + (dry ? WS_KB : WS_QB)), (const unsigned long long*)(ws + WS_CAUG)};
                unsigned* cq = (unsigned*)(ws + WS_CTL) + CW_CQ + (l * 2 + (dry ? 1 : 0)) * 64;
                const bool cmain = l == 0; const int clo = cmain ? TR_I_WIN : 0, chi = cmain ? TR_NITEMS : 6144;
                _Pragma("unroll 1") for (int pass = 0; pass < 2; ++pass) {
                    if (pass == 1 || (F.vcu & 3) == 0) conv_drain(args, ws, F, cq, cmain, 2, clo, chi);
                    if (pass == 0) { attn_body::attn_phase_dyn<8>((char*)lds + RING_OFF, AT, (unsigned*)(ws + WS_CTL) + CW_AQ + (l * 2 + (dry ? 1 : 0)) * 64); __syncthreads(); }
                }
            });
            RUN(4, {
                p_opr<false>(args, F, l, (const bf16*)(ws + WS_WOA) + (size_t)l * DM * DM, l == 0 ? args.in(0) : args.out(), dry);
            });
        } else {
            const int j = l - NA;
            RUN(6, {
                const int N = j == 0 ? 5120 : 3072;
                pg8::Gemm g{(const pg8::bf16_t*)(ws + WS_HB), j == 0 ? (const pg8::bf16_t*)(ws + WS_WKVQ0) : (const pg8::bf16_t*)(ws + WS_WQ1), TOK, N, DM};
                pg8::StaticOrder S; S.init(TOK, N, F.G, bid_fresh());
                pg8::EpiBKvq E{(pg8::bf16_t*)(ws + WS_KB), (pg8::bf16_t*)(ws + WS_VB), (pg8::bf16_t*)(ws + WS_QB), (const float*)(ws + WS_RSTD), args.in(10), args.in(13) + j * BG * BHD,
                               (const unsigned*)(ws + WS_ROPEC), j == 0 ? 0 : 8, (PG8_LAS float*)(F.lds + XS_OFF)};
                pg8::gemm_phase<pg8::EpiBKvq, pg8::StaticOrder, true, true>(F.lds + RING_OFF, g, S, E);
            });
            RUN(7, p_battn(args, F, dry));
            RUN(9, {
                if (l == 2) {
                    LAS float* scr = (LAS float*)(F.lds + RING_OFF + F.wave * 16384);
                    tr_run<false>(args, ws, 3, 6144, F.vcu * NWAVES + F.wave, F.G * NWAVES, scr, F.lane);
                    __syncthreads();
                }
                p_opr<true>(args, F, l, (const bf16*)(ws + WS_WOB) + (size_t)j * DM * DM, args.out(), dry);
            });
        }
        RUN(11, p_moe(args, F, l, dry ? 0.f : 1.f));
    }
#undef RUN
}
constexpr int N_PHASES = 1 + NA * 5 + NB * 4;

#ifndef MK_ONE_LAUNCH
#define MK_ONE_LAUNCH 1
#endif
extern "C" void kernel_launch(void* const* d_in, const int* in_sizes, int n_in, void* d_out, int out_size, void* d_ws, size_t ws_size, hipStream_t stream) {
    static int grid = 0;
    if (grid == 0) {
        if (n_in != 23 || out_size != TOK * DM || ws_size < WS_END) { fprintf(stderr, "kernel_launch: unexpected shapes (n_in %d, out %d, ws %zu)\n", n_in, out_size, ws_size); grid = -1; return; }
        int dev = 0, cus = 0;
        if (hipGetDevice(&dev) != hipSuccess || hipDeviceGetAttribute(&cus, hipDeviceAttributeMultiprocessorCount, dev) != hipSuccess) { grid = -1; return; }
        if (hipFuncSetAttribute((const void*)fwd_kernel, hipFuncAttributeMaxDynamicSharedMemorySize, LDS_BYTES) != hipSuccess) { fprintf(stderr, "kernel_launch: hipFuncSetAttribute failed\n"); grid = -1; return; }
        int per_cu = 0;
        if (hipOccupancyMaxActiveBlocksPerMultiprocessor(&per_cu, (const void*)fwd_kernel, NWAVES * 64, LDS_BYTES) != hipSuccess || per_cu < 1) fprintf(stderr, "kernel_launch: occupancy query says %d\n", per_cu);
        (void)hipGetLastError();
        grid = cus;
    }
    if (grid < 0) return;
    if (hipMemsetAsync((char*)d_ws + WS_CTL, 0, CTL_ZERO_BYTES, stream) != hipSuccess) return;
    Args a{};
    for (int i = 0; i < 23; ++i) a.in[i] = (const float*)d_in[i];
    a.in[23] = nullptr;
    a.out = (float*)d_out; a.ws = (unsigned char*)d_ws;
#if MK_ONE_LAUNCH
    a.ph_lo = 0; a.ph_hi = N_PHASES;
    hipLaunchKernelGGL(fwd_kernel, dim3(grid), dim3(NWAVES * 64), LDS_BYTES, stream, a);
#else
    for (int p = 0; p < N_PHASES; ++p) { a.ph_lo = p; a.ph_hi = p + 1;
        hipLaunchKernelGGL(fwd_kernel, dim3(grid), dim3(NWAVES * 64), LDS_BYTES, stream, a); }
#endif
}
```

```cpp
#include <hip/hip_runtime.h>
#include <hip/hip_bf16.h>
#include <cstdio>
#include <cstdint>
#include <cmath>
__device__ __forceinline__ int tid_fresh() { int t = (int)threadIdx.x; asm volatile("" : "+v"(t)); return t; }
__device__ __forceinline__ int bid_fresh() { int t = (int)blockIdx.x; asm volatile("" : "+s"(t)); return t; }
#if defined(__HIP_DEVICE_COMPILE__)
#define ASSUME_GLOBAL(p_) do { __builtin_assume(!__builtin_amdgcn_is_shared((const void*)(p_))); __builtin_assume(!__builtin_amdgcn_is_private((const void*)(p_))); } while (0)
#else
#define ASSUME_GLOBAL(p_) do { } while (0)
#endif
namespace pg8 {
#define PG8_LAS __attribute__((address_space(3)))
typedef unsigned short bf16_t;
typedef short bf16x8 __attribute__((ext_vector_type(8)));
typedef float f32x4 __attribute__((ext_vector_type(4)));
typedef unsigned u32x4 __attribute__((ext_vector_type(4)));
constexpr int BM = 256, BK = 64, HALF = 128, HTB = HALF * BK * 2  , STAGE_BYTES = 8 * HTB, NXCD = 8, WGM = 8;

__host__ __device__ __forceinline__ int lds_byte(int r, int c) { const int st = (r >> 4) * 2 + (c >> 5), rr = r & 15, cc = c & 31, ob = rr * 64 + cc * 2; return st * 1024 + (ob ^ (((ob >> 9) & 1) << 5)); }
__host__ __device__ __forceinline__ void stage_rc(int b, int& R, int& C) { const int st = b / 1024, sb = b % 1024, swz = sb ^ (((sb >> 9) & 1) << 5); R = (st >> 1) * 16 + swz / 64; C = (st & 1) * 32 + (swz % 64) / 2; }
__host__ __device__ __forceinline__ int perm32(int rho) { const int n = rho >> 4, i = rho & 15; return 8 * (i >> 2) + 4 * n + (i & 3); }

struct Unit { int pm, pn; };
struct Gemm { const bf16_t* A; const bf16_t* Bt; int M, N, K; };

struct StaticOrder {
    int nM, nN, nwg, G, c;
    __host__ __device__ void init(int M, int N, int G_, int c_) { nM = M / BM; nN = N / BM; nwg = nM * nN; G = G_; c = c_; }
    __host__ __device__ bool next(int i, Unit& u) const {
        const long L = (long)i * G + c; if (L >= nwg) return false;
        int wgid = (int)L; { const int q = nwg / NXCD, r = nwg % NXCD, xcd = wgid % NXCD, off = wgid / NXCD; wgid = (xcd < r ? xcd * (q + 1) : r * (q + 1) + (xcd - r) * q) + off; }
        const int nig = WGM * nN, gid = wgid / nig, fm = gid * WGM, gsz = (nM - fm) < WGM ? (nM - fm) : WGM;
        u.pm = fm + ((wgid % nig) % gsz); u.pn = (wgid % nig) / gsz; return true;
    }
    __device__ __forceinline__ void a_ready(const Unit&) const {}
    __device__ __forceinline__ void done(const Unit&) const {}
};

__device__ __forceinline__ unsigned cvt_pk_bf16(float lo, float hi) { unsigned r; asm volatile("v_cvt_pk_bf16_f32 %0, %1, %2" : "=v"(r) : "v"(lo), "v"(hi)); return r; }
typedef float f32x2 __attribute__((ext_vector_type(2)));
constexpr float RMS_EPS = 1e-6f;
#define PG8_GAS __attribute__((address_space(1)))
__device__ __forceinline__ void st16(bf16_t* p, const float (&o)[8]) { u32x4 w; w.x = cvt_pk_bf16(o[0], o[1]); w.y = cvt_pk_bf16(o[2], o[3]); w.z = cvt_pk_bf16(o[4], o[5]); w.w = cvt_pk_bf16(o[6], o[7]); *(PG8_GAS u32x4*)p = w; }
struct EpiAQkv {
    static constexpr bool PERM = true, AFTER_DRAIN = false;
    bf16_t* QKV; size_t sec_stride; const float* rstd; const float* gtab;
    __device__ __forceinline__ void operator()(const f32x4 (&acc)[2][2][4][2], const Unit& u, int wr, int wc, int fr, int fq) const {
        const int sec = u.pn >> 2, head = (u.pn & 3) * 4 + wc;
        bf16_t* dst = QKV + (size_t)sec * sec_stride + head * 64 + 8 * fq;
        const float* gp = gtab + sec * 64 + 8 * fq;
        const bool nrm = sec < 2;
        float rsv[2][4]; const float* rp = rstd + u.pm * BM + wr * 64 + fr;
#pragma unroll
        for (int ai = 0; ai < 2; ++ai)
#pragma unroll
            for (int m = 0; m < 4; ++m) rsv[ai][m] = *(const PG8_GAS float*)(rp + ai * HALF + m * 16);
        f32x4 g[2][2];
#pragma unroll
        for (int bj = 0; bj < 2; ++bj)
#pragma unroll
            for (int n = 0; n < 2; ++n) g[bj][n] = *(const PG8_GAS f32x4*)(gp + 32 * bj + 4 * n);
#pragma unroll
        for (int ai = 0; ai < 2; ++ai)
#pragma unroll
            for (int m = 0; m < 4; ++m) {
                const int row = u.pm * BM + ai * HALF + wr * 64 + m * 16 + fr;
                const float rs = rsv[ai][m];
                f32x4 v[2][2];
#pragma unroll
                for (int bj = 0; bj < 2; ++bj)
#pragma unroll
                    for (int n = 0; n < 2; ++n) v[bj][n] = acc[ai][bj][m][n] * rs;
                float s = 0.f;
#pragma unroll
                for (int bj = 0; bj < 2; ++bj)
#pragma unroll
                    for (int n = 0; n < 2; ++n) { const f32x4 x = v[bj][n]; s += (x[0] * x[0] + x[1] * x[1]) + (x[2] * x[2] + x[3] * x[3]); }
                s += __shfl_xor(s, 16); s += __shfl_xor(s, 32);
                const float sc = nrm ? __builtin_amdgcn_rsqf(s * (1.0f / 64.0f) + RMS_EPS) : 1.0f;
#pragma unroll
                for (int bj = 0; bj < 2; ++bj) { const f32x4 o0 = v[bj][0] * sc * g[bj][0], o1 = v[bj][1] * sc * g[bj][1];
                    u32x4 w; w.x = cvt_pk_bf16(o0[0], o0[1]); w.y = cvt_pk_bf16(o0[2], o0[3]); w.z = cvt_pk_bf16(o1[0], o1[1]); w.w = cvt_pk_bf16(o1[2], o1[3]);
                    *(PG8_GAS u32x4*)(dst + (size_t)row * 1024 + 32 * bj) = w; }
            }
    }
};
struct EpiBKvq {
    static constexpr bool PERM = true, AFTER_DRAIN = false;
    bf16_t *KB, *VB, *QB; const float* rstd; const float *kg, *qg  ; const unsigned* rcs  ; int tile_off; PG8_LAS float* xs;
    __device__ __forceinline__ void operator()(const f32x4 (&acc)[2][2][4][2], const Unit& u, int wr, int wc, int fr, int fq) const {
        const int T = u.pn + tile_off;
        float rsv[2][4]; const float* rp = rstd + u.pm * BM + wr * 64 + fr;
#pragma unroll
        for (int ai = 0; ai < 2; ++ai)
#pragma unroll
            for (int m = 0; m < 4; ++m) rsv[ai][m] = *(const PG8_GAS float*)(rp + ai * HALF + m * 16);
        if (T >= 4 && T < 8) {
            bf16_t* dst = VB + (T - 4) * 256 + 32 * wc + 8 * fq;
#pragma unroll
            for (int ai = 0; ai < 2; ++ai)
#pragma unroll
                for (int m = 0; m < 4; ++m) {
                    const int row = u.pm * BM + ai * HALF + wr * 64 + m * 16 + fr; const float rs = rsv[ai][m];
#pragma unroll
                    for (int bj = 0; bj < 2; ++bj) { float o[8];
#pragma unroll
                        for (int n = 0; n < 2; ++n)
#pragma unroll
                            for (int e = 0; e < 4; ++e) o[4 * n + e] = acc[ai][bj][m][n][e] * rs;
                        st16(dst + (size_t)row * 1024 + 128 * bj, o); }
                }
            return;
        }
        const bool isq = T >= 8; const int grp = isq ? ((T - 8) >> 2) : 0, head = (isq ? ((T - 8) & 3) : T) * 2 + (wc >> 1);
        const int d1 = 32 * (wc & 1) + 8 * fq;
        const float* gp = isq ? (qg + grp * 128) : kg;
        f32x4 g[2][2];
#pragma unroll
        for (int bj = 0; bj < 2; ++bj)
#pragma unroll
            for (int n = 0; n < 2; ++n) g[bj][n] = *(const PG8_GAS f32x4*)(gp + 64 * bj + d1 + 4 * n);
        const unsigned* rcp = rcs + (size_t)(u.pm * BM + wr * 64 + fr) * 64 + d1;
        u32x4 rn0 = *(const PG8_GAS u32x4*)(rcp), rn1 = *(const PG8_GAS u32x4*)(rcp + 4);
        float ss[2][4];
#pragma unroll
        for (int ai = 0; ai < 2; ++ai)
#pragma unroll
            for (int m = 0; m < 4; ++m) {
                const float rs = rsv[ai][m];
                float s = 0.f;
#pragma unroll
                for (int bj = 0; bj < 2; ++bj)
#pragma unroll
                    for (int n = 0; n < 2; ++n) { const f32x4 x = acc[ai][bj][m][n] * rs; s += (x[0] * x[0] + x[1] * x[1]) + (x[2] * x[2] + x[3] * x[3]); }
                s += __shfl_xor(s, 16); s += __shfl_xor(s, 32);
                ss[ai][m] = s;
                if (fq == 0) xs[(ai * HALF + wr * 64 + m * 16 + fr) * 4 + wc] = s;
            }
        asm volatile("s_waitcnt lgkmcnt(0)" ::: "memory"); __builtin_amdgcn_s_barrier(); asm volatile("" ::: "memory");
        bf16_t* dst = isq ? (QB + grp * 1024 + head * 128 + d1) : (KB + head * 128 + d1);
        const size_t pitch = isq ? 3072 : 1024;
#pragma unroll
        for (int ai = 0; ai < 2; ++ai)
#pragma unroll
            for (int m = 0; m < 4; ++m) {
                const int rl = ai * HALF + wr * 64 + m * 16 + fr, row = u.pm * BM + rl; const float rs = rsv[ai][m];
                const u32x4 rc0 = rn0, rc1 = rn1;
                { const int gi = ai * 4 + m + 1, an = (gi >> 2) & 1, mn = gi & 3; rn0 = *(const PG8_GAS u32x4*)(rcp + (size_t)(an * HALF + mn * 16) * 64); rn1 = *(const PG8_GAS u32x4*)(rcp + (size_t)(an * HALF + mn * 16) * 64 + 4); }
                const float tot = ss[ai][m] + xs[rl * 4 + (wc ^ 1)];
                const float sc = rs * __builtin_amdgcn_rsqf(tot * (1.0f / 128.0f) + RMS_EPS);
                float o1[8], o2[8];
#pragma unroll
                for (int n = 0; n < 2; ++n)
#pragma unroll
                    for (int e = 0; e < 4; ++e) { const int j = 4 * n + e;
                        const float y1 = acc[ai][0][m][n][e] * sc * g[0][n][e], y2 = acc[ai][1][m][n][e] * sc * g[1][n][e];
                        const unsigned cw = n ? rc1[e] : rc0[e];
                        const float c = (float)__builtin_bit_cast(_Float16, (unsigned short)(cw & 0xffffu)), sn = (float)__builtin_bit_cast(_Float16, (unsigned short)(cw >> 16));
                        o1[j] = y1 * c - y2 * sn; o2[j] = y2 * c + y1 * sn; }
                st16(dst + (size_t)row * pitch, o1); st16(dst + (size_t)row * pitch + 64, o2);
            }
        asm volatile("s_waitcnt lgkmcnt(0)" ::: "memory"); __builtin_amdgcn_s_barrier(); asm volatile("" ::: "memory");
    }
};
struct EpiResid {
    static constexpr bool PERM = true, AFTER_DRAIN = false;
    const float* B; float* H; float upd;
    __device__ __forceinline__ void operator()(const f32x4 (&acc)[2][2][4][2], const Unit& u, int wr, int wc, int fr, int fq) const {
        const size_t r0 = (size_t)(u.pm * BM + wr * 64 + fr) * 1024 + u.pn * BM + wc * 32 + 8 * fq;
        const float* bp = B + r0; float* hp = H + r0;
        f32x4 nx[2][2];
#pragma unroll
        for (int bj = 0; bj < 2; ++bj)
#pragma unroll
            for (int n = 0; n < 2; ++n) nx[bj][n] = *(const PG8_GAS f32x4*)(bp + bj * HALF + 4 * n);
#pragma unroll
        for (int ai = 0; ai < 2; ++ai)
#pragma unroll
            for (int m = 0; m < 4; ++m) { const size_t ro = (size_t)(ai * HALF + m * 16) * 1024;
                f32x4 cu[2][2];
#pragma unroll
                for (int bj = 0; bj < 2; ++bj)
#pragma unroll
                    for (int n = 0; n < 2; ++n) cu[bj][n] = nx[bj][n];
                { const int gi = ai * 4 + m + 1, an = (gi >> 2) & 1, mn = gi & 3; const size_t rn = (size_t)(an * HALF + mn * 16) * 1024;
#pragma unroll
                  for (int bj = 0; bj < 2; ++bj)
#pragma unroll
                      for (int n = 0; n < 2; ++n) nx[bj][n] = *(const PG8_GAS f32x4*)(bp + rn + bj * HALF + 4 * n); }
#pragma unroll
                for (int bj = 0; bj < 2; ++bj)
#pragma unroll
                    for (int n = 0; n < 2; ++n) *(PG8_GAS f32x4*)(hp + ro + bj * HALF + 4 * n) = cu[bj][n] + acc[ai][bj][m][n] * upd; }
    }
};

template <class Epi, class Sched, bool ALIGN_EPI = false, bool SP2 = false>
__device__ __forceinline__ void gemm_phase(PG8_LAS unsigned char* lds, const Gemm g, const Sched& S, const Epi& E) {
    const int tid = tid_fresh(), wid = __builtin_amdgcn_readfirstlane(tid >> 6), lane = tid & 63, wr = wid >> 2, wc = wid & 3, fr = lane & 15, fq = lane >> 4;
    const int K = g.K, nt = K / BK;
    unsigned voffA[2], voffB[2];
#pragma unroll
    for (int i = 0; i < 2; ++i) { int R, C; stage_rc(tid * 16 + i * 8192, R, C); const int Rb = Epi::PERM ? ((R & ~31) + perm32(R & 31)) : R;
        voffA[i] = (unsigned)(R * K + C) * 2u; voffB[i] = (unsigned)(Rb * K + C) * 2u; }
    const size_t kstep = (size_t)(BK * 2);
    const size_t hstep = (size_t)HALF * K * 2;
    const size_t tstep = 2 * hstep;
    const unsigned ldsw = (unsigned)wid * 1024u;
    const int aoff = lds_byte(wr * 64 + fr, fq * 8), boff = lds_byte(wc * 32 + fr, fq * 8);
#define PG8_SA(b, h) (((b) * 2 + (h)) * HTB)
#define PG8_SB(b, h) ((4 + (b) * 2 + (h)) * HTB)
#define PG8_STAGE(bufoff, gbase, voff) do { _Pragma("unroll") for (int _i = 0; _i < 2; ++_i) \
        __builtin_amdgcn_global_load_lds((const unsigned*)((const char*)(gbase) + (voff)[_i]), (PG8_LAS unsigned*)(lds + (bufoff) + ldsw + _i * 8192), 16, 0, 0); } while (0)
#define PG8_LDA(dst, b, h) do { _Pragma("unroll") for (int m = 0; m < 4; ++m) _Pragma("unroll") for (int k = 0; k < 2; ++k) dst[m][k] = *(const PG8_LAS bf16x8*)(lds + PG8_SA(b, h) + aoff + m * 2048 + k * 1024); } while (0)
#define PG8_LDB(dst, b, h) do { _Pragma("unroll") for (int n = 0; n < 2; ++n) _Pragma("unroll") for (int k = 0; k < 2; ++k) dst[n][k] = *(const PG8_LAS bf16x8*)(lds + PG8_SB(b, h) + boff + n * 2048 + k * 1024); } while (0)
#define PG8_MMA(ai, bj, At, Bt) do { __builtin_amdgcn_s_setprio(1); _Pragma("unroll") for (int m = 0; m < 4; ++m) _Pragma("unroll") for (int n = 0; n < 2; ++n) _Pragma("unroll") for (int k = 0; k < 2; ++k) \
        acc[ai][bj][m][n] = __builtin_amdgcn_mfma_f32_16x16x32_bf16(Bt[n][k], At[m][k], acc[ai][bj][m][n], 0, 0, 0); __builtin_amdgcn_s_setprio(0); } while (0)
#define PG8_WAIT_V(n) asm volatile("s_waitcnt vmcnt(" #n ")" ::: "memory")
#define PG8_WAIT_L(n) asm volatile("s_waitcnt lgkmcnt(" #n ")" ::: "memory")
#define PG8_BAR __builtin_amdgcn_s_barrier()
#define PG8_SCHED __builtin_amdgcn_sched_barrier(0)
    Unit cur, nxt; int ui = 0;
    if (!S.next(0, cur)) return;
    f32x4 acc[2][2][4][2];
#pragma unroll
    for (int a = 0; a < 2; ++a)
#pragma unroll
        for (int b = 0; b < 2; ++b)
#pragma unroll
            for (int m = 0; m < 4; ++m)
#pragma unroll
                for (int n = 0; n < 2; ++n) acc[a][b][m][n] = (f32x4){0.f, 0.f, 0.f, 0.f};
    bf16x8 At[4][2], B0[2][2], B1[2][2];
    const char* cA = (const char*)g.A + (size_t)cur.pm * tstep; const char* cB = (const char*)g.Bt + (size_t)cur.pn * tstep;
    S.a_ready(cur);
    if constexpr (SP2) {
        PG8_STAGE(PG8_SB(0, 0), cB, voffB); PG8_STAGE(PG8_SB(0, 1), cB + hstep, voffB); PG8_STAGE(PG8_SA(0, 0), cA, voffA); PG8_STAGE(PG8_SA(0, 1), cA + hstep, voffA);
        if (wr == 1) PG8_BAR;
        PG8_WAIT_V(2); PG8_BAR;
        PG8_STAGE(PG8_SB(1, 0), cB + kstep, voffB); PG8_STAGE(PG8_SA(1, 0), cA + kstep, voffA); PG8_STAGE(PG8_SB(1, 1), cB + hstep + kstep, voffB);
        PG8_WAIT_V(6); PG8_BAR;
    } else {
        PG8_STAGE(PG8_SB(0, 0), cB, voffB); PG8_STAGE(PG8_SA(0, 0), cA, voffA); PG8_STAGE(PG8_SB(0, 1), cB + hstep, voffB); PG8_STAGE(PG8_SA(0, 1), cA + hstep, voffA);
        if (wr == 1) PG8_BAR;
        PG8_WAIT_V(4); PG8_BAR;
        PG8_STAGE(PG8_SB(1, 0), cB + kstep, voffB); PG8_STAGE(PG8_SA(1, 0), cA + kstep, voffA); PG8_STAGE(PG8_SB(1, 1), cB + hstep + kstep, voffB);
        PG8_WAIT_V(6); PG8_BAR;
    }
    for (;;) {
        const bool has_next = S.next(ui + 1, nxt);
        const char* nA = has_next ? (const char*)g.A + (size_t)nxt.pm * tstep : cA; const char* nB = has_next ? (const char*)g.Bt + (size_t)nxt.pn * tstep : cB;
        for (int t = 0; t < nt; t += 2) {
            const bool last = (t == nt - 2);
            const char* a1 = cA + (size_t)(t + 1) * kstep;
            const char* a2 = last ? nA : cA + (size_t)(t + 2) * kstep; const char* b2 = last ? nB : cB + (size_t)(t + 2) * kstep;
            const char* a3 = a2 + kstep; const char* b3 = b2 + kstep;
            if (last && has_next) S.a_ready(nxt);
            if constexpr (SP2) {
            PG8_LDB(B0, 0, 0); PG8_LDB(B1, 0, 1); PG8_SCHED; PG8_LDA(At, 0, 0); PG8_STAGE(PG8_SA(1, 1), a1 + hstep, voffA);
            PG8_WAIT_V(8); PG8_WAIT_L(0); PG8_BAR; PG8_MMA(0, 0, At, B0); PG8_MMA(0, 1, At, B1); PG8_BAR; PG8_SCHED;
            PG8_LDA(At, 0, 1); PG8_STAGE(PG8_SB(0, 0), b2, voffB); PG8_STAGE(PG8_SB(0, 1), b2 + hstep, voffB); PG8_STAGE(PG8_SA(0, 0), a2, voffA);
            PG8_WAIT_V(8); PG8_WAIT_L(0); PG8_BAR; PG8_MMA(1, 0, At, B0); PG8_MMA(1, 1, At, B1); PG8_BAR; PG8_SCHED;
            PG8_LDB(B0, 1, 0); PG8_LDB(B1, 1, 1); PG8_SCHED; PG8_LDA(At, 1, 0); PG8_STAGE(PG8_SA(0, 1), a2 + hstep, voffA);
            PG8_WAIT_V(8); PG8_WAIT_L(0); PG8_BAR; PG8_MMA(0, 0, At, B0); PG8_MMA(0, 1, At, B1); PG8_BAR; PG8_SCHED;
            PG8_LDA(At, 1, 1); PG8_STAGE(PG8_SB(1, 0), b3, voffB); PG8_STAGE(PG8_SB(1, 1), b3 + hstep, voffB); PG8_STAGE(PG8_SA(1, 0), a3, voffA);
            PG8_WAIT_V(8); PG8_WAIT_L(0); PG8_BAR; PG8_MMA(1, 0, At, B0); PG8_MMA(1, 1, At, B1); PG8_BAR; PG8_SCHED;
            } else {
            PG8_LDB(B0, 0, 0); PG8_SCHED; PG8_LDA(At, 0, 0); PG8_STAGE(PG8_SA(1, 1), a1 + hstep, voffA);
            PG8_WAIT_L(8); PG8_BAR; PG8_WAIT_L(0); PG8_MMA(0, 0, At, B0); PG8_BAR; PG8_SCHED;
            PG8_LDB(B1, 0, 1); PG8_STAGE(PG8_SB(0, 0), b2, voffB);
            PG8_BAR; PG8_WAIT_L(0); PG8_MMA(0, 1, At, B1); PG8_BAR;
            PG8_LDA(At, 0, 1); PG8_STAGE(PG8_SA(0, 0), a2, voffA);
            PG8_BAR; PG8_WAIT_L(0); PG8_MMA(1, 0, At, B0); PG8_BAR; PG8_SCHED;
            PG8_STAGE(PG8_SB(0, 1), b2 + hstep, voffB);
            PG8_WAIT_V(6); PG8_BAR; PG8_MMA(1, 1, At, B1); PG8_BAR;
            PG8_LDB(B0, 1, 0); PG8_SCHED; PG8_LDA(At, 1, 0); PG8_STAGE(PG8_SA(0, 1), a2 + hstep, voffA);
            PG8_WAIT_L(8); PG8_BAR; PG8_WAIT_L(0); PG8_MMA(0, 0, At, B0); PG8_BAR; PG8_SCHED;
            PG8_LDB(B1, 1, 1); PG8_STAGE(PG8_SB(1, 0), b3, voffB);
            PG8_BAR; PG8_WAIT_L(0); PG8_MMA(0, 1, At, B1); PG8_BAR;
            PG8_LDA(At, 1, 1); PG8_STAGE(PG8_SA(1, 0), a3, voffA);
            PG8_BAR; PG8_WAIT_L(0); PG8_MMA(1, 0, At, B0); PG8_BAR; PG8_SCHED;
            PG8_STAGE(PG8_SB(1, 1), b3 + hstep, voffB);
            PG8_WAIT_V(6); PG8_BAR; PG8_MMA(1, 1, At, B1); PG8_BAR;
            }
        }
        if constexpr (ALIGN_EPI) { if (wr == 0) PG8_BAR; }
        if constexpr (!Epi::AFTER_DRAIN) { E(acc, cur, wr, wc, fr, fq); S.done(cur); }
        if (!has_next) break;
#pragma unroll
        for (int a = 0; a < 2; ++a)
#pragma unroll
            for (int b = 0; b < 2; ++b)
#pragma unroll
                for (int m = 0; m < 4; ++m)
#pragma unroll
                    for (int n = 0; n < 2; ++n) acc[a][b][m][n] = (f32x4){0.f, 0.f, 0.f, 0.f};
        cur = nxt; cA = nA; cB = nB; ++ui;
        if constexpr (ALIGN_EPI) { if (wr == 1) PG8_BAR; }
    }
    PG8_WAIT_V(0);
    if constexpr (!ALIGN_EPI) { if (wr == 0) PG8_BAR; }
    PG8_BAR;
    if constexpr (Epi::AFTER_DRAIN) { E.fused(acc, cur, wr, wc, fr, fq, lds, wid, lane); S.done(cur); }
#undef PG8_SA
#undef PG8_SB
#undef PG8_STAGE
#undef PG8_LDA
#undef PG8_LDB
#undef PG8_MMA
#undef PG8_WAIT_V
#undef PG8_WAIT_L
#undef PG8_BAR
#undef PG8_SCHED
}
}

#ifndef PG8_SP2
#define PG8_SP2 true
#endif
#ifndef PG8_ALIGN
#define PG8_ALIGN true
#endif

namespace attn_body {
using bf16=__hip_bfloat16;
using bf16x8=__attribute__((ext_vector_type(8)))short;
using s16x4=__attribute__((ext_vector_type(4)))short;
using f32x16=__attribute__((ext_vector_type(16)))float;
using u32x4=__attribute__((ext_vector_type(4)))unsigned;
constexpr int BATCH=2,NHEAD=16,SEQ=8192,D=64,DM=NHEAD*D;
constexpr int NW=8,QBLK=32,QB=QBLK*NW,KVBLK=64,NQB=SEQ/QB;
constexpr int ATTN_PITCH=DM, ATTN_UNIT_ROWS=QB;
__device__ __forceinline__ int crow(int r,int hi){return (r&3)+8*(r>>2)+4*hi;}
#define SBAR() __builtin_amdgcn_sched_barrier(0)
__device__ __forceinline__ void cmask(f32x16&p0,f32x16&p1,int jb,int qrel,int hi){
  const float NEG=-INFINITY; int kb=64*jb+4*hi;
  #pragma unroll
  for(int r=0;r<16;++r){int kv=kb+(r&3)+8*(r>>2); if(kv>qrel)p0[r]=NEG; if(kv+32>qrel)p1[r]=NEG;}
}

constexpr int NSLOT=3, SLOTB=8192;
constexpr int LDS_K=0, LDS_V=NSLOT*SLOTB, LDS_WS=2*NSLOT*SLOTB, LDS_OST=LDS_WS+NW*64*4, LDS_BYTES=LDS_OST+NW*4096;
constexpr float C2=0.125f*1.4426950408889634f;
__device__ __forceinline__ void glds16(const void*gsrc,unsigned lds_dst){unsigned keep;
  asm volatile("s_mov_b32 %0, m0\n\ts_mov_b32 m0, %2\n\ts_nop 0\n\tglobal_load_lds_dwordx4 %1, off\n\ts_mov_b32 m0, %0":"=&s"(keep):"v"(gsrc),"s"(lds_dst):"memory");}
__device__ __forceinline__ float max3f(float a,float b,float c){float r;asm("v_max3_f32 %0, %1, %2, %3":"=v"(r):"v"(a),"v"(b),"v"(c));return r;}
__device__ __forceinline__ float max2f(float a,float b){float r;asm("v_max_f32_e32 %0, %1, %2":"=v"(r):"v"(a),"v"(b));return r;}
__device__ __forceinline__ float fadd_s(float a,float b){float r;asm("v_add_f32_e32 %0, %1, %2":"=v"(r):"v"(a),"v"(b));return r;}
__device__ __forceinline__ float fsub_s(float a,float b){float r;asm("v_sub_f32_e32 %0, %1, %2":"=v"(r):"v"(a),"v"(b));return r;}
typedef float f32x2_t __attribute__((ext_vector_type(2))); typedef __bf16 bf16x2_t __attribute__((ext_vector_type(2)));
__device__ __forceinline__ unsigned cvtpk_s(float lo,float hi){f32x2_t v={lo,hi};bf16x2_t b=__builtin_convertvector(v,bf16x2_t);return __builtin_bit_cast(unsigned,b);}
#define WAIT_BAR(N) asm volatile("s_waitcnt vmcnt(" #N ") lgkmcnt(0)\n\ts_barrier":::"memory")

__device__ __forceinline__ void qkt(f32x16&p0,f32x16&p1,const char*Kslot,const bf16x8*qr,const f32x16&negm,int r32,int hi,s16x4 ka0,s16x4 ka1,s16x4 qa){
  const char*kb=Kslot+hi*1024+r32*16;
  #pragma unroll
  for(int d0=0;d0<4;++d0){
    const bf16x8 b0=*reinterpret_cast<const bf16x8*>(kb+d0*2048);
    const bf16x8 b1=*reinterpret_cast<const bf16x8*>(kb+d0*2048+512);
    if(d0==0){p0=__builtin_amdgcn_mfma_f32_32x32x16_bf16(b0,qr[0],negm,0,0,0);p1=__builtin_amdgcn_mfma_f32_32x32x16_bf16(b1,qr[0],negm,0,0,0);}
    else{p0=__builtin_amdgcn_mfma_f32_32x32x16_bf16(b0,qr[d0],p0,0,0,0);p1=__builtin_amdgcn_mfma_f32_32x32x16_bf16(b1,qr[d0],p1,0,0,0);}}
  p0=__builtin_amdgcn_mfma_f32_32x32x8bf16_1k(ka0,qa,p0,0,0,0);p1=__builtin_amdgcn_mfma_f32_32x32x8bf16_1k(ka1,qa,p1,0,0,0);
}
typedef __attribute__((address_space(3))) const char* lds_cptr;
typedef short v4i16_t __attribute__((ext_vector_type(4)));
__device__ __forceinline__ void kload8(bf16x8*kf,lds_cptr kp){
  kf[0]=*(const __attribute__((address_space(3))) bf16x8*)(kp);      kf[1]=*(const __attribute__((address_space(3))) bf16x8*)(kp+512);
  kf[2]=*(const __attribute__((address_space(3))) bf16x8*)(kp+2048); kf[3]=*(const __attribute__((address_space(3))) bf16x8*)(kp+2560);
  kf[4]=*(const __attribute__((address_space(3))) bf16x8*)(kp+4096); kf[5]=*(const __attribute__((address_space(3))) bf16x8*)(kp+4608);
  kf[6]=*(const __attribute__((address_space(3))) bf16x8*)(kp+6144); kf[7]=*(const __attribute__((address_space(3))) bf16x8*)(kp+6656);
}
__device__ __forceinline__ void kload2(bf16x8*kf,lds_cptr kp,int j){ kf[2*j]=*(const __attribute__((address_space(3))) bf16x8*)(kp+j*2048); kf[2*j+1]=*(const __attribute__((address_space(3))) bf16x8*)(kp+j*2048+512); }
__device__ __forceinline__ s16x4 vtr(lds_cptr p){ return __builtin_bit_cast(s16x4,__builtin_amdgcn_ds_read_tr16_b64_v4i16((__attribute__((address_space(3))) v4i16_t*)p)); }
__device__ __forceinline__ float rowmax(const f32x16&p0,const f32x16&p1){
  float a=max3f(p0[0],p0[1],p1[0]),b=max3f(p0[2],p0[3],p1[1]);a=max3f(a,p1[2],p1[3]);
  #pragma unroll
  for(int r=4;r<16;r+=4){a=max3f(a,p0[r],p0[r+1]);b=max3f(b,p0[r+2],p0[r+3]);a=max3f(a,p1[r],p1[r+1]);b=max3f(b,p1[r+2],p1[r+3]);}
  const float m=max2f(a,b);
  auto rr=__builtin_amdgcn_permlane32_swap(__float_as_uint(m),__float_as_uint(m),false,false);
  return max2f(__uint_as_float(rr[0]),__uint_as_float(rr[1]));
}
__device__ __forceinline__ void pv(f32x16*o,int vb,bf16x8 pa0,bf16x8 pa1,bf16x8 pa2,bf16x8 pa3){
  #pragma unroll
  for(int d0=0;d0<2;++d0){s16x4 lo[4],hi[4];
    #pragma unroll
    for(int ks=0;ks<4;++ks){
      asm volatile("ds_read_b64_tr_b16 %0,%1 offset:%c2":"=&v"(lo[ks]):"v"(vb),"i"(d0*4096+ks*1024):"memory");
      asm volatile("ds_read_b64_tr_b16 %0,%1 offset:%c2":"=&v"(hi[ks]):"v"(vb),"i"(d0*4096+ks*1024+512):"memory");}
    asm volatile("s_waitcnt lgkmcnt(0)":::"memory");SBAR();
    #define PK(k) (bf16x8){lo[k][0],lo[k][1],lo[k][2],lo[k][3],hi[k][0],hi[k][1],hi[k][2],hi[k][3]}
    o[d0]=__builtin_amdgcn_mfma_f32_32x32x16_bf16(pa0,PK(0),o[d0],0,0,0);
    o[d0]=__builtin_amdgcn_mfma_f32_32x32x16_bf16(pa1,PK(1),o[d0],0,0,0);
    o[d0]=__builtin_amdgcn_mfma_f32_32x32x16_bf16(pa2,PK(2),o[d0],0,0,0);
    o[d0]=__builtin_amdgcn_mfma_f32_32x32x16_bf16(pa3,PK(3),o[d0],0,0,0);
    #undef PK
  }
}

#ifndef ATTN_STORE16
#define ATTN_STORE16(p,v) (*(u32x4*)(p)=(v))
#endif
template<int THRL> __device__ __forceinline__ void attn_unit(int b,int h,int qb,int t0,const bf16*Q,const bf16*__restrict__ K,const bf16*__restrict__ V,bf16*O,char*shm){
  const int tid=tid_fresh(),lane=tid&63,r32=lane&31,hi=lane>>5; const int wid=__builtin_amdgcn_readfirstlane(tid>>6);
  const long rowbase=(long)b*SEQ; const int q0=qb*QB;
  const bf16*Qw=Q+(rowbase+q0+wid*QBLK)*DM+h*D;
  const bf16*Kh=K+(rowbase+(long)t0*KVBLK)*DM+h*D,*Vh=V+(rowbase+(long)t0*KVBLK)*DM+h*D;
  const unsigned lds0=(unsigned)(uintptr_t)shm;
  float*wsf=(float*)(shm+LDS_WS)+wid*64;
  const bf16*ksrc=Kh+(long)lane*DM+wid*8;
  const bf16*vsrc=Vh+(long)(16*(wid&3)+(lane>>2))*DM+(wid>>2)*32+(lane&3)*8;
  const unsigned kdst=lds0+LDS_K+wid*1024, vdst=lds0+LDS_V+wid*1024;
  #define DMA_K(t,slot) glds16(ksrc+(long)(t)*KVBLK*DM,(unsigned)__builtin_amdgcn_readfirstlane(kdst+(slot)))
  #define DMA_V(t,slot) glds16(vsrc+(long)(t)*KVBLK*DM,(unsigned)__builtin_amdgcn_readfirstlane(vdst+(slot)))
  const int vb0=(int)(lds0+LDS_V)+((lane>>4)&1)*32+(lane&3)*8+(4*hi+((lane&15)>>2))*64;
  const char*Kbase=shm+LDS_K; bf16x8 kf[8];
  const lds_cptr shm3=(lds_cptr)shm; const lds_cptr kp0=shm3+LDS_K+hi*1024+r32*16; const lds_cptr vp0=shm3+LDS_V+((lane>>4)&1)*32+(lane&3)*8+(4*hi+((lane&15)>>2))*64;
  const int NT=(q0+QB)/KVBLK-t0;
  DMA_K(0,0);DMA_V(0,0);DMA_K(1,SLOTB);
  bf16x8 qr[4];
  #pragma unroll
  for(int d0=0;d0<4;++d0)qr[d0]=*reinterpret_cast<const bf16x8*>(&Qw[(long)r32*DM+d0*16+hi*8]);
  typedef __attribute__((address_space(3))) unsigned long long lds_u64;
  const lds_u64* const ctab=(const lds_u64*)(__attribute__((address_space(3))) char*)(shm+LDS_BYTES);
  float mhat; { const float h1_=__uint_as_float((unsigned)ctab[q0-t0*KVBLK+wid*QBLK+r32]<<16), a0_=h1_+48.0f; mhat=__uint_as_float((__float_as_uint(a0_)+0x7fffu+((__float_as_uint(a0_)>>16)&1u))&0xffff0000u);
    if(h1_>=8192.0f) mhat=h1_; }
  float l_reg=0.f;f32x16 o[2];o[0]=f32x16{};o[1]=f32x16{};const f32x16 negm=f32x16{};
  typedef short s16x4k __attribute__((ext_vector_type(4))); typedef unsigned u32x2k __attribute__((ext_vector_type(2)));
  u32x2k qaw=(u32x2k){hi==0?0x3F803F80u:0u,0u};
  #define SETQA() do{ qaw[1]=(hi==0)?(0x3F80u|(((__float_as_uint(mhat)>>16)^0x8000u)<<16)):0u; }while(0)
  #define QAUG __builtin_bit_cast(s16x4k,qaw)
  #define MFA8(a_,b_,c_) __builtin_amdgcn_mfma_f32_32x32x8bf16_1k(a_,b_,c_,0,0,0)
  #define RNDBF(x_) __uint_as_float((__float_as_uint(x_)+0x7fffu+((__float_as_uint(x_)>>16)&1u))&0xffff0000u)
  SETQA();
  #define KAUG(t_,A0,A1) do{ const lds_u64* cp_=ctab+(t_)*KVBLK+r32; const unsigned long long w0_=cp_[0],w1_=cp_[32]; \
    A0=__builtin_bit_cast(s16x4k,w0_); A1=__builtin_bit_cast(s16x4k,w1_); }while(0)
  const int qrel=wid*QBLK+r32;
  #define CMASK(P0,P1,t) do{int jb_=(t)-(NT-4); if(jb_>=0)cmask(P0,P1,jb_,qrel,hi);}while(0)
  bool resc=false;
  #define START(P0,P1) do{ const float rm=rowmax(P0,P1); resc=false; \
    if(__builtin_expect(__any(rm>(float)THRL),0)){ const float rn_=mhat+__builtin_fmaxf(rm,0.f); const float mn_=RNDBF(rn_); const float dl=mn_-mhat; mhat=mn_; SETQA(); \
      _Pragma("unroll") for(int r=0;r<16;++r){P0[r]-=dl;P1[r]-=dl;} \
      } \
    _Pragma("unroll") for(int r=0;r<16;++r)P0[r]=__builtin_amdgcn_exp2f(P0[r]); }while(0)
  #define RESC() do{ if(resc){ asm volatile("s_waitcnt lgkmcnt(0)":::"memory"); \
      _Pragma("unroll") for(int d_=0;d_<2;++d_) _Pragma("unroll") for(int r=0;r<16;++r)o[d_][r]*=wsf[crow(r,hi)]; } }while(0)
  f32x16 pA0,pA1,pB0,pB1;
  int sl_prev=0,sl_cur=0,sl_next=SLOTB;
  #define ROT() do{sl_prev=sl_cur;sl_cur=sl_next;sl_next=(sl_next==(NSLOT-1)*SLOTB)?0:sl_next+SLOTB;}while(0)
  DMA_K(2,2*SLOTB);
  WAIT_BAR(3);
  { s16x4k ka0_,ka1_; KAUG(0,ka0_,ka1_); qkt(pA0,pA1,Kbase,qr,negm,r32,hi,ka0_,ka1_,QAUG); } asm volatile("s_nop 15\n\ts_nop 7":"+v"(pA0),"+v"(pA1));CMASK(pA0,pA1,0);
  START(pA0,pA1);
  _Pragma("unroll") for(int r=0;r<16;++r)pA1[r]=__builtin_amdgcn_exp2f(pA1[r]);
  WAIT_BAR(0);
  DMA_K(3,0);DMA_V(1,SLOTB);
  ROT();
  kload8(kf,kp0+sl_cur);
  WAIT_BAR(2);
  s16x4 vlo[8],vhi[8]; u32x4 pw0,pw1,pw2,pw3;
  #define PKW(P,B) cvtpk_s(P[B],P[B+1])
  #define PAF(k) __builtin_bit_cast(bf16x8,pw##k)
  #define VFR(i) (bf16x8){vlo[i][0],vlo[i][1],vlo[i][2],vlo[i][3],vhi[i][0],vhi[i][1],vhi[i][2],vhi[i][3]}
  #define PIN(x) asm volatile("":"+v"(x))
  #define MX3(a,b,c) __builtin_fmaxf(__builtin_fmaxf((a),(b)),(c))
  #define GAPA(MF,A0,A1,A2,A3,W0,W1,PW) do{ MF; sacc+=A0; sacc+=A1; sacc+=A2; sacc+=A3; PIN(sacc); W0; W1; PIN(PW); SBAR(); }while(0)
  #define EX(v) __builtin_amdgcn_exp2f(v)
  #define GAPB(MF,X,B) do{ MF; X[B]=EX(X[B]); X[B+1]=EX(X[B+1]); X[B+2]=EX(X[B+2]); X[B+3]=EX(X[B+3]); PIN(X); SBAR(); }while(0)
  #define VRD(i) do{ vlo[i]=vtr(vp_+(((i)>>2)*4096+((i)&3)*1024)); vhi[i]=vtr(vp_+(((i)>>2)*4096+((i)&3)*1024+512)); }while(0)
  #define KRD(G,j) do{ if(G){ kload2(kf,kp0+sl_next,j); SBAR(); } }while(0)
  #define STEP(C0,C1,P0,P1,t,GK,GV,GL) do{ SBAR(); \
    const lds_cptr vp_=vp0+sl_prev; s16x4k ka0_,ka1_; \
    VRD(0); SBAR(); float sacc=(P0[0]+P0[1]); \
    GAPA(C0=__builtin_amdgcn_mfma_f32_32x32x16_bf16(kf[0],qr[0],negm,0,0,0), P0[2],P0[3],P0[4],P0[5],     pw0[0]=PKW(P0,0), pw0[1]=PKW(P0,2), pw0); \
    VRD(4); SBAR(); GAPA(C1=__builtin_amdgcn_mfma_f32_32x32x16_bf16(kf[1],qr[0],negm,0,0,0), P0[6],P0[7],P0[8],P0[9],     pw0[2]=PKW(P0,4), pw0[3]=PKW(P0,6), pw0); \
    VRD(1); SBAR(); GAPA(C0=__builtin_amdgcn_mfma_f32_32x32x16_bf16(kf[2],qr[1],C0,0,0,0),   P0[10],P0[11],P0[12],P0[13], pw1[0]=PKW(P0,8), pw1[1]=PKW(P0,10), pw1); \
    VRD(5); SBAR(); GAPA(C1=__builtin_amdgcn_mfma_f32_32x32x16_bf16(kf[3],qr[1],C1,0,0,0),   P0[14],P0[15],P1[0],P1[1],   pw1[2]=PKW(P0,12),pw1[3]=PKW(P0,14), pw1); \
    VRD(2); SBAR(); GAPA(C0=__builtin_amdgcn_mfma_f32_32x32x16_bf16(kf[4],qr[2],C0,0,0,0),   P1[2],P1[3],P1[4],P1[5],     pw2[0]=PKW(P1,0), pw2[1]=PKW(P1,2), pw2); \
    VRD(6); SBAR(); GAPA(C1=__builtin_amdgcn_mfma_f32_32x32x16_bf16(kf[5],qr[2],C1,0,0,0),   P1[6],P1[7],P1[8],P1[9],     pw2[2]=PKW(P1,4), pw2[3]=PKW(P1,6), pw2); \
    VRD(3); SBAR(); GAPA(C0=__builtin_amdgcn_mfma_f32_32x32x16_bf16(kf[6],qr[3],C0,0,0,0),   P1[10],P1[11],P1[12],P1[13], pw3[0]=PKW(P1,8), pw3[1]=PKW(P1,10), pw3); \
    VRD(7); KAUG(t,ka0_,ka1_); SBAR(); GAPA(C1=__builtin_amdgcn_mfma_f32_32x32x16_bf16(kf[7],qr[3],C1,0,0,0),   P1[14],P1[15],0.f,0.f,       pw3[2]=PKW(P1,12),pw3[3]=PKW(P1,14), pw3); \
    C0=MFA8(ka0_,QAUG,C0); C1=MFA8(ka1_,QAUG,C1); \
    l_reg+=sacc; \
    if(GK){DMA_K((t)+3,sl_cur);} if(GV){DMA_V((t)+1,sl_next);} \
    CMASK(C0,C1,t); \
    { float a=MX3(C0[0],C0[1],C1[0]),b=MX3(C0[2],C0[3],C1[1]); a=MX3(a,C1[2],C1[3]); \
      _Pragma("unroll") for(int r=4;r<16;r+=4){a=MX3(a,C0[r],C0[r+1]);b=MX3(b,C0[r+2],C0[r+3]);a=MX3(a,C1[r],C1[r+1]);b=MX3(b,C1[r+2],C1[r+3]);} \
      float rm=__builtin_fmaxf(a,b); { auto rr=__builtin_amdgcn_permlane32_swap(__float_as_uint(rm),__float_as_uint(rm),false,false); rm=__builtin_fmaxf(__uint_as_float(rr[0]),__uint_as_float(rr[1])); } \
      resc=false; \
      if(__builtin_expect(__any(rm>(float)THRL),0)){ const float rn_=mhat+__builtin_fmaxf(rm,0.f); const float mn_=RNDBF(rn_); const float dl=mn_-mhat; mhat=mn_; SETQA(); \
        _Pragma("unroll") for(int r=0;r<16;++r){C0[r]-=dl;C1[r]-=dl;} \
        const float f=__builtin_amdgcn_exp2f(-dl); l_reg*=f; if(hi==0)wsf[r32]=f; resc=true; } } \
    SBAR(); \
    GAPB(o[0]=__builtin_amdgcn_mfma_f32_32x32x16_bf16(PAF(0),VFR(0),o[0],0,0,0), C0,0); \
    GAPB(o[1]=__builtin_amdgcn_mfma_f32_32x32x16_bf16(PAF(0),VFR(4),o[1],0,0,0), C0,4); \
    KRD(GL,0); GAPB(o[0]=__builtin_amdgcn_mfma_f32_32x32x16_bf16(PAF(1),VFR(1),o[0],0,0,0), C0,8); \
    KRD(GL,1); GAPB(o[1]=__builtin_amdgcn_mfma_f32_32x32x16_bf16(PAF(1),VFR(5),o[1],0,0,0), C0,12); \
    KRD(GL,2); GAPB(o[0]=__builtin_amdgcn_mfma_f32_32x32x16_bf16(PAF(2),VFR(2),o[0],0,0,0), C1,0); \
    KRD(GL,3); GAPB(o[1]=__builtin_amdgcn_mfma_f32_32x32x16_bf16(PAF(2),VFR(6),o[1],0,0,0), C1,4); \
    GAPB(o[0]=__builtin_amdgcn_mfma_f32_32x32x16_bf16(PAF(3),VFR(3),o[0],0,0,0), C1,8); \
    GAPB(o[1]=__builtin_amdgcn_mfma_f32_32x32x16_bf16(PAF(3),VFR(7),o[1],0,0,0), C1,12); \
    }while(0)
  int t=1;
  #undef CMASK
  #define CMASK(P0,P1,t) do{}while(0)
  for(;t+5<NT;t+=2){
    STEP(pB0,pB1,pA0,pA1,t,true,true,true);     WAIT_BAR(2); RESC(); ROT();
    STEP(pA0,pA1,pB0,pB1,t+1,true,true,true);   WAIT_BAR(2); RESC(); ROT();
  }
  #undef CMASK
  #define CMASK(P0,P1,t) do{int jb_=(t)-(NT-4); if(jb_>=0)cmask(P0,P1,jb_,qrel,hi);}while(0)
  #define ENDW(tt) do{ if((tt)+3<NT){WAIT_BAR(2);} else if((tt)+2<NT){WAIT_BAR(1);} else {WAIT_BAR(0);} }while(0)
  for(;t+1<NT;t+=2){
    STEP(pB0,pB1,pA0,pA1,t,(t+3<NT),(t+1<NT),(t+1<NT));       ENDW(t);   RESC(); ROT();
    STEP(pA0,pA1,pB0,pB1,t+1,(t+4<NT),(t+2<NT),(t+2<NT));     ENDW(t+1); RESC(); ROT();
  }
  STEP(pB0,pB1,pA0,pA1,NT-1,false,false,false); RESC();
  { float sacc=pB0[0]+pB0[1]; _Pragma("unroll") for(int r=2;r<16;++r)sacc+=pB0[r]; _Pragma("unroll") for(int r=0;r<16;++r)sacc+=pB1[r]; l_reg+=sacc;
    pw0=(u32x4){PKW(pB0,0),PKW(pB0,2),PKW(pB0,4),PKW(pB0,6)};pw1=(u32x4){PKW(pB0,8),PKW(pB0,10),PKW(pB0,12),PKW(pB0,14)};pw2=(u32x4){PKW(pB1,0),PKW(pB1,2),PKW(pB1,4),PKW(pB1,6)};pw3=(u32x4){PKW(pB1,8),PKW(pB1,10),PKW(pB1,12),PKW(pB1,14)};
    SBAR(); pv(o,vb0+sl_cur,PAF(0),PAF(1),PAF(2),PAF(3)); }
  #undef PKW
  #undef PAF
  #undef VFR
  #undef PIN
  #undef MX3
  #undef GAPA
  #undef GAPB
  #undef EX
  #undef VRD
  #undef KRD
  #undef STEP
  #undef ENDW
  {auto rr=__builtin_amdgcn_permlane32_swap(__float_as_uint(l_reg),__float_as_uint(l_reg),false,false);l_reg=__uint_as_float(rr[0])+__uint_as_float(rr[1]);}
  if(hi==0)wsf[32+r32]=l_reg;asm volatile("s_waitcnt lgkmcnt(0)":::"memory");
  float rli[16];
  #pragma unroll
  for(int r=0;r<16;++r)rli[r]=__builtin_amdgcn_rcpf(wsf[32+crow(r,hi)]);
  bf16*Ow=O+(rowbase+q0+wid*QBLK)*DM+h*D;
  { bf16*stg=(bf16*)(shm+LDS_OST)+wid*2048;
    #pragma unroll
    for(int r=0;r<16;++r){const int orow=crow(r,hi);
      #pragma unroll
      for(int d0=0;d0<2;++d0)stg[orow*64+d0*32+r32]=__float2bfloat16(o[d0][r]*rli[r]);}
    asm volatile("s_waitcnt lgkmcnt(0)":::"memory");
    #pragma unroll
    for(int i=0;i<4;++i){const int row=i*8+(lane>>3),ch=lane&7; const u32x4 v=*(const u32x4*)(stg+row*64+ch*8); ATTN_STORE16(Ow+(long)row*DM+ch*8,v);} }
  asm volatile("s_waitcnt lgkmcnt(0)\n\ts_barrier":::"memory");
  #undef KAUG
  #undef SETQA
  #undef QAUG
  #undef RNDBF
  #undef MFA8
  #undef DMA_K
  #undef DMA_V
  #undef CMASK
  #undef START
  #undef RESC
  #undef ROT
}
constexpr int ATTN_LDS_BYTES=LDS_BYTES+SEQ*8+16;
struct AttnTensors { const bf16* Q; const bf16* K; const bf16* V; bf16* O; const unsigned long long* CAUG; };
struct AttnUnit { int bh; int qb; };
struct StaticOrder {
  int vcu;
  __device__ __forceinline__ explicit StaticOrder(int grid,int block):vcu((block%8)*(grid/8)+block/8){}
  __device__ __forceinline__ bool next(int i,AttnUnit&u)const{ if(i>=4)return false; const int s=vcu&7; u.bh=vcu>>3; u.qb=(i==0)?s:(i==1)?15-s:(i==2)?16+s:31-s; return true; }
  __device__ __forceinline__ void a_ready(const AttnUnit&)const{}
  __device__ __forceinline__ void done(const AttnUnit&)const{}
};
__device__ __forceinline__ unsigned f2bf_rne(float f){unsigned u=__float_as_uint(f);return (u+0x7fffu+((u>>16)&1u))>>16;}
__device__ __forceinline__ void fox_scan(char*lds,const float*__restrict__ lf,unsigned long long*__restrict__ tab){
  typedef __attribute__((address_space(3))) double lds_f64;
  lds_f64* sums=(lds_f64*)(__attribute__((address_space(3))) char*)lds;
  const int tid=tid_fresh(); double acc=0.0;
  #pragma unroll
  for(int i=0;i<16;++i)acc+=(double)lf[tid*16+i];
  sums[tid]=acc; __syncthreads();
  double run=0.0; for(int i=0;i<tid;++i)run+=sums[i];
  #pragma unroll 1
  for(int i=0;i<16;++i){ run+=(double)lf[tid*16+i]; const float nv=(float)(run*-1.4426950408889634);
    const unsigned h1=f2bf_rne(nv); const float r1=nv-__uint_as_float(h1<<16); const unsigned h2=f2bf_rne(r1); const float r2=r1-__uint_as_float(h2<<16); const unsigned h3=f2bf_rne(r2);
    tab[tid*16+i]=(unsigned long long)(h1|(h2<<16))|((unsigned long long)(h3|0x3F800000u)<<32); }
  __syncthreads();
}
__device__ __forceinline__ float caug_val(unsigned long long w){ return (__uint_as_float((unsigned)w<<16)+__uint_as_float((unsigned)w&0xffff0000u))+__uint_as_float((unsigned)(w>>32)<<16); }
constexpr float SKIP_TH=72.0f;
template<int THRL=8> __device__ __forceinline__ void attn_phase_dyn(char*lds,const AttnTensors&T,unsigned*ctr){
  typedef __attribute__((address_space(3))) unsigned long long lds_u64; typedef __attribute__((address_space(3))) int lds_i32;
  lds_i32* slotw=(lds_i32*)(__attribute__((address_space(3))) char*)(lds+LDS_BYTES+SEQ*8);
  lds_u64* tab=(lds_u64*)(__attribute__((address_space(3))) char*)(lds+LDS_BYTES);
  for(;;){
    const int tid=tid_fresh();
    if(tid==0){ slotw[0]=(int)__hip_atomic_fetch_add(ctr,1u,__ATOMIC_RELAXED,__HIP_MEMORY_SCOPE_AGENT); slotw[1]=0; }
    __syncthreads();
    const int slot=__builtin_amdgcn_readfirstlane(slotw[0]);
    if(slot>=BATCH*NHEAD*NQB) break;
    const int qb=NQB-1-(slot>>5), bh=slot&31, q0=qb*QB, NTF=(q0+QB)/KVBLK;
    const unsigned long long* cg=T.CAUG+(long)bh*SEQ;
    const float lim=caug_val(cg[q0])-SKIP_TH;
    if(tid<NTF-4){ const bool p0_=caug_val(cg[tid*KVBLK+KVBLK-1])<lim, p1_=(tid+1<NTF-4)&&(caug_val(cg[(tid+1)*KVBLK+KVBLK-1])<lim);
      if(p0_&&!p1_) slotw[1]=tid+1; }
    __syncthreads();
    const int nskip=__builtin_amdgcn_readfirstlane(slotw[1]);
    const int t0=nskip&~1;
    for(int i=tid;i<(NTF-t0)*KVBLK;i+=NW*64) tab[i]=cg[t0*KVBLK+i];
    __syncthreads();
    attn_unit<THRL>(bh/NHEAD,bh%NHEAD,qb,t0,T.Q,T.K,T.V,T.O,lds);
  }
}
#undef SBAR
#undef WAIT_BAR
}

namespace swa {
constexpr int D = 128; constexpr float THR = 8.f; constexpr bool WSKIP = true;
constexpr float SCALE = 0.08838834764831845f;
constexpr int NW = 8, QBLK = 32, KVBLK = 64, QB = NW * QBLK;
constexpr int SHM_V = KVBLK * D * 2, SHM_K = KVBLK * D * 2;
constexpr int LDS_BYTES = 2 * SHM_V + 2 * SHM_K + NW * 64 * 4;

using bf16 = __hip_bfloat16;
typedef short bf16x8 __attribute__((ext_vector_type(8)));
typedef short s16x4 __attribute__((ext_vector_type(4)));
typedef float f32x16 __attribute__((ext_vector_type(16)));
typedef float f32x4 __attribute__((ext_vector_type(4)));
typedef unsigned u32x4 __attribute__((ext_vector_type(4)));
template <class A, class Bt> struct same_t { static constexpr bool v = false; };
template <class A> struct same_t<A, A> { static constexpr bool v = true; };

#define KSWZ(row, colB) ((row) * 256 + ((colB) ^ (((row) & 7) << 4)))
#define SBAR() __builtin_amdgcn_sched_barrier(0)
__device__ __forceinline__ int v_st(int k, int c) { const int kk = (k & ~0xC) | ((k & 4) << 1) | ((k & 8) >> 1); return ((kk >> 3) * 4 + (c >> 5)) * 512 + ((kk & 7) * 32 + (c & 31)) * 2; }
__device__ __forceinline__ int v_rd_base(int lane) { return ((lane & 3) << 3) | (((lane >> 2) & 3) << 6) | (((lane >> 4) & 1) << 5) | (((lane >> 5) & 1) << 8); }
constexpr int v_rd_off(int d0, int ks, int half) { return d0 * 512 + ks * 4096 + half * 2048; }
__device__ __forceinline__ int crow(int r, int hi) { return (r & 3) + 8 * (r >> 2) + 4 * hi; }
__device__ __forceinline__ unsigned cvtpk(float lo, float hi) {
    unsigned r; asm volatile("v_cvt_pk_bf16_f32 %0, %1, %2" : "=v"(r) : "v"(lo), "v"(hi)); return r;
}
__device__ __forceinline__ bf16x8 pack8(f32x4 a, f32x4 b) {
    u32x4 w = {cvtpk(a[0], a[1]), cvtpk(a[2], a[3]), cvtpk(b[0], b[1]), cvtpk(b[2], b[3])};
    return *reinterpret_cast<bf16x8*>(&w);
}
template <class T> __device__ __forceinline__ bf16x8 load8(const T* p) {
    if constexpr (same_t<T, float>::v) { return pack8(*(const f32x4*)p, *(const f32x4*)(p + 4)); }
    else { return *reinterpret_cast<const bf16x8*>(p); }
}
__device__ __forceinline__ void mask_tile(f32x16& p0, f32x16& p1, int dq, unsigned W) {
    const float NEG = -__builtin_inff();
#pragma unroll
    for (int r = 0; r < 16; ++r) {
        const int c = (r & 3) + 8 * (r >> 2);
        if ((unsigned)(dq - c) >= W) p0[r] = NEG;
        if ((unsigned)(dq - c - 32) >= W) p1[r] = NEG;
    }
}
__device__ __forceinline__ void partialSM(f32x16& p0, f32x16& p1, float& m_reg, float& mn, float& alpha) {
    float pmax = p0[0]; for (int r = 1; r < 16; ++r) pmax = fmaxf(pmax, p0[r]); for (int r = 0; r < 16; ++r) pmax = fmaxf(pmax, p1[r]);
    { auto rr = __builtin_amdgcn_permlane32_swap(__float_as_uint(pmax), __float_as_uint(pmax), false, false);
      pmax = fmaxf(__uint_as_float(rr[0]), __uint_as_float(rr[1])); }
    constexpr float C2 = 1.4426950408889634f * SCALE;
    if (__builtin_expect(__all((pmax - m_reg) * SCALE <= THR), 1)) { mn = m_reg; alpha = 1.f; }
    else { mn = fmaxf(m_reg, pmax); alpha = __builtin_amdgcn_exp2f((m_reg - mn) * C2); m_reg = mn; }
    const float mnL = -mn * C2;
    for (int r = 0; r < 16; ++r) p0[r] = fmaf(p0[r], C2, mnL); for (int r = 0; r < 16; ++r) p1[r] = fmaf(p1[r], C2, mnL);
    for (int r = 0; r < 16; ++r) p0[r] = __builtin_amdgcn_exp2f(p0[r]);
}
__device__ __forceinline__ void finishSM(f32x16& p0, f32x16& p1, float alpha, float& l_reg, bf16x8& pa0, bf16x8& pa1, bf16x8& pa2, bf16x8& pa3) {
    for (int r = 0; r < 16; ++r) p1[r] = __builtin_amdgcn_exp2f(p1[r]);
    float ps = 0; for (int r = 0; r < 16; ++r) ps += p0[r]; for (int r = 0; r < 16; ++r) ps += p1[r];
    { auto rr = __builtin_amdgcn_permlane32_swap(__float_as_uint(ps), __float_as_uint(ps), false, false);
      ps = __uint_as_float(rr[0]) + __uint_as_float(rr[1]); }
    l_reg = l_reg * alpha + ps;
#define PK4(P, B_, OUT) do { unsigned a0 = cvtpk(P[B_+0], P[B_+1]), a1 = cvtpk(P[B_+2], P[B_+3]);                          \
        unsigned b0 = cvtpk(P[B_+4], P[B_+5]), b1 = cvtpk(P[B_+6], P[B_+7]);                                             \
        auto r0 = __builtin_amdgcn_permlane32_swap(a0, b0, false, false); auto r1 = __builtin_amdgcn_permlane32_swap(a1, b1, false, false); \
        u32x4 w = {r0[0], r1[0], r0[1], r1[1]}; OUT = *reinterpret_cast<bf16x8*>(&w); } while (0)
    PK4(p0, 0, pa0); PK4(p0, 8, pa1); PK4(p1, 0, pa2); PK4(p1, 8, pa3);
#undef PK4
}
template <int KB, bool SK>
__device__ __forceinline__ void qkt(f32x16& p0, f32x16& p1, const char* K_lds, int r32, int hi, const bf16x8* qr, bool act) {
    if (SK && !act) { const float NEG = -__builtin_inff();
#pragma unroll
        for (int r = 0; r < 16; ++r) { p0[r] = NEG; p1[r] = NEG; } return; }
    p0 = f32x16{}; p1 = f32x16{};
    const char* kb[4];
#pragma unroll
    for (int dd = 0; dd < 4; ++dd) kb[dd] = K_lds + KB * SHM_K + KSWZ(r32, (dd * 16 + hi * 8) * 2);
#pragma unroll
    for (int d0 = 0; d0 < 8; ++d0) { const char* a = kb[d0 & 3] + (d0 >> 2) * 128;
        bf16x8 b0 = *reinterpret_cast<const bf16x8*>(a);
        bf16x8 b1 = *reinterpret_cast<const bf16x8*>(a + 32 * 256);
        p0 = __builtin_amdgcn_mfma_f32_32x32x16_bf16(b0, qr[d0], p0, 0, 0, 0);
        p1 = __builtin_amdgcn_mfma_f32_32x32x16_bf16(b1, qr[d0], p1, 0, 0, 0); }
}
template <int VB, bool SK>
__device__ __forceinline__ void pv_tile(f32x16* o, int vb0, bf16x8 pa0, bf16x8 pa1, bf16x8 pa2, bf16x8 pa3, bool act) {
    if (SK && !act) return;
#define TRRD(dst, off) asm volatile("ds_read_b64_tr_b16 %0, %1 offset:%2" : "=&v"(dst) : "v"(vb0), "i"(off) : "memory")
#define PV_D0(d0) do { s16x4 l0, l1, l2, l3, h0, h1, h2, h3; constexpr int b_ = VB * SHM_V + v_rd_off(d0, 0, 0);     \
        TRRD(l0, b_); TRRD(h0, b_ + 2048); TRRD(l1, b_ + 4096); TRRD(h1, b_ + 6144); TRRD(l2, b_ + 8192); TRRD(h2, b_ + 10240); TRRD(l3, b_ + 12288); TRRD(h3, b_ + 14336); \
        asm volatile("s_waitcnt lgkmcnt(0)" ::: "memory"); SBAR();                 \
        o[d0] = __builtin_amdgcn_mfma_f32_32x32x16_bf16(pa0, (bf16x8){l0[0], l0[1], l0[2], l0[3], h0[0], h0[1], h0[2], h0[3]}, o[d0], 0, 0, 0);   \
        o[d0] = __builtin_amdgcn_mfma_f32_32x32x16_bf16(pa1, (bf16x8){l1[0], l1[1], l1[2], l1[3], h1[0], h1[1], h1[2], h1[3]}, o[d0], 0, 0, 0);   \
        o[d0] = __builtin_amdgcn_mfma_f32_32x32x16_bf16(pa2, (bf16x8){l2[0], l2[1], l2[2], l2[3], h2[0], h2[1], h2[2], h2[3]}, o[d0], 0, 0, 0);   \
        o[d0] = __builtin_amdgcn_mfma_f32_32x32x16_bf16(pa3, (bf16x8){l3[0], l3[1], l3[2], l3[3], h3[0], h3[1], h3[2], h3[3]}, o[d0], 0, 0, 0); } while (0)
    PV_D0(0); PV_D0(1); PV_D0(2); PV_D0(3);
#undef PV_D0
#undef TRRD
}

template <class TIn, class TOut> struct BlockRef { const TIn* Q; const TIn* K; const TIn* V; TOut* O; int P0; int qp, kp, op; float* L; int lp; };
template <class TIn> struct Seam {
    bf16x8 qr[8];
    bf16x8 st_v0, st_v1, st_k0, st_k1; f32x4 sf0, sf1, sf2, sf3;
    f32x4 tq[16];
};
__device__ __forceinline__ int swa_jlo(int P0, int W) { const int lowk = P0 - W + 1; return lowk > 0 ? lowk / KVBLK : 0; }
#define ROW(p, k0, rr) ((p) + (size_t)((k0) + (rr)) * D + sc)
#define VMW() asm volatile("s_waitcnt vmcnt(0)" ::: "memory")
#define VMWN(n) asm volatile("s_waitcnt vmcnt(%0)" :: "i"(n) : "memory")
#define ROWP(p, k0, rr, pt) ((const TIn*)((const char*)(p) + (unsigned)((((k0) + (rr)) * (pt) + sc) * 2)))
#define SLOAD_H(Kp, Vp, k0, pt) do { S.st_v0 = load8<TIn>(ROWP(Vp, k0, sr, pt)); S.st_v1 = load8<TIn>(ROWP(Vp, k0, 32 + sr, pt));              \
                         S.st_k0 = load8<TIn>(ROWP(Kp, k0, sr, pt)); S.st_k1 = load8<TIn>(ROWP(Kp, k0, 32 + sr, pt)); } while (0)
#define SWRITE_HK(bf) do { *(bf16x8*)(K_lds + (bf) * SHM_K + kws) = S.st_k0; *(bf16x8*)(K_lds + (bf) * SHM_K + kws + 32 * 256) = S.st_k1; } while (0)
#define SWRITE_HV(bf) do { *(bf16x8*)(V_lds + (bf) * SHM_V + vst0) = S.st_v0; *(bf16x8*)(V_lds + (bf) * SHM_V + vst1) = S.st_v1; } while (0)
#define SWRITE_H(bf) do { SWRITE_HV(bf); SWRITE_HK(bf); } while (0)
#define SLOAD_F(p, k0) do { S.sf0 = *(const f32x4*)ROW(p, k0, sr); S.sf1 = *(const f32x4*)(ROW(p, k0, sr) + 4);                \
                            S.sf2 = *(const f32x4*)ROW(p, k0, 32 + sr); S.sf3 = *(const f32x4*)(ROW(p, k0, 32 + sr) + 4); } while (0)
#define SWRITE_KF(bf) do { *(bf16x8*)(K_lds + (bf) * SHM_K + kws) = pack8(S.sf0, S.sf1); *(bf16x8*)(K_lds + (bf) * SHM_K + kws + 32 * 256) = pack8(S.sf2, S.sf3); } while (0)
#define SWRITE_VF(bf) do { *(bf16x8*)(V_lds + (bf) * SHM_V + vst0) = pack8(S.sf0, S.sf1); *(bf16x8*)(V_lds + (bf) * SHM_V + vst1) = pack8(S.sf2, S.sf3); } while (0)
template <class TIn, class TOut>
__device__ __forceinline__ void causal_swa_prime(const BlockRef<TIn, TOut>& cur, int W, char* lds, Seam<TIn>& S) {
    constexpr bool F32 = same_t<TIn, float>::v;
    const int tid = tid_fresh(), wid = __builtin_amdgcn_readfirstlane(tid >> 6), lane = tid & 63, r32 = lane & 31, hi = lane >> 5;
    const int sr = tid >> 4, sc = (tid & 15) * 8, kws = KSWZ(sr, sc * 2); char* K_lds = lds + 2 * SHM_V;
    const int kb0 = swa_jlo(cur.P0, W) * KVBLK;
    for (int d0 = 0; d0 < 8; ++d0) S.qr[d0] = load8<TIn>((const TIn*)((const char*)cur.Q + (unsigned)(((wid * QBLK + r32) * cur.qp + hi * 8) * 2) + d0 * 32));
    if constexpr (F32) { SLOAD_F((const float*)cur.K, kb0); VMW(); SWRITE_KF(0); SBAR(); SLOAD_F((const float*)cur.V, kb0); }
    else { SLOAD_H(cur.K, cur.V, kb0, cur.kp); VMW(); SWRITE_HK(0); }
    __syncthreads();
}
template <class TIn, class TOut>
__device__ __forceinline__ void causal_swa_block(const BlockRef<TIn, TOut>& cur, const BlockRef<TIn, TOut>& nxt, int skv, int W, char* lds, Seam<TIn>& S) {
    constexpr bool F32 = same_t<TIn, float>::v;
    const int tid = tid_fresh(), wid = __builtin_amdgcn_readfirstlane(tid >> 6), lane = tid & 63, r32 = lane & 31, hi = lane >> 5;
    const int j_lo = swa_jlo(cur.P0, W);
    int j_hi = (cur.P0 + QB - 1) / KVBLK + 1; if (j_hi > skv / KVBLK) j_hi = skv / KVBLK;
    const int NT = j_hi - j_lo;
    const int kbn = swa_jlo(nxt.P0, W) * KVBLK;
    const int qlo = cur.P0 + wid * QBLK, qm = qlo + r32 - 4 * hi;
    char* V_lds = lds; char* K_lds = lds + 2 * SHM_V;
    float* ws = (float*)(lds + 2 * SHM_V + 2 * SHM_K) + wid * 64; float* li_l = ws, * al_l = ws + 32;
    float m_reg = -1e30f, l_reg = 0; f32x16 o[4] = {};
    const int sr = tid >> 4, sc = (tid & 15) * 8, vst0 = v_st(sr, sc), vst1 = v_st(32 + sr, sc), kws = KSWZ(sr, sc * 2);
    const int vb0 = (int)(uintptr_t)V_lds + v_rd_base(lane);
    const TIn* Kh = cur.K; const TIn* Vh = cur.V;
#define RESC(a) do { if (__any((a) < 1.f)) { if (hi == 0) al_l[r32] = (a); asm volatile("s_waitcnt lgkmcnt(0)" ::: "memory");              \
                     for (int d_ = 0; d_ < 4; ++d_) for (int r = 0; r < 16; ++r) o[d_][r] *= al_l[crow(r, hi)]; } } while (0)
#define KBASE(t) ((j_lo + (t)) * KVBLK)
#define ACT(t) (KBASE(t) <= qlo + QBLK - 1 && KBASE(t) + KVBLK - 1 >= qlo - W + 1)
#define MASKT(P0_, P1_, t) do { const int kb_ = KBASE(t); if ((!SK || ACT(t)) && (kb_ + KVBLK - 1 > qlo || kb_ <= qlo + QBLK - 1 - W)) mask_tile(P0_, P1_, qm - kb_, (unsigned)W); } while (0)
    constexpr int NQL = F32 ? 16 : 8;
    constexpr bool SK = WSKIP && !F32;
#define SEAM_K0() do { VMWN(NQL); if constexpr (F32) { SWRITE_KF(0); SBAR(); SLOAD_F((const float*)nxt.V, kbn); } else { SWRITE_HK(0); } SBAR(); } while (0)
    f32x16 pA0, pA1, pB0, pB1; float mnA, mnB, alA, alB; bf16x8 pa0, pa1, pa2, pa3;
    if constexpr (F32) { VMW(); SWRITE_VF(0); SBAR(); } else { SWRITE_HV(0); SBAR(); }
    if (NT > 1) { if constexpr (F32) SLOAD_F((const float*)Kh, KBASE(1)); else SLOAD_H(Kh, Vh, KBASE(1), cur.kp); }
    SBAR(); qkt<0, SK>(pA0, pA1, K_lds, r32, hi, S.qr, ACT(0));
    if constexpr (F32) { if (NT > 1) { VMW(); SWRITE_KF(1); SBAR(); SLOAD_F((const float*)Vh, KBASE(1)); } }
    MASKT(pA0, pA1, 0); partialSM(pA0, pA1, m_reg, mnA, alA);
    if (NT > 1) { VMW(); if constexpr (F32) { SWRITE_VF(1); SBAR(); if (NT > 2) SLOAD_F((const float*)Kh, KBASE(2)); } else SWRITE_H(1); }
    __syncthreads();
#define HALF_STEP(PX0, PX1, mnX, alX, PY0, PY1, alY, t, KB, VB, SB) do {                                                      \
        SBAR(); qkt<KB, SK>(PX0, PX1, K_lds, r32, hi, S.qr, ACT(t));                                             \
        finishSM(PY0, PY1, alY, l_reg, pa0, pa1, pa2, pa3); SBAR();                                                           \
        if ((t) + 1 < NT) { if constexpr (F32) { VMW(); SWRITE_KF(SB); SBAR(); SLOAD_F((const float*)Vh, KBASE((t) + 1)); }  \
                            else { SLOAD_H(Kh, Vh, KBASE((t) + 1), cur.kp); } SBAR(); }                                               \
        pv_tile<VB, SK>(o, vb0, pa0, pa1, pa2, pa3, ACT((t) - 1)); MASKT(PX0, PX1, (t)); partialSM(PX0, PX1, m_reg, mnX, alX);                                        \
        __syncthreads();                                                                                                      \
        if ((t) + 1 < NT) { VMW(); if constexpr (F32) { SWRITE_VF(SB); SBAR(); if ((t) + 2 < NT) SLOAD_F((const float*)Kh, KBASE((t) + 2)); } \
                            else { SWRITE_H(SB); } }                                                                          \
        RESC(alX); __syncthreads(); } while (0)
    for (int t = 1; t + 1 < NT; t += 2) {
        HALF_STEP(pB0, pB1, mnB, alB, pA0, pA1, alA, t, 1, 0, 0);
        HALF_STEP(pA0, pA1, mnA, alA, pB0, pB1, alB, t + 1, 0, 1, 1);
    }
    const bool even = (NT & 1) == 0;
    if (even) { SBAR(); qkt<1, SK>(pB0, pB1, K_lds, r32, hi, S.qr, ACT(NT - 1)); SBAR(); }
#define QROW(e) (nxt.Q + (size_t)(wid * QBLK + r32) * D + ((e) >> 1) * 16 + hi * 8 + ((e) & 1) * 4)
    if constexpr (F32) { SLOAD_F((const float*)nxt.K, kbn); SBAR();
#pragma unroll
        for (int e = 0; e < 8; ++e) S.tq[e] = *(const f32x4*)QROW(e); }
    else { SLOAD_H(nxt.K, nxt.V, kbn, nxt.kp); SBAR();
#pragma unroll
        for (int d0 = 0; d0 < 8; ++d0) S.qr[d0] = load8<TIn>((const TIn*)((const char*)nxt.Q + (unsigned)(((wid * QBLK + r32) * nxt.qp + hi * 8) * 2) + d0 * 32)); }
    SBAR();
    finishSM(pA0, pA1, alA, l_reg, pa0, pa1, pa2, pa3); SBAR();
    if constexpr (F32) {
#pragma unroll
        for (int e = 8; e < 16; ++e) S.tq[e] = *(const f32x4*)QROW(e); SBAR(); }
#undef QROW
    pv_tile<0, SK>(o, vb0, pa0, pa1, pa2, pa3, ACT(even ? NT - 2 : NT - 1));
    if (even) { MASKT(pB0, pB1, NT - 1); partialSM(pB0, pB1, m_reg, mnB, alB); __syncthreads(); RESC(alB);
        finishSM(pB0, pB1, alB, l_reg, pa0, pa1, pa2, pa3); SBAR(); pv_tile<1, SK>(o, vb0, pa0, pa1, pa2, pa3, ACT(NT - 1)); }
    SBAR(); SEAM_K0();
    if (hi == 0) { li_l[r32] = l_reg; if (cur.L) cur.L[(unsigned)((wid * QBLK + r32) * cur.lp)] = m_reg * SCALE + logf(l_reg); }
    asm volatile("s_waitcnt lgkmcnt(0)" ::: "memory");
    float rli[16];
#pragma unroll
    for (int r = 0; r < 16; ++r) rli[r] = __builtin_amdgcn_rcpf(li_l[crow(r, hi)]);
    TOut* Ow = cur.O + (unsigned)(wid * QBLK * cur.op); const int opitch = cur.op;
#pragma unroll
    for (int r = 0; r < 16; ++r) { const int orow = crow(r, hi);
#pragma unroll
        for (int d0 = 0; d0 < 4; ++d0) { const float v = o[d0][r] * rli[r];
            if constexpr (same_t<TOut, float>::v) { Ow[(unsigned)(orow * opitch + d0 * 32 + r32)] = v; }
            else { const float vn = __shfl_xor(v, 1);
                   if ((r32 & 1) == 0) *(unsigned*)(Ow + (unsigned)(orow * opitch + d0 * 32 + r32)) = cvtpk(v, vn); } } }
    if constexpr (F32) {
#pragma unroll
        for (int d0 = 0; d0 < 8; ++d0) S.qr[d0] = pack8(S.tq[2 * d0], S.tq[2 * d0 + 1]); }
    __syncthreads();
#undef RESC
#undef KBASE
#undef ACT
#undef MASKT
#undef SEAM_K0
#undef HALF_STEP
}
#undef ROW
#undef VMW
#undef VMWN
#undef SLOAD_H
#undef SWRITE_HK
#undef SWRITE_HV
#undef SWRITE_H
#undef SLOAD_F
#undef SWRITE_KF
#undef SWRITE_VF

#undef ROWP
#undef KSWZ
#undef SBAR
}

constexpr int NWAVES = 8;
constexpr int BATCH = 2, SEQ = 8192, DM = 1024, TOK = BATCH * SEQ;
constexpr int AH = 16, AHD = 64;
constexpr int BH = 8, BHD = 128, BG = 3;
constexpr int NE = 16, FF = 256, NCLS = 24, MROWS = 80;
constexpr int NA = 2, NB = 2, NL = 4;
constexpr int WIN_LD = 3 * DM + AH;
constexpr float LOG2E = 1.4426950408889634f;

constexpr size_t MiB = 1u << 20;
constexpr size_t WS_CTL = 0, CTL_ZERO_BYTES = 1 * MiB;
constexpr size_t WS_RSTD = 1 * MiB;
constexpr size_t WS_GA = 1 * MiB + 256 * 1024, WS_GB = 1 * MiB + 512 * 1024;
constexpr size_t WS_LOGF = 2 * MiB;
constexpr size_t WS_CL = 3 * MiB;
constexpr size_t WS_CAUG = 4 * MiB;
constexpr size_t WS_ROPEC = 6 * MiB, WS_ROPES = 10 * MiB;
constexpr size_t WS_WF = 14 * MiB;
constexpr size_t WS_WR = 14 * MiB + 512 * 1024;
constexpr size_t WS_GTAB = 15 * MiB;
constexpr size_t WS_LSE = 16 * MiB;
constexpr size_t WS_LIST = 18 * MiB;
constexpr size_t WS_WIN = 20 * MiB;
constexpr size_t WS_WOA = 32 * MiB;
constexpr size_t WS_WKVQ0 = 36 * MiB;
constexpr size_t WS_WQ1 = 46 * MiB;
constexpr size_t WS_WOB = 52 * MiB;
constexpr size_t WS_WGU = 56 * MiB;
constexpr size_t WS_WD = 88 * MiB;
constexpr size_t WS_HB = 104 * MiB;
constexpr size_t WS_KB = 136 * MiB, WS_VB = 168 * MiB;
constexpr size_t WS_QB = 200 * MiB;
constexpr size_t WS_END = 296 * MiB;
constexpr int CW_BAR = 4096, CW_CNT = 16384, CW_AQ = 20480;

constexpr int RING_OFF = 0, RING_BYTES = 131072;
constexpr int XS_OFF = 131072;
constexpr int LDS_BYTES = 163840;
constexpr int MISC_OFF = LDS_BYTES - 256;
static_assert(attn_body::ATTN_LDS_BYTES <= MISC_OFF, "attention LDS");

#define GAS __attribute__((address_space(1)))
#define LAS __attribute__((address_space(3)))
typedef unsigned short bf16;
typedef unsigned v4u __attribute__((ext_vector_type(4)));
typedef float f32x4 __attribute__((ext_vector_type(4)));
typedef short bf16x8 __attribute__((ext_vector_type(8)));
typedef GAS unsigned gu32;
#define RLX_AGENT __ATOMIC_RELAXED, __HIP_MEMORY_SCOPE_AGENT
#define LDS_WAIT() asm volatile("s_waitcnt lgkmcnt(0)" ::: "memory")
__device__ __forceinline__ unsigned f2bf(float f) { unsigned u = __builtin_bit_cast(unsigned, f); return (u + 0x7fffu + ((u >> 16) & 1u)) >> 16; }
__device__ __forceinline__ unsigned pk2(float lo, float hi) { return f2bf(lo) | (f2bf(hi) << 16); }
__device__ __forceinline__ float bf2f(unsigned b) { return __builtin_bit_cast(float, b << 16); }

#define XB_TMO      128
#define XB_XCNT(j)  (256  + 64 * (j))
#define XB_XSUB(j)  (1280 + 64 * (j))
#define XB_XGEN(j)  (2304 + 64 * (j))
#define XB_TOP      3328
#define XB_TOPGEN   3392
#define XCD_BAR_WORDS 3456
#define XB_SPIN_CAP (1u << 18)

__device__ __forceinline__ unsigned xb_ld(unsigned* p)              { return __hip_atomic_load(p, __ATOMIC_RELAXED, __HIP_MEMORY_SCOPE_AGENT); }
__device__ __forceinline__ unsigned xb_add(unsigned* p, unsigned v) { return __hip_atomic_fetch_add(p, v, __ATOMIC_RELAXED, __HIP_MEMORY_SCOPE_AGENT); }
__device__ __forceinline__ unsigned xb_xcc_id() { return (unsigned)__builtin_amdgcn_s_getreg((3 << 11) | 20) & 0xFu; }
#define XB_SPIN(cond, bar) do { unsigned _sp = 0; while (cond) { __builtin_amdgcn_s_sleep(1); \
    if ((++_sp & 255u) == 0u) { if (xb_ld(&(bar)[XB_TMO])) break; if (_sp > XB_SPIN_CAP) { atomicAdd(&(bar)[XB_TMO], 1u); break; } } } } while (0)

struct XcdBarrier {
    unsigned* bar; unsigned x;
    volatile LAS unsigned* st;
};

__device__ __forceinline__ XcdBarrier xcd_barrier_post(unsigned* bar, volatile LAS unsigned* st) {
    XcdBarrier b; b.bar = bar; b.x = xb_xcc_id(); b.st = st;
    if (threadIdx.x == 0) (void)xb_add(&bar[XB_XCNT(b.x)], 1u);
    return b;
}
__device__ __forceinline__ void xcd_barrier_complete(unsigned* bar, unsigned x, unsigned& nloc, unsigned& nx) {
    const unsigned G = gridDim.x * gridDim.y * gridDim.z;
    unsigned sum, cnt, mine, sp = 0u;
    for (;;) {
        sum = 0u; cnt = 0u; mine = 0u;
#pragma unroll
        for (unsigned j = 0; j < 16; ++j) { const unsigned c = xb_ld(&bar[XB_XCNT(j)]); sum += c; cnt += (c > 0u) ? 1u : 0u; mine = (j == x) ? c : mine; }
        if (sum == G) break;
        __builtin_amdgcn_s_sleep(1);
        if ((++sp & 255u) == 0u) { if (xb_ld(&bar[XB_TMO])) break; if (sp > XB_SPIN_CAP) { atomicAdd(&bar[XB_TMO], 1u); break; } }
    }
    nloc = mine > 0u ? mine : 1u; nx = cnt > 0u ? cnt : 1u;
}

__device__ __forceinline__ void xcd_barrier(const XcdBarrier& b) {
    asm volatile("s_waitcnt vmcnt(0)" ::: "memory");
    __syncthreads();
    if (threadIdx.x == 0) {
        unsigned* bar = b.bar;
        __builtin_amdgcn_s_waitcnt(0);
        unsigned nloc = b.st[0], nx = b.st[1];
        if (nloc == 0u) { xcd_barrier_complete(bar, b.x, nloc, nx); b.st[0] = nloc; b.st[1] = nx; }
        const unsigned old = xb_add(&bar[XB_XSUB(b.x)], 1u);
        const unsigned gen = old / nloc;
        if (old + 1u == (gen + 1u) * nloc) {
            __builtin_amdgcn_fence(__ATOMIC_RELEASE, "agent");
            asm volatile("s_waitcnt vmcnt(0)" ::: "memory");
            const unsigned og = xb_add(&bar[XB_TOP], 1u);
            const unsigned tg = og / nx;
            if (og + 1u == (tg + 1u) * nx) xb_add(&bar[XB_TOPGEN], 1u);
            else XB_SPIN(xb_ld(&bar[XB_TOPGEN]) == tg, bar);
            __builtin_amdgcn_fence(__ATOMIC_ACQUIRE, "agent");
            xb_add(&bar[XB_XGEN(b.x)], 1u);
            asm volatile("s_waitcnt vmcnt(0)" ::: "memory");
        } else {
            XB_SPIN(xb_ld(&bar[XB_XGEN(b.x)]) == gen, bar);
            __builtin_amdgcn_fence(__ATOMIC_ACQUIRE, "agent");
            asm volatile("s_waitcnt vmcnt(0)" ::: "memory");
        }
    }
    __syncthreads();
}

struct Args { const float* in[24]; float* out; unsigned char* ws; int ph_lo, ph_hi; };
typedef const __attribute__((address_space(4))) char* kptr_t;
struct KA { kptr_t k;
    __device__ __forceinline__ const float* in(int i) const { return (const float*)(const GAS float*)*(const float* const __attribute__((address_space(4)))*)(k + 8 * i); }
    __device__ __forceinline__ float* out() const { return (float*)(GAS float*)*(float* const __attribute__((address_space(4)))*)(k + 192); }
    __device__ __forceinline__ unsigned char* ws() const { return (unsigned char*)(GAS unsigned char*)*(unsigned char* const __attribute__((address_space(4)))*)(k + 200); } };
static_assert(sizeof(Args) == 216 && __builtin_offsetof(Args, out) == 192 && __builtin_offsetof(Args, ws) == 200, "Args layout");
struct Frame { LAS unsigned char* lds; int tid, lane, wave, vcu, G; };

__device__ __forceinline__ float wave_sum(float v) {
#pragma unroll
    for (int o = 1; o < 64; o <<= 1) v += __shfl_xor(v, o);
    return v;
}
struct TrD { const float* src; const float* gain; bf16* dst; int ld, mode, dK, n0, drow0, k0, up; };
__device__ __forceinline__ int map64(int n)  { return (n & ~255) + 128 * ((n >> 5) & 1) + 32 * ((n >> 6) & 3) + (n & 31); }
__device__ __forceinline__ int map128(int n) { return (n & ~255) + 128 * ((n >> 6) & 1) + 64 * ((n >> 7) & 1) + (n & 63); }
__device__ __forceinline__ void tr_load(const TrD& d, f32x4 (&rg)[8], int lane) {
    const int r = lane >> 3, c4 = lane & 7;
#pragma unroll
    for (int i = 0; i < 8; ++i) { const int kk = 8 * i + r; f32x4 v = *(const GAS f32x4*)(d.src + (size_t)(d.k0 + kk) * d.ld + d.n0 + 4 * c4);
        const float g = d.gain ? *(const GAS float*)(d.gain + d.k0 + kk) : 1.0f; rg[i] = v * g; }
}
__device__ __forceinline__ void tr_store(const TrD& d, const f32x4 (&rg)[8], LAS float* scr, int lane) {
    { const int r = lane >> 3, c4 = lane & 7;
#pragma unroll
      for (int i = 0; i < 8; ++i) { LAS float* p = scr + (8 * i + r) * 33 + 4 * c4; p[0] = rg[i].x; p[1] = rg[i].y; p[2] = rg[i].z; p[3] = rg[i].w; } }
    LDS_WAIT(); asm volatile("" ::: "memory");
    const int c = lane & 7;
#pragma unroll
    for (int j = 0; j < 4; ++j) { const int n = (lane >> 3) + 8 * j; const LAS float* s = scr + (8 * c) * 33 + n;
        v4u o; o.x = pk2(s[0 * 33], s[1 * 33]); o.y = pk2(s[2 * 33], s[3 * 33]); o.z = pk2(s[4 * 33], s[5 * 33]); o.w = pk2(s[6 * 33], s[7 * 33]);
        size_t pos;
        if (d.mode == 0) pos = (size_t)(d.drow0 + n) * d.dK + d.k0 + 8 * c;
        else { const int f = d.n0 + n, k8 = (d.k0 >> 3) + c, ks = k8 >> 2, fq = k8 & 3, fr = f & 15;
            if (d.mode == 1) { const int w = f >> 5, cb = 2 * d.up + ((f >> 4) & 1); pos = ((size_t)((w * 32 + ks) * 4 + cb) * 64 + fq * 16 + fr) * 8; }
            else { const int p = f >> 9, w = (f >> 6) & 7, cb = (f >> 4) & 3, KS = d.mode == 2 ? 8 : 32; pos = ((size_t)(((p * 8 + w) * KS + ks) * 4 + cb) * 64 + fq * 16 + fr) * 8; } }
        *(GAS v4u*)(d.dst + pos) = o; }
    LDS_WAIT(); asm volatile("" ::: "memory");
}
__device__ __forceinline__ TrD tr_decode_moe(const KA a, unsigned char* ws, int l, int it);
__device__ __forceinline__ TrD tr_decode_moe(const KA a, unsigned char* ws, int l, int it) {
    TrD d; const int slot = l & 1; d.dK = 0; d.drow0 = 0;
    if (it < 4096) {
        const int e = it >> 8, r = it & 255, up = r >> 7, q = r & 127, kb = q >> 3, nb = q & 7;
        d.src = a.in(up ? 21 : 20) + ((size_t)(l * NE + e)) * DM * FF; d.ld = FF; d.gain = a.in(15) + (size_t)l * DM;
        d.dst = (bf16*)(ws + WS_WGU) + ((size_t)(slot * NE + e)) * 512 * DM; d.mode = 1; d.n0 = 32 * nb; d.up = up; d.k0 = 64 * kb;
    } else {
        const int r0 = it - 4096, e = r0 >> 7, q = r0 & 127, kb = q >> 5, nb = q & 31;
        d.src = a.in(22) + ((size_t)(l * NE + e)) * FF * DM; d.ld = DM; d.gain = nullptr;
        d.dst = (bf16*)(ws + WS_WD) + ((size_t)(slot * NE + e)) * DM * FF; d.mode = 2; d.n0 = 32 * nb; d.up = 0; d.k0 = 64 * kb;
    }
    return d;
}
constexpr int TR_I_WIN = 16 * 96, TR_I_WO = 16 * 32, TR_I_KV = 16 * 64, TR_I_Q = 16 * 96, TR_I_MOE = 6144;
constexpr int TR_NITEMS = 2 * TR_I_WIN + 2 * TR_I_WO + TR_I_KV + 2 * TR_I_Q + 2 * TR_I_WO + 2 * TR_I_MOE;
__device__ __forceinline__ TrD tr_decode_main(const KA a, unsigned char* ws, int it) {
    TrD d; d.mode = 0; d.dK = DM; d.up = 0; int r = it;
    if (r < 2 * TR_I_WIN) { const int l = r / TR_I_WIN; r -= l * TR_I_WIN; const int kb = r / 96, nb = r % 96, n0 = 32 * nb;
        d.src = a.in(3) + (size_t)l * DM * WIN_LD; d.ld = WIN_LD; d.gain = a.in(2) + l * DM; d.dst = (bf16*)(ws + WS_WIN) + (size_t)l * 3072 * DM; d.n0 = n0; d.drow0 = map64(n0); d.k0 = 64 * kb; return d; }
    r -= 2 * TR_I_WIN;
    if (r < 2 * TR_I_WO) { const int l = r / TR_I_WO; r -= l * TR_I_WO; const int kb = r / 32, nb = r % 32;
        d.src = a.in(7) + (size_t)l * DM * DM; d.ld = DM; d.gain = nullptr; d.dst = (bf16*)(ws + WS_WOA) + (size_t)l * DM * DM; d.n0 = 32 * nb; d.drow0 = 32 * nb; d.k0 = 64 * kb; d.mode = 3; return d; }
    r -= 2 * TR_I_WO;
    if (r < TR_I_KV) { const int kb = r / 64, nb = r % 64, n0 = 32 * nb;
        d.src = a.in(9); d.ld = 2 * DM; d.gain = a.in(8); d.dst = (bf16*)(ws + WS_WKVQ0); d.n0 = n0; d.drow0 = n0 < DM ? map128(n0) : n0; d.k0 = 64 * kb; return d; }
    r -= TR_I_KV;
    if (r < 2 * TR_I_Q) { const int j = r / TR_I_Q; r -= j * TR_I_Q; const int kb = r / 96, nb = r % 96, n0 = 32 * nb;
        d.src = a.in(12) + (size_t)j * DM * 3072; d.ld = 3072; d.gain = a.in(11) + j * DM; d.dst = j == 0 ? (bf16*)(ws + WS_WKVQ0) + (size_t)2048 * DM : (bf16*)(ws + WS_WQ1); d.n0 = n0; d.drow0 = map128(n0); d.k0 = 64 * kb; return d; }
    r -= 2 * TR_I_Q;
    if (r < 2 * TR_I_WO) { const int j = r / TR_I_WO; r -= j * TR_I_WO; const int kb = r / 32, nb = r % 32;
        d.src = a.in(14) + (size_t)j * DM * DM; d.ld = DM; d.gain = nullptr; d.dst = (bf16*)(ws + WS_WOB) + (size_t)j * DM * DM; d.n0 = 32 * nb; d.drow0 = 32 * nb; d.k0 = 64 * kb; d.mode = 3; return d; }
    r -= 2 * TR_I_WO;
    { const int l = r / TR_I_MOE; return tr_decode_moe(a, ws, l, r - l * TR_I_MOE); }
}
template <bool MAIN> __device__ __forceinline__ void tr_run(const KA a, unsigned char* ws, int layer, int nitems, int gw, int NGW, LAS float* scr, int lane) {
    int it = gw; if (it >= nitems) return;
    TrD d = MAIN ? tr_decode_main(a, ws, it) : tr_decode_moe(a, ws, layer, it);
    f32x4 rg[8]; tr_load(d, rg, lane);
    for (;;) {
        const int itn = it + NGW; const bool more = itn < nitems;
        TrD dn = d; f32x4 rn[8];
        if (more) { dn = MAIN ? tr_decode_main(a, ws, itn) : tr_decode_moe(a, ws, layer, itn); tr_load(dn, rn, lane); }
        tr_store(d, rg, scr, lane);
        if (!more) break;
        d = dn; it = itn;
#pragma unroll
        for (int i = 0; i < 8; ++i) rg[i] = rn[i];
    }
}
constexpr int CW_CQ = 24576;
__device__ __forceinline__ void conv_drain(const KA a, unsigned char* ws, Frame& F, unsigned* cctr, bool main, int layer, int lo, int hi) {
    volatile LAS int* cw = (volatile LAS int*)(F.lds + MISC_OFF) + 16;
    LAS float* scr = (LAS float*)(F.lds + RING_OFF + F.wave * 16384);
    const int nb = (hi - lo + 63) >> 6;
    for (;;) {
        __syncthreads();
        if (F.tid == 0) cw[0] = (int)__hip_atomic_fetch_add(cctr, 1u, RLX_AGENT);
        __syncthreads();
        const int b = __builtin_amdgcn_readfirstlane(cw[0]);
        if (b >= nb) break;
        const int base = lo + b * 64, end = (base + 64 < hi) ? base + 64 : hi;
        int it = base + F.wave; if (it >= end) continue;
        TrD d = main ? tr_decode_main(a, ws, it) : tr_decode_moe(a, ws, layer, it);
        f32x4 rg[8]; tr_load(d, rg, F.lane);
        for (;;) {
            const int itn = it + 8; const bool more = itn < end;
            TrD dn = d; f32x4 rn[8];
            if (more) { dn = main ? tr_decode_main(a, ws, itn) : tr_decode_moe(a, ws, layer, itn); tr_load(dn, rn, F.lane); }
            tr_store(d, rg, scr, F.lane);
            if (!more) break;
            d = dn; it = itn;
#pragma unroll
            for (int i = 0; i < 8; ++i) rg[i] = rn[i];
        }
    }
    __syncthreads();
}
__device__ __forceinline__ void sincos_f64(double a, float& c, float& s) {
    const double q = __builtin_rint(a * 0.63661977236758134308);
    const double r = __builtin_fma(-q, 6.123233995736766036e-17, __builtin_fma(-q, 1.5707963267948966192, a));
    const double r2 = r * r;
    double sp = -1.0 / 39916800.0; sp = sp * r2 + 1.0 / 362880.0; sp = sp * r2 - 1.0 / 5040.0; sp = sp * r2 + 1.0 / 120.0; sp = sp * r2 - 1.0 / 6.0; sp = sp * r2 * r + r;
    double cp = 1.0 / 479001600.0; cp = cp * r2 - 1.0 / 3628800.0; cp = cp * r2 + 1.0 / 40320.0; cp = cp * r2 - 1.0 / 720.0; cp = cp * r2 + 1.0 / 24.0; cp = cp * r2 - 0.5; cp = cp * r2 + 1.0;
    const int qi = (int)((long long)q & 3);
    const double cs = (qi == 0) ? cp : (qi == 1) ? -sp : (qi == 2) ? -cp : sp;
    const double sn = (qi == 0) ? sp : (qi == 1) ? cp : (qi == 2) ? -sp : -cp;
    c = (float)cs; s = (float)sn;
}
__device__ __forceinline__ void p_prologue(const KA a, Frame& F) {
    unsigned char* ws = a.ws(); asm volatile("" : "+s"(ws)); ASSUME_GLOBAL(ws);
    LAS float* scr = (LAS float*)(F.lds + RING_OFF + F.wave * 16384);
    const int gw = F.vcu * NWAVES + F.wave, NGW = F.G * NWAVES;
    tr_run<true>(a, ws, 0, TR_I_WIN, gw, NGW, scr, F.lane);
    const int gt = (F.vcu * NWAVES + F.wave) * 64 + F.lane, NGT = NGW * 64;
    for (int i = gt; i < 2 * 16 * DM; i += NGT) { const int l = i / (16 * DM), v = (i / DM) % 16, k = i % DM;
        ((float*)(ws + WS_WF))[i] = a.in(3)[(size_t)l * DM * WIN_LD + (size_t)k * WIN_LD + 3 * DM + v] * a.in(2)[l * DM + k]; }
    for (int i = gt; i < 4 * 20 * DM; i += NGT) { const int l = i / (20 * DM), v = (i / DM) % 20, k = i % DM;
        const float w = v < 4 ? a.in(16)[(size_t)l * DM * 4 + k * 4 + v] : a.in(18)[(size_t)l * DM * 16 + k * 16 + (v - 4)];
        ((float*)(ws + WS_WR))[i] = w * a.in(15)[l * DM + k]; }
    for (int i = gt; i < 2 * 192; i += NGT) { const int l = i / 192, sec = (i / 64) % 3, dd = i % 64;
        ((float*)(ws + WS_GTAB))[i] = sec == 0 ? a.in(5)[l * AHD + dd] * (0.125f * LOG2E) : (sec == 1 ? a.in(6)[l * AHD + dd] : 1.0f); }
    const int* pos = (const int*)a.in(1);
    for (int i = gt; i < TOK * 64; i += NGT) { const int m = i >> 6, f = i & 63;
        const float invf = powf(10000.0f, -(float)f / 64.0f);
        const float ang = (float)pos[m] * invf;
        float c, s; sincos_f64((double)ang, c, s);
        ((unsigned*)(ws + WS_ROPEC))[i] = (unsigned)__builtin_bit_cast(unsigned short, (_Float16)c) | ((unsigned)__builtin_bit_cast(unsigned short, (_Float16)s) << 16); }
}

template <int N, int O> struct RedTree {
    static __device__ __forceinline__ void run(float (&v)[80], int lane, int& base) {
        if constexpr (O >= 1) {
            if constexpr (N % 2 == 0) {
                const bool up = (lane & O) != 0;
#pragma unroll
                for (int i = 0; i < N / 2; ++i) { const float keep = up ? v[i + N / 2] : v[i], send = up ? v[i] : v[i + N / 2]; v[i] = keep + __shfl_xor(send, O); }
                if (up) base += N / 2;
                RedTree<N / 2, O / 2>::run(v, lane, base);
            } else {
#pragma unroll
                for (int i = 0; i < N; ++i) v[i] += __shfl_xor(v[i], O);
                RedTree<N, O / 2>::run(v, lane, base);
            }
        }
    }
};
template <int MODE> __device__ __forceinline__ void p_rowpass(const KA a, Frame& F, int layer, bool dry = false, const float* Hsrc = nullptr, bool raw_wf = false) {
    unsigned char* ws = a.ws(); asm volatile("" : "+s"(ws)); ASSUME_GLOBAL(ws);
    constexpr int NV = MODE == 1 ? 16 : (MODE == 2 ? 20 : 0), NT = MODE == 2 ? 2 : 4, NVAL = NT * NV;
    constexpr int NFIN = MODE == 2 ? 5 : 1;
    LAS float* wl = (LAS float*)(F.lds + RING_OFF);
    LAS float* red = (LAS float*)(F.lds + RING_OFF + 96 * 1024) + F.wave * 96;
    if (NV) {
        if (MODE == 1 && raw_wf) {
            const float* win = a.in(3) + (size_t)layer * DM * WIN_LD + 3 * DM; const float* gn = a.in(2) + layer * DM;
            for (int i = F.tid; i < 16 * DM; i += NWAVES * 64) { const int k = i >> 4, v = i & 15; wl[v * DM + k] = *(const GAS float*)(win + (size_t)k * WIN_LD + v) * *(const GAS float*)(gn + k); }
        } else {
        const float* wsrc = MODE == 1 ? (const float*)(ws + WS_WF) + (size_t)layer * 16 * DM : (const float*)(ws + WS_WR) + (size_t)layer * 20 * DM;
        for (int i = F.tid; i < NV * DM / 4; i += NWAVES * 64) ((LAS f32x4*)wl)[i] = ((const f32x4*)wsrc)[i];
        }
        __syncthreads();
    }
    const int gw = F.vcu * NWAVES + F.wave, NGW = F.G * NWAVES;
    const float* H = Hsrc ? Hsrc : a.out(); float* rstd = (float*)(ws + WS_RSTD); bf16* hb = (bf16*)(ws + WS_HB);
    for (int m0 = NT * gw; m0 < TOK; m0 += NT * NGW) {
        f32x4 v[NT][4]; float rs[4] = {0.f, 0.f, 0.f, 0.f};
#pragma unroll
        for (int r = 0; r < NT; ++r) { const f32x4* xr = (const f32x4*)(H + (size_t)(m0 + r) * DM) + F.lane;
#pragma unroll
            for (int j = 0; j < 4; ++j) v[r][j] = xr[64 * j]; }
#pragma unroll
        for (int r = 0; r < NT; ++r) { float s = 0.f;
#pragma unroll
            for (int j = 0; j < 4; ++j) s += (v[r][j].x * v[r][j].x + v[r][j].y * v[r][j].y) + (v[r][j].z * v[r][j].z + v[r][j].w * v[r][j].w);
            rs[r] = 1.0f / sqrtf(wave_sum(s) * (1.0f / DM) + 1e-6f);
            unsigned long long* o8 = (unsigned long long*)(hb + (size_t)(m0 + r) * DM) + F.lane;
#pragma unroll
            for (int j = 0; j < 4; ++j) o8[64 * j] = (unsigned long long)pk2(v[r][j].x, v[r][j].y) | ((unsigned long long)pk2(v[r][j].z, v[r][j].w) << 32); }
        if (F.lane < NT) rstd[m0 + F.lane] = F.lane == 0 ? rs[0] : (F.lane == 1 ? rs[1] : (F.lane == 2 ? rs[2] : rs[3]));
        if (NV) {
            float pv[80];
#pragma unroll
            for (int q = 0; q < NV; ++q) {
                f32x4 w[4];
#pragma unroll
                for (int j = 0; j < 4; ++j) w[j] = ((const LAS f32x4*)(wl + q * DM))[F.lane + 64 * j];
#pragma unroll
                for (int r = 0; r < NT; ++r) { float p = 0.f;
#pragma unroll
                    for (int j = 0; j < 4; ++j) p += (v[r][j].x * w[j].x + v[r][j].y * w[j].y) + (v[r][j].z * w[j].z + v[r][j].w * w[j].w);
                    pv[r * NV + q] = p; }
            }
            int base = 0;
            RedTree<NVAL, 32>::run(pv, F.lane, base);
            if (MODE == 1) {
                const int r = base >> 4, hh = base & 15; const float rsr = r == 0 ? rs[0] : (r == 1 ? rs[1] : (r == 2 ? rs[2] : rs[3]));
                const float z = pv[0] * rsr + a.in(4)[layer * AH + hh]; const float ls = fminf(z, 0.f) - __logf(1.0f + __expf(-fabsf(z)));
                const int m = m0 + r, b = m / SEQ, sidx = m % SEQ; ((float*)(ws + WS_LOGF))[(size_t)(b * AH + hh) * SEQ + sidx] = ls;
            } else if (MODE == 2) {
#pragma unroll
                for (int i = 0; i < NFIN; ++i) red[base + i] = pv[i];
                LDS_WAIT(); asm volatile("" ::: "memory");
                if (F.lane < NT) {
                    const int m = m0 + F.lane; const float rsr = F.lane == 0 ? rs[0] : (F.lane == 1 ? rs[1] : (F.lane == 2 ? rs[2] : rs[3]));
                    float d[20];
#pragma unroll
                    for (int q = 0; q < 20; ++q) d[q] = red[F.lane * 20 + q] * rsr;
                    const float* gb = a.in(17) + layer * 4;
                    float lg[4];
#pragma unroll
                    for (int q = 0; q < 4; ++q) lg[q] = d[q] + gb[q];
                    int gi = 0; float gm = lg[0];
#pragma unroll
                    for (int q = 1; q < 4; ++q) if (lg[q] > gm) { gm = lg[q]; gi = q; }
                    float gs = 0.f;
#pragma unroll
                    for (int q = 0; q < 4; ++q) gs += expf(lg[q] - gm);
                    const float gp = 1.0f / gs;
                    const float* ebp = a.in(19) + layer * 16;
                    float el[4];
#pragma unroll
                    for (int q = 0; q < 4; ++q) { float t = 0.f;
#pragma unroll
                        for (int g2 = 0; g2 < 4; ++g2) if (g2 == gi) t = d[4 + 4 * g2 + q] + ebp[4 * g2 + q];
                        el[q] = t; }
                    int i1 = 0; float v1 = el[0];
#pragma unroll
                    for (int q = 1; q < 4; ++q) if (el[q] > v1) { v1 = el[q]; i1 = q; }
                    int i2 = -1; float v2 = 0.f;
#pragma unroll
                    for (int q = 0; q < 4; ++q) if (q != i1 && (i2 < 0 || el[q] > v2)) { v2 = el[q]; i2 = q; }
                    const float e2 = expf(v2 - v1), g1 = gp / (1.0f + e2), g2v = gp * e2 / (1.0f + e2);
                    const int lo = i1 < i2 ? i1 : i2, hi = i1 < i2 ? i2 : i1;
                    const int pidx = (lo == 0) ? (hi - 1) : (lo == 1 ? hi + 1 : 5);
                    const int cls = gi * 6 + pidx;
                    if (!dry) {
                        const unsigned p = __hip_atomic_fetch_add((unsigned*)(ws + WS_CTL) + CW_CNT + layer * 64 + cls, 1u, RLX_AGENT);
                        ((int*)(ws + WS_LIST))[(size_t)cls * TOK + p] = m;
                        ((float*)(ws + WS_GA))[m] = (i1 < i2) ? g1 : g2v;
                        ((float*)(ws + WS_GB))[m] = (i1 < i2) ? g2v : g1;
                    }
                }
                LDS_WAIT(); asm volatile("" ::: "memory");
            }
        }
    }
    __syncthreads();
}

__device__ __forceinline__ swa::BlockRef<swa::bf16, swa::bf16> b_unit_ref(unsigned char* ws, int id, bool dry) {
    const int g = id >> 9, r0 = id & 511, bh = r0 >> 5, r1 = r0 & 31;
    const int dl = (g == 0) ? 1 : (g == 1 ? 4 : 16), nq = 32 / dl, res = r1 / nq, qb = r1 % nq;
    const int b = bh >> 3, h = bh & 7;
    const size_t tok0 = (size_t)b * SEQ + res;
    swa::BlockRef<swa::bf16, swa::bf16> R;
    swa::bf16* qbase = (swa::bf16*)(ws + WS_QB) + tok0 * 3072 + g * 1024 + h * 128;
    R.Q = qbase + (size_t)qb * 256 * dl * 3072; R.O = qbase + (size_t)qb * 256 * dl * 3072; R.qp = dl * 3072; R.op = dl * 3072;
    R.K = (const swa::bf16*)(ws + WS_KB) + tok0 * 1024 + h * 128; R.V = (const swa::bf16*)(ws + WS_VB) + tok0 * 1024 + h * 128; R.kp = dl * 1024;
    R.L = (float*)(ws + WS_LSE) + (tok0 + (size_t)qb * 256 * dl) * 24 + g * 8 + h; R.lp = dl * 24;
    R.P0 = qb * 256;
    if (dry) { R.O = (swa::bf16*)(ws + WS_HB) + tok0 * 1024 + h * 128 + (size_t)qb * 256 * dl * 1024; R.op = dl * 1024; R.L = nullptr; }
    return R;
}
__device__ __forceinline__ void p_battn(const KA a, Frame& F, bool dry) {
    unsigned char* ws = a.ws(); asm volatile("" : "+s"(ws)); ASSUME_GLOBAL(ws); char* lds = (char*)(F.lds + RING_OFF);
    constexpr int NUNITS = 3 * 512;
    const int bid0 = bid_fresh();
    const bool xdeal = gridDim.x == 256; const int vc = (bid0 & 7) * 32 + (bid0 >> 3), xj = vc & 31, xb = (vc >> 5) * 2; int it = 0;
#define B_PAIR(it_) (xj + 32 * ((it_) >> 1))
#define B_UNIT_ID(it_) (xdeal ? ((((B_PAIR(it_)) / 16) % 3) * 512 + (xb + (B_PAIR(it_)) / 48) * 32 + 2 * ((B_PAIR(it_)) % 16) + ((it_) & 1)) : (bid0 + (it_) * (int)gridDim.x))
    int id = B_UNIT_ID(0);
    if (id >= NUNITS) return;
    typedef swa::BlockRef<swa::bf16, swa::bf16> Ref;
    Ref cur = b_unit_ref(ws, id, dry);
    swa::Seam<swa::bf16> S;
    swa::causal_swa_prime<swa::bf16, swa::bf16>(cur, 129, lds, S);
    for (;;) {
        ++it; const int idn = (xdeal && it >= 6) ? NUNITS : B_UNIT_ID(it); const bool last = idn >= NUNITS;
        const Ref nxt = last ? cur : b_unit_ref(ws, idn, dry);
        const int dl = (id >> 9) == 0 ? 1 : ((id >> 9) == 1 ? 4 : 16);
        swa::causal_swa_block<swa::bf16, swa::bf16>(cur, nxt, SEQ / dl, 129, lds, S);
        if (last) break;
        cur = nxt; id = idn;
    }
#undef B_UNIT_ID
#undef B_PAIR
}
__device__ __forceinline__ void p_bmerge(const KA a, Frame& F) {
    unsigned char* ws = a.ws(); asm volatile("" : "+s"(ws)); ASSUME_GLOBAL(ws);
    const int gw = F.vcu * NWAVES + F.wave, NGW = F.G * NWAVES;
    const bf16* og = (const bf16*)(ws + WS_QB); const float* lse = (const float*)(ws + WS_LSE); bf16* o = (bf16*)(ws + WS_HB);
    for (int m = gw; m < TOK; m += NGW) {
        const int h = F.lane >> 3;
        const float l0 = lse[(size_t)m * 24 + h], l1 = lse[(size_t)m * 24 + 8 + h], l2 = lse[(size_t)m * 24 + 16 + h];
        const float mx = fmaxf(l0, fmaxf(l1, l2));
        const float e0 = expf(l0 - mx), e1 = expf(l1 - mx), e2 = expf(l2 - mx), inv = 1.0f / (e0 + e1 + e2);
        const float w0 = e0 * inv, w1 = e1 * inv, w2 = e2 * inv;
        float accv[16];
#pragma unroll
        for (int i = 0; i < 16; ++i) accv[i] = 0.f;
#pragma unroll
        for (int g = 0; g < 3; ++g) { const float w = g == 0 ? w0 : (g == 1 ? w1 : w2);
            const v4u* p = (const v4u*)(og + (size_t)m * 3072 + g * 1024 + F.lane * 16);
#pragma unroll
            for (int q = 0; q < 2; ++q) { const v4u x = p[q];
                const unsigned xs[4] = {x.x, x.y, x.z, x.w};
#pragma unroll
                for (int e = 0; e < 4; ++e) { accv[q * 8 + 2 * e] += w * bf2f(xs[e] & 0xffffu); accv[q * 8 + 2 * e + 1] += w * bf2f(xs[e] >> 16); } } }
        v4u* po = (v4u*)(o + (size_t)m * DM + F.lane * 16);
#pragma unroll
        for (int q = 0; q < 2; ++q) { v4u w; w.x = pk2(accv[q * 8 + 0], accv[q * 8 + 1]); w.y = pk2(accv[q * 8 + 2], accv[q * 8 + 3]); w.z = pk2(accv[q * 8 + 4], accv[q * 8 + 5]); w.w = pk2(accv[q * 8 + 6], accv[q * 8 + 7]); po[q] = w; }
    }
}

constexpr int MOE_AP = 128 + 8;
constexpr int MOE_HP = 512 + 8;
constexpr int MOE_A_BYTES = MROWS * MOE_AP * 2;
constexpr int MOE_A_OFF = 0, MOE_H_OFF = 2 * MOE_A_BYTES, MOE_T_OFF = MOE_H_OFF + MROWS * MOE_HP * 2;
static_assert(MOE_T_OFF + 3 * MROWS * 4 <= RING_BYTES, "MoE LDS");
typedef float f32x4m __attribute__((ext_vector_type(4)));
__device__ __forceinline__ void p_moe(const KA a, Frame& F, int layer, float upd) {
    unsigned char* ws = a.ws(); asm volatile("" : "+s"(ws)); ASSUME_GLOBAL(ws);
    const unsigned* cnt = (const unsigned*)(ws + WS_CTL) + CW_CNT + layer * 64;
    for (int u = F.vcu; ; u += (int)gridDim.x) {
    int cls = -1, tile = 0, n_c = 0;
    { int accu = 0;
      for (int c = 0; c < NCLS; ++c) { const int n = (int)__hip_atomic_load(cnt + c, RLX_AGENT); const int nt = (n + MROWS - 1) / MROWS;
          if (cls < 0 && u < accu + nt) { cls = c; tile = u - accu; n_c = n; } accu += nt; } }
    if (cls < 0) break;
    const int nrow = (n_c - tile * MROWS) < MROWS ? (n_c - tile * MROWS) : MROWS;
    const int grp = cls / 6, pidx = cls % 6;
    const int elo = pidx < 3 ? 0 : (pidx < 5 ? 1 : 2), ehi = pidx < 3 ? pidx + 1 : (pidx < 5 ? pidx - 1 : 3);
    const int slot = layer & 1;
    const int ea = grp * 4 + elo, eb = grp * 4 + ehi;
    LAS bf16* Al = (LAS bf16*)(F.lds + RING_OFF + MOE_A_OFF); LAS bf16* Hl = (LAS bf16*)(F.lds + RING_OFF + MOE_H_OFF);
    LAS int* tokl = (LAS int*)(F.lds + RING_OFF + MOE_T_OFF); LAS float* gal = (LAS float*)(tokl + MROWS); LAS float* gbl = gal + MROWS;
    if (F.tid < MROWS) { const bool ok = F.tid < nrow; const int t = ok ? ((const int*)(ws + WS_LIST))[(size_t)cls * TOK + tile * MROWS + F.tid] : 0;
        tokl[F.tid] = ok ? t : -1; gal[F.tid] = ok ? ((const float*)(ws + WS_GA))[t] : 0.f; gbl[F.tid] = ok ? ((const float*)(ws + WS_GB))[t] : 0.f; }
    __syncthreads();
    const bf16* hb = (const bf16*)(ws + WS_HB);
    const int fr = F.lane & 15, fq = F.lane >> 4, w = F.wave; const unsigned lb = (unsigned)F.lane * 16u;
    int grow[3]; unsigned gsrc[3]; bool gld[3];
#pragma unroll
    for (int i = 0; i < 3; ++i) { const int idx = F.tid + 512 * i; const int r = idx >> 4; const int t = (idx < MROWS * 16) ? tokl[r] : -1; grow[i] = (idx < MROWS * 16) ? (r * MOE_AP + (idx & 15) * 8) : -1;
        gsrc[i] = (unsigned)((t >= 0 ? t : 0) * DM + (idx & 15) * 8); gld[i] = t >= 0; }
#define MOE_GLOAD(kc_) do { _Pragma("unroll") for (int i = 0; i < 3; ++i) { const v4u t_ = *(const GAS v4u*)((const char*)hb + (gsrc[i] + (unsigned)((kc_) * 128)) * 2u); \
        greg[i].x = gld[i] ? t_.x : 0u; greg[i].y = gld[i] ? t_.y : 0u; greg[i].z = gld[i] ? t_.z : 0u; greg[i].w = gld[i] ? t_.w : 0u; } } while (0)
#define MOE_GSTORE(buf_) do { _Pragma("unroll") for (int i = 0; i < 3; ++i) { if (grow[i] >= 0) *(LAS v4u*)(Al + (buf_) * (MOE_A_BYTES / 2) + grow[i]) = greg[i]; } } while (0)
#pragma unroll 1
    for (int xi = 0; xi < 2; ++xi) { const int x = xi ^ (tile & 1);
        const bf16* Wt = (const bf16*)(ws + WS_WGU) + ((size_t)(slot * NE + (x ? eb : ea))) * 512 * DM + (size_t)w * (32 * 4 * 64 * 8);
        f32x4m acc[5][4];
#pragma unroll
        for (int rb = 0; rb < 5; ++rb)
#pragma unroll
            for (int cb = 0; cb < 4; ++cb) acc[rb][cb] = (f32x4m){0.f, 0.f, 0.f, 0.f};
        v4u greg[3]; bf16x8 bfr[4][4];
#pragma unroll
        for (int i = 0; i < 3; ++i) { greg[i].x = 0u; greg[i].y = 0u; greg[i].z = 0u; greg[i].w = 0u; }
        MOE_GLOAD(0);
#pragma unroll
        for (int r = 0; r < 3; ++r)
#pragma unroll
            for (int cb = 0; cb < 4; ++cb) bfr[r][cb] = *(const GAS bf16x8*)((const char*)(Wt + (r * 4 + cb) * 512) + lb);
        MOE_GSTORE(0);
        LDS_WAIT(); __builtin_amdgcn_s_barrier(); asm volatile("" ::: "memory");
#pragma unroll 1
        for (int kc = 0; kc < 8; ++kc) {
            MOE_GLOAD(kc < 7 ? kc + 1 : 7);
            const LAS bf16* Ab = Al + (kc & 1) * (MOE_A_BYTES / 2);
            bf16x8 afn = *(const LAS bf16x8*)(Ab + fr * MOE_AP + fq * 8);
#pragma unroll
            for (int j = 0; j < 4; ++j) {
                const int ks = kc * 4 + j, kn = (ks + 3 < 32) ? ks + 3 : 31;
#pragma unroll
                for (int cb = 0; cb < 4; ++cb) bfr[(j + 3) & 3][cb] = *(const GAS bf16x8*)((const char*)(Wt + (kn * 4 + cb) * 512) + lb);
#pragma unroll
                for (int rb = 0; rb < 5; ++rb) { const bf16x8 af = afn; const int tn = j * 5 + rb + 1, jn = tn / 5, rn = tn % 5;
                    if (tn < 20) afn = *(const LAS bf16x8*)(Ab + (rn * 16 + fr) * MOE_AP + jn * 32 + fq * 8);
                    __builtin_amdgcn_sched_barrier(0);
#pragma unroll
                    for (int cb = 0; cb < 4; ++cb) acc[rb][cb] = __builtin_amdgcn_mfma_f32_16x16x32_bf16(bfr[j][cb], af, acc[rb][cb], 0, 0, 0);
                    __builtin_amdgcn_sched_barrier(0); }
            }
            if (kc < 7) MOE_GSTORE((kc + 1) & 1);
            LDS_WAIT(); __builtin_amdgcn_s_barrier(); asm volatile("" ::: "memory");
        }
        { const int l2 = tid_fresh() & 63, fr = l2 & 15, fq = l2 >> 4;
#pragma unroll
        for (int rb = 0; rb < 5; ++rb) { const int row = rb * 16 + fr; const float gt = x ? gbl[row] : gal[row];
#pragma unroll
            for (int cb = 0; cb < 2; ++cb) { float hv[4];
#pragma unroll
                for (int j = 0; j < 4; ++j) { const float gv = acc[rb][cb][j], uv = acc[rb][cb + 2][j]; hv[j] = gv / (1.0f + __expf(-gv)) * uv * gt; }
                *(LAS unsigned long long*)(Hl + row * MOE_HP + x * 256 + 32 * w + 16 * cb + 4 * fq) = (unsigned long long)pk2(hv[0], hv[1]) | ((unsigned long long)pk2(hv[2], hv[3]) << 32); } }
        }
    }
    __syncthreads();
    float* H = a.out(); LAS float* ssl = (LAS float*)(F.lds + RING_OFF + MOE_A_OFF);
#pragma unroll 1
    for (int pi = 0; pi < 2; ++pi) { const int p = pi ^ ((tile >> 1) & 1);
        const bf16* WtA = (const bf16*)(ws + WS_WD) + ((size_t)(slot * NE + ea)) * DM * FF + (size_t)(p * 8 + w) * (8 * 4 * 64 * 8);
        const bf16* WtB = (const bf16*)(ws + WS_WD) + ((size_t)(slot * NE + eb)) * DM * FF + (size_t)(p * 8 + w) * (8 * 4 * 64 * 8);
        f32x4m acc[5][4];
#pragma unroll
        for (int rb = 0; rb < 5; ++rb)
#pragma unroll
            for (int cb = 0; cb < 4; ++cb) acc[rb][cb] = (f32x4m){0.f, 0.f, 0.f, 0.f};
        bf16x8 bfr[4][4];
#pragma unroll
        for (int r = 0; r < 3; ++r)
#pragma unroll
            for (int cb = 0; cb < 4; ++cb) bfr[r][cb] = *(const GAS bf16x8*)((const char*)(WtA + (r * 4 + cb) * 512) + lb);
        bf16x8 afn = *(const LAS bf16x8*)(Hl + fr * MOE_HP + fq * 8);
#pragma unroll 1
        for (int kc = 0; kc < 4; ++kc) {
#pragma unroll
            for (int j = 0; j < 4; ++j) {
                const int ks = kc * 4 + j, kn = (ks + 3 < 16) ? ks + 3 : 15;
                { const bf16* Wn = (kn < 8 ? WtA : WtB) + ((kn & 7) * 4) * 512;
#pragma unroll
                    for (int cb = 0; cb < 4; ++cb) bfr[(j + 3) & 3][cb] = *(const GAS bf16x8*)((const char*)(Wn + cb * 512) + lb); }
#pragma unroll
                for (int rb = 0; rb < 5; ++rb) { const bf16x8 af = afn; const int rn = (rb + 1) % 5, kq = ks + (rb == 4 ? 1 : 0);
                    afn = *(const LAS bf16x8*)(Hl + (rn * 16 + fr) * MOE_HP + (kq < 16 ? kq : 15) * 32 + fq * 8);
                    __builtin_amdgcn_sched_barrier(0);
#pragma unroll
                    for (int cb = 0; cb < 4; ++cb) acc[rb][cb] = __builtin_amdgcn_mfma_f32_16x16x32_bf16(bfr[j][cb], af, acc[rb][cb], 0, 0, 0);
                    __builtin_amdgcn_sched_barrier(0); }
            }
        }
        const int l3 = tid_fresh() & 63, fr3 = l3 & 15, fq3 = l3 >> 4;
        bf16* hbw = (bf16*)(ws + WS_HB);
#pragma unroll
        for (int rb = 0; rb < 5; ++rb) { const int t = tokl[rb * 16 + fr3]; float ssq = 0.f;
            if (t >= 0) { GAS f32x4* hp = (GAS f32x4*)(H + (size_t)t * DM + 512 * p + 64 * w + 4 * fq3); GAS unsigned long long* bp = (GAS unsigned long long*)(hbw + (size_t)t * DM + 512 * p + 64 * w + 4 * fq3);
#pragma unroll
                for (int cb = 0; cb < 4; ++cb) { const f32x4 hn = hp[4 * cb] + acc[rb][cb] * upd; hp[4 * cb] = hn; ssq += (hn.x * hn.x + hn.y * hn.y) + (hn.z * hn.z + hn.w * hn.w);
                    bp[4 * cb] = (unsigned long long)pk2(hn.x, hn.y) | ((unsigned long long)pk2(hn.z, hn.w) << 32); } }
            ssq += __shfl_xor(ssq, 16); ssq += __shfl_xor(ssq, 32);
            if (fq3 == 0) ssl[(rb * 16 + fr3) * 16 + p * 8 + w] = ssq; }
    }
    __syncthreads();
    if (F.tid < MROWS) { const int t = tokl[F.tid]; float tot = 0.f;
#pragma unroll
        for (int i = 0; i < 16; ++i) tot += ssl[F.tid * 16 + i];
        if (t >= 0) ((float*)(ws + WS_RSTD))[t] = 1.0f / sqrtf(tot * (1.0f / DM) + 1e-6f); }
    __syncthreads();
#undef MOE_GLOAD
#undef MOE_GSTORE
    }
}

constexpr int OPR_ROWS = 64;
constexpr int OPR_A_OFF = 0, OPR_APB = 2048 + 16;
constexpr int OPR_RW_OFF = OPR_ROWS * OPR_APB;
constexpr int OPR_PART_OFF = OPR_RW_OFF + 20480;
constexpr int OPR_SSQ_OFF = OPR_PART_OFF + 10240;
static_assert(OPR_SSQ_OFF + 512 <= MISC_OFF, "OPR LDS");
__device__ __forceinline__ float opr_red4(const float (&v)[4], int fq) {
    const bool b0 = fq & 1, b1 = fq & 2;
    const float s0 = b0 ? v[0] : v[2], s1 = b0 ? v[1] : v[3], k0 = b0 ? v[2] : v[0], k1 = b0 ? v[3] : v[1];
    const float a0 = k0 + __shfl_xor(s0, 16), a1 = k1 + __shfl_xor(s1, 16);
    const float s = b1 ? a0 : a1, k = b1 ? a1 : a0;
    return k + __shfl_xor(s, 32);
}
__device__ __forceinline__ void opr_fxadd(LAS long long* p, float v, float scale) { const long long fx = (long long)(v * scale); (void)__hip_atomic_fetch_add(p, fx, __ATOMIC_RELAXED, __HIP_MEMORY_SCOPE_WORKGROUP); }
struct OprCtx { const bf16* wt; LAS unsigned char* Al; LAS float* rwl; LAS long long* part; LAS long long* ssl; const float* base; float* H; bf16* hbw; const float* wr; int row0, rot, w; bool dry; };
#define OPR_KS(s_) (((((s_) >> 2) + C.rot) & 7) * 4 + ((s_) & 3))
template <bool K, bool EPI> __device__ __forceinline__ void opr_pass(const OprCtx& C, int p, f32x4m (&acc)[4][2], f32x4m (&hd)[4][2], bf16x8 (&bfr)[8][2], f32x4m (&rwreg)[3]) {
    const int q = p - 1;
    const int tid = tid_fresh(), lane = tid & 63, fr = lane & 15, fq = lane >> 4;
    const unsigned lb = (unsigned)lane * 16u;
    const unsigned eoff = (unsigned)((C.row0 + fr) * DM + 32 * C.w + 4 * fq);
    const LAS unsigned char* ap0 = C.Al + fr * OPR_APB + fq * 16;
    float ss[4] = {0.f, 0.f, 0.f, 0.f};
#pragma unroll
    for (int ks = 0; ks < 32; ++ks) {
        bf16x8 af[4];
        if (K) {
            { int sn = p * 32 + ks + 7; sn = sn < 127 ? sn : 127; const int pn = sn >> 5, kn = OPR_KS(sn & 31);
              const unsigned o = (unsigned)(((((pn >> 1) * 8 + 4 * (pn & 1) + (C.w >> 1)) * 32 + kn) * 4 + 2 * (C.w & 1))) * 1024u;
              const GAS char* wp = (const GAS char*)C.wt + o;
              bfr[(ks + 7) & 7][0] = *(const GAS bf16x8*)(wp + lb); bfr[(ks + 7) & 7][1] = *(const GAS bf16x8*)(wp + 1024 + lb); }
            { const LAS unsigned char* ap = ap0 + OPR_KS(ks) * 64;
#pragma unroll
              for (int rb = 0; rb < 4; ++rb) af[rb] = *(const LAS bf16x8*)(ap + rb * 16 * OPR_APB); }
        }
        __builtin_amdgcn_sched_barrier(0);
        if (K) {
#pragma unroll
            for (int rb = 0; rb < 4; ++rb)
#pragma unroll
                for (int cb = 0; cb < 2; ++cb) acc[rb][cb] = __builtin_amdgcn_mfma_f32_16x16x32_bf16(bfr[ks & 7][cb], af[rb], acc[rb][cb], 0, 0, 0);
        }
        if (EPI) {
            if (ks < 4) {
                const int rb = ks; const unsigned off = eoff + (unsigned)(rb * 16 * DM + 256 * q);
#pragma unroll
                for (int cb = 0; cb < 2; ++cb) { const f32x4m hn = hd[rb][cb];
                    if (!C.dry) { *(GAS f32x4m*)((GAS char*)C.H + (size_t)(off + 16 * cb) * 4u) = hn;
                                  *(GAS unsigned long long*)((GAS char*)C.hbw + (size_t)(off + 16 * cb) * 2u) = (unsigned long long)pk2(hn.x, hn.y) | ((unsigned long long)pk2(hn.z, hn.w) << 32); }
                    ss[rb] += (hn.x * hn.x + hn.y * hn.y) + (hn.z * hn.z + hn.w * hn.w); }
            } else if (ks == 4) {
                const float t = opr_red4(ss, fq); const int rs = 2 * (fq & 1) + (fq >> 1);
                opr_fxadd(C.ssl + rs * 16 + fr, t, 16777216.0f);
            } else if (ks < 25) {
                const int qc = ks - 5; const LAS float* wv = C.rwl + qc * 256 + 32 * C.w + 4 * fq;
                const f32x4m w0 = *(const LAS f32x4m*)wv, w1 = *(const LAS f32x4m*)(wv + 16);
                float pd[4];
#pragma unroll
                for (int rb = 0; rb < 4; ++rb) pd[rb] = ((hd[rb][0].x * w0.x + hd[rb][0].y * w0.y) + (hd[rb][0].z * w0.z + hd[rb][0].w * w0.w)) + ((hd[rb][1].x * w1.x + hd[rb][1].y * w1.y) + (hd[rb][1].z * w1.z + hd[rb][1].w * w1.w));
                const float t = opr_red4(pd, fq); const int rs = 2 * (fq & 1) + (fq >> 1);
                opr_fxadd(C.part + qc * 64 + rs * 16 + fr, t, 4294967296.0f);
            }
        }
        if (K) {
            if (ks >= 25 && ks < 29) {
                const int rb = ks - 25; const GAS char* bp = (const GAS char*)C.base + (size_t)(eoff + (unsigned)(rb * 16 * DM + 256 * p)) * 4u;
                hd[rb][0] = *(const GAS f32x4m*)bp; hd[rb][1] = *(const GAS f32x4m*)(bp + 64);
            } else if (ks == 29) {
#pragma unroll
                for (int i = 0; i < 3; ++i) { const int idx = tid + 512 * i; const int qq = idx >> 6, c4 = idx & 63;
                    if (idx < 1280) rwreg[i] = *(const GAS f32x4m*)((const GAS char*)C.wr + (size_t)(unsigned)(qq * DM + 256 * p + 4 * c4) * 4u); }
            }
        }
        __builtin_amdgcn_sched_barrier(0);
    }
}
template <bool MERGE> __device__ __forceinline__ void p_opr(const KA a, Frame& F, int layer, const bf16* Wt_all, const float* base, bool dry) {
    unsigned char* ws = a.ws(); asm volatile("" : "+s"(ws)); ASSUME_GLOBAL(ws);
    OprCtx C;
    C.Al = F.lds + OPR_A_OFF; C.rwl = (LAS float*)(F.lds + OPR_RW_OFF); C.part = (LAS long long*)(F.lds + OPR_PART_OFF); C.ssl = (LAS long long*)(F.lds + OPR_SSQ_OFF);
    C.base = base; C.H = a.out(); C.hbw = (bf16*)(ws + WS_HB); C.wr = (const float*)(ws + WS_WR) + (size_t)layer * 20 * DM;
    C.w = F.wave; C.dry = dry; C.wt = Wt_all;
    LAS float* wql = C.rwl;
    for (int u = bid_fresh(); u < TOK / OPR_ROWS; u += (int)gridDim.x) {
    C.row0 = u * OPR_ROWS; C.rot = (u * 3) & 7;
    for (int i = F.tid; i < 21 * 64; i += NWAVES * 64) C.part[i] = 0ll;
    if (MERGE) {
        const int r = F.tid >> 3, hh = F.tid & 7; const float* lp = (const float*)(ws + WS_LSE) + (size_t)(C.row0 + r) * 24 + hh;
        const float l0 = *(const GAS float*)lp, l1 = *(const GAS float*)(lp + 8), l2 = *(const GAS float*)(lp + 16);
        const float mx = fmaxf(l0, fmaxf(l1, l2)); const float e0 = expf(l0 - mx), e1 = expf(l1 - mx), e2 = expf(l2 - mx), inv = 1.0f / (e0 + e1 + e2);
        *(LAS f32x4*)(wql + (r * 8 + hh) * 4) = (f32x4){e0 * inv, e1 * inv, e2 * inv, 0.f};
        __syncthreads();
    }
    { const bf16* asrc = (const bf16*)(ws + WS_QB);
      const int c = F.tid & 127, r0 = F.tid >> 7;
      constexpr int NG = MERGE ? 3 : 1, NB = MERGE ? 2 : 1, PB = 16 / NB;
#pragma unroll 1
      for (int b = 0; b < NB; ++b) {
          v4u greg[PB][NG];
#pragma unroll
          for (int i = 0; i < PB; ++i)
#pragma unroll
              for (int g = 0; g < NG; ++g) greg[i][g] = *(const GAS v4u*)(asrc + (size_t)(C.row0 + r0 + 4 * (b * PB + i)) * (MERGE ? 3072 : 1024) + g * 1024 + c * 8);
#pragma unroll
          for (int i = 0; i < PB; ++i) { const int r = r0 + 4 * (b * PB + i); v4u o_;
              if (MERGE) { const f32x4 wq_ = *(const LAS f32x4*)(wql + (r * 8 + (c >> 4)) * 4);
                  const unsigned x0_[4] = {greg[i][0].x, greg[i][0].y, greg[i][0].z, greg[i][0].w}, x1_[4] = {greg[i][NG > 1 ? 1 : 0].x, greg[i][NG > 1 ? 1 : 0].y, greg[i][NG > 1 ? 1 : 0].z, greg[i][NG > 1 ? 1 : 0].w},
                                 x2_[4] = {greg[i][NG > 2 ? 2 : 0].x, greg[i][NG > 2 ? 2 : 0].y, greg[i][NG > 2 ? 2 : 0].z, greg[i][NG > 2 ? 2 : 0].w}; unsigned y_[4];
#pragma unroll
                  for (int e = 0; e < 4; ++e) { const float lo_ = wq_.x * bf2f(x0_[e] & 0xffffu) + wq_.y * bf2f(x1_[e] & 0xffffu) + wq_.z * bf2f(x2_[e] & 0xffffu),
                                                            hi_ = wq_.x * bf2f(x0_[e] >> 16) + wq_.y * bf2f(x1_[e] >> 16) + wq_.z * bf2f(x2_[e] >> 16); y_[e] = pk2(lo_, hi_); }
                  o_ = (v4u){y_[0], y_[1], y_[2], y_[3]}; } else o_ = greg[i][0];
              *(LAS v4u*)(C.Al + r * OPR_APB + c * 16) = o_; }
      } }
    __builtin_amdgcn_sched_barrier(0);
    f32x4m acc[4][2], hd[4][2], rwreg[3]; bf16x8 bfr[8][2];
#pragma unroll
    for (int rb = 0; rb < 4; ++rb)
#pragma unroll
        for (int cb = 0; cb < 2; ++cb) { acc[rb][cb] = (f32x4m){0.f, 0.f, 0.f, 0.f}; hd[rb][cb] = (f32x4m){0.f, 0.f, 0.f, 0.f}; }
#pragma unroll
    for (int i = 0; i < 3; ++i) rwreg[i] = (f32x4m){0.f, 0.f, 0.f, 0.f};
#pragma unroll
    for (int s = 0; s < 7; ++s) { const unsigned o = (unsigned)((((C.w >> 1) * 32 + OPR_KS(s)) * 4 + 2 * (C.w & 1))) * 1024u; const unsigned lb = (unsigned)F.lane * 16u;
        bfr[s][0] = *(const GAS bf16x8*)((const GAS char*)Wt_all + o + lb); bfr[s][1] = *(const GAS bf16x8*)((const GAS char*)Wt_all + o + 1024 + lb); }
    LDS_WAIT(); __builtin_amdgcn_s_barrier(); asm volatile("" ::: "memory");
#define OPR_BOUNDARY() do { \
        _Pragma("unroll") for (int rb = 0; rb < 4; ++rb) _Pragma("unroll") for (int cb = 0; cb < 2; ++cb) { hd[rb][cb] = acc[rb][cb] + hd[rb][cb]; acc[rb][cb] = (f32x4m){0.f, 0.f, 0.f, 0.f}; } \
        LDS_WAIT(); __builtin_amdgcn_s_barrier(); asm volatile("" ::: "memory"); \
        _Pragma("unroll") for (int i = 0; i < 3; ++i) { const int idx = F.tid + 512 * i; if (idx < 1280) *(LAS f32x4m*)(C.rwl + 4 * idx) = rwreg[i]; } \
        LDS_WAIT(); __builtin_amdgcn_s_barrier(); asm volatile("" ::: "memory"); } while (0)
    opr_pass<true, false>(C, 0, acc, hd, bfr, rwreg);
    OPR_BOUNDARY();
#pragma unroll 1
    for (int p = 1; p < 4; ++p) { opr_pass<true, true>(C, p, acc, hd, bfr, rwreg); OPR_BOUNDARY(); }
    opr_pass<false, true>(C, 4, acc, hd, bfr, rwreg);
#undef OPR_BOUNDARY
    LDS_WAIT(); __builtin_amdgcn_s_barrier(); asm volatile("" ::: "memory");
    if (F.tid < OPR_ROWS) { const int m = C.row0 + F.tid;
        const float tot = (float)C.ssl[F.tid] * (1.0f / 16777216.0f);
        const float rsr = 1.0f / sqrtf(tot * (1.0f / DM) + 1e-6f);
        ((float*)(ws + WS_RSTD))[m] = rsr;
        float d[20];
#pragma unroll
        for (int q = 0; q < 20; ++q) d[q] = ((float)C.part[q * 64 + F.tid] * (1.0f / 4294967296.0f)) * rsr;
        const float* gb = a.in(17) + layer * 4;
        float lg[4];
#pragma unroll
        for (int q = 0; q < 4; ++q) lg[q] = d[q] + gb[q];
        int gi = 0; float gm = lg[0];
#pragma unroll
        for (int q = 1; q < 4; ++q) if (lg[q] > gm) { gm = lg[q]; gi = q; }
        float gs = 0.f;
#pragma unroll
        for (int q = 0; q < 4; ++q) gs += expf(lg[q] - gm);
        const float gp = 1.0f / gs;
        const float* ebp = a.in(19) + layer * 16;
        float el[4];
#pragma unroll
        for (int q = 0; q < 4; ++q) { float t = 0.f;
#pragma unroll
            for (int g2 = 0; g2 < 4; ++g2) if (g2 == gi) t = d[4 + 4 * g2 + q] + ebp[4 * g2 + q];
            el[q] = t; }
        int i1 = 0; float v1 = el[0];
#pragma unroll
        for (int q = 1; q < 4; ++q) if (el[q] > v1) { v1 = el[q]; i1 = q; }
        int i2 = -1; float v2 = 0.f;
#pragma unroll
        for (int q = 0; q < 4; ++q) if (q != i1 && (i2 < 0 || el[q] > v2)) { v2 = el[q]; i2 = q; }
        const float e2 = expf(v2 - v1), g1 = gp / (1.0f + e2), g2v = gp * e2 / (1.0f + e2);
        const int lo = i1 < i2 ? i1 : i2, hi = i1 < i2 ? i2 : i1;
        const int pidx = (lo == 0) ? (hi - 1) : (lo == 1 ? hi + 1 : 5);
        const int cls = gi * 6 + pidx;
        if (!dry) {
            const unsigned pp = __hip_atomic_fetch_add((unsigned*)(ws + WS_CTL) + CW_CNT + layer * 64 + cls, 1u, RLX_AGENT);
            ((int*)(ws + WS_LIST))[(size_t)cls * TOK + pp] = m;
            ((float*)(ws + WS_GA))[m] = (i1 < i2) ? g1 : g2v;
            ((float*)(ws + WS_GB))[m] = (i1 < i2) ? g2v : g1;
        }
    }
    __syncthreads();
    }
#undef OPR_KS
}

__global__ void __launch_bounds__(NWAVES * 64, 2) fwd_kernel(Args args_unused_directly) {
    extern __shared__ __attribute__((aligned(16))) unsigned char lds[];
    Frame F;
    F.lds = (LAS unsigned char*)lds;
    F.tid = threadIdx.x; F.lane = F.tid & 63; F.wave = __builtin_amdgcn_readfirstlane(F.tid >> 6);
    F.G = gridDim.x; { const int bx = blockIdx.x; F.vcu = (F.G % 8 == 0) ? (bx % 8) * (F.G / 8) + bx / 8 : bx; }
    const kptr_t kbase = (kptr_t)__builtin_amdgcn_kernarg_segment_ptr();
    unsigned char* const ws0 = KA{kbase}.ws();
    volatile LAS unsigned* MISC = (volatile LAS unsigned*)(F.lds + MISC_OFF);
    if (F.tid < 64) MISC[F.tid] = 0u;
    __syncthreads();
    const int lo = *(const int __attribute__((address_space(4)))*)(kbase + 208), hi = *(const int __attribute__((address_space(4)))*)(kbase + 212);
    XcdBarrier bar; bar.bar = (unsigned*)(ws0 + WS_CTL) + CW_BAR; bar.x = 0; bar.st = nullptr;
    if (hi - lo > 1) bar = xcd_barrier_post((unsigned*)(ws0 + WS_CTL) + CW_BAR, MISC + 8);
    int pc = 0;
#ifndef PH_EN
#define PH_EN 0xFFFF
#endif
#ifndef REP_MASK
#define REP_MASK 0
#endif
#define RUN(id, ...) RUN_(id, 1, __VA_ARGS__)
#define RUN_(id, bar_, ...) do { if (((PH_EN >> (id)) & 1) && pc >= lo && pc < hi) { \
      for (int rep_ = ((REP_MASK >> (id)) & 1); rep_ >= 0; --rep_) { const bool dry = rep_ > 0; (void)dry; kptr_t kl_ = kbase; asm volatile("" : "+s"(kl_)); const KA args{kl_}; unsigned char* ws = args.ws(); asm volatile("" : "+s"(ws)); ASSUME_GLOBAL(ws); \
        F.tid = tid_fresh(); F.lane = F.tid & 63; F.wave = __builtin_amdgcn_readfirstlane(F.tid >> 6); { const int bx = bid_fresh(); F.vcu = (F.G % 8 == 0) ? (bx % 8) * (F.G / 8) + bx / 8 : bx; } \
        __VA_ARGS__; } } if ((bar_) && pc >= lo && pc + 1 < hi) xcd_barrier(bar); ++pc; } while (0)

    RUN_(0, 0, { p_prologue(args, F); __syncthreads(); });
    for (int l = 0; l < NL; ++l) {
        if (l < NA) {
            RUN(1, p_rowpass<1>(args, F, l, false, l == 0 ? args.in(0) : args.out(), l == 0));
            RUN(2, {

                { const int bx = bid_fresh(); if (bx < BATCH * AH) attn_body::fox_scan((char*)lds + RING_OFF, (const float*)(ws + WS_LOGF) + (size_t)bx * SEQ, (unsigned long long*)(ws + WS_CAUG) + (size_t)bx * SEQ); }
                pg8::Gemm g{(const pg8::bf16_t*)(ws + WS_HB), (const pg8::bf16_t*)(ws + WS_WIN) + (size_t)l * 3072 * DM, TOK, 3072, DM};
                pg8::StaticOrder S; S.init(TOK, 3072, F.G, bid_fresh());
                pg8::EpiAQkv E{(pg8::bf16_t*)(ws + WS_QB), (size_t)(16 * MiB), (const float*)(ws + WS_RSTD), (const float*)(ws + WS_GTAB) + l * 192};
                pg8::gemm_phase<pg8::EpiAQkv, pg8::StaticOrder, true, true>(F.lds + RING_OFF, g, S, E);
            });
            RUN(3, {
                const attn_body::AttnTensors AT{(const attn_body::bf16*)(ws + WS_QB), (const attn_body::bf16*)(ws + WS_QB + 32 * MiB), (const attn_body::bf16*)(ws + WS_QB + 64 * MiB),
                                                (attn_body::bf16*)(ws + (dry ? WS_KB : WS_QB)), (const unsigned long long*)(ws + WS_CAUG)};
                unsigned* cq = (unsigned*)(ws + WS_CTL) + CW_CQ + (l * 2 + (dry ? 1 : 0)) * 64;
                const bool cmain = l == 0; const int clo = cmain ? TR_I_WIN : 0, chi = cmain ? TR_NITEMS : 6144;
                _Pragma("unroll 1") for (int pass = 0; pass < 2; ++pass) {
                    if (pass == 1 || (F.vcu & 3) == 0) conv_drain(args, ws, F, cq, cmain, 2, clo, chi);
                    if (pass == 0) { attn_body::attn_phase_dyn<8>((char*)lds + RING_OFF, AT, (unsigned*)(ws + WS_CTL) + CW_AQ + (l * 2 + (dry ? 1 : 0)) * 64); __syncthreads(); }
                }
            });
            RUN(4, {
                p_opr<false>(args, F, l, (const bf16*)(ws + WS_WOA) + (size_t)l * DM * DM, l == 0 ? args.in(0) : args.out(), dry);
            });
        } else {
            const int j = l - NA;
            RUN(6, {
                const int N = j == 0 ? 5120 : 3072;
                pg8::Gemm g{(const pg8::bf16_t*)(ws + WS_HB), j == 0 ? (const pg8::bf16_t*)(ws + WS_WKVQ0) : (const pg8::bf16_t*)(ws + WS_WQ1), TOK, N, DM};
                pg8::StaticOrder S; S.init(TOK, N, F.G, bid_fresh());
                pg8::EpiBKvq E{(pg8::bf16_t*)(ws + WS_KB), (pg8::bf16_t*)(ws + WS_VB), (pg8::bf16_t*)(ws + WS_QB), (const float*)(ws + WS_RSTD), args.in(10), args.in(13) + j * BG * BHD,
                               (const unsigned*)(ws + WS_ROPEC), j == 0 ? 0 : 8, (PG8_LAS float*)(F.lds + XS_OFF)};
                pg8::gemm_phase<pg8::EpiBKvq, pg8::StaticOrder, true, true>(F.lds + RING_OFF, g, S, E);
            });
            RUN(7, p_battn(args, F, dry));
            RUN(9, {
                if (l == 2) {
                    LAS float* scr = (LAS float*)(F.lds + RING_OFF + F.wave * 16384);
                    tr_run<false>(args, ws, 3, 6144, F.vcu * NWAVES + F.wave, F.G * NWAVES, scr, F.lane);
                    __syncthreads();
                }
                p_opr<true>(args, F, l, (const bf16*)(ws + WS_WOB) + (size_t)j * DM * DM, args.out(), dry);
            });
        }
        RUN(11, p_moe(args, F, l, dry ? 0.f : 1.f));
    }
#undef RUN
}
constexpr int N_PHASES = 1 + NA * 5 + NB * 4;

#ifndef MK_ONE_LAUNCH
#define MK_ONE_LAUNCH 1
#endif
extern "C" void kernel_launch(void* const* d_in, const int* in_sizes, int n_in, void* d_out, int out_size, void* d_ws, size_t ws_size, hipStream_t stream) {
    static int grid = 0;
    if (grid == 0) {
        if (n_in != 23 || out_size != TOK * DM || ws_size < WS_END) { fprintf(stderr, "kernel_launch: unexpected shapes (n_in %d, out %d, ws %zu)\n", n_in, out_size, ws_size); grid = -1; return; }
        int dev = 0, cus = 0;
        if (hipGetDevice(&dev) != hipSuccess || hipDeviceGetAttribute(&cus, hipDeviceAttributeMultiprocessorCount, dev) != hipSuccess) { grid = -1; return; }
        if (hipFuncSetAttribute((const void*)fwd_kernel, hipFuncAttributeMaxDynamicSharedMemorySize, LDS_BYTES) != hipSuccess) { fprintf(stderr, "kernel_launch: hipFuncSetAttribute failed\n"); grid = -1; return; }
        int per_cu = 0;
        if (hipOccupancyMaxActiveBlocksPerMultiprocessor(&per_cu, (const void*)fwd_kernel, NWAVES * 64, LDS_BYTES) != hipSuccess || per_cu < 1) fprintf(stderr, "kernel_launch: occupancy query says %d\n", per_cu);
        (void)hipGetLastError();
        grid = cus;
    }
    if (grid < 0) return;
    if (hipMemsetAsync((char*)d_ws + WS_CTL, 0, CTL_ZERO_BYTES, stream) != hipSuccess) return;
    Args a{};
    for (int i = 0; i < 23; ++i) a.in[i] = (const float*)d_in[i];
    a.in[23] = nullptr;
    a.out = (float*)d_out; a.ws = (unsigned char*)d_ws;
#if MK_ONE_LAUNCH
    a.ph_lo = 0; a.ph_hi = N_PHASES;
    hipLaunchKernelGGL(fwd_kernel, dim3(grid), dim3(NWAVES * 64), LDS_BYTES, stream, a);
#else
    for (int p = 0; p < N_PHASES; ++p) { a.ph_lo = p; a.ph_hi = p + 1;
        hipLaunchKernelGGL(fwd_kernel, dim3(grid), dim3(NWAVES * 64), LDS_BYTES, stream, a); }
#endif
}
```

```cpp
#include <hip/hip_runtime.h>
#include <hip/hip_bf16.h>
#include <cstdio>
#include <cstdint>
#include <cmath>
__device__ __forceinline__ int tid_fresh() { int t = (int)threadIdx.x; asm volatile("" : "+v"(t)); return t; }
__device__ __forceinline__ int bid_fresh() { int t = (int)blockIdx.x; asm volatile("" : "+s"(t)); return t; }
#if defined(__HIP_DEVICE_COMPILE__)
#define ASSUME_GLOBAL(p_) do { __builtin_assume(!__builtin_amdgcn_is_shared((const void*)(p_))); __builtin_assume(!__builtin_amdgcn_is_private((const void*)(p_))); } while (0)
#else
#define ASSUME_GLOBAL(p_) do { } while (0)
#endif
namespace pg8 {
#define PG8_LAS __attribute__((address_space(3)))
typedef unsigned short bf16_t;
typedef short bf16x8 __attribute__((ext_vector_type(8)));
typedef float f32x4 __attribute__((ext_vector_type(4)));
typedef unsigned u32x4 __attribute__((ext_vector_type(4)));
constexpr int BM = 256, BK = 64, HALF = 128, HTB = HALF * BK * 2  , STAGE_BYTES = 8 * HTB, NXCD = 8, WGM = 8;

__host__ __device__ __forceinline__ int lds_byte(int r, int c) { const int st = (r >> 4) * 2 + (c >> 5), rr = r & 15, cc = c & 31, ob = rr * 64 + cc * 2; return st * 1024 + (ob ^ (((ob >> 9) & 1) << 5)); }
__host__ __device__ __forceinline__ void stage_rc(int b, int& R, int& C) { const int st = b / 1024, sb = b % 1024, swz = sb ^ (((sb >> 9) & 1) << 5); R = (st >> 1) * 16 + swz / 64; C = (st & 1) * 32 + (swz % 64) / 2; }
__host__ __device__ __forceinline__ int perm32(int rho) { const int n = rho >> 4, i = rho & 15; return 8 * (i >> 2) + 4 * n + (i & 3); }

struct Unit { int pm, pn; };
struct Gemm { const bf16_t* A; const bf16_t* Bt; int M, N, K; };

struct StaticOrder {
    int nM, nN, nwg, G, c;
    __host__ __device__ void init(int M, int N, int G_, int c_) { nM = M / BM; nN = N / BM; nwg = nM * nN; G = G_; c = c_; }
    __host__ __device__ bool next(int i, Unit& u) const {
        const long L = (long)i * G + c; if (L >= nwg) return false;
        int wgid = (int)L; { const int q = nwg / NXCD, r = nwg % NXCD, xcd = wgid % NXCD, off = wgid / NXCD; wgid = (xcd < r ? xcd * (q + 1) : r * (q + 1) + (xcd - r) * q) + off; }
        const int nig = WGM * nN, gid = wgid / nig, fm = gid * WGM, gsz = (nM - fm) < WGM ? (nM - fm) : WGM;
        u.pm = fm + ((wgid % nig) % gsz); u.pn = (wgid % nig) / gsz; return true;
    }
    __device__ __forceinline__ void a_ready(const Unit&) const {}
    __device__ __forceinline__ void done(const Unit&) const {}
};

__device__ __forceinline__ unsigned cvt_pk_bf16(float lo, float hi) { unsigned r; asm volatile("v_cvt_pk_bf16_f32 %0, %1, %2" : "=v"(r) : "v"(lo), "v"(hi)); return r; }
typedef float f32x2 __attribute__((ext_vector_type(2)));
constexpr float RMS_EPS = 1e-6f;
#define PG8_GAS __attribute__((address_space(1)))
__device__ __forceinline__ void st16(bf16_t* p, const float (&o)[8]) { u32x4 w; w.x = cvt_pk_bf16(o[0], o[1]); w.y = cvt_pk_bf16(o[2], o[3]); w.z = cvt_pk_bf16(o[4], o[5]); w.w = cvt_pk_bf16(o[6], o[7]); *(PG8_GAS u32x4*)p = w; }
struct EpiAQkv {
    static constexpr bool PERM = true, AFTER_DRAIN = false;
    bf16_t* QKV; size_t sec_stride; const float* rstd; const float* gtab;
    __device__ __forceinline__ void operator()(const f32x4 (&acc)[2][2][4][2], const Unit& u, int wr, int wc, int fr, int fq) const {
        const int sec = u.pn >> 2, head = (u.pn & 3) * 4 + wc;
        bf16_t* dst = QKV + (size_t)sec * sec_stride + head * 64 + 8 * fq;
        const float* gp = gtab + sec * 64 + 8 * fq;
        const bool nrm = sec < 2;
        float rsv[2][4]; const float* rp = rstd + u.pm * BM + wr * 64 + fr;
#pragma unroll
        for (int ai = 0; ai < 2; ++ai)
#pragma unroll
            for (int m = 0; m < 4; ++m) rsv[ai][m] = *(const PG8_GAS float*)(rp + ai * HALF + m * 16);
        f32x4 g[2][2];
#pragma unroll
        for (int bj = 0; bj < 2; ++bj)
#pragma unroll
            for (int n = 0; n < 2; ++n) g[bj][n] = *(const PG8_GAS f32x4*)(gp + 32 * bj + 4 * n);
#pragma unroll
        for (int ai = 0; ai < 2; ++ai)
#pragma unroll
            for (int m = 0; m < 4; ++m) {
                const int row = u.pm * BM + ai * HALF + wr * 64 + m * 16 + fr;
                const float rs = rsv[ai][m];
                f32x4 v[2][2];
#pragma unroll
                for (int bj = 0; bj < 2; ++bj)
#pragma unroll
                    for (int n = 0; n < 2; ++n) v[bj][n] = acc[ai][bj][m][n] * rs;
                float s = 0.f;
#pragma unroll
                for (int bj = 0; bj < 2; ++bj)
#pragma unroll
                    for (int n = 0; n < 2; ++n) { const f32x4 x = v[bj][n]; s += (x[0] * x[0] + x[1] * x[1]) + (x[2] * x[2] + x[3] * x[3]); }
                s += __shfl_xor(s, 16); s += __shfl_xor(s, 32);
                const float sc = nrm ? __builtin_amdgcn_rsqf(s * (1.0f / 64.0f) + RMS_EPS) : 1.0f;
#pragma unroll
                for (int bj = 0; bj < 2; ++bj) { const f32x4 o0 = v[bj][0] * sc * g[bj][0], o1 = v[bj][1] * sc * g[bj][1];
                    u32x4 w; w.x = cvt_pk_bf16(o0[0], o0[1]); w.y = cvt_pk_bf16(o0[2], o0[3]); w.z = cvt_pk_bf16(o1[0], o1[1]); w.w = cvt_pk_bf16(o1[2], o1[3]);
                    *(PG8_GAS u32x4*)(dst + (size_t)row * 1024 + 32 * bj) = w; }
            }
    }
};
struct EpiBKvq {
    static constexpr bool PERM = true, AFTER_DRAIN = false;
    bf16_t *KB, *VB, *QB; const float* rstd; const float *kg, *qg  ; const unsigned* rcs  ; int tile_off; PG8_LAS float* xs;
    __device__ __forceinline__ void operator()(const f32x4 (&acc)[2][2][4][2], const Unit& u, int wr, int wc, int fr, int fq) const {
        const int T = u.pn + tile_off;
        float rsv[2][4]; const float* rp = rstd + u.pm * BM + wr * 64 + fr;
#pragma unroll
        for (int ai = 0; ai < 2; ++ai)
#pragma unroll
            for (int m = 0; m < 4; ++m) rsv[ai][m] = *(const PG8_GAS float*)(rp + ai * HALF + m * 16);
        if (T >= 4 && T < 8) {
            bf16_t* dst = VB + (T - 4) * 256 + 32 * wc + 8 * fq;
#pragma unroll
            for (int ai = 0; ai < 2; ++ai)
#pragma unroll
                for (int m = 0; m < 4; ++m) {
                    const int row = u.pm * BM + ai * HALF + wr * 64 + m * 16 + fr; const float rs = rsv[ai][m];
#pragma unroll
                    for (int bj = 0; bj < 2; ++bj) { float o[8];
#pragma unroll
                        for (int n = 0; n < 2; ++n)
#pragma unroll
                            for (int e = 0; e < 4; ++e) o[4 * n + e] = acc[ai][bj][m][n][e] * rs;
                        st16(dst + (size_t)row * 1024 + 128 * bj, o); }
                }
            return;
        }
        const bool isq = T >= 8; const int grp = isq ? ((T - 8) >> 2) : 0, head = (isq ? ((T - 8) & 3) : T) * 2 + (wc >> 1);
        const int d1 = 32 * (wc & 1) + 8 * fq;
        const float* gp = isq ? (qg + grp * 128) : kg;
        f32x4 g[2][2];
#pragma unroll
        for (int bj = 0; bj < 2; ++bj)
#pragma unroll
            for (int n = 0; n < 2; ++n) g[bj][n] = *(const PG8_GAS f32x4*)(gp + 64 * bj + d1 + 4 * n);
        const unsigned* rcp = rcs + (size_t)(u.pm * BM + wr * 64 + fr) * 64 + d1;
        u32x4 rn0 = *(const PG8_GAS u32x4*)(rcp), rn1 = *(const PG8_GAS u32x4*)(rcp + 4);
        float ss[2][4];
#pragma unroll
        for (int ai = 0; ai < 2; ++ai)
#pragma unroll
            for (int m = 0; m < 4; ++m) {
                const float rs = rsv[ai][m];
                float s = 0.f;
#pragma unroll
                for (int bj = 0; bj < 2; ++bj)
#pragma unroll
                    for (int n = 0; n < 2; ++n) { const f32x4 x = acc[ai][bj][m][n] * rs; s += (x[0] * x[0] + x[1] * x[1]) + (x[2] * x[2] + x[3] * x[3]); }
                s += __shfl_xor(s, 16); s += __shfl_xor(s, 32);
                ss[ai][m] = s;
                if (fq == 0) xs[(ai * HALF + wr * 64 + m * 16 + fr) * 4 + wc] = s;
            }
        asm volatile("s_waitcnt lgkmcnt(0)" ::: "memory"); __builtin_amdgcn_s_barrier(); asm volatile("" ::: "memory");
        bf16_t* dst = isq ? (QB + grp * 1024 + head * 128 + d1) : (KB + head * 128 + d1);
        const size_t pitch = isq ? 3072 : 1024;
#pragma unroll
        for (int ai = 0; ai < 2; ++ai)
#pragma unroll
            for (int m = 0; m < 4; ++m) {
                const int rl = ai * HALF + wr * 64 + m * 16 + fr, row = u.pm * BM + rl; const float rs = rsv[ai][m];
                const u32x4 rc0 = rn0, rc1 = rn1;
                { const int gi = ai * 4 + m + 1, an = (gi >> 2) & 1, mn = gi & 3; rn0 = *(const PG8_GAS u32x4*)(rcp + (size_t)(an * HALF + mn * 16) * 64); rn1 = *(const PG8_GAS u32x4*)(rcp + (size_t)(an * HALF + mn * 16) * 64 + 4); }
                const float tot = ss[ai][m] + xs[rl * 4 + (wc ^ 1)];
                const float sc = rs * __builtin_amdgcn_rsqf(tot * (1.0f / 128.0f) + RMS_EPS);
                float o1[8], o2[8];
#pragma unroll
                for (int n = 0; n < 2; ++n)
#pragma unroll
                    for (int e = 0; e < 4; ++e) { const int j = 4 * n + e;
                        const float y1 = acc[ai][0][m][n][e] * sc * g[0][n][e], y2 = acc[ai][1][m][n][e] * sc * g[1][n][e];
                        const unsigned cw = n ? rc1[e] : rc0[e];
                        const float c = (float)__builtin_bit_cast(_Float16, (unsigned short)(cw & 0xffffu)), sn = (float)__builtin_bit_cast(_Float16, (unsigned short)(cw >> 16));
                        o1[j] = y1 * c - y2 * sn; o2[j] = y2 * c + y1 * sn; }
                st16(dst + (size_t)row * pitch, o1); st16(dst + (size_t)row * pitch + 64, o2);
            }
        asm volatile("s_waitcnt lgkmcnt(0)" ::: "memory"); __builtin_amdgcn_s_barrier(); asm volatile("" ::: "memory");
    }
};
struct EpiResid {
    static constexpr bool PERM = true, AFTER_DRAIN = false;
    const float* B; float* H; float upd;
    __device__ __forceinline__ void operator()(const f32x4 (&acc)[2][2][4][2], const Unit& u, int wr, int wc, int fr, int fq) const {
        const size_t r0 = (size_t)(u.pm * BM + wr * 64 + fr) * 1024 + u.pn * BM + wc * 32 + 8 * fq;
        const float* bp = B + r0; float* hp = H + r0;
        f32x4 nx[2][2];
#pragma unroll
        for (int bj = 0; bj < 2; ++bj)
#pragma unroll
            for (int n = 0; n < 2; ++n) nx[bj][n] = *(const PG8_GAS f32x4*)(bp + bj * HALF + 4 * n);
#pragma unroll
        for (int ai = 0; ai < 2; ++ai)
#pragma unroll
            for (int m = 0; m < 4; ++m) { const size_t ro = (size_t)(ai * HALF + m * 16) * 1024;
                f32x4 cu[2][2];
#pragma unroll
                for (int bj = 0; bj < 2; ++bj)
#pragma unroll
                    for (int n = 0; n < 2; ++n) cu[bj][n] = nx[bj][n];
                { const int gi = ai * 4 + m + 1, an = (gi >> 2) & 1, mn = gi & 3; const size_t rn = (size_t)(an * HALF + mn * 16) * 1024;
#pragma unroll
                  for (int bj = 0; bj < 2; ++bj)
#pragma unroll
                      for (int n = 0; n < 2; ++n) nx[bj][n] = *(const PG8_GAS f32x4*)(bp + rn + bj * HALF + 4 * n); }
#pragma unroll
                for (int bj = 0; bj < 2; ++bj)
#pragma unroll
                    for (int n = 0; n < 2; ++n) *(PG8_GAS f32x4*)(hp + ro + bj * HALF + 4 * n) = cu[bj][n] + acc[ai][bj][m][n] * upd; }
    }
};

template <class Epi, class Sched, bool ALIGN_EPI = false, bool SP2 = false>
__device__ __forceinline__ void gemm_phase(PG8_LAS unsigned char* lds, const Gemm g, const Sched& S, const Epi& E) {
    const int tid = tid_fresh(), wid = __builtin_amdgcn_readfirstlane(tid >> 6), lane = tid & 63, wr = wid >> 2, wc = wid & 3, fr = lane & 15, fq = lane >> 4;
    const int K = g.K, nt = K / BK;
    unsigned voffA[2], voffB[2];
#pragma unroll
    for (int i = 0; i < 2; ++i) { int R, C; stage_rc(tid * 16 + i * 8192, R, C); const int Rb = Epi::PERM ? ((R & ~31) + perm32(R & 31)) : R;
        voffA[i] = (unsigned)(R * K + C) * 2u; voffB[i] = (unsigned)(Rb * K + C) * 2u; }
    const size_t kstep = (size_t)(BK * 2);
    const size_t hstep = (size_t)HALF * K * 2;
    const size_t tstep = 2 * hstep;
    const unsigned ldsw = (unsigned)wid * 1024u;
    const int aoff = lds_byte(wr * 64 + fr, fq * 8), boff = lds_byte(wc * 32 + fr, fq * 8);
#define PG8_SA(b, h) (((b) * 2 + (h)) * HTB)
#define PG8_SB(b, h) ((4 + (b) * 2 + (h)) * HTB)
#define PG8_STAGE(bufoff, gbase, voff) do { _Pragma("unroll") for (int _i = 0; _i < 2; ++_i) \
        __builtin_amdgcn_global_load_lds((const unsigned*)((const char*)(gbase) + (voff)[_i]), (PG8_LAS unsigned*)(lds + (bufoff) + ldsw + _i * 8192), 16, 0, 0); } while (0)
#define PG8_LDA(dst, b, h) do { _Pragma("unroll") for (int m = 0; m < 4; ++m) _Pragma("unroll") for (int k = 0; k < 2; ++k) dst[m][k] = *(const PG8_LAS bf16x8*)(lds + PG8_SA(b, h) + aoff + m * 2048 + k * 1024); } while (0)
#define PG8_LDB(dst, b, h) do { _Pragma("unroll") for (int n = 0; n < 2; ++n) _Pragma("unroll") for (int k = 0; k < 2; ++k) dst[n][k] = *(const PG8_LAS bf16x8*)(lds + PG8_SB(b, h) + boff + n * 2048 + k * 1024); } while (0)
#define PG8_MMA(ai, bj, At, Bt) do { __builtin_amdgcn_s_setprio(1); _Pragma("unroll") for (int m = 0; m < 4; ++m) _Pragma("unroll") for (int n = 0; n < 2; ++n) _Pragma("unroll") for (int k = 0; k < 2; ++k) \
        acc[ai][bj][m][n] = __builtin_amdgcn_mfma_f32_16x16x32_bf16(Bt[n][k], At[m][k], acc[ai][bj][m][n], 0, 0, 0); __builtin_amdgcn_s_setprio(0); } while (0)
#define PG8_WAIT_V(n) asm volatile("s_waitcnt vmcnt(" #n ")" ::: "memory")
#define PG8_WAIT_L(n) asm volatile("s_waitcnt lgkmcnt(" #n ")" ::: "memory")
#define PG8_BAR __builtin_amdgcn_s_barrier()
#define PG8_SCHED __builtin_amdgcn_sched_barrier(0)
    Unit cur, nxt; int ui = 0;
    if (!S.next(0, cur)) return;
    f32x4 acc[2][2][4][2];
#pragma unroll
    for (int a = 0; a < 2; ++a)
#pragma unroll
        for (int b = 0; b < 2; ++b)
#pragma unroll
            for (int m = 0; m < 4; ++m)
#pragma unroll
                for (int n = 0; n < 2; ++n) acc[a][b][m][n] = (f32x4){0.f, 0.f, 0.f, 0.f};
    bf16x8 At[4][2], B0[2][2], B1[2][2];
    const char* cA = (const char*)g.A + (size_t)cur.pm * tstep; const char* cB = (const char*)g.Bt + (size_t)cur.pn * tstep;
    S.a_ready(cur);
    if constexpr (SP2) {
        PG8_STAGE(PG8_SB(0, 0), cB, voffB); PG8_STAGE(PG8_SB(0, 1), cB + hstep, voffB); PG8_STAGE(PG8_SA(0, 0), cA, voffA); PG8_STAGE(PG8_SA(0, 1), cA + hstep, voffA);
        if (wr == 1) PG8_BAR;
        PG8_WAIT_V(2); PG8_BAR;
        PG8_STAGE(PG8_SB(1, 0), cB + kstep, voffB); PG8_STAGE(PG8_SA(1, 0), cA + kstep, voffA); PG8_STAGE(PG8_SB(1, 1), cB + hstep + kstep, voffB);
        PG8_WAIT_V(6); PG8_BAR;
    } else {
        PG8_STAGE(PG8_SB(0, 0), cB, voffB); PG8_STAGE(PG8_SA(0, 0), cA, voffA); PG8_STAGE(PG8_SB(0, 1), cB + hstep, voffB); PG8_STAGE(PG8_SA(0, 1), cA + hstep, voffA);
        if (wr == 1) PG8_BAR;
        PG8_WAIT_V(4); PG8_BAR;
        PG8_STAGE(PG8_SB(1, 0), cB + kstep, voffB); PG8_STAGE(PG8_SA(1, 0), cA + kstep, voffA); PG8_STAGE(PG8_SB(1, 1), cB + hstep + kstep, voffB);
        PG8_WAIT_V(6); PG8_BAR;
    }
    for (;;) {
        const bool has_next = S.next(ui + 1, nxt);
        const char* nA = has_next ? (const char*)g.A + (size_t)nxt.pm * tstep : cA; const char* nB = has_next ? (const char*)g.Bt + (size_t)nxt.pn * tstep : cB;
        for (int t = 0; t < nt; t += 2) {
            const bool last = (t == nt - 2);
            const char* a1 = cA + (size_t)(t + 1) * kstep;
            const char* a2 = last ? nA : cA + (size_t)(t + 2) * kstep; const char* b2 = last ? nB : cB + (size_t)(t + 2) * kstep;
            const char* a3 = a2 + kstep; const char* b3 = b2 + kstep;
            if (last && has_next) S.a_ready(nxt);
            if constexpr (SP2) {
            PG8_LDB(B0, 0, 0); PG8_LDB(B1, 0, 1); PG8_SCHED; PG8_LDA(At, 0, 0); PG8_STAGE(PG8_SA(1, 1), a1 + hstep, voffA);
            PG8_WAIT_V(8); PG8_WAIT_L(0); PG8_BAR; PG8_MMA(0, 0, At, B0); PG8_MMA(0, 1, At, B1); PG8_BAR; PG8_SCHED;
            PG8_LDA(At, 0, 1); PG8_STAGE(PG8_SB(0, 0), b2, voffB); PG8_STAGE(PG8_SB(0, 1), b2 + hstep, voffB); PG8_STAGE(PG8_SA(0, 0), a2, voffA);
            PG8_WAIT_V(8); PG8_WAIT_L(0); PG8_BAR; PG8_MMA(1, 0, At, B0); PG8_MMA(1, 1, At, B1); PG8_BAR; PG8_SCHED;
            PG8_LDB(B0, 1, 0); PG8_LDB(B1, 1, 1); PG8_SCHED; PG8_LDA(At, 1, 0); PG8_STAGE(PG8_SA(0, 1), a2 + hstep, voffA);
            PG8_WAIT_V(8); PG8_WAIT_L(0); PG8_BAR; PG8_MMA(0, 0, At, B0); PG8_MMA(0, 1, At, B1); PG8_BAR; PG8_SCHED;
            PG8_LDA(At, 1, 1); PG8_STAGE(PG8_SB(1, 0), b3, voffB); PG8_STAGE(PG8_SB(1, 1), b3 + hstep, voffB); PG8_STAGE(PG8_SA(1, 0), a3, voffA);
            PG8_WAIT_V(8); PG8_WAIT_L(0); PG8_BAR; PG8_MMA(1, 0, At, B0); PG8_MMA(1, 1, At, B1); PG8_BAR; PG8_SCHED;
            } else {
            PG8_LDB(B0, 0, 0); PG8_SCHED; PG8_LDA(At, 0, 0); PG8_STAGE(PG8_SA(1, 1), a1 + hstep, voffA);
            PG8_WAIT_L(8); PG8_BAR; PG8_WAIT_L(0); PG8_MMA(0, 0, At, B0); PG8_BAR; PG8_SCHED;
            PG8_LDB(B1, 0, 1); PG8_STAGE(PG8_SB(0, 0), b2, voffB);
            PG8_BAR; PG8_WAIT_L(0); PG8_MMA(0, 1, At, B1); PG8_BAR;
            PG8_LDA(At, 0, 1); PG8_STAGE(PG8_SA(0, 0), a2, voffA);
            PG8_BAR; PG8_WAIT_L(0); PG8_MMA(1, 0, At, B0); PG8_BAR; PG8_SCHED;
            PG8_STAGE(PG8_SB(0, 1), b2 + hstep, voffB);
            PG8_WAIT_V(6); PG8_BAR; PG8_MMA(1, 1, At, B1); PG8_BAR;
            PG8_LDB(B0, 1, 0); PG8_SCHED; PG8_LDA(At, 1, 0); PG8_STAGE(PG8_SA(0, 1), a2 + hstep, voffA);
            PG8_WAIT_L(8); PG8_BAR; PG8_WAIT_L(0); PG8_MMA(0, 0, At, B0); PG8_BAR; PG8_SCHED;
            PG8_LDB(B1, 1, 1); PG8_STAGE(PG8_SB(1, 0), b3, voffB);
            PG8_BAR; PG8_WAIT_L(0); PG8_MMA(0, 1, At, B1); PG8_BAR;
            PG8_LDA(At, 1, 1); PG8_STAGE(PG8_SA(1, 0), a3, voffA);
            PG8_BAR; PG8_WAIT_L(0); PG8_MMA(1, 0, At, B0); PG8_BAR; PG8_SCHED;
            PG8_STAGE(PG8_SB(1, 1), b3 + hstep, voffB);
            PG8_WAIT_V(6); PG8_BAR; PG8_MMA(1, 1, At, B1); PG8_BAR;
            }
        }
        if constexpr (ALIGN_EPI) { if (wr == 0) PG8_BAR; }
        if constexpr (!Epi::AFTER_DRAIN) { E(acc, cur, wr, wc, fr, fq); S.done(cur); }
        if (!has_next) break;
#pragma unroll
        for (int a = 0; a < 2; ++a)
#pragma unroll
            for (int b = 0; b < 2; ++b)
#pragma unroll
                for (int m = 0; m < 4; ++m)
#pragma unroll
                    for (int n = 0; n < 2; ++n) acc[a][b][m][n] = (f32x4){0.f, 0.f, 0.f, 0.f};
        cur = nxt; cA = nA; cB = nB; ++ui;
        if constexpr (ALIGN_EPI) { if (wr == 1) PG8_BAR; }
    }
    PG8_WAIT_V(0);
    if constexpr (!ALIGN_EPI) { if (wr == 0) PG8_BAR; }
    PG8_BAR;
    if constexpr (Epi::AFTER_DRAIN) { E.fused(acc, cur, wr, wc, fr, fq, lds, wid, lane); S.done(cur); }
#undef PG8_SA
#undef PG8_SB
#undef PG8_STAGE
#undef PG8_LDA
#undef PG8_LDB
#undef PG8_MMA
#undef PG8_WAIT_V
#undef PG8_WAIT_L
#undef PG8_BAR
#undef PG8_SCHED
}
}

#ifndef PG8_SP2
#define PG8_SP2 true
#endif
#ifndef PG8_ALIGN
#define PG8_ALIGN true
#endif

namespace attn_body {
using bf16=__hip_bfloat16;
using bf16x8=__attribute__((ext_vector_type(8)))short;
using s16x4=__attribute__((ext_vector_type(4)))short;
using f32x16=__attribute__((ext_vector_type(16)))float;
using u32x4=__attribute__((ext_vector_type(4)))unsigned;
constexpr int BATCH=2,NHEAD=16,SEQ=8192,D=64,DM=NHEAD*D;
constexpr int NW=8,QBLK=32,QB=QBLK*NW,KVBLK=64,NQB=SEQ/QB;
constexpr int ATTN_PITCH=DM, ATTN_UNIT_ROWS=QB;
__device__ __forceinline__ int crow(int r,int hi){return (r&3)+8*(r>>2)+4*hi;}
#define SBAR() __builtin_amdgcn_sched_barrier(0)
__device__ __forceinline__ void cmask(f32x16&p0,f32x16&p1,int jb,int qrel,int hi){
  const float NEG=-INFINITY; int kb=64*jb+4*hi;
  #pragma unroll
  for(int r=0;r<16;++r){int kv=kb+(r&3)+8*(r>>2); if(kv>qrel)p0[r]=NEG; if(kv+32>qrel)p1[r]=NEG;}
}

constexpr int NSLOT=3, SLOTB=8192;
constexpr int LDS_K=0, LDS_V=NSLOT*SLOTB, LDS_WS=2*NSLOT*SLOTB, LDS_OST=LDS_WS+NW*64*4, LDS_BYTES=LDS_OST+NW*4096;
constexpr float C2=0.125f*1.4426950408889634f;
__device__ __forceinline__ void glds16(const void*gsrc,unsigned lds_dst){unsigned keep;
  asm volatile("s_mov_b32 %0, m0\n\ts_mov_b32 m0, %2\n\ts_nop 0\n\tglobal_load_lds_dwordx4 %1, off\n\ts_mov_b32 m0, %0":"=&s"(keep):"v"(gsrc),"s"(lds_dst):"memory");}
__device__ __forceinline__ float max3f(float a,float b,float c){float r;asm("v_max3_f32 %0, %1, %2, %3":"=v"(r):"v"(a),"v"(b),"v"(c));return r;}
__device__ __forceinline__ float max2f(float a,float b){float r;asm("v_max_f32_e32 %0, %1, %2":"=v"(r):"v"(a),"v"(b));return r;}
__device__ __forceinline__ float fadd_s(float a,float b){float r;asm("v_add_f32_e32 %0, %1, %2":"=v"(r):"v"(a),"v"(b));return r;}
__device__ __forceinline__ float fsub_s(float a,float b){float r;asm("v_sub_f32_e32 %0, %1, %2":"=v"(r):"v"(a),"v"(b));return r;}
typedef float f32x2_t __attribute__((ext_vector_type(2))); typedef __bf16 bf16x2_t __attribute__((ext_vector_type(2)));
__device__ __forceinline__ unsigned cvtpk_s(float lo,float hi){f32x2_t v={lo,hi};bf16x2_t b=__builtin_convertvector(v,bf16x2_t);return __builtin_bit_cast(unsigned,b);}
#define WAIT_BAR(N) asm volatile("s_waitcnt vmcnt(" #N ") lgkmcnt(0)\n\ts_barrier":::"memory")

__device__ __forceinline__ void qkt(f32x16&p0,f32x16&p1,const char*Kslot,const bf16x8*qr,const f32x16&negm,int r32,int hi,s16x4 ka0,s16x4 ka1,s16x4 qa){
  const char*kb=Kslot+hi*1024+r32*16;
  #pragma unroll
  for(int d0=0;d0<4;++d0){
    const bf16x8 b0=*reinterpret_cast<const bf16x8*>(kb+d0*2048);
    const bf16x8 b1=*reinterpret_cast<const bf16x8*>(kb+d0*2048+512);
    if(d0==0){p0=__builtin_amdgcn_mfma_f32_32x32x16_bf16(b0,qr[0],negm,0,0,0);p1=__builtin_amdgcn_mfma_f32_32x32x16_bf16(b1,qr[0],negm,0,0,0);}
    else{p0=__builtin_amdgcn_mfma_f32_32x32x16_bf16(b0,qr[d0],p0,0,0,0);p1=__builtin_amdgcn_mfma_f32_32x32x16_bf16(b1,qr[d0],p1,0,0,0);}}
  p0=__builtin_amdgcn_mfma_f32_32x32x8bf16_1k(ka0,qa,p0,0,0,0);p1=__builtin_amdgcn_mfma_f32_32x32x8bf16_1k(ka1,qa,p1,0,0,0);
}
typedef __attribute__((address_space(3))) const char* lds_cptr;
typedef short v4i16_t __attribute__((ext_vector_type(4)));
__device__ __forceinline__ void kload8(bf16x8*kf,lds_cptr kp){
  kf[0]=*(const __attribute__((address_space(3))) bf16x8*)(kp);      kf[1]=*(const __attribute__((address_space(3))) bf16x8*)(kp+512);
  kf[2]=*(const __attribute__((address_space(3))) bf16x8*)(kp+2048); kf[3]=*(const __attribute__((address_space(3))) bf16x8*)(kp+2560);
  kf[4]=*(const __attribute__((address_space(3))) bf16x8*)(kp+4096); kf[5]=*(const __attribute__((address_space(3))) bf16x8*)(kp+4608);
  kf[6]=*(const __attribute__((address_space(3))) bf16x8*)(kp+6144); kf[7]=*(const __attribute__((address_space(3))) bf16x8*)(kp+6656);
}
__device__ __forceinline__ void kload2(bf16x8*kf,lds_cptr kp,int j){ kf[2*j]=*(const __attribute__((address_space(3))) bf16x8*)(kp+j*2048); kf[2*j+1]=*(const __attribute__((address_space(3))) bf16x8*)(kp+j*2048+512); }
__device__ __forceinline__ s16x4 vtr(lds_cptr p){ return __builtin_bit_cast(s16x4,__builtin_amdgcn_ds_read_tr16_b64_v4i16((__attribute__((address_space(3))) v4i16_t*)p)); }
__device__ __forceinline__ float rowmax(const f32x16&p0,const f32x16&p1){
  float a=max3f(p0[0],p0[1],p1[0]),b=max3f(p0[2],p0[3],p1[1]);a=max3f(a,p1[2],p1[3]);
  #pragma unroll
  for(int r=4;r<16;r+=4){a=max3f(a,p0[r],p0[r+1]);b=max3f(b,p0[r+2],p0[r+3]);a=max3f(a,p1[r],p1[r+1]);b=max3f(b,p1[r+2],p1[r+3]);}
  const float m=max2f(a,b);
  auto rr=__builtin_amdgcn_permlane32_swap(__float_as_uint(m),__float_as_uint(m),false,false);
  return max2f(__uint_as_float(rr[0]),__uint_as_float(rr[1]));
}
__device__ __forceinline__ void pv(f32x16*o,int vb,bf16x8 pa0,bf16x8 pa1,bf16x8 pa2,bf16x8 pa3){
  #pragma unroll
  for(int d0=0;d0<2;++d0){s16x4 lo[4],hi[4];
    #pragma unroll
    for(int ks=0;ks<4;++ks){
      asm volatile("ds_read_b64_tr_b16 %0,%1 offset:%c2":"=&v"(lo[ks]):"v"(vb),"i"(d0*4096+ks*1024):"memory");
      asm volatile("ds_read_b64_tr_b16 %0,%1 offset:%c2":"=&v"(hi[ks]):"v"(vb),"i"(d0*4096+ks*1024+512):"memory");}
    asm volatile("s_waitcnt lgkmcnt(0)":::"memory");SBAR();
    #define PK(k) (bf16x8){lo[k][0],lo[k][1],lo[k][2],lo[k][3],hi[k][0],hi[k][1],hi[k][2],hi[k][3]}
    o[d0]=__builtin_amdgcn_mfma_f32_32x32x16_bf16(pa0,PK(0),o[d0],0,0,0);
    o[d0]=__builtin_amdgcn_mfma_f32_32x32x16_bf16(pa1,PK(1),o[d0],0,0,0);
    o[d0]=__builtin_amdgcn_mfma_f32_32x32x16_bf16(pa2,PK(2),o[d0],0,0,0);
    o[d0]=__builtin_amdgcn_mfma_f32_32x32x16_bf16(pa3,PK(3),o[d0],0,0,0);
    #undef PK
  }
}

#ifndef ATTN_STORE16
#define ATTN_STORE16(p,v) (*(u32x4*)(p)=(v))
#endif
template<int THRL> __device__ __forceinline__ void attn_unit(int b,int h,int qb,int t0,const bf16*Q,const bf16*__restrict__ K,const bf16*__restrict__ V,bf16*O,char*shm){
  const int tid=tid_fresh(),lane=tid&63,r32=lane&31,hi=lane>>5; const int wid=__builtin_amdgcn_readfirstlane(tid>>6);
  const long rowbase=(long)b*SEQ; const int q0=qb*QB;
  const bf16*Qw=Q+(rowbase+q0+wid*QBLK)*DM+h*D;
  const bf16*Kh=K+(rowbase+(long)t0*KVBLK)*DM+h*D,*Vh=V+(rowbase+(long)t0*KVBLK)*DM+h*D;
  const unsigned lds0=(unsigned)(uintptr_t)shm;
  float*wsf=(float*)(shm+LDS_WS)+wid*64;
  const bf16*ksrc=Kh+(long)lane*DM+wid*8;
  const bf16*vsrc=Vh+(long)(16*(wid&3)+(lane>>2))*DM+(wid>>2)*32+(lane&3)*8;
  const unsigned kdst=lds0+LDS_K+wid*1024, vdst=lds0+LDS_V+wid*1024;
  #define DMA_K(t,slot) glds16(ksrc+(long)(t)*KVBLK*DM,(unsigned)__builtin_amdgcn_readfirstlane(kdst+(slot)))
  #define DMA_V(t,slot) glds16(vsrc+(long)(t)*KVBLK*DM,(unsigned)__builtin_amdgcn_readfirstlane(vdst+(slot)))
  const int vb0=(int)(lds0+LDS_V)+((lane>>4)&1)*32+(lane&3)*8+(4*hi+((lane&15)>>2))*64;
  const char*Kbase=shm+LDS_K; bf16x8 kf[8];
  const lds_cptr shm3=(lds_cptr)shm; const lds_cptr kp0=shm3+LDS_K+hi*1024+r32*16; const lds_cptr vp0=shm3+LDS_V+((lane>>4)&1)*32+(lane&3)*8+(4*hi+((lane&15)>>2))*64;
  const int NT=(q0+QB)/KVBLK-t0;
  DMA_K(0,0);DMA_V(0,0);DMA_K(1,SLOTB);
  bf16x8 qr[4];
  #pragma unroll
  for(int d0=0;d0<4;++d0)qr[d0]=*reinterpret_cast<const bf16x8*>(&Qw[(long)r32*DM+d0*16+hi*8]);
  typedef __attribute__((address_space(3))) unsigned long long lds_u64;
  const lds_u64* const ctab=(const lds_u64*)(__attribute__((address_space(3))) char*)(shm+LDS_BYTES);
  float mhat; { const float h1_=__uint_as_float((unsigned)ctab[q0-t0*KVBLK+wid*QBLK+r32]<<16), a0_=h1_+48.0f; mhat=__uint_as_float((__float_as_uint(a0_)+0x7fffu+((__float_as_uint(a0_)>>16)&1u))&0xffff0000u);
    if(h1_>=8192.0f) mhat=h1_; }
  float l_reg=0.f;f32x16 o[2];o[0]=f32x16{};o[1]=f32x16{};const f32x16 negm=f32x16{};
  typedef short s16x4k __attribute__((ext_vector_type(4))); typedef unsigned u32x2k __attribute__((ext_vector_type(2)));
  u32x2k qaw=(u32x2k){hi==0?0x3F803F80u:0u,0u};
  #define SETQA() do{ qaw[1]=(hi==0)?(0x3F80u|(((__float_as_uint(mhat)>>16)^0x8000u)<<16)):0u; }while(0)
  #define QAUG __builtin_bit_cast(s16x4k,qaw)
  #define MFA8(a_,b_,c_) __builtin_amdgcn_mfma_f32_32x32x8bf16_1k(a_,b_,c_,0,0,0)
  #define RNDBF(x_) __uint_as_float((__float_as_uint(x_)+0x7fffu+((__float_as_uint(x_)>>16)&1u))&0xffff0000u)
  SETQA();
  #define KAUG(t_,A0,A1) do{ const lds_u64* cp_=ctab+(t_)*KVBLK+r32; const unsigned long long w0_=cp_[0],w1_=cp_[32]; \
    A0=__builtin_bit_cast(s16x4k,w0_); A1=__builtin_bit_cast(s16x4k,w1_); }while(0)
  const int qrel=wid*QBLK+r32;
  #define CMASK(P0,P1,t) do{int jb_=(t)-(NT-4); if(jb_>=0)cmask(P0,P1,jb_,qrel,hi);}while(0)
  bool resc=false;
  #define START(P0,P1) do{ const float rm=rowmax(P0,P1); resc=false; \
    if(__builtin_expect(__any(rm>(float)THRL),0)){ const float rn_=mhat+__builtin_fmaxf(rm,0.f); const float mn_=RNDBF(rn_); const float dl=mn_-mhat; mhat=mn_; SETQA(); \
      _Pragma("unroll") for(int r=0;r<16;++r){P0[r]-=dl;P1[r]-=dl;} \
      } \
    _Pragma("unroll") for(int r=0;r<16;++r)P0[r]=__builtin_amdgcn_exp2f(P0[r]); }while(0)
  #define RESC() do{ if(resc){ asm volatile("s_waitcnt lgkmcnt(0)":::"memory"); \
      _Pragma("unroll") for(int d_=0;d_<2;++d_) _Pragma("unroll") for(int r=0;r<16;++r)o[d_][r]*=wsf[crow(r,hi)]; } }while(0)
  f32x16 pA0,pA1,pB0,pB1;
  int sl_prev=0,sl_cur=0,sl_next=SLOTB;
  #define ROT() do{sl_prev=sl_cur;sl_cur=sl_next;sl_next=(sl_next==(NSLOT-1)*SLOTB)?0:sl_next+SLOTB;}while(0)
  DMA_K(2,2*SLOTB);
  WAIT_BAR(3);
  { s16x4k ka0_,ka1_; KAUG(0,ka0_,ka1_); qkt(pA0,pA1,Kbase,qr,negm,r32,hi,ka0_,ka1_,QAUG); } asm volatile("s_nop 15\n\ts_nop 7":"+v"(pA0),"+v"(pA1));CMASK(pA0,pA1,0);
  START(pA0,pA1);
  _Pragma("unroll") for(int r=0;r<16;++r)pA1[r]=__builtin_amdgcn_exp2f(pA1[r]);
  WAIT_BAR(0);
  DMA_K(3,0);DMA_V(1,SLOTB);
  ROT();
  kload8(kf,kp0+sl_cur);
  WAIT_BAR(2);
  s16x4 vlo[8],vhi[8]; u32x4 pw0,pw1,pw2,pw3;
  #define PKW(P,B) cvtpk_s(P[B],P[B+1])
  #define PAF(k) __builtin_bit_cast(bf16x8,pw##k)
  #define VFR(i) (bf16x8){vlo[i][0],vlo[i][1],vlo[i][2],vlo[i][3],vhi[i][0],vhi[i][1],vhi[i][2],vhi[i][3]}
  #define PIN(x) asm volatile("":"+v"(x))
  #define MX3(a,b,c) __builtin_fmaxf(__builtin_fmaxf((a),(b)),(c))
  #define GAPA(MF,A0,A1,A2,A3,W0,W1,PW) do{ MF; sacc+=A0; sacc+=A1; sacc+=A2; sacc+=A3; PIN(sacc); W0; W1; PIN(PW); SBAR(); }while(0)
  #define EX(v) __builtin_amdgcn_exp2f(v)
  #define GAPB(MF,X,B) do{ MF; X[B]=EX(X[B]); X[B+1]=EX(X[B+1]); X[B+2]=EX(X[B+2]); X[B+3]=EX(X[B+3]); PIN(X); SBAR(); }while(0)
  #define VRD(i) do{ vlo[i]=vtr(vp_+(((i)>>2)*4096+((i)&3)*1024)); vhi[i]=vtr(vp_+(((i)>>2)*4096+((i)&3)*1024+512)); }while(0)
  #define KRD(G,j) do{ if(G){ kload2(kf,kp0+sl_next,j); SBAR(); } }while(0)
  #define STEP(C0,C1,P0,P1,t,GK,GV,GL) do{ SBAR(); \
    const lds_cptr vp_=vp0+sl_prev; s16x4k ka0_,ka1_; \
    VRD(0); SBAR(); float sacc=(P0[0]+P0[1]); \
    GAPA(C0=__builtin_amdgcn_mfma_f32_32x32x16_bf16(kf[0],qr[0],negm,0,0,0), P0[2],P0[3],P0[4],P0[5],     pw0[0]=PKW(P0,0), pw0[1]=PKW(P0,2), pw0); \
    VRD(4); SBAR(); GAPA(C1=__builtin_amdgcn_mfma_f32_32x32x16_bf16(kf[1],qr[0],negm,0,0,0), P0[6],P0[7],P0[8],P0[9],     pw0[2]=PKW(P0,4), pw0[3]=PKW(P0,6), pw0); \
    VRD(1); SBAR(); GAPA(C0=__builtin_amdgcn_mfma_f32_32x32x16_bf16(kf[2],qr[1],C0,0,0,0),   P0[10],P0[11],P0[12],P0[13], pw1[0]=PKW(P0,8), pw1[1]=PKW(P0,10), pw1); \
    VRD(5); SBAR(); GAPA(C1=__builtin_amdgcn_mfma_f32_32x32x16_bf16(kf[3],qr[1],C1,0,0,0),   P0[14],P0[15],P1[0],P1[1],   pw1[2]=PKW(P0,12),pw1[3]=PKW(P0,14), pw1); \
    VRD(2); SBAR(); GAPA(C0=__builtin_amdgcn_mfma_f32_32x32x16_bf16(kf[4],qr[2],C0,0,0,0),   P1[2],P1[3],P1[4],P1[5],     pw2[0]=PKW(P1,0), pw2[1]=PKW(P1,2), pw2); \
    VRD(6); SBAR(); GAPA(C1=__builtin_amdgcn_mfma_f32_32x32x16_bf16(kf[5],qr[2],C1,0,0,0),   P1[6],P1[7],P1[8],P1[9],     pw2[2]=PKW(P1,4), pw2[3]=PKW(P1,6), pw2); \
    VRD(3); SBAR(); GAPA(C0=__builtin_amdgcn_mfma_f32_32x32x16_bf16(kf[6],qr[3],C0,0,0,0),   P1[10],P1[11],P1[12],P1[13], pw3[0]=PKW(P1,8), pw3[1]=PKW(P1,10), pw3); \
    VRD(7); KAUG(t,ka0_,ka1_); SBAR(); GAPA(C1=__builtin_amdgcn_mfma_f32_32x32x16_bf16(kf[7],qr[3],C1,0,0,0),   P1[14],P1[15],0.f,0.f,       pw3[2]=PKW(P1,12),pw3[3]=PKW(P1,14), pw3); \
    C0=MFA8(ka0_,QAUG,C0); C1=MFA8(ka1_,QAUG,C1); \
    l_reg+=sacc; \
    if(GK){DMA_K((t)+3,sl_cur);} if(GV){DMA_V((t)+1,sl_next);} \
    CMASK(C0,C1,t); \
    { float a=MX3(C0[0],C0[1],C1[0]),b=MX3(C0[2],C0[3],C1[1]); a=MX3(a,C1[2],C1[3]); \
      _Pragma("unroll") for(int r=4;r<16;r+=4){a=MX3(a,C0[r],C0[r+1]);b=MX3(b,C0[r+2],C0[r+3]);a=MX3(a,C1[r],C1[r+1]);b=MX3(b,C1[r+2],C1[r+3]);} \
      float rm=__builtin_fmaxf(a,b); { auto rr=__builtin_amdgcn_permlane32_swap(__float_as_uint(rm),__float_as_uint(rm),false,false); rm=__builtin_fmaxf(__uint_as_float(rr[0]),__uint_as_float(rr[1])); } \
      resc=false; \
      if(__builtin_expect(__any(rm>(float)THRL),0)){ const float rn_=mhat+__builtin_fmaxf(rm,0.f); const float mn_=RNDBF(rn_); const float dl=mn_-mhat; mhat=mn_; SETQA(); \
        _Pragma("unroll") for(int r=0;r<16;++r){C0[r]-=dl;C1[r]-=dl;} \
        const float f=__builtin_amdgcn_exp2f(-dl); l_reg*=f; if(hi==0)wsf[r32]=f; resc=true; } } \
    SBAR(); \
    GAPB(o[0]=__builtin_amdgcn_mfma_f32_32x32x16_bf16(PAF(0),VFR(0),o[0],0,0,0), C0,0); \
    GAPB(o[1]=__builtin_amdgcn_mfma_f32_32x32x16_bf16(PAF(0),VFR(4),o[1],0,0,0), C0,4); \
    KRD(GL,0); GAPB(o[0]=__builtin_amdgcn_mfma_f32_32x32x16_bf16(PAF(1),VFR(1),o[0],0,0,0), C0,8); \
    KRD(GL,1); GAPB(o[1]=__builtin_amdgcn_mfma_f32_32x32x16_bf16(PAF(1),VFR(5),o[1],0,0,0), C0,12); \
    KRD(GL,2); GAPB(o[0]=__builtin_amdgcn_mfma_f32_32x32x16_bf16(PAF(2),VFR(2),o[0],0,0,0), C1,0); \
    KRD(GL,3); GAPB(o[1]=__builtin_amdgcn_mfma_f32_32x32x16_bf16(PAF(2),VFR(6),o[1],0,0,0), C1,4); \
    GAPB(o[0]=__builtin_amdgcn_mfma_f32_32x32x16_bf16(PAF(3),VFR(3),o[0],0,0,0), C1,8); \
    GAPB(o[1]=__builtin_amdgcn_mfma_f32_32x32x16_bf16(PAF(3),VFR(7),o[1],0,0,0), C1,12); \
    }while(0)
  int t=1;
  #undef CMASK
  #define CMASK(P0,P1,t) do{}while(0)
  for(;t+5<NT;t+=2){
    STEP(pB0,pB1,pA0,pA1,t,true,true,true);     WAIT_BAR(2); RESC(); ROT();
    STEP(pA0,pA1,pB0,pB1,t+1,true,true,true);   WAIT_BAR(2); RESC(); ROT();
  }
  #undef CMASK
  #define CMASK(P0,P1,t) do{int jb_=(t)-(NT-4); if(jb_>=0)cmask(P0,P1,jb_,qrel,hi);}while(0)
  #define ENDW(tt) do{ if((tt)+3<NT){WAIT_BAR(2);} else if((tt)+2<NT){WAIT_BAR(1);} else {WAIT_BAR(0);} }while(0)
  for(;t+1<NT;t+=2){
    STEP(pB0,pB1,pA0,pA1,t,(t+3<NT),(t+1<NT),(t+1<NT));       ENDW(t);   RESC(); ROT();
    STEP(pA0,pA1,pB0,pB1,t+1,(t+4<NT),(t+2<NT),(t+2<NT));     ENDW(t+1); RESC(); ROT();
  }
  STEP(pB0,pB1,pA0,pA1,NT-1,false,false,false); RESC();
  { float sacc=pB0[0]+pB0[1]; _Pragma("unroll") for(int r=2;r<16;++r)sacc+=pB0[r]; _Pragma("unroll") for(int r=0;r<16;++r)sacc+=pB1[r]; l_reg+=sacc;
    pw0=(u32x4){PKW(pB0,0),PKW(pB0,2),PKW(pB0,4),PKW(pB0,6)};pw1=(u32x4){PKW(pB0,8),PKW(pB0,10),PKW(pB0,12),PKW(pB0,14)};pw2=(u32x4){PKW(pB1,0),PKW(pB1,2),PKW(pB1,4),PKW(pB1,6)};pw3=(u32x4){PKW(pB1,8),PKW(pB1,10),PKW(pB1,12),PKW(pB1,14)};
    SBAR(); pv(o,vb0+sl_cur,PAF(0),PAF(1),PAF(2),PAF(3)); }
  #undef PKW
  #undef PAF
  #undef VFR
  #undef PIN
  #undef MX3
  #undef GAPA
  #undef GAPB
  #undef EX
  #undef VRD
  #undef KRD
  #undef STEP
  #undef ENDW
  {auto rr=__builtin_amdgcn_permlane32_swap(__float_as_uint(l_reg),__float_as_uint(l_reg),false,false);l_reg=__uint_as_float(rr[0])+__uint_as_float(rr[1]);}
  if(hi==0)wsf[32+r32]=l_reg;asm volatile("s_waitcnt lgkmcnt(0)":::"memory");
  float rli[16];
  #pragma unroll
  for(int r=0;r<16;++r)rli[r]=__builtin_amdgcn_rcpf(wsf[32+crow(r,hi)]);
  bf16*Ow=O+(rowbase+q0+wid*QBLK)*DM+h*D;
  { bf16*stg=(bf16*)(shm+LDS_OST)+wid*2048;
    #pragma unroll
    for(int r=0;r<16;++r){const int orow=crow(r,hi);
      #pragma unroll
      for(int d0=0;d0<2;++d0)stg[orow*64+d0*32+r32]=__float2bfloat16(o[d0][r]*rli[r]);}
    asm volatile("s_waitcnt lgkmcnt(0)":::"memory");
    #pragma unroll
    for(int i=0;i<4;++i){const int row=i*8+(lane>>3),ch=lane&7; const u32x4 v=*(const u32x4*)(stg+row*64+ch*8); ATTN_STORE16(Ow+(long)row*DM+ch*8,v);} }
  asm volatile("s_waitcnt lgkmcnt(0)\n\ts_barrier":::"memory");
  #undef KAUG
  #undef SETQA
  #undef QAUG
  #undef RNDBF
  #undef MFA8
  #undef DMA_K
  #undef DMA_V
  #undef CMASK
  #undef START
  #undef RESC
  #undef ROT
}
constexpr int ATTN_LDS_BYTES=LDS_BYTES+SEQ*8+16;
struct AttnTensors { const bf16* Q; const bf16* K; const bf16* V; bf16* O; const unsigned long long* CAUG; };
struct AttnUnit { int bh; int qb; };
struct StaticOrder {
  int vcu;
  __device__ __forceinline__ explicit StaticOrder(int grid,int block):vcu((block%8)*(grid/8)+block/8){}
  __device__ __forceinline__ bool next(int i,AttnUnit&u)const{ if(i>=4)return false; const int s=vcu&7; u.bh=vcu>>3; u.qb=(i==0)?s:(i==1)?15-s:(i==2)?16+s:31-s; return true; }
  __device__ __forceinline__ void a_ready(const AttnUnit&)const{}
  __device__ __forceinline__ void done(const AttnUnit&)const{}
};
__device__ __forceinline__ unsigned f2bf_rne(float f){unsigned u=__float_as_uint(f);return (u+0x7fffu+((u>>16)&1u))>>16;}
__device__ __forceinline__ void fox_scan(char*lds,const float*__restrict__ lf,unsigned long long*__restrict__ tab){
  typedef __attribute__((address_space(3))) double lds_f64;
  lds_f64* sums=(lds_f64*)(__attribute__((address_space(3))) char*)lds;
  const int tid=tid_fresh(); double acc=0.0;
  #pragma unroll
  for(int i=0;i<16;++i)acc+=(double)lf[tid*16+i];
  sums[tid]=acc; __syncthreads();
  double run=0.0; for(int i=0;i<tid;++i)run+=sums[i];
  #pragma unroll 1
  for(int i=0;i<16;++i){ run+=(double)lf[tid*16+i]; const float nv=(float)(run*-1.4426950408889634);
    const unsigned h1=f2bf_rne(nv); const float r1=nv-__uint_as_float(h1<<16); const unsigned h2=f2bf_rne(r1); const float r2=r1-__uint_as_float(h2<<16); const unsigned h3=f2bf_rne(r2);
    tab[tid*16+i]=(unsigned long long)(h1|(h2<<16))|((unsigned long long)(h3|0x3F800000u)<<32); }
  __syncthreads();
}
__device__ __forceinline__ float caug_val(unsigned long long w){ return (__uint_as_float((unsigned)w<<16)+__uint_as_float((unsigned)w&0xffff0000u))+__uint_as_float((unsigned)(w>>32)<<16); }
constexpr float SKIP_TH=72.0f;
template<int THRL=8> __device__ __forceinline__ void attn_phase_dyn(char*lds,const AttnTensors&T,unsigned*ctr){
  typedef __attribute__((address_space(3))) unsigned long long lds_u64; typedef __attribute__((address_space(3))) int lds_i32;
  lds_i32* slotw=(lds_i32*)(__attribute__((address_space(3))) char*)(lds+LDS_BYTES+SEQ*8);
  lds_u64* tab=(lds_u64*)(__attribute__((address_space(3))) char*)(lds+LDS_BYTES);
  for(;;){
    const int tid=tid_fresh();
    if(tid==0){ slotw[0]=(int)__hip_atomic_fetch_add(ctr,1u,__ATOMIC_RELAXED,__HIP_MEMORY_SCOPE_AGENT); slotw[1]=0; }
    __syncthreads();
    const int slot=__builtin_amdgcn_readfirstlane(slotw[0]);
    if(slot>=BATCH*NHEAD*NQB) break;
    const int qb=NQB-1-(slot>>5), bh=slot&31, q0=qb*QB, NTF=(q0+QB)/KVBLK;
    const unsigned long long* cg=T.CAUG+(long)bh*SEQ;
    const float lim=caug_val(cg[q0])-SKIP_TH;
    if(tid<NTF-4){ const bool p0_=caug_val(cg[tid*KVBLK+KVBLK-1])<lim, p1_=(tid+1<NTF-4)&&(caug_val(cg[(tid+1)*KVBLK+KVBLK-1])<lim);
      if(p0_&&!p1_) slotw[1]=tid+1; }
    __syncthreads();
    const int nskip=__builtin_amdgcn_readfirstlane(slotw[1]);
    const int t0=nskip&~1;
    for(int i=tid;i<(NTF-t0)*KVBLK;i+=NW*64) tab[i]=cg[t0*KVBLK+i];
    __syncthreads();
    attn_unit<THRL>(bh/NHEAD,bh%NHEAD,qb,t0,T.Q,T.K,T.V,T.O,lds);
  }
}
#undef SBAR
#undef WAIT_BAR
}

namespace swa {
constexpr int D = 128; constexpr float THR = 8.f; constexpr bool WSKIP = true;
constexpr float SCALE = 0.08838834764831845f;
constexpr int NW = 8, QBLK = 32, KVBLK = 64, QB = NW * QBLK;
constexpr int SHM_V = KVBLK * D * 2, SHM_K = KVBLK * D * 2;
constexpr int LDS_BYTES = 2 * SHM_V + 2 * SHM_K + NW * 64 * 4;

using bf16 = __hip_bfloat16;
typedef short bf16x8 __attribute__((ext_vector_type(8)));
typedef short s16x4 __attribute__((ext_vector_type(4)));
typedef float f32x16 __attribute__((ext_vector_type(16)));
typedef float f32x4 __attribute__((ext_vector_type(4)));
typedef unsigned u32x4 __attribute__((ext_vector_type(4)));
template <class A, class Bt> struct same_t { static constexpr bool v = false; };
template <class A> struct same_t<A, A> { static constexpr bool v = true; };

#define KSWZ(row, colB) ((row) * 256 + ((colB) ^ (((row) & 7) << 4)))
#define SBAR() __builtin_amdgcn_sched_barrier(0)
__device__ __forceinline__ int v_st(int k, int c) { const int kk = (k & ~0xC) | ((k & 4) << 1) | ((k & 8) >> 1); return ((kk >> 3) * 4 + (c >> 5)) * 512 + ((kk & 7) * 32 + (c & 31)) * 2; }
__device__ __forceinline__ int v_rd_base(int lane) { return ((lane & 3) << 3) | (((lane >> 2) & 3) << 6) | (((lane >> 4) & 1) << 5) | (((lane >> 5) & 1) << 8); }
constexpr int v_rd_off(int d0, int ks, int half) { return d0 * 512 + ks * 4096 + half * 2048; }
__device__ __forceinline__ int crow(int r, int hi) { return (r & 3) + 8 * (r >> 2) + 4 * hi; }
__device__ __forceinline__ unsigned cvtpk(float lo, float hi) {
    unsigned r; asm volatile("v_cvt_pk_bf16_f32 %0, %1, %2" : "=v"(r) : "v"(lo), "v"(hi)); return r;
}
__device__ __forceinline__ bf16x8 pack8(f32x4 a, f32x4 b) {
    u32x4 w = {cvtpk(a[0], a[1]), cvtpk(a[2], a[3]), cvtpk(b[0], b[1]), cvtpk(b[2], b[3])};
    return *reinterpret_cast<bf16x8*>(&w);
}
template <class T> __device__ __forceinline__ bf16x8 load8(const T* p) {
    if constexpr (same_t<T, float>::v) { return pack8(*(const f32x4*)p, *(const f32x4*)(p + 4)); }
    else { return *reinterpret_cast<const bf16x8*>(p); }
}
__device__ __forceinline__ void mask_tile(f32x16& p0, f32x16& p1, int dq, unsigned W) {
    const float NEG = -__builtin_inff();
#pragma unroll
    for (int r = 0; r < 16; ++r) {
        const int c = (r & 3) + 8 * (r >> 2);
        if ((unsigned)(dq - c) >= W) p0[r] = NEG;
        if ((unsigned)(dq - c - 32) >= W) p1[r] = NEG;
    }
}
__device__ __forceinline__ void partialSM(f32x16& p0, f32x16& p1, float& m_reg, float& mn, float& alpha) {
    float pmax = p0[0]; for (int r = 1; r < 16; ++r) pmax = fmaxf(pmax, p0[r]); for (int r = 0; r < 16; ++r) pmax = fmaxf(pmax, p1[r]);
    { auto rr = __builtin_amdgcn_permlane32_swap(__float_as_uint(pmax), __float_as_uint(pmax), false, false);
      pmax = fmaxf(__uint_as_float(rr[0]), __uint_as_float(rr[1])); }
    constexpr float C2 = 1.4426950408889634f * SCALE;
    if (__builtin_expect(__all((pmax - m_reg) * SCALE <= THR), 1)) { mn = m_reg; alpha = 1.f; }
    else { mn = fmaxf(m_reg, pmax); alpha = __builtin_amdgcn_exp2f((m_reg - mn) * C2); m_reg = mn; }
    const float mnL = -mn * C2;
    for (int r = 0; r < 16; ++r) p0[r] = fmaf(p0[r], C2, mnL); for (int r = 0; r < 16; ++r) p1[r] = fmaf(p1[r], C2, mnL);
    for (int r = 0; r < 16; ++r) p0[r] = __builtin_amdgcn_exp2f(p0[r]);
}
__device__ __forceinline__ void finishSM(f32x16& p0, f32x16& p1, float alpha, float& l_reg, bf16x8& pa0, bf16x8& pa1, bf16x8& pa2, bf16x8& pa3) {
    for (int r = 0; r < 16; ++r) p1[r] = __builtin_amdgcn_exp2f(p1[r]);
    float ps = 0; for (int r = 0; r < 16; ++r) ps += p0[r]; for (int r = 0; r < 16; ++r) ps += p1[r];
    { auto rr = __builtin_amdgcn_permlane32_swap(__float_as_uint(ps), __float_as_uint(ps), false, false);
      ps = __uint_as_float(rr[0]) + __uint_as_float(rr[1]); }
    l_reg = l_reg * alpha + ps;
#define PK4(P, B_, OUT) do { unsigned a0 = cvtpk(P[B_+0], P[B_+1]), a1 = cvtpk(P[B_+2], P[B_+3]);                          \
        unsigned b0 = cvtpk(P[B_+4], P[B_+5]), b1 = cvtpk(P[B_+6], P[B_+7]);                                             \
        auto r0 = __builtin_amdgcn_permlane32_swap(a0, b0, false, false); auto r1 = __builtin_amdgcn_permlane32_swap(a1, b1, false, false); \
        u32x4 w = {r0[0], r1[0], r0[1], r1[1]}; OUT = *reinterpret_cast<bf16x8*>(&w); } while (0)
    PK4(p0, 0, pa0); PK4(p0, 8, pa1); PK4(p1, 0, pa2); PK4(p1, 8, pa3);
#undef PK4
}
template <int KB, bool SK>
__device__ __forceinline__ void qkt(f32x16& p0, f32x16& p1, const char* K_lds, int r32, int hi, const bf16x8* qr, bool act) {
    if (SK && !act) { const float NEG = -__builtin_inff();
#pragma unroll
        for (int r = 0; r < 16; ++r) { p0[r] = NEG; p1[r] = NEG; } return; }
    p0 = f32x16{}; p1 = f32x16{};
    const char* kb[4];
#pragma unroll
    for (int dd = 0; dd < 4; ++dd) kb[dd] = K_lds + KB * SHM_K + KSWZ(r32, (dd * 16 + hi * 8) * 2);
#pragma unroll
    for (int d0 = 0; d0 < 8; ++d0) { const char* a = kb[d0 & 3] + (d0 >> 2) * 128;
        bf16x8 b0 = *reinterpret_cast<const bf16x8*>(a);
        bf16x8 b1 = *reinterpret_cast<const bf16x8*>(a + 32 * 256);
        p0 = __builtin_amdgcn_mfma_f32_32x32x16_bf16(b0, qr[d0], p0, 0, 0, 0);
        p1 = __builtin_amdgcn_mfma_f32_32x32x16_bf16(b1, qr[d0], p1, 0, 0, 0); }
}
template <int VB, bool SK>
__device__ __forceinline__ void pv_tile(f32x16* o, int vb0, bf16x8 pa0, bf16x8 pa1, bf16x8 pa2, bf16x8 pa3, bool act) {
    if (SK && !act) return;
#define TRRD(dst, off) asm volatile("ds_read_b64_tr_b16 %0, %1 offset:%2" : "=&v"(dst) : "v"(vb0), "i"(off) : "memory")
#define PV_D0(d0) do { s16x4 l0, l1, l2, l3, h0, h1, h2, h3; constexpr int b_ = VB * SHM_V + v_rd_off(d0, 0, 0);     \
        TRRD(l0, b_); TRRD(h0, b_ + 2048); TRRD(l1, b_ + 4096); TRRD(h1, b_ + 6144); TRRD(l2, b_ + 8192); TRRD(h2, b_ + 10240); TRRD(l3, b_ + 12288); TRRD(h3, b_ + 14336); \
        asm volatile("s_waitcnt lgkmcnt(0)" ::: "memory"); SBAR();                 \
        o[d0] = __builtin_amdgcn_mfma_f32_32x32x16_bf16(pa0, (bf16x8){l0[0], l0[1], l0[2], l0[3], h0[0], h0[1], h0[2], h0[3]}, o[d0], 0, 0, 0);   \
        o[d0] = __builtin_amdgcn_mfma_f32_32x32x16_bf16(pa1, (bf16x8){l1[0], l1[1], l1[2], l1[3], h1[0], h1[1], h1[2], h1[3]}, o[d0], 0, 0, 0);   \
        o[d0] = __builtin_amdgcn_mfma_f32_32x32x16_bf16(pa2, (bf16x8){l2[0], l2[1], l2[2], l2[3], h2[0], h2[1], h2[2], h2[3]}, o[d0], 0, 0, 0);   \
        o[d0] = __builtin_amdgcn_mfma_f32_32x32x16_bf16(pa3, (bf16x8){l3[0], l3[1], l3[2], l3[3], h3[0], h3[1], h3[2], h3[3]}, o[d0], 0, 0, 0); } while (0)
    PV_D0(0); PV_D0(1); PV_D0(2); PV_D0(3);
#undef PV_D0
#undef TRRD
}

template <class TIn, class TOut> struct BlockRef { const TIn* Q; const TIn* K; const TIn* V; TOut* O; int P0; int qp, kp, op; float* L; int lp; };
template <class TIn> struct Seam {
    bf16x8 qr[8];
    bf16x8 st_v0, st_v1, st_k0, st_k1; f32x4 sf0, sf1, sf2, sf3;
    f32x4 tq[16];
};
__device__ __forceinline__ int swa_jlo(int P0, int W) { const int lowk = P0 - W + 1; return lowk > 0 ? lowk / KVBLK : 0; }
#define ROW(p, k0, rr) ((p) + (size_t)((k0) + (rr)) * D + sc)
#define VMW() asm volatile("s_waitcnt vmcnt(0)" ::: "memory")
#define VMWN(n) asm volatile("s_waitcnt vmcnt(%0)" :: "i"(n) : "memory")
#define ROWP(p, k0, rr, pt) ((const TIn*)((const char*)(p) + (unsigned)((((k0) + (rr)) * (pt) + sc) * 2)))
#define SLOAD_H(Kp, Vp, k0, pt) do { S.st_v0 = load8<TIn>(ROWP(Vp, k0, sr, pt)); S.st_v1 = load8<TIn>(ROWP(Vp, k0, 32 + sr, pt));              \
                         S.st_k0 = load8<TIn>(ROWP(Kp, k0, sr, pt)); S.st_k1 = load8<TIn>(ROWP(Kp, k0, 32 + sr, pt)); } while (0)
#define SWRITE_HK(bf) do { *(bf16x8*)(K_lds + (bf) * SHM_K + kws) = S.st_k0; *(bf16x8*)(K_lds + (bf) * SHM_K + kws + 32 * 256) = S.st_k1; } while (0)
#define SWRITE_HV(bf) do { *(bf16x8*)(V_lds + (bf) * SHM_V + vst0) = S.st_v0; *(bf16x8*)(V_lds + (bf) * SHM_V + vst1) = S.st_v1; } while (0)
#define SWRITE_H(bf) do { SWRITE_HV(bf); SWRITE_HK(bf); } while (0)
#define SLOAD_F(p, k0) do { S.sf0 = *(const f32x4*)ROW(p, k0, sr); S.sf1 = *(const f32x4*)(ROW(p, k0, sr) + 4);                \
                            S.sf2 = *(const f32x4*)ROW(p, k0, 32 + sr); S.sf3 = *(const f32x4*)(ROW(p, k0, 32 + sr) + 4); } while (0)
#define SWRITE_KF(bf) do { *(bf16x8*)(K_lds + (bf) * SHM_K + kws) = pack8(S.sf0, S.sf1); *(bf16x8*)(K_lds + (bf) * SHM_K + kws + 32 * 256) = pack8(S.sf2, S.sf3); } while (0)
#define SWRITE_VF(bf) do { *(bf16x8*)(V_lds + (bf) * SHM_V + vst0) = pack8(S.sf0, S.sf1); *(bf16x8*)(V_lds + (bf) * SHM_V + vst1) = pack8(S.sf2, S.sf3); } while (0)
template <class TIn, class TOut>
__device__ __forceinline__ void causal_swa_prime(const BlockRef<TIn, TOut>& cur, int W, char* lds, Seam<TIn>& S) {
    constexpr bool F32 = same_t<TIn, float>::v;
    const int tid = tid_fresh(), wid = __builtin_amdgcn_readfirstlane(tid >> 6), lane = tid & 63, r32 = lane & 31, hi = lane >> 5;
    const int sr = tid >> 4, sc = (tid & 15) * 8, kws = KSWZ(sr, sc * 2); char* K_lds = lds + 2 * SHM_V;
    const int kb0 = swa_jlo(cur.P0, W) * KVBLK;
    for (int d0 = 0; d0 < 8; ++d0) S.qr[d0] = load8<TIn>((const TIn*)((const char*)cur.Q + (unsigned)(((wid * QBLK + r32) * cur.qp + hi * 8) * 2) + d0 * 32));
    if constexpr (F32) { SLOAD_F((const float*)cur.K, kb0); VMW(); SWRITE_KF(0); SBAR(); SLOAD_F((const float*)cur.V, kb0); }
    else { SLOAD_H(cur.K, cur.V, kb0, cur.kp); VMW(); SWRITE_HK(0); }
    __syncthreads();
}
template <class TIn, class TOut>
__device__ __forceinline__ void causal_swa_block(const BlockRef<TIn, TOut>& cur, const BlockRef<TIn, TOut>& nxt, int skv, int W, char* lds, Seam<TIn>& S) {
    constexpr bool F32 = same_t<TIn, float>::v;
    const int tid = tid_fresh(), wid = __builtin_amdgcn_readfirstlane(tid >> 6), lane = tid & 63, r32 = lane & 31, hi = lane >> 5;
    const int j_lo = swa_jlo(cur.P0, W);
    int j_hi = (cur.P0 + QB - 1) / KVBLK + 1; if (j_hi > skv / KVBLK) j_hi = skv / KVBLK;
    const int NT = j_hi - j_lo;
    const int kbn = swa_jlo(nxt.P0, W) * KVBLK;
    const int qlo = cur.P0 + wid * QBLK, qm = qlo + r32 - 4 * hi;
    char* V_lds = lds; char* K_lds = lds + 2 * SHM_V;
    float* ws = (float*)(lds + 2 * SHM_V + 2 * SHM_K) + wid * 64; float* li_l = ws, * al_l = ws + 32;
    float m_reg = -1e30f, l_reg = 0; f32x16 o[4] = {};
    const int sr = tid >> 4, sc = (tid & 15) * 8, vst0 = v_st(sr, sc), vst1 = v_st(32 + sr, sc), kws = KSWZ(sr, sc * 2);
    const int vb0 = (int)(uintptr_t)V_lds + v_rd_base(lane);
    const TIn* Kh = cur.K; const TIn* Vh = cur.V;
#define RESC(a) do { if (__any((a) < 1.f)) { if (hi == 0) al_l[r32] = (a); asm volatile("s_waitcnt lgkmcnt(0)" ::: "memory");              \
                     for (int d_ = 0; d_ < 4; ++d_) for (int r = 0; r < 16; ++r) o[d_][r] *= al_l[crow(r, hi)]; } } while (0)
#define KBASE(t) ((j_lo + (t)) * KVBLK)
#define ACT(t) (KBASE(t) <= qlo + QBLK - 1 && KBASE(t) + KVBLK - 1 >= qlo - W + 1)
#define MASKT(P0_, P1_, t) do { const int kb_ = KBASE(t); if ((!SK || ACT(t)) && (kb_ + KVBLK - 1 > qlo || kb_ <= qlo + QBLK - 1 - W)) mask_tile(P0_, P1_, qm - kb_, (unsigned)W); } while (0)
    constexpr int NQL = F32 ? 16 : 8;
    constexpr bool SK = WSKIP && !F32;
#define SEAM_K0() do { VMWN(NQL); if constexpr (F32) { SWRITE_KF(0); SBAR(); SLOAD_F((const float*)nxt.V, kbn); } else { SWRITE_HK(0); } SBAR(); } while (0)
    f32x16 pA0, pA1, pB0, pB1; float mnA, mnB, alA, alB; bf16x8 pa0, pa1, pa2, pa3;
    if constexpr (F32) { VMW(); SWRITE_VF(0); SBAR(); } else { SWRITE_HV(0); SBAR(); }
    if (NT > 1) { if constexpr (F32) SLOAD_F((const float*)Kh, KBASE(1)); else SLOAD_H(Kh, Vh, KBASE(1), cur.kp); }
    SBAR(); qkt<0, SK>(pA0, pA1, K_lds, r32, hi, S.qr, ACT(0));
    if constexpr (F32) { if (NT > 1) { VMW(); SWRITE_KF(1); SBAR(); SLOAD_F((const float*)Vh, KBASE(1)); } }
    MASKT(pA0, pA1, 0); partialSM(pA0, pA1, m_reg, mnA, alA);
    if (NT > 1) { VMW(); if constexpr (F32) { SWRITE_VF(1); SBAR(); if (NT > 2) SLOAD_F((const float*)Kh, KBASE(2)); } else SWRITE_H(1); }
    __syncthreads();
#define HALF_STEP(PX0, PX1, mnX, alX, PY0, PY1, alY, t, KB, VB, SB) do {                                                      \
        SBAR(); qkt<KB, SK>(PX0, PX1, K_lds, r32, hi, S.qr, ACT(t));                                             \
        finishSM(PY0, PY1, alY, l_reg, pa0, pa1, pa2, pa3); SBAR();                                                           \
        if ((t) + 1 < NT) { if constexpr (F32) { VMW(); SWRITE_KF(SB); SBAR(); SLOAD_F((const float*)Vh, KBASE((t) + 1)); }  \
                            else { SLOAD_H(Kh, Vh, KBASE((t) + 1), cur.kp); } SBAR(); }                                               \
        pv_tile<VB, SK>(o, vb0, pa0, pa1, pa2, pa3, ACT((t) - 1)); MASKT(PX0, PX1, (t)); partialSM(PX0, PX1, m_reg, mnX, alX);                                        \
        __syncthreads();                                                                                                      \
        if ((t) + 1 < NT) { VMW(); if constexpr (F32) { SWRITE_VF(SB); SBAR(); if ((t) + 2 < NT) SLOAD_F((const float*)Kh, KBASE((t) + 2)); } \
                            else { SWRITE_H(SB); } }                                                                          \
        RESC(alX); __syncthreads(); } while (0)
    for (int t = 1; t + 1 < NT; t += 2) {
        HALF_STEP(pB0, pB1, mnB, alB, pA0, pA1, alA, t, 1, 0, 0);
        HALF_STEP(pA0, pA1, mnA, alA, pB0, pB1, alB, t + 1, 0, 1, 1);
    }
    const bool even = (NT & 1) == 0;
    if (even) { SBAR(); qkt<1, SK>(pB0, pB1, K_lds, r32, hi, S.qr, ACT(NT - 1)); SBAR(); }
#define QROW(e) (nxt.Q + (size_t)(wid * QBLK + r32) * D + ((e) >> 1) * 16 + hi * 8 + ((e) & 1) * 4)
    if constexpr (F32) { SLOAD_F((const float*)nxt.K, kbn); SBAR();
#pragma unroll
        for (int e = 0; e < 8; ++e) S.tq[e] = *(const f32x4*)QROW(e); }
    else { SLOAD_H(nxt.K, nxt.V, kbn, nxt.kp); SBAR();
#pragma unroll
        for (int d0 = 0; d0 < 8; ++d0) S.qr[d0] = load8<TIn>((const TIn*)((const char*)nxt.Q + (unsigned)(((wid * QBLK + r32) * nxt.qp + hi * 8) * 2) + d0 * 32)); }
    SBAR();
    finishSM(pA0, pA1, alA, l_reg, pa0, pa1, pa2, pa3); SBAR();
    if constexpr (F32) {
#pragma unroll
        for (int e = 8; e < 16; ++e) S.tq[e] = *(const f32x4*)QROW(e); SBAR(); }
#undef QROW
    pv_tile<0, SK>(o, vb0, pa0, pa1, pa2, pa3, ACT(even ? NT - 2 : NT - 1));
    if (even) { MASKT(pB0, pB1, NT - 1); partialSM(pB0, pB1, m_reg, mnB, alB); __syncthreads(); RESC(alB);
        finishSM(pB0, pB1, alB, l_reg, pa0, pa1, pa2, pa3); SBAR(); pv_tile<1, SK>(o, vb0, pa0, pa1, pa2, pa3, ACT(NT - 1)); }
    SBAR(); SEAM_K0();
    if (hi == 0) { li_l[r32] = l_reg; if (cur.L) cur.L[(unsigned)((wid * QBLK + r32) * cur.lp)] = m_reg * SCALE + logf(l_reg); }
    asm volatile("s_waitcnt lgkmcnt(0)" ::: "memory");
    float rli[16];
#pragma unroll
    for (int r = 0; r < 16; ++r) rli[r] = __builtin_amdgcn_rcpf(li_l[crow(r, hi)]);
    TOut* Ow = cur.O + (unsigned)(wid * QBLK * cur.op); const int opitch = cur.op;
#pragma unroll
    for (int r = 0; r < 16; ++r) { const int orow = crow(r, hi);
#pragma unroll
        for (int d0 = 0; d0 < 4; ++d0) { const float v = o[d0][r] * rli[r];
            if constexpr (same_t<TOut, float>::v) { Ow[(unsigned)(orow * opitch + d0 * 32 + r32)] = v; }
            else { const float vn = __shfl_xor(v, 1);
                   if ((r32 & 1) == 0) *(unsigned*)(Ow + (unsigned)(orow * opitch + d0 * 32 + r32)) = cvtpk(v, vn); } } }
    if constexpr (F32) {
#pragma unroll
        for (int d0 = 0; d0 < 8; ++d0) S.qr[d0] = pack8(S.tq[2 * d0], S.tq[2 * d0 + 1]); }
    __syncthreads();
#undef RESC
#undef KBASE
#undef ACT
#undef MASKT
#undef SEAM_K0
#undef HALF_STEP
}
#undef ROW
#undef VMW
#undef VMWN
#undef SLOAD_H
#undef SWRITE_HK
#undef SWRITE_HV
#undef SWRITE_H
#undef SLOAD_F
#undef SWRITE_KF
#undef SWRITE_VF

#undef ROWP
#undef KSWZ
#undef SBAR
}

constexpr int NWAVES = 8;
constexpr int BATCH = 2, SEQ = 8192, DM = 1024, TOK = BATCH * SEQ;
constexpr int AH = 16, AHD = 64;
constexpr int BH = 8, BHD = 128, BG = 3;
constexpr int NE = 16, FF = 256, NCLS = 24, MROWS = 80;
constexpr int NA = 2, NB = 2, NL = 4;
constexpr int WIN_LD = 3 * DM + AH;
constexpr float LOG2E = 1.4426950408889634f;

constexpr size_t MiB = 1u << 20;
constexpr size_t WS_CTL = 0, CTL_ZERO_BYTES = 1 * MiB;
constexpr size_t WS_RSTD = 1 * MiB;
constexpr size_t WS_GA = 1 * MiB + 256 * 1024, WS_GB = 1 * MiB + 512 * 1024;
constexpr size_t WS_LOGF = 2 * MiB;
constexpr size_t WS_CL = 3 * MiB;
constexpr size_t WS_CAUG = 4 * MiB;
constexpr size_t WS_ROPEC = 6 * MiB, WS_ROPES = 10 * MiB;
constexpr size_t WS_WF = 14 * MiB;
constexpr size_t WS_WR = 14 * MiB + 512 * 1024;
constexpr size_t WS_GTAB = 15 * MiB;
constexpr size_t WS_LSE = 16 * MiB;
constexpr size_t WS_LIST = 18 * MiB;
constexpr size_t WS_WIN = 20 * MiB;
constexpr size_t WS_WOA = 32 * MiB;
constexpr size_t WS_WKVQ0 = 36 * MiB;
constexpr size_t WS_WQ1 = 46 * MiB;
constexpr size_t WS_WOB = 52 * MiB;
constexpr size_t WS_WGU = 56 * MiB;
constexpr size_t WS_WD = 88 * MiB;
constexpr size_t WS_HB = 104 * MiB;
constexpr size_t WS_KB = 136 * MiB, WS_VB = 168 * MiB;
constexpr size_t WS_QB = 200 * MiB;
constexpr size_t WS_END = 296 * MiB;
constexpr int CW_CNT2 = 32768;
constexpr int CW_BAR = 4096, CW_CNT = 16384, CW_AQ = 20480;

constexpr int RING_OFF = 0, RING_BYTES = 131072;
constexpr int XS_OFF = 131072;
constexpr int LDS_BYTES = 163840;
constexpr int MISC_OFF = LDS_BYTES - 256;
static_assert(attn_body::ATTN_LDS_BYTES <= MISC_OFF, "attention LDS");

#define GAS __attribute__((address_space(1)))
#define LAS __attribute__((address_space(3)))
typedef unsigned short bf16;
typedef unsigned v4u __attribute__((ext_vector_type(4)));
typedef float f32x4 __attribute__((ext_vector_type(4)));
typedef short bf16x8 __attribute__((ext_vector_type(8)));
typedef GAS unsigned gu32;
#define RLX_AGENT __ATOMIC_RELAXED, __HIP_MEMORY_SCOPE_AGENT
#define LDS_WAIT() asm volatile("s_waitcnt lgkmcnt(0)" ::: "memory")
__device__ __forceinline__ unsigned f2bf(float f) { unsigned u = __builtin_bit_cast(unsigned, f); return (u + 0x7fffu + ((u >> 16) & 1u)) >> 16; }
__device__ __forceinline__ unsigned pk2(float lo, float hi) { return f2bf(lo) | (f2bf(hi) << 16); }
__device__ __forceinline__ float bf2f(unsigned b) { return __builtin_bit_cast(float, b << 16); }

#define XB_TMO      128
#define XB_XCNT(j)  (256  + 64 * (j))
#define XB_XSUB(j)  (1280 + 64 * (j))
#define XB_XGEN(j)  (2304 + 64 * (j))
#define XB_TOP      3328
#define XB_TOPGEN   3392
#define XCD_BAR_WORDS 3456
#define XB_SPIN_CAP (1u << 18)

__device__ __forceinline__ unsigned xb_ld(unsigned* p)              { return __hip_atomic_load(p, __ATOMIC_RELAXED, __HIP_MEMORY_SCOPE_AGENT); }
__device__ __forceinline__ unsigned xb_add(unsigned* p, unsigned v) { return __hip_atomic_fetch_add(p, v, __ATOMIC_RELAXED, __HIP_MEMORY_SCOPE_AGENT); }
__device__ __forceinline__ unsigned xb_xcc_id() { return (unsigned)__builtin_amdgcn_s_getreg((3 << 11) | 20) & 0xFu; }
#define XB_SPIN(cond, bar) do { unsigned _sp = 0; while (cond) { __builtin_amdgcn_s_sleep(1); \
    if ((++_sp & 255u) == 0u) { if (xb_ld(&(bar)[XB_TMO])) break; if (_sp > XB_SPIN_CAP) { atomicAdd(&(bar)[XB_TMO], 1u); break; } } } } while (0)

struct XcdBarrier {
    unsigned* bar; unsigned x;
    volatile LAS unsigned* st;
};

__device__ __forceinline__ XcdBarrier xcd_barrier_post(unsigned* bar, volatile LAS unsigned* st) {
    XcdBarrier b; b.bar = bar; b.x = xb_xcc_id(); b.st = st;
    if (threadIdx.x == 0) (void)xb_add(&bar[XB_XCNT(b.x)], 1u);
    return b;
}
__device__ __forceinline__ void xcd_barrier_complete(unsigned* bar, unsigned x, unsigned& nloc, unsigned& nx) {
    const unsigned G = gridDim.x * gridDim.y * gridDim.z;
    unsigned sum, cnt, mine, sp = 0u;
    for (;;) {
        sum = 0u; cnt = 0u; mine = 0u;
#pragma unroll
        for (unsigned j = 0; j < 16; ++j) { const unsigned c = xb_ld(&bar[XB_XCNT(j)]); sum += c; cnt += (c > 0u) ? 1u : 0u; mine = (j == x) ? c : mine; }
        if (sum == G) break;
        __builtin_amdgcn_s_sleep(1);
        if ((++sp & 255u) == 0u) { if (xb_ld(&bar[XB_TMO])) break; if (sp > XB_SPIN_CAP) { atomicAdd(&bar[XB_TMO], 1u); break; } }
    }
    nloc = mine > 0u ? mine : 1u; nx = cnt > 0u ? cnt : 1u;
}

__device__ __forceinline__ void xcd_barrier(const XcdBarrier& b) {
    asm volatile("s_waitcnt vmcnt(0)" ::: "memory");
    __syncthreads();
    if (threadIdx.x == 0) {
        unsigned* bar = b.bar;
        __builtin_amdgcn_s_waitcnt(0);
        unsigned nloc = b.st[0], nx = b.st[1];
        if (nloc == 0u) { xcd_barrier_complete(bar, b.x, nloc, nx); b.st[0] = nloc; b.st[1] = nx; }
        const unsigned old = xb_add(&bar[XB_XSUB(b.x)], 1u);
        const unsigned gen = old / nloc;
        if (old + 1u == (gen + 1u) * nloc) {
            __builtin_amdgcn_fence(__ATOMIC_RELEASE, "agent");
            asm volatile("s_waitcnt vmcnt(0)" ::: "memory");
            const unsigned og = xb_add(&bar[XB_TOP], 1u);
            const unsigned tg = og / nx;
            if (og + 1u == (tg + 1u) * nx) xb_add(&bar[XB_TOPGEN], 1u);
            else XB_SPIN(xb_ld(&bar[XB_TOPGEN]) == tg, bar);
            __builtin_amdgcn_fence(__ATOMIC_ACQUIRE, "agent");
            xb_add(&bar[XB_XGEN(b.x)], 1u);
            asm volatile("s_waitcnt vmcnt(0)" ::: "memory");
        } else {
            XB_SPIN(xb_ld(&bar[XB_XGEN(b.x)]) == gen, bar);
            __builtin_amdgcn_fence(__ATOMIC_ACQUIRE, "agent");
            asm volatile("s_waitcnt vmcnt(0)" ::: "memory");
        }
    }
    __syncthreads();
}

struct Args { const float* in[24]; float* out; unsigned char* ws; int ph_lo, ph_hi; };
typedef const __attribute__((address_space(4))) char* kptr_t;
struct KA { kptr_t k;
    __device__ __forceinline__ const float* in(int i) const { return (const float*)(const GAS float*)*(const float* const __attribute__((address_space(4)))*)(k + 8 * i); }
    __device__ __forceinline__ float* out() const { return (float*)(GAS float*)*(float* const __attribute__((address_space(4)))*)(k + 192); }
    __device__ __forceinline__ unsigned char* ws() const { return (unsigned char*)(GAS unsigned char*)*(unsigned char* const __attribute__((address_space(4)))*)(k + 200); } };
static_assert(sizeof(Args) == 216 && __builtin_offsetof(Args, out) == 192 && __builtin_offsetof(Args, ws) == 200, "Args layout");
struct Frame { LAS unsigned char* lds; int tid, lane, wave, vcu, G; };

__device__ __forceinline__ float wave_sum(float v) {
#pragma unroll
    for (int o = 1; o < 64; o <<= 1) v += __shfl_xor(v, o);
    return v;
}
struct TrD { const float* src; const float* gain; bf16* dst; int ld, mode, dK, n0, drow0, k0, up; };
__device__ __forceinline__ int map64(int n)  { return (n & ~255) + 128 * ((n >> 5) & 1) + 32 * ((n >> 6) & 3) + (n & 31); }
__device__ __forceinline__ int map128(int n) { return (n & ~255) + 128 * ((n >> 6) & 1) + 64 * ((n >> 7) & 1) + (n & 63); }
__device__ __forceinline__ void tr_load(const TrD& d, f32x4 (&rg)[8], int lane) {
    const int r = lane >> 3, c4 = lane & 7;
#pragma unroll
    for (int i = 0; i < 8; ++i) { const int kk = 8 * i + r; f32x4 v = *(const GAS f32x4*)(d.src + (size_t)(d.k0 + kk) * d.ld + d.n0 + 4 * c4);
        const float g = d.gain ? *(const GAS float*)(d.gain + d.k0 + kk) : 1.0f; rg[i] = v * g; }
}
__device__ __forceinline__ void tr_store(const TrD& d, const f32x4 (&rg)[8], LAS float* scr, int lane) {
    { const int r = lane >> 3, c4 = lane & 7;
#pragma unroll
      for (int i = 0; i < 8; ++i) { LAS float* p = scr + (8 * i + r) * 33 + 4 * c4; p[0] = rg[i].x; p[1] = rg[i].y; p[2] = rg[i].z; p[3] = rg[i].w; } }
    LDS_WAIT(); asm volatile("" ::: "memory");
    const int c = lane & 7;
#pragma unroll
    for (int j = 0; j < 4; ++j) { const int n = (lane >> 3) + 8 * j; const LAS float* s = scr + (8 * c) * 33 + n;
        v4u o; o.x = pk2(s[0 * 33], s[1 * 33]); o.y = pk2(s[2 * 33], s[3 * 33]); o.z = pk2(s[4 * 33], s[5 * 33]); o.w = pk2(s[6 * 33], s[7 * 33]);
        size_t pos;
        if (d.mode == 0) pos = (size_t)(d.drow0 + n) * d.dK + d.k0 + 8 * c;
        else { const int f = d.n0 + n, k8 = (d.k0 >> 3) + c, ks = k8 >> 2, fq = k8 & 3, fr = f & 15;
            if (d.mode == 1) { const int w = f >> 5, cb = 2 * d.up + ((f >> 4) & 1); pos = ((size_t)((w * 32 + ks) * 4 + cb) * 64 + fq * 16 + fr) * 8; }
            else { const int p = f >> 9, w = (f >> 6) & 7, cb = (f >> 4) & 3, KS = d.mode == 2 ? 8 : 32; pos = ((size_t)(((p * 8 + w) * KS + ks) * 4 + cb) * 64 + fq * 16 + fr) * 8; } }
        *(GAS v4u*)(d.dst + pos) = o; }
    LDS_WAIT(); asm volatile("" ::: "memory");
}
__device__ __forceinline__ TrD tr_decode_moe(const KA a, unsigned char* ws, int l, int it);
__device__ __forceinline__ TrD tr_decode_moe(const KA a, unsigned char* ws, int l, int it) {
    TrD d; const int slot = l & 1; d.dK = 0; d.drow0 = 0;
    if (it < 4096) {
        const int e = it >> 8, r = it & 255, up = r >> 7, q = r & 127, kb = q >> 3, nb = q & 7;
        d.src = a.in(up ? 21 : 20) + ((size_t)(l * NE + e)) * DM * FF; d.ld = FF; d.gain = a.in(15) + (size_t)l * DM;
        d.dst = (bf16*)(ws + WS_WGU) + ((size_t)(slot * NE + e)) * 512 * DM; d.mode = 1; d.n0 = 32 * nb; d.up = up; d.k0 = 64 * kb;
    } else {
        const int r0 = it - 4096, e = r0 >> 7, q = r0 & 127, kb = q >> 5, nb = q & 31;
        d.src = a.in(22) + ((size_t)(l * NE + e)) * FF * DM; d.ld = DM; d.gain = nullptr;
        d.dst = (bf16*)(ws + WS_WD) + ((size_t)(slot * NE + e)) * DM * FF; d.mode = 2; d.n0 = 32 * nb; d.up = 0; d.k0 = 64 * kb;
    }
    return d;
}
constexpr int TR_I_WIN = 16 * 96, TR_I_WO = 16 * 32, TR_I_KV = 16 * 64, TR_I_Q = 16 * 96, TR_I_MOE = 6144;
constexpr int TR_NITEMS = 2 * TR_I_WIN + 2 * TR_I_WO + TR_I_KV + 2 * TR_I_Q + 2 * TR_I_WO + 2 * TR_I_MOE;
__device__ __forceinline__ TrD tr_decode_main(const KA a, unsigned char* ws, int it) {
    TrD d; d.mode = 0; d.dK = DM; d.up = 0; int r = it;
    if (r < 2 * TR_I_WIN) { const int l = r / TR_I_WIN; r -= l * TR_I_WIN; const int kb = r / 96, nb = r % 96, n0 = 32 * nb;
        d.src = a.in(3) + (size_t)l * DM * WIN_LD; d.ld = WIN_LD; d.gain = a.in(2) + l * DM; d.dst = (bf16*)(ws + WS_WIN) + (size_t)l * 3072 * DM; d.n0 = n0; d.drow0 = map64(n0); d.k0 = 64 * kb; return d; }
    r -= 2 * TR_I_WIN;
    if (r < 2 * TR_I_WO) { const int l = r / TR_I_WO; r -= l * TR_I_WO; const int kb = r / 32, nb = r % 32;
        d.src = a.in(7) + (size_t)l * DM * DM; d.ld = DM; d.gain = nullptr; d.dst = (bf16*)(ws + WS_WOA) + (size_t)l * DM * DM; d.n0 = 32 * nb; d.drow0 = 32 * nb; d.k0 = 64 * kb; d.mode = 3; return d; }
    r -= 2 * TR_I_WO;
    if (r < TR_I_KV) { const int kb = r / 64, nb = r % 64, n0 = 32 * nb;
        d.src = a.in(9); d.ld = 2 * DM; d.gain = a.in(8); d.dst = (bf16*)(ws + WS_WKVQ0); d.n0 = n0; d.drow0 = n0 < DM ? map128(n0) : n0; d.k0 = 64 * kb; return d; }
    r -= TR_I_KV;
    if (r < 2 * TR_I_Q) { const int j = r / TR_I_Q; r -= j * TR_I_Q; const int kb = r / 96, nb = r % 96, n0 = 32 * nb;
        d.src = a.in(12) + (size_t)j * DM * 3072; d.ld = 3072; d.gain = a.in(11) + j * DM; d.dst = j == 0 ? (bf16*)(ws + WS_WKVQ0) + (size_t)2048 * DM : (bf16*)(ws + WS_WQ1); d.n0 = n0; d.drow0 = map128(n0); d.k0 = 64 * kb; return d; }
    r -= 2 * TR_I_Q;
    if (r < 2 * TR_I_WO) { const int j = r / TR_I_WO; r -= j * TR_I_WO; const int kb = r / 32, nb = r % 32;
        d.src = a.in(14) + (size_t)j * DM * DM; d.ld = DM; d.gain = nullptr; d.dst = (bf16*)(ws + WS_WOB) + (size_t)j * DM * DM; d.n0 = 32 * nb; d.drow0 = 32 * nb; d.k0 = 64 * kb; d.mode = 3; return d; }
    r -= 2 * TR_I_WO;
    { const int l = r / TR_I_MOE; return tr_decode_moe(a, ws, l, r - l * TR_I_MOE); }
}
template <bool MAIN> __device__ __forceinline__ void tr_run(const KA a, unsigned char* ws, int layer, int nitems, int gw, int NGW, LAS float* scr, int lane) {
    int it = gw; if (it >= nitems) return;
    TrD d = MAIN ? tr_decode_main(a, ws, it) : tr_decode_moe(a, ws, layer, it);
    f32x4 rg[8]; tr_load(d, rg, lane);
    for (;;) {
        const int itn = it + NGW; const bool more = itn < nitems;
        TrD dn = d; f32x4 rn[8];
        if (more) { dn = MAIN ? tr_decode_main(a, ws, itn) : tr_decode_moe(a, ws, layer, itn); tr_load(dn, rn, lane); }
        tr_store(d, rg, scr, lane);
        if (!more) break;
        d = dn; it = itn;
#pragma unroll
        for (int i = 0; i < 8; ++i) rg[i] = rn[i];
    }
}
constexpr int CW_CQ = 24576;
__device__ __forceinline__ void conv_drain(const KA a, unsigned char* ws, Frame& F, unsigned* cctr, bool main, int layer, int lo, int hi) {
    volatile LAS int* cw = (volatile LAS int*)(F.lds + MISC_OFF) + 16;
    LAS float* scr = (LAS float*)(F.lds + RING_OFF + F.wave * 16384);
    const int nb = (hi - lo + 63) >> 6;
    for (;;) {
        __syncthreads();
        if (F.tid == 0) cw[0] = (int)__hip_atomic_fetch_add(cctr, 1u, RLX_AGENT);
        __syncthreads();
        const int b = __builtin_amdgcn_readfirstlane(cw[0]);
        if (b >= nb) break;
        const int base = lo + b * 64, end = (base + 64 < hi) ? base + 64 : hi;
        int it = base + F.wave; if (it >= end) continue;
        TrD d = main ? tr_decode_main(a, ws, it) : tr_decode_moe(a, ws, layer, it);
        f32x4 rg[8]; tr_load(d, rg, F.lane);
        for (;;) {
            const int itn = it + 8; const bool more = itn < end;
            TrD dn = d; f32x4 rn[8];
            if (more) { dn = main ? tr_decode_main(a, ws, itn) : tr_decode_moe(a, ws, layer, itn); tr_load(dn, rn, F.lane); }
            tr_store(d, rg, scr, F.lane);
            if (!more) break;
            d = dn; it = itn;
#pragma unroll
            for (int i = 0; i < 8; ++i) rg[i] = rn[i];
        }
    }
    __syncthreads();
}
__device__ __forceinline__ void sincos_f64(double a, float& c, float& s) {
    const double q = __builtin_rint(a * 0.63661977236758134308);
    const double r = __builtin_fma(-q, 6.123233995736766036e-17, __builtin_fma(-q, 1.5707963267948966192, a));
    const double r2 = r * r;
    double sp = -1.0 / 39916800.0; sp = sp * r2 + 1.0 / 362880.0; sp = sp * r2 - 1.0 / 5040.0; sp = sp * r2 + 1.0 / 120.0; sp = sp * r2 - 1.0 / 6.0; sp = sp * r2 * r + r;
    double cp = 1.0 / 479001600.0; cp = cp * r2 - 1.0 / 3628800.0; cp = cp * r2 + 1.0 / 40320.0; cp = cp * r2 - 1.0 / 720.0; cp = cp * r2 + 1.0 / 24.0; cp = cp * r2 - 0.5; cp = cp * r2 + 1.0;
    const int qi = (int)((long long)q & 3);
    const double cs = (qi == 0) ? cp : (qi == 1) ? -sp : (qi == 2) ? -cp : sp;
    const double sn = (qi == 0) ? sp : (qi == 1) ? cp : (qi == 2) ? -sp : -cp;
    c = (float)cs; s = (float)sn;
}
__device__ __forceinline__ void p_prologue(const KA a, Frame& F) {
    unsigned char* ws = a.ws(); asm volatile("" : "+s"(ws)); ASSUME_GLOBAL(ws);
    LAS float* scr = (LAS float*)(F.lds + RING_OFF + F.wave * 16384);
    const int gw = F.vcu * NWAVES + F.wave, NGW = F.G * NWAVES;
    tr_run<true>(a, ws, 0, TR_I_WIN, gw, NGW, scr, F.lane);
    const int gt = (F.vcu * NWAVES + F.wave) * 64 + F.lane, NGT = NGW * 64;
    for (int i = gt; i < 2 * 16 * DM; i += NGT) { const int l = i / (16 * DM), v = (i / DM) % 16, k = i % DM;
        ((float*)(ws + WS_WF))[i] = a.in(3)[(size_t)l * DM * WIN_LD + (size_t)k * WIN_LD + 3 * DM + v] * a.in(2)[l * DM + k]; }
    for (int i = gt; i < 4 * 20 * DM; i += NGT) { const int l = i / (20 * DM), v = (i / DM) % 20, k = i % DM;
        const float w = v < 4 ? a.in(16)[(size_t)l * DM * 4 + k * 4 + v] : a.in(18)[(size_t)l * DM * 16 + k * 16 + (v - 4)];
        ((float*)(ws + WS_WR))[i] = w * a.in(15)[l * DM + k]; }
    for (int i = gt; i < 2 * 192; i += NGT) { const int l = i / 192, sec = (i / 64) % 3, dd = i % 64;
        ((float*)(ws + WS_GTAB))[i] = sec == 0 ? a.in(5)[l * AHD + dd] * (0.125f * LOG2E) : (sec == 1 ? a.in(6)[l * AHD + dd] : 1.0f); }
    const int* pos = (const int*)a.in(1);
    for (int i = gt; i < TOK * 64; i += NGT) { const int m = i >> 6, f = i & 63;
        const float invf = powf(10000.0f, -(float)f / 64.0f);
        const float ang = (float)pos[m] * invf;
        float c, s; sincos_f64((double)ang, c, s);
        ((unsigned*)(ws + WS_ROPEC))[i] = (unsigned)__builtin_bit_cast(unsigned short, (_Float16)c) | ((unsigned)__builtin_bit_cast(unsigned short, (_Float16)s) << 16); }
}

template <int N, int O> struct RedTree {
    static __device__ __forceinline__ void run(float (&v)[80], int lane, int& base) {
        if constexpr (O >= 1) {
            if constexpr (N % 2 == 0) {
                const bool up = (lane & O) != 0;
#pragma unroll
                for (int i = 0; i < N / 2; ++i) { const float keep = up ? v[i + N / 2] : v[i], send = up ? v[i] : v[i + N / 2]; v[i] = keep + __shfl_xor(send, O); }
                if (up) base += N / 2;
                RedTree<N / 2, O / 2>::run(v, lane, base);
            } else {
#pragma unroll
                for (int i = 0; i < N; ++i) v[i] += __shfl_xor(v[i], O);
                RedTree<N, O / 2>::run(v, lane, base);
            }
        }
    }
};
template <int MODE> __device__ __forceinline__ void p_rowpass(const KA a, Frame& F, int layer, bool dry = false, const float* Hsrc = nullptr, bool raw_wf = false) {
    unsigned char* ws = a.ws(); asm volatile("" : "+s"(ws)); ASSUME_GLOBAL(ws);
    constexpr int NV = MODE == 1 ? 16 : (MODE == 2 ? 20 : 0), NT = MODE == 2 ? 2 : 4, NVAL = NT * NV;
    constexpr int NFIN = MODE == 2 ? 5 : 1;
    LAS float* wl = (LAS float*)(F.lds + RING_OFF);
    LAS float* red = (LAS float*)(F.lds + RING_OFF + 96 * 1024) + F.wave * 96;
    if (NV) {
        if (MODE == 1 && raw_wf) {
            const float* win = a.in(3) + (size_t)layer * DM * WIN_LD + 3 * DM; const float* gn = a.in(2) + layer * DM;
            for (int i = F.tid; i < 16 * DM; i += NWAVES * 64) { const int k = i >> 4, v = i & 15; wl[v * DM + k] = *(const GAS float*)(win + (size_t)k * WIN_LD + v) * *(const GAS float*)(gn + k); }
        } else {
        const float* wsrc = MODE == 1 ? (const float*)(ws + WS_WF) + (size_t)layer * 16 * DM : (const float*)(ws + WS_WR) + (size_t)layer * 20 * DM;
        for (int i = F.tid; i < NV * DM / 4; i += NWAVES * 64) ((LAS f32x4*)wl)[i] = ((const f32x4*)wsrc)[i];
        }
        __syncthreads();
    }
    const int gw = F.vcu * NWAVES + F.wave, NGW = F.G * NWAVES;
    const float* H = Hsrc ? Hsrc : a.out(); float* rstd = (float*)(ws + WS_RSTD); bf16* hb = (bf16*)(ws + WS_HB);
    for (int m0 = NT * gw; m0 < TOK; m0 += NT * NGW) {
        f32x4 v[NT][4]; float rs[4] = {0.f, 0.f, 0.f, 0.f};
#pragma unroll
        for (int r = 0; r < NT; ++r) { const f32x4* xr = (const f32x4*)(H + (size_t)(m0 + r) * DM) + F.lane;
#pragma unroll
            for (int j = 0; j < 4; ++j) v[r][j] = xr[64 * j]; }
#pragma unroll
        for (int r = 0; r < NT; ++r) { float s = 0.f;
#pragma unroll
            for (int j = 0; j < 4; ++j) s += (v[r][j].x * v[r][j].x + v[r][j].y * v[r][j].y) + (v[r][j].z * v[r][j].z + v[r][j].w * v[r][j].w);
            rs[r] = 1.0f / sqrtf(wave_sum(s) * (1.0f / DM) + 1e-6f);
            unsigned long long* o8 = (unsigned long long*)(hb + (size_t)(m0 + r) * DM) + F.lane;
#pragma unroll
            for (int j = 0; j < 4; ++j) o8[64 * j] = (unsigned long long)pk2(v[r][j].x, v[r][j].y) | ((unsigned long long)pk2(v[r][j].z, v[r][j].w) << 32); }
        if (F.lane < NT) rstd[m0 + F.lane] = F.lane == 0 ? rs[0] : (F.lane == 1 ? rs[1] : (F.lane == 2 ? rs[2] : rs[3]));
        if (NV) {
            float pv[80];
#pragma unroll
            for (int q = 0; q < NV; ++q) {
                f32x4 w[4];
#pragma unroll
                for (int j = 0; j < 4; ++j) w[j] = ((const LAS f32x4*)(wl + q * DM))[F.lane + 64 * j];
#pragma unroll
                for (int r = 0; r < NT; ++r) { float p = 0.f;
#pragma unroll
                    for (int j = 0; j < 4; ++j) p += (v[r][j].x * w[j].x + v[r][j].y * w[j].y) + (v[r][j].z * w[j].z + v[r][j].w * w[j].w);
                    pv[r * NV + q] = p; }
            }
            int base = 0;
            RedTree<NVAL, 32>::run(pv, F.lane, base);
            if (MODE == 1) {
                const int r = base >> 4, hh = base & 15; const float rsr = r == 0 ? rs[0] : (r == 1 ? rs[1] : (r == 2 ? rs[2] : rs[3]));
                const float z = pv[0] * rsr + a.in(4)[layer * AH + hh]; const float ls = fminf(z, 0.f) - __logf(1.0f + __expf(-fabsf(z)));
                const int m = m0 + r, b = m / SEQ, sidx = m % SEQ; ((float*)(ws + WS_LOGF))[(size_t)(b * AH + hh) * SEQ + sidx] = ls;
            } else if (MODE == 2) {
#pragma unroll
                for (int i = 0; i < NFIN; ++i) red[base + i] = pv[i];
                LDS_WAIT(); asm volatile("" ::: "memory");
                if (F.lane < NT) {
                    const int m = m0 + F.lane; const float rsr = F.lane == 0 ? rs[0] : (F.lane == 1 ? rs[1] : (F.lane == 2 ? rs[2] : rs[3]));
                    float d[20];
#pragma unroll
                    for (int q = 0; q < 20; ++q) d[q] = red[F.lane * 20 + q] * rsr;
                    const float* gb = a.in(17) + layer * 4;
                    float lg[4];
#pragma unroll
                    for (int q = 0; q < 4; ++q) lg[q] = d[q] + gb[q];
                    int gi = 0; float gm = lg[0];
#pragma unroll
                    for (int q = 1; q < 4; ++q) if (lg[q] > gm) { gm = lg[q]; gi = q; }
                    float gs = 0.f;
#pragma unroll
                    for (int q = 0; q < 4; ++q) gs += expf(lg[q] - gm);
                    const float gp = 1.0f / gs;
                    const float* ebp = a.in(19) + layer * 16;
                    float el[4];
#pragma unroll
                    for (int q = 0; q < 4; ++q) { float t = 0.f;
#pragma unroll
                        for (int g2 = 0; g2 < 4; ++g2) if (g2 == gi) t = d[4 + 4 * g2 + q] + ebp[4 * g2 + q];
                        el[q] = t; }
                    int i1 = 0; float v1 = el[0];
#pragma unroll
                    for (int q = 1; q < 4; ++q) if (el[q] > v1) { v1 = el[q]; i1 = q; }
                    int i2 = -1; float v2 = 0.f;
#pragma unroll
                    for (int q = 0; q < 4; ++q) if (q != i1 && (i2 < 0 || el[q] > v2)) { v2 = el[q]; i2 = q; }
                    const float e2 = expf(v2 - v1), g1 = gp / (1.0f + e2), g2v = gp * e2 / (1.0f + e2);
                    const int lo = i1 < i2 ? i1 : i2, hi = i1 < i2 ? i2 : i1;
                    const int pidx = (lo == 0) ? (hi - 1) : (lo == 1 ? hi + 1 : 5);
                    const int cls = gi * 6 + pidx;
                    if (!dry) {
                        const unsigned p = __hip_atomic_fetch_add((unsigned*)(ws + WS_CTL) + CW_CNT + layer * 64 + cls, 1u, RLX_AGENT);
                        ((int*)(ws + WS_LIST))[(size_t)cls * TOK + p] = m;
                        ((float*)(ws + WS_GA))[m] = (i1 < i2) ? g1 : g2v;
                        ((float*)(ws + WS_GB))[m] = (i1 < i2) ? g2v : g1;
                    }
                }
                LDS_WAIT(); asm volatile("" ::: "memory");
            }
        }
    }
    __syncthreads();
}

__device__ __forceinline__ swa::BlockRef<swa::bf16, swa::bf16> b_unit_ref(unsigned char* ws, int id, bool dry) {
    const int g = id >> 9, r0 = id & 511, bh = r0 >> 5, r1 = r0 & 31;
    const int dl = (g == 0) ? 1 : (g == 1 ? 4 : 16), nq = 32 / dl, res = r1 / nq, qb = r1 % nq;
    const int b = bh >> 3, h = bh & 7;
    const size_t tok0 = (size_t)b * SEQ + res;
    swa::BlockRef<swa::bf16, swa::bf16> R;
    swa::bf16* qbase = (swa::bf16*)(ws + WS_QB) + tok0 * 3072 + g * 1024 + h * 128;
    R.Q = qbase + (size_t)qb * 256 * dl * 3072; R.O = qbase + (size_t)qb * 256 * dl * 3072; R.qp = dl * 3072; R.op = dl * 3072;
    R.K = (const swa::bf16*)(ws + WS_KB) + tok0 * 1024 + h * 128; R.V = (const swa::bf16*)(ws + WS_VB) + tok0 * 1024 + h * 128; R.kp = dl * 1024;
    R.L = (float*)(ws + WS_LSE) + (tok0 + (size_t)qb * 256 * dl) * 24 + g * 8 + h; R.lp = dl * 24;
    R.P0 = qb * 256;
    if (dry) { R.O = (swa::bf16*)(ws + WS_HB) + tok0 * 1024 + h * 128 + (size_t)qb * 256 * dl * 1024; R.op = dl * 1024; R.L = nullptr; }
    return R;
}
__device__ __forceinline__ void p_battn(const KA a, Frame& F, bool dry) {
    unsigned char* ws = a.ws(); asm volatile("" : "+s"(ws)); ASSUME_GLOBAL(ws); char* lds = (char*)(F.lds + RING_OFF);
    constexpr int NUNITS = 3 * 512;
    const int bid0 = bid_fresh();
    const bool xdeal = gridDim.x == 256; const int vc = (bid0 & 7) * 32 + (bid0 >> 3), xj = vc & 31, xb = (vc >> 5) * 2; int it = 0;
#define B_PAIR(it_) (xj + 32 * ((it_) >> 1))
#define B_UNIT_ID(it_) (xdeal ? ((((B_PAIR(it_)) / 16) % 3) * 512 + (xb + (B_PAIR(it_)) / 48) * 32 + 2 * ((B_PAIR(it_)) % 16) + ((it_) & 1)) : (bid0 + (it_) * (int)gridDim.x))
    int id = B_UNIT_ID(0);
    if (id >= NUNITS) return;
    typedef swa::BlockRef<swa::bf16, swa::bf16> Ref;
    Ref cur = b_unit_ref(ws, id, dry);
    swa::Seam<swa::bf16> S;
    swa::causal_swa_prime<swa::bf16, swa::bf16>(cur, 129, lds, S);
    for (;;) {
        ++it; const int idn = (xdeal && it >= 6) ? NUNITS : B_UNIT_ID(it); const bool last = idn >= NUNITS;
        const Ref nxt = last ? cur : b_unit_ref(ws, idn, dry);
        const int dl = (id >> 9) == 0 ? 1 : ((id >> 9) == 1 ? 4 : 16);
        swa::causal_swa_block<swa::bf16, swa::bf16>(cur, nxt, SEQ / dl, 129, lds, S);
        if (last) break;
        cur = nxt; id = idn;
    }
#undef B_UNIT_ID
#undef B_PAIR
}
__device__ __forceinline__ void p_bmerge(const KA a, Frame& F) {
    unsigned char* ws = a.ws(); asm volatile("" : "+s"(ws)); ASSUME_GLOBAL(ws);
    const int gw = F.vcu * NWAVES + F.wave, NGW = F.G * NWAVES;
    const bf16* og = (const bf16*)(ws + WS_QB); const float* lse = (const float*)(ws + WS_LSE); bf16* o = (bf16*)(ws + WS_HB);
    for (int m = gw; m < TOK; m += NGW) {
        const int h = F.lane >> 3;
        const float l0 = lse[(size_t)m * 24 + h], l1 = lse[(size_t)m * 24 + 8 + h], l2 = lse[(size_t)m * 24 + 16 + h];
        const float mx = fmaxf(l0, fmaxf(l1, l2));
        const float e0 = expf(l0 - mx), e1 = expf(l1 - mx), e2 = expf(l2 - mx), inv = 1.0f / (e0 + e1 + e2);
        const float w0 = e0 * inv, w1 = e1 * inv, w2 = e2 * inv;
        float accv[16];
#pragma unroll
        for (int i = 0; i < 16; ++i) accv[i] = 0.f;
#pragma unroll
        for (int g = 0; g < 3; ++g) { const float w = g == 0 ? w0 : (g == 1 ? w1 : w2);
            const v4u* p = (const v4u*)(og + (size_t)m * 3072 + g * 1024 + F.lane * 16);
#pragma unroll
            for (int q = 0; q < 2; ++q) { const v4u x = p[q];
                const unsigned xs[4] = {x.x, x.y, x.z, x.w};
#pragma unroll
                for (int e = 0; e < 4; ++e) { accv[q * 8 + 2 * e] += w * bf2f(xs[e] & 0xffffu); accv[q * 8 + 2 * e + 1] += w * bf2f(xs[e] >> 16); } } }
        v4u* po = (v4u*)(o + (size_t)m * DM + F.lane * 16);
#pragma unroll
        for (int q = 0; q < 2; ++q) { v4u w; w.x = pk2(accv[q * 8 + 0], accv[q * 8 + 1]); w.y = pk2(accv[q * 8 + 2], accv[q * 8 + 3]); w.z = pk2(accv[q * 8 + 4], accv[q * 8 + 5]); w.w = pk2(accv[q * 8 + 6], accv[q * 8 + 7]); po[q] = w; }
    }
}

constexpr int MOE_AP = 128 + 8;
constexpr int MOE_HP = 512 + 8;
constexpr int MOE_A_BYTES = MROWS * MOE_AP * 2;
constexpr int MOE_A_OFF = 0, MOE_H_OFF = 2 * MOE_A_BYTES, MOE_T_OFF = MOE_H_OFF + MROWS * MOE_HP * 2;
static_assert(MOE_T_OFF + 3 * MROWS * 4 + 768 <= RING_BYTES, "MoE LDS");
typedef float f32x4m __attribute__((ext_vector_type(4)));
__device__ __forceinline__ void p_moe(const KA a, Frame& F, int layer, float upd) {
    unsigned char* ws = a.ws(); asm volatile("" : "+s"(ws)); ASSUME_GLOBAL(ws);
    LAS int* cl = (LAS int*)(F.lds + RING_OFF + MOE_T_OFF + 3 * MROWS * 4);
    if (F.tid < NCLS * 8) cl[F.tid] = (int)__hip_atomic_load((const unsigned*)(ws + WS_CTL) + CW_CNT2 + layer * 8192 + F.tid * 32, RLX_AGENT);
    __syncthreads();
    for (int u = F.vcu; ; u += (int)gridDim.x) {
    int cls = -1, tile = 0, n_c = 0;
    { int accu = 0;
      for (int c = 0; c < NCLS; ++c) { int n = 0;
#pragma unroll
          for (int k = 0; k < 8; ++k) n += cl[c * 8 + k];
          const int nt = (n + MROWS - 1) / MROWS;
          if (cls < 0 && u < accu + nt) { cls = c; tile = u - accu; n_c = n; } accu += nt; } }
    if (cls < 0) break;
    const int nrow = (n_c - tile * MROWS) < MROWS ? (n_c - tile * MROWS) : MROWS;
    const int grp = cls / 6, pidx = cls % 6;
    const int elo = pidx < 3 ? 0 : (pidx < 5 ? 1 : 2), ehi = pidx < 3 ? pidx + 1 : (pidx < 5 ? pidx - 1 : 3);
    const int slot = layer & 1;
    const int ea = grp * 4 + elo, eb = grp * 4 + ehi;
    LAS bf16* Al = (LAS bf16*)(F.lds + RING_OFF + MOE_A_OFF); LAS bf16* Hl = (LAS bf16*)(F.lds + RING_OFF + MOE_H_OFF);
    LAS int* tokl = (LAS int*)(F.lds + RING_OFF + MOE_T_OFF); LAS float* gal = (LAS float*)(tokl + MROWS); LAS float* gbl = gal + MROWS;
    if (F.tid < MROWS) { const bool ok = F.tid < nrow; int kk = 0, off = tile * MROWS + F.tid;
#pragma unroll
        for (int k = 0; k < 7; ++k) { const int nk = cl[cls * 8 + k]; const bool adv = (kk == k) && (off >= nk); off = adv ? off - nk : off; kk = adv ? kk + 1 : kk; }
        const int t = ok ? ((const int*)(ws + WS_LIST))[(size_t)cls * TOK + kk * 2048 + off] : 0;
        tokl[F.tid] = ok ? t : -1; gal[F.tid] = ok ? ((const float*)(ws + WS_GA))[t] : 0.f; gbl[F.tid] = ok ? ((const float*)(ws + WS_GB))[t] : 0.f; }
    __syncthreads();
    const bf16* hb = (const bf16*)(ws + WS_HB);
    const int fr = F.lane & 15, fq = F.lane >> 4, w = F.wave; const unsigned lb = (unsigned)F.lane * 16u;
    int grow[3]; unsigned gsrc[3]; bool gld[3];
#pragma unroll
    for (int i = 0; i < 3; ++i) { const int idx = F.tid + 512 * i; const int r = idx >> 4; const int t = (idx < MROWS * 16) ? tokl[r] : -1; grow[i] = (idx < MROWS * 16) ? (r * MOE_AP + (idx & 15) * 8) : -1;
        gsrc[i] = (unsigned)((t >= 0 ? t : 0) * DM + (idx & 15) * 8); gld[i] = t >= 0; }
#define MOE_GLOAD(kc_) do { _Pragma("unroll") for (int i = 0; i < 3; ++i) { const v4u t_ = *(const GAS v4u*)((const char*)hb + (gsrc[i] + (unsigned)((kc_) * 128)) * 2u); \
        greg[i].x = gld[i] ? t_.x : 0u; greg[i].y = gld[i] ? t_.y : 0u; greg[i].z = gld[i] ? t_.z : 0u; greg[i].w = gld[i] ? t_.w : 0u; } } while (0)
#define MOE_GSTORE(buf_) do { _Pragma("unroll") for (int i = 0; i < 3; ++i) { if (grow[i] >= 0) *(LAS v4u*)(Al + (buf_) * (MOE_A_BYTES / 2) + grow[i]) = greg[i]; } } while (0)
#pragma unroll 1
    for (int xi = 0; xi < 2; ++xi) { const int x = xi ^ (tile & 1);
        const bf16* Wt = (const bf16*)(ws + WS_WGU) + ((size_t)(slot * NE + (x ? eb : ea))) * 512 * DM + (size_t)w * (32 * 4 * 64 * 8);
        f32x4m acc[5][4];
#pragma unroll
        for (int rb = 0; rb < 5; ++rb)
#pragma unroll
            for (int cb = 0; cb < 4; ++cb) acc[rb][cb] = (f32x4m){0.f, 0.f, 0.f, 0.f};
        v4u greg[3]; bf16x8 bfr[4][4];
#pragma unroll
        for (int i = 0; i < 3; ++i) { greg[i].x = 0u; greg[i].y = 0u; greg[i].z = 0u; greg[i].w = 0u; }
        MOE_GLOAD(0);
#pragma unroll
        for (int r = 0; r < 3; ++r)
#pragma unroll
            for (int cb = 0; cb < 4; ++cb) bfr[r][cb] = *(const GAS bf16x8*)((const char*)(Wt + (r * 4 + cb) * 512) + lb);
        MOE_GSTORE(0);
        LDS_WAIT(); __builtin_amdgcn_s_barrier(); asm volatile("" ::: "memory");
#pragma unroll 1
        for (int kc = 0; kc < 8; ++kc) {
            MOE_GLOAD(kc < 7 ? kc + 1 : 7);
            const LAS bf16* Ab = Al + (kc & 1) * (MOE_A_BYTES / 2);
            bf16x8 afn = *(const LAS bf16x8*)(Ab + fr * MOE_AP + fq * 8);
#pragma unroll
            for (int j = 0; j < 4; ++j) {
                const int ks = kc * 4 + j, kn = (ks + 3 < 32) ? ks + 3 : 31;
#pragma unroll
                for (int cb = 0; cb < 4; ++cb) bfr[(j + 3) & 3][cb] = *(const GAS bf16x8*)((const char*)(Wt + (kn * 4 + cb) * 512) + lb);
#pragma unroll
                for (int rb = 0; rb < 5; ++rb) { const bf16x8 af = afn; const int tn = j * 5 + rb + 1, jn = tn / 5, rn = tn % 5;
                    if (tn < 20) afn = *(const LAS bf16x8*)(Ab + (rn * 16 + fr) * MOE_AP + jn * 32 + fq * 8);
                    __builtin_amdgcn_sched_barrier(0);
#pragma unroll
                    for (int cb = 0; cb < 4; ++cb) acc[rb][cb] = __builtin_amdgcn_mfma_f32_16x16x32_bf16(bfr[j][cb], af, acc[rb][cb], 0, 0, 0);
                    __builtin_amdgcn_sched_barrier(0); }
            }
            if (kc < 7) MOE_GSTORE((kc + 1) & 1);
            LDS_WAIT(); __builtin_amdgcn_s_barrier(); asm volatile("" ::: "memory");
        }
        { const int l2 = tid_fresh() & 63, fr = l2 & 15, fq = l2 >> 4;
#pragma unroll
        for (int rb = 0; rb < 5; ++rb) { const int row = rb * 16 + fr; const float gt = x ? gbl[row] : gal[row];
#pragma unroll
            for (int cb = 0; cb < 2; ++cb) { float hv[4];
#pragma unroll
                for (int j = 0; j < 4; ++j) { const float gv = acc[rb][cb][j], uv = acc[rb][cb + 2][j]; hv[j] = gv / (1.0f + __expf(-gv)) * uv * gt; }
                *(LAS unsigned long long*)(Hl + row * MOE_HP + x * 256 + 32 * w + 16 * cb + 4 * fq) = (unsigned long long)pk2(hv[0], hv[1]) | ((unsigned long long)pk2(hv[2], hv[3]) << 32); } }
        }
    }
    __syncthreads();
    float* H = a.out(); LAS float* ssl = (LAS float*)(F.lds + RING_OFF + MOE_A_OFF);
#pragma unroll 1
    for (int pi = 0; pi < 2; ++pi) { const int p = pi ^ ((tile >> 1) & 1);
        const bf16* WtA = (const bf16*)(ws + WS_WD) + ((size_t)(slot * NE + ea)) * DM * FF + (size_t)(p * 8 + w) * (8 * 4 * 64 * 8);
        const bf16* WtB = (const bf16*)(ws + WS_WD) + ((size_t)(slot * NE + eb)) * DM * FF + (size_t)(p * 8 + w) * (8 * 4 * 64 * 8);
        f32x4m acc[5][4];
#pragma unroll
        for (int rb = 0; rb < 5; ++rb)
#pragma unroll
            for (int cb = 0; cb < 4; ++cb) acc[rb][cb] = (f32x4m){0.f, 0.f, 0.f, 0.f};
        bf16x8 bfr[4][4];
#pragma unroll
        for (int r = 0; r < 3; ++r)
#pragma unroll
            for (int cb = 0; cb < 4; ++cb) bfr[r][cb] = *(const GAS bf16x8*)((const char*)(WtA + (r * 4 + cb) * 512) + lb);
        bf16x8 afn = *(const LAS bf16x8*)(Hl + fr * MOE_HP + fq * 8);
#pragma unroll 1
        for (int kc = 0; kc < 4; ++kc) {
#pragma unroll
            for (int j = 0; j < 4; ++j) {
                const int ks = kc * 4 + j, kn = (ks + 3 < 16) ? ks + 3 : 15;
                { const bf16* Wn = (kn < 8 ? WtA : WtB) + ((kn & 7) * 4) * 512;
#pragma unroll
                    for (int cb = 0; cb < 4; ++cb) bfr[(j + 3) & 3][cb] = *(const GAS bf16x8*)((const char*)(Wn + cb * 512) + lb); }
#pragma unroll
                for (int rb = 0; rb < 5; ++rb) { const bf16x8 af = afn; const int rn = (rb + 1) % 5, kq = ks + (rb == 4 ? 1 : 0);
                    afn = *(const LAS bf16x8*)(Hl + (rn * 16 + fr) * MOE_HP + (kq < 16 ? kq : 15) * 32 + fq * 8);
                    __builtin_amdgcn_sched_barrier(0);
#pragma unroll
                    for (int cb = 0; cb < 4; ++cb) acc[rb][cb] = __builtin_amdgcn_mfma_f32_16x16x32_bf16(bfr[j][cb], af, acc[rb][cb], 0, 0, 0);
                    __builtin_amdgcn_sched_barrier(0); }
            }
        }
        const int l3 = tid_fresh() & 63, fr3 = l3 & 15, fq3 = l3 >> 4;
        bf16* hbw = (bf16*)(ws + WS_HB);
#pragma unroll
        for (int rb = 0; rb < 5; ++rb) { const int t = tokl[rb * 16 + fr3]; float ssq = 0.f;
            if (t >= 0) { GAS f32x4* hp = (GAS f32x4*)(H + (size_t)t * DM + 512 * p + 64 * w + 4 * fq3); GAS unsigned long long* bp = (GAS unsigned long long*)(hbw + (size_t)t * DM + 512 * p + 64 * w + 4 * fq3);
#pragma unroll
                for (int cb = 0; cb < 4; ++cb) { const f32x4 hn = hp[4 * cb] + acc[rb][cb] * upd; hp[4 * cb] = hn; ssq += (hn.x * hn.x + hn.y * hn.y) + (hn.z * hn.z + hn.w * hn.w);
                    bp[4 * cb] = (unsigned long long)pk2(hn.x, hn.y) | ((unsigned long long)pk2(hn.z, hn.w) << 32); } }
            ssq += __shfl_xor(ssq, 16); ssq += __shfl_xor(ssq, 32);
            if (fq3 == 0) ssl[(rb * 16 + fr3) * 16 + p * 8 + w] = ssq; }
    }
    __syncthreads();
    if (F.tid < MROWS) { const int t = tokl[F.tid]; float tot = 0.f;
#pragma unroll
        for (int i = 0; i < 16; ++i) tot += ssl[F.tid * 16 + i];
        if (t >= 0) ((float*)(ws + WS_RSTD))[t] = 1.0f / sqrtf(tot * (1.0f / DM) + 1e-6f); }
    __syncthreads();
#undef MOE_GLOAD
#undef MOE_GSTORE
    }
}

constexpr int OPR_ROWS = 64;
constexpr int OPR_A_OFF = 0, OPR_APB = 2048 + 16;
constexpr int OPR_RW_OFF = OPR_ROWS * OPR_APB;
constexpr int OPR_PART_OFF = OPR_RW_OFF + 20480;
constexpr int OPR_SSQ_OFF = OPR_PART_OFF + 10240;
static_assert(OPR_SSQ_OFF + 512 <= MISC_OFF, "OPR LDS");
__device__ __forceinline__ float opr_red4(const float (&v)[4], int fq) {
    const bool b0 = fq & 1, b1 = fq & 2;
    const float s0 = b0 ? v[0] : v[2], s1 = b0 ? v[1] : v[3], k0 = b0 ? v[2] : v[0], k1 = b0 ? v[3] : v[1];
    const float a0 = k0 + __shfl_xor(s0, 16), a1 = k1 + __shfl_xor(s1, 16);
    const float s = b1 ? a0 : a1, k = b1 ? a1 : a0;
    return k + __shfl_xor(s, 32);
}
__device__ __forceinline__ void opr_fxadd(LAS long long* p, float v, float scale) { const long long fx = (long long)(v * scale); (void)__hip_atomic_fetch_add(p, fx, __ATOMIC_RELAXED, __HIP_MEMORY_SCOPE_WORKGROUP); }
struct OprCtx { const bf16* wt; LAS unsigned char* Al; LAS float* rwl; LAS long long* part; LAS long long* ssl; const float* base; float* H; bf16* hbw; const float* wr; int row0, rot, w; bool dry; };
#define OPR_KS(s_) (((((s_) >> 2) + C.rot) & 7) * 4 + ((s_) & 3))
template <bool K, bool EPI> __device__ __forceinline__ void opr_pass(const OprCtx& C, int p, f32x4m (&acc)[4][2], f32x4m (&hd)[4][2], bf16x8 (&bfr)[8][2], f32x4m (&rwreg)[3]) {
    const int q = p - 1;
    const int tid = tid_fresh(), lane = tid & 63, fr = lane & 15, fq = lane >> 4;
    const unsigned lb = (unsigned)lane * 16u;
    const unsigned eoff = (unsigned)((C.row0 + fr) * DM + 32 * C.w + 4 * fq);
    const LAS unsigned char* ap0 = C.Al + fr * OPR_APB + fq * 16;
    float ss[4] = {0.f, 0.f, 0.f, 0.f};
#pragma unroll
    for (int ks = 0; ks < 32; ++ks) {
        bf16x8 af[4];
        if (K) {
            { int sn = p * 32 + ks + 7; sn = sn < 127 ? sn : 127; const int pn = sn >> 5, kn = OPR_KS(sn & 31);
              const unsigned o = (unsigned)(((((pn >> 1) * 8 + 4 * (pn & 1) + (C.w >> 1)) * 32 + kn) * 4 + 2 * (C.w & 1))) * 1024u;
              const GAS char* wp = (const GAS char*)C.wt + o;
              bfr[(ks + 7) & 7][0] = *(const GAS bf16x8*)(wp + lb); bfr[(ks + 7) & 7][1] = *(const GAS bf16x8*)(wp + 1024 + lb); }
            { const LAS unsigned char* ap = ap0 + OPR_KS(ks) * 64;
#pragma unroll
              for (int rb = 0; rb < 4; ++rb) af[rb] = *(const LAS bf16x8*)(ap + rb * 16 * OPR_APB); }
        }
        __builtin_amdgcn_sched_barrier(0);
        if (K) {
#pragma unroll
            for (int rb = 0; rb < 4; ++rb)
#pragma unroll
                for (int cb = 0; cb < 2; ++cb) acc[rb][cb] = __builtin_amdgcn_mfma_f32_16x16x32_bf16(bfr[ks & 7][cb], af[rb], acc[rb][cb], 0, 0, 0);
        }
        if (EPI) {
            if (ks < 4) {
                const int rb = ks; const unsigned off = eoff + (unsigned)(rb * 16 * DM + 256 * q);
#pragma unroll
                for (int cb = 0; cb < 2; ++cb) { const f32x4m hn = hd[rb][cb];
                    if (!C.dry) { *(GAS f32x4m*)((GAS char*)C.H + (size_t)(off + 16 * cb) * 4u) = hn;
                                  *(GAS unsigned long long*)((GAS char*)C.hbw + (size_t)(off + 16 * cb) * 2u) = (unsigned long long)pk2(hn.x, hn.y) | ((unsigned long long)pk2(hn.z, hn.w) << 32); }
                    ss[rb] += (hn.x * hn.x + hn.y * hn.y) + (hn.z * hn.z + hn.w * hn.w); }
            } else if (ks == 4) {
                const float t = opr_red4(ss, fq); const int rs = 2 * (fq & 1) + (fq >> 1);
                opr_fxadd(C.ssl + rs * 16 + fr, t, 16777216.0f);
            } else if (ks < 25) {
                const int qc = ks - 5; const LAS float* wv = C.rwl + qc * 256 + 32 * C.w + 4 * fq;
                const f32x4m w0 = *(const LAS f32x4m*)wv, w1 = *(const LAS f32x4m*)(wv + 16);
                float pd[4];
#pragma unroll
                for (int rb = 0; rb < 4; ++rb) pd[rb] = ((hd[rb][0].x * w0.x + hd[rb][0].y * w0.y) + (hd[rb][0].z * w0.z + hd[rb][0].w * w0.w)) + ((hd[rb][1].x * w1.x + hd[rb][1].y * w1.y) + (hd[rb][1].z * w1.z + hd[rb][1].w * w1.w));
                const float t = opr_red4(pd, fq); const int rs = 2 * (fq & 1) + (fq >> 1);
                opr_fxadd(C.part + qc * 64 + rs * 16 + fr, t, 4294967296.0f);
            }
        }
        if (K) {
            if (ks >= 25 && ks < 29) {
                const int rb = ks - 25; const GAS char* bp = (const GAS char*)C.base + (size_t)(eoff + (unsigned)(rb * 16 * DM + 256 * p)) * 4u;
                hd[rb][0] = *(const GAS f32x4m*)bp; hd[rb][1] = *(const GAS f32x4m*)(bp + 64);
            } else if (ks == 29) {
#pragma unroll
                for (int i = 0; i < 3; ++i) { const int idx = tid + 512 * i; const int qq = idx >> 6, c4 = idx & 63;
                    if (idx < 1280) rwreg[i] = *(const GAS f32x4m*)((const GAS char*)C.wr + (size_t)(unsigned)(qq * DM + 256 * p + 4 * c4) * 4u); }
            }
        }
        __builtin_amdgcn_sched_barrier(0);
    }
}
template <bool MERGE> __device__ __forceinline__ void p_opr(const KA a, Frame& F, int layer, const bf16* Wt_all, const float* base, bool dry) {
    unsigned char* ws = a.ws(); asm volatile("" : "+s"(ws)); ASSUME_GLOBAL(ws);
    OprCtx C;
    C.Al = F.lds + OPR_A_OFF; C.rwl = (LAS float*)(F.lds + OPR_RW_OFF); C.part = (LAS long long*)(F.lds + OPR_PART_OFF); C.ssl = (LAS long long*)(F.lds + OPR_SSQ_OFF);
    C.base = base; C.H = a.out(); C.hbw = (bf16*)(ws + WS_HB); C.wr = (const float*)(ws + WS_WR) + (size_t)layer * 20 * DM;
    C.w = F.wave; C.dry = dry; C.wt = Wt_all;
    LAS float* wql = C.rwl;
    for (int u = bid_fresh(); u < TOK / OPR_ROWS; u += (int)gridDim.x) {
    C.row0 = u * OPR_ROWS; C.rot = (u * 3) & 7;
    for (int i = F.tid; i < 21 * 64; i += NWAVES * 64) C.part[i] = 0ll;
    if (MERGE) {
        const int r = F.tid >> 3, hh = F.tid & 7; const float* lp = (const float*)(ws + WS_LSE) + (size_t)(C.row0 + r) * 24 + hh;
        const float l0 = *(const GAS float*)lp, l1 = *(const GAS float*)(lp + 8), l2 = *(const GAS float*)(lp + 16);
        const float mx = fmaxf(l0, fmaxf(l1, l2)); const float e0 = expf(l0 - mx), e1 = expf(l1 - mx), e2 = expf(l2 - mx), inv = 1.0f / (e0 + e1 + e2);
        *(LAS f32x4*)(wql + (r * 8 + hh) * 4) = (f32x4){e0 * inv, e1 * inv, e2 * inv, 0.f};
        __syncthreads();
    }
    { const bf16* asrc = (const bf16*)(ws + WS_QB);
      const int c = F.tid & 127, r0 = F.tid >> 7;
      constexpr int NG = MERGE ? 3 : 1, NB = MERGE ? 2 : 1, PB = 16 / NB;
#pragma unroll 1
      for (int b = 0; b < NB; ++b) {
          v4u greg[PB][NG];
#pragma unroll
          for (int i = 0; i < PB; ++i)
#pragma unroll
              for (int g = 0; g < NG; ++g) greg[i][g] = *(const GAS v4u*)(asrc + (size_t)(C.row0 + r0 + 4 * (b * PB + i)) * (MERGE ? 3072 : 1024) + g * 1024 + c * 8);
#pragma unroll
          for (int i = 0; i < PB; ++i) { const int r = r0 + 4 * (b * PB + i); v4u o_;
              if (MERGE) { const f32x4 wq_ = *(const LAS f32x4*)(wql + (r * 8 + (c >> 4)) * 4);
                  const unsigned x0_[4] = {greg[i][0].x, greg[i][0].y, greg[i][0].z, greg[i][0].w}, x1_[4] = {greg[i][NG > 1 ? 1 : 0].x, greg[i][NG > 1 ? 1 : 0].y, greg[i][NG > 1 ? 1 : 0].z, greg[i][NG > 1 ? 1 : 0].w},
                                 x2_[4] = {greg[i][NG > 2 ? 2 : 0].x, greg[i][NG > 2 ? 2 : 0].y, greg[i][NG > 2 ? 2 : 0].z, greg[i][NG > 2 ? 2 : 0].w}; unsigned y_[4];
#pragma unroll
                  for (int e = 0; e < 4; ++e) { const float lo_ = wq_.x * bf2f(x0_[e] & 0xffffu) + wq_.y * bf2f(x1_[e] & 0xffffu) + wq_.z * bf2f(x2_[e] & 0xffffu),
                                                            hi_ = wq_.x * bf2f(x0_[e] >> 16) + wq_.y * bf2f(x1_[e] >> 16) + wq_.z * bf2f(x2_[e] >> 16); y_[e] = pk2(lo_, hi_); }
                  o_ = (v4u){y_[0], y_[1], y_[2], y_[3]}; } else o_ = greg[i][0];
              *(LAS v4u*)(C.Al + r * OPR_APB + c * 16) = o_; }
      } }
    __builtin_amdgcn_sched_barrier(0);
    f32x4m acc[4][2], hd[4][2], rwreg[3]; bf16x8 bfr[8][2];
#pragma unroll
    for (int rb = 0; rb < 4; ++rb)
#pragma unroll
        for (int cb = 0; cb < 2; ++cb) { acc[rb][cb] = (f32x4m){0.f, 0.f, 0.f, 0.f}; hd[rb][cb] = (f32x4m){0.f, 0.f, 0.f, 0.f}; }
#pragma unroll
    for (int i = 0; i < 3; ++i) rwreg[i] = (f32x4m){0.f, 0.f, 0.f, 0.f};
#pragma unroll
    for (int s = 0; s < 7; ++s) { const unsigned o = (unsigned)((((C.w >> 1) * 32 + OPR_KS(s)) * 4 + 2 * (C.w & 1))) * 1024u; const unsigned lb = (unsigned)F.lane * 16u;
        bfr[s][0] = *(const GAS bf16x8*)((const GAS char*)Wt_all + o + lb); bfr[s][1] = *(const GAS bf16x8*)((const GAS char*)Wt_all + o + 1024 + lb); }
    LDS_WAIT(); __builtin_amdgcn_s_barrier(); asm volatile("" ::: "memory");
#define OPR_BOUNDARY() do { \
        _Pragma("unroll") for (int rb = 0; rb < 4; ++rb) _Pragma("unroll") for (int cb = 0; cb < 2; ++cb) { hd[rb][cb] = acc[rb][cb] + hd[rb][cb]; acc[rb][cb] = (f32x4m){0.f, 0.f, 0.f, 0.f}; } \
        LDS_WAIT(); __builtin_amdgcn_s_barrier(); asm volatile("" ::: "memory"); \
        _Pragma("unroll") for (int i = 0; i < 3; ++i) { const int idx = F.tid + 512 * i; if (idx < 1280) *(LAS f32x4m*)(C.rwl + 4 * idx) = rwreg[i]; } \
        LDS_WAIT(); __builtin_amdgcn_s_barrier(); asm volatile("" ::: "memory"); } while (0)
    opr_pass<true, false>(C, 0, acc, hd, bfr, rwreg);
    OPR_BOUNDARY();
#pragma unroll 1
    for (int p = 1; p < 4; ++p) { opr_pass<true, true>(C, p, acc, hd, bfr, rwreg); OPR_BOUNDARY(); }
    opr_pass<false, true>(C, 4, acc, hd, bfr, rwreg);
#undef OPR_BOUNDARY
    LDS_WAIT(); __builtin_amdgcn_s_barrier(); asm volatile("" ::: "memory");
    if (F.tid < OPR_ROWS) { const int m = C.row0 + F.tid;
        const float tot = (float)C.ssl[F.tid] * (1.0f / 16777216.0f);
        const float rsr = 1.0f / sqrtf(tot * (1.0f / DM) + 1e-6f);
        ((float*)(ws + WS_RSTD))[m] = rsr;
        float d[20];
#pragma unroll
        for (int q = 0; q < 20; ++q) d[q] = ((float)C.part[q * 64 + F.tid] * (1.0f / 4294967296.0f)) * rsr;
        const float* gb = a.in(17) + layer * 4;
        float lg[4];
#pragma unroll
        for (int q = 0; q < 4; ++q) lg[q] = d[q] + gb[q];
        int gi = 0; float gm = lg[0];
#pragma unroll
        for (int q = 1; q < 4; ++q) if (lg[q] > gm) { gm = lg[q]; gi = q; }
        float gs = 0.f;
#pragma unroll
        for (int q = 0; q < 4; ++q) gs += expf(lg[q] - gm);
        const float gp = 1.0f / gs;
        const float* ebp = a.in(19) + layer * 16;
        float el[4];
#pragma unroll
        for (int q = 0; q < 4; ++q) { float t = 0.f;
#pragma unroll
            for (int g2 = 0; g2 < 4; ++g2) if (g2 == gi) t = d[4 + 4 * g2 + q] + ebp[4 * g2 + q];
            el[q] = t; }
        int i1 = 0; float v1 = el[0];
#pragma unroll
        for (int q = 1; q < 4; ++q) if (el[q] > v1) { v1 = el[q]; i1 = q; }
        int i2 = -1; float v2 = 0.f;
#pragma unroll
        for (int q = 0; q < 4; ++q) if (q != i1 && (i2 < 0 || el[q] > v2)) { v2 = el[q]; i2 = q; }
        const float e2 = expf(v2 - v1), g1 = gp / (1.0f + e2), g2v = gp * e2 / (1.0f + e2);
        const int lo = i1 < i2 ? i1 : i2, hi = i1 < i2 ? i2 : i1;
        const int pidx = (lo == 0) ? (hi - 1) : (lo == 1 ? hi + 1 : 5);
        const int cls = gi * 6 + pidx;
        int rank = 0, mycnt = 0;
#pragma unroll 1
        for (int c = 0; c < NCLS; ++c) { const unsigned long long mk = __ballot(cls == c); if (cls == c) rank = __popcll(mk & ((1ull << F.tid) - 1ull)); if (F.tid == c) mycnt = __popcll(mk); }
        const int sub = u & 7;
        unsigned basev = 0u;
        if (!dry && F.tid < NCLS && mycnt > 0) basev = __hip_atomic_fetch_add((unsigned*)(ws + WS_CTL) + CW_CNT2 + layer * 8192 + (F.tid * 8 + sub) * 32, (unsigned)mycnt, RLX_AGENT);
        const unsigned pp = (unsigned)__shfl((int)basev, cls) + (unsigned)rank;
        if (!dry) {
            ((int*)(ws + WS_LIST))[(size_t)cls * TOK + sub * 2048 + pp] = m;
            ((float*)(ws + WS_GA))[m] = (i1 < i2) ? g1 : g2v;
            ((float*)(ws + WS_GB))[m] = (i1 < i2) ? g2v : g1;
        }
    }
    __syncthreads();
    }
#undef OPR_KS
}

__global__ void __launch_bounds__(NWAVES * 64, 2) fwd_kernel(Args args_unused_directly) {
    extern __shared__ __attribute__((aligned(16))) unsigned char lds[];
    Frame F;
    F.lds = (LAS unsigned char*)lds;
    F.tid = threadIdx.x; F.lane = F.tid & 63; F.wave = __builtin_amdgcn_readfirstlane(F.tid >> 6);
    F.G = gridDim.x; { const int bx = blockIdx.x; F.vcu = (F.G % 8 == 0) ? (bx % 8) * (F.G / 8) + bx / 8 : bx; }
    const kptr_t kbase = (kptr_t)__builtin_amdgcn_kernarg_segment_ptr();
    unsigned char* const ws0 = KA{kbase}.ws();
    volatile LAS unsigned* MISC = (volatile LAS unsigned*)(F.lds + MISC_OFF);
    if (F.tid < 64) MISC[F.tid] = 0u;
    __syncthreads();
    const int lo = *(const int __attribute__((address_space(4)))*)(kbase + 208), hi = *(const int __attribute__((address_space(4)))*)(kbase + 212);
    XcdBarrier bar; bar.bar = (unsigned*)(ws0 + WS_CTL) + CW_BAR; bar.x = 0; bar.st = nullptr;
    if (hi - lo > 1) bar = xcd_barrier_post((unsigned*)(ws0 + WS_CTL) + CW_BAR, MISC + 8);
    int pc = 0;
#ifndef PH_EN
#define PH_EN 0xFFFF
#endif
#ifndef REP_MASK
#define REP_MASK 0
#endif
#define RUN(id, ...) RUN_(id, 1, __VA_ARGS__)
#define RUN_(id, bar_, ...) do { if (((PH_EN >> (id)) & 1) && pc >= lo && pc < hi) { \
      for (int rep_ = ((REP_MASK >> (id)) & 1); rep_ >= 0; --rep_) { const bool dry = rep_ > 0; (void)dry; kptr_t kl_ = kbase; asm volatile("" : "+s"(kl_)); const KA args{kl_}; unsigned char* ws = args.ws(); asm volatile("" : "+s"(ws)); ASSUME_GLOBAL(ws); \
        F.tid = tid_fresh(); F.lane = F.tid & 63; F.wave = __builtin_amdgcn_readfirstlane(F.tid >> 6); { const int bx = bid_fresh(); F.vcu = (F.G % 8 == 0) ? (bx % 8) * (F.G / 8) + bx / 8 : bx; } \
        __VA_ARGS__; } } if ((bar_) && pc >= lo && pc + 1 < hi) xcd_barrier(bar); ++pc; } while (0)

    RUN_(0, 0, { p_prologue(args, F); __syncthreads(); });
    for (int l = 0; l < NL; ++l) {
        if (l < NA) {
            RUN(1, p_rowpass<1>(args, F, l, false, l == 0 ? args.in(0) : args.out(), l == 0));
            RUN(2, {

                { const int bx = bid_fresh(); if (bx < BATCH * AH) attn_body::fox_scan((char*)lds + RING_OFF, (const float*)(ws + WS_LOGF) + (size_t)bx * SEQ, (unsigned long long*)(ws + WS_CAUG) + (size_t)bx * SEQ); }
                pg8::Gemm g{(const pg8::bf16_t*)(ws + WS_HB), (const pg8::bf16_t*)(ws + WS_WIN) + (size_t)l * 3072 * DM, TOK, 3072, DM};
                pg8::StaticOrder S; S.init(TOK, 3072, F.G, bid_fresh());
                pg8::EpiAQkv E{(pg8::bf16_t*)(ws + WS_QB), (size_t)(16 * MiB), (const float*)(ws + WS_RSTD), (const float*)(ws + WS_GTAB) + l * 192};
                pg8::gemm_phase<pg8::EpiAQkv, pg8::StaticOrder, true, true>(F.lds + RING_OFF, g, S, E);
            });
            RUN(3, {
                const attn_body::AttnTensors AT{(const attn_body::bf16*)(ws + WS_QB), (const attn_body::bf16*)(ws + WS_QB + 32 * MiB), (const attn_body::bf16*)(ws + WS_QB + 64 * MiB),
                                                (attn_body::bf16*)(ws + (dry ? WS_KB : WS_QB)), (const unsigned long long*)(ws + WS_CAUG)};
                unsigned* cq = (unsigned*)(ws + WS_CTL) + CW_CQ + (l * 2 + (dry ? 1 : 0)) * 64;
                const bool cmain = l == 0; const int clo = cmain ? TR_I_WIN : 0, chi = cmain ? TR_NITEMS : 6144;
                _Pragma("unroll 1") for (int pass = 0; pass < 2; ++pass) {
                    if (pass == 1 || (F.vcu & 3) == 0) conv_drain(args, ws, F, cq, cmain, 2, clo, chi);
                    if (pass == 0) { attn_body::attn_phase_dyn<8>((char*)lds + RING_OFF, AT, (unsigned*)(ws + WS_CTL) + CW_AQ + (l * 2 + (dry ? 1 : 0)) * 64); __syncthreads(); }
                }
            });
            RUN(4, {
                p_opr<false>(args, F, l, (const bf16*)(ws + WS_WOA) + (size_t)l * DM * DM, l == 0 ? args.in(0) : args.out(), dry);
            });
        } else {
            const int j = l - NA;
            RUN(6, {
                const int N = j == 0 ? 5120 : 3072;
                pg8::Gemm g{(const pg8::bf16_t*)(ws + WS_HB), j == 0 ? (const pg8::bf16_t*)(ws + WS_WKVQ0) : (const pg8::bf16_t*)(ws + WS_WQ1), TOK, N, DM};
                pg8::StaticOrder S; S.init(TOK, N, F.G, bid_fresh());
                pg8::EpiBKvq E{(pg8::bf16_t*)(ws + WS_KB), (pg8::bf16_t*)(ws + WS_VB), (pg8::bf16_t*)(ws + WS_QB), (const float*)(ws + WS_RSTD), args.in(10), args.in(13) + j * BG * BHD,
                               (const unsigned*)(ws + WS_ROPEC), j == 0 ? 0 : 8, (PG8_LAS float*)(F.lds + XS_OFF)};
                pg8::gemm_phase<pg8::EpiBKvq, pg8::StaticOrder, true, true>(F.lds + RING_OFF, g, S, E);
            });
            RUN(7, p_battn(args, F, dry));
            RUN(9, {
                if (l == 2) {
                    LAS float* scr = (LAS float*)(F.lds + RING_OFF + F.wave * 16384);
                    tr_run<false>(args, ws, 3, 6144, F.vcu * NWAVES + F.wave, F.G * NWAVES, scr, F.lane);
                    __syncthreads();
                }
                p_opr<true>(args, F, l, (const bf16*)(ws + WS_WOB) + (size_t)j * DM * DM, args.out(), dry);
            });
        }
        RUN(11, p_moe(args, F, l, dry ? 0.f : 1.f));
    }
#undef RUN
}
constexpr int N_PHASES = 1 + NA * 5 + NB * 4;

#ifndef MK_ONE_LAUNCH
#define MK_ONE_LAUNCH 1
#endif
extern "C" void kernel_launch(void* const* d_in, const int* in_sizes, int n_in, void* d_out, int out_size, void* d_ws, size_t ws_size, hipStream_t stream) {
    static int grid = 0;
    if (grid == 0) {
        if (n_in != 23 || out_size != TOK * DM || ws_size < WS_END) { fprintf(stderr, "kernel_launch: unexpected shapes (n_in %d, out %d, ws %zu)\n", n_in, out_size, ws_size); grid = -1; return; }
        int dev = 0, cus = 0;
        if (hipGetDevice(&dev) != hipSuccess || hipDeviceGetAttribute(&cus, hipDeviceAttributeMultiprocessorCount, dev) != hipSuccess) { grid = -1; return; }
        if (hipFuncSetAttribute((const void*)fwd_kernel, hipFuncAttributeMaxDynamicSharedMemorySize, LDS_BYTES) != hipSuccess) { fprintf(stderr, "kernel_launch: hipFuncSetAttribute failed\n"); grid = -1; return; }
        int per_cu = 0;
        if (hipOccupancyMaxActiveBlocksPerMultiprocessor(&per_cu, (const void*)fwd_kernel, NWAVES * 64, LDS_BYTES) != hipSuccess || per_cu < 1) fprintf(stderr, "kernel_launch: occupancy query says %d\n", per_cu);
        (void)hipGetLastError();
        grid = cus;
    }
    if (grid < 0) return;
    if (hipMemsetAsync((char*)d_ws + WS_CTL, 0, CTL_ZERO_BYTES, stream) != hipSuccess) return;
    Args a{};
    for (int i = 0; i < 23; ++i) a.in[i] = (const float*)d_in[i];
    a.in[23] = nullptr;
    a.out = (float*)d_out; a.ws = (unsigned char*)d_ws;
#if MK_ONE_LAUNCH
    a.ph_lo = 0; a.ph_hi = N_PHASES;
    hipLaunchKernelGGL(fwd_kernel, dim3(grid), dim3(NWAVES * 64), LDS_BYTES, stream, a);
#else
    for (int p = 0; p < N_PHASES; ++p) { a.ph_lo = p; a.ph_hi = p + 1;
        hipLaunchKernelGGL(fwd_kernel, dim3(grid), dim3(NWAVES * 64), LDS_BYTES, stream, a); }
#endif
}
```

```cpp
#include <hip/hip_runtime.h>
#include <hip/hip_bf16.h>
#include <cstdio>
#include <cstdint>
#include <cmath>
__device__ __forceinline__ int tid_fresh() { int t = (int)threadIdx.x; asm volatile("" : "+v"(t)); return t; }
__device__ __forceinline__ int bid_fresh() { int t = (int)blockIdx.x; asm volatile("" : "+s"(t)); return t; }
#if defined(__HIP_DEVICE_COMPILE__)
#define ASSUME_GLOBAL(p_) do { __builtin_assume(!__builtin_amdgcn_is_shared((const void*)(p_))); __builtin_assume(!__builtin_amdgcn_is_private((const void*)(p_))); } while (0)
#else
#define ASSUME_GLOBAL(p_) do { } while (0)
#endif
namespace pg8 {
#define PG8_LAS __attribute__((address_space(3)))
typedef unsigned short bf16_t;
typedef short bf16x8 __attribute__((ext_vector_type(8)));
typedef float f32x4 __attribute__((ext_vector_type(4)));
typedef unsigned u32x4 __attribute__((ext_vector_type(4)));
constexpr int BM = 256, BK = 64, HALF = 128, HTB = HALF * BK * 2  , STAGE_BYTES = 8 * HTB, NXCD = 8, WGM = 8;

__host__ __device__ __forceinline__ int lds_byte(int r, int c) { const int st = (r >> 4) * 2 + (c >> 5), rr = r & 15, cc = c & 31, ob = rr * 64 + cc * 2; return st * 1024 + (ob ^ (((ob >> 9) & 1) << 5)); }
__host__ __device__ __forceinline__ void stage_rc(int b, int& R, int& C) { const int st = b / 1024, sb = b % 1024, swz = sb ^ (((sb >> 9) & 1) << 5); R = (st >> 1) * 16 + swz / 64; C = (st & 1) * 32 + (swz % 64) / 2; }
__host__ __device__ __forceinline__ int perm32(int rho) { const int n = rho >> 4, i = rho & 15; return 8 * (i >> 2) + 4 * n + (i & 3); }

struct Unit { int pm, pn; };
struct Gemm { const bf16_t* A; const bf16_t* Bt; int M, N, K; };

struct StaticOrder {
    int nM, nN, nwg, G, c;
    __host__ __device__ void init(int M, int N, int G_, int c_) { nM = M / BM; nN = N / BM; nwg = nM * nN; G = G_; c = c_; }
    __host__ __device__ bool next(int i, Unit& u) const {
        const long L = (long)i * G + c; if (L >= nwg) return false;
        int wgid = (int)L; { const int q = nwg / NXCD, r = nwg % NXCD, xcd = wgid % NXCD, off = wgid / NXCD; wgid = (xcd < r ? xcd * (q + 1) : r * (q + 1) + (xcd - r) * q) + off; }
        const int nig = WGM * nN, gid = wgid / nig, fm = gid * WGM, gsz = (nM - fm) < WGM ? (nM - fm) : WGM;
        u.pm = fm + ((wgid % nig) % gsz); u.pn = (wgid % nig) / gsz; return true;
    }
    __device__ __forceinline__ void a_ready(const Unit&) const {}
    __device__ __forceinline__ void done(const Unit&) const {}
};

__device__ __forceinline__ unsigned cvt_pk_bf16(float lo, float hi) { unsigned r; asm volatile("v_cvt_pk_bf16_f32 %0, %1, %2" : "=v"(r) : "v"(lo), "v"(hi)); return r; }
typedef float f32x2 __attribute__((ext_vector_type(2)));
constexpr float RMS_EPS = 1e-6f;
#define PG8_GAS __attribute__((address_space(1)))
__device__ __forceinline__ void st16(bf16_t* p, const float (&o)[8]) { u32x4 w; w.x = cvt_pk_bf16(o[0], o[1]); w.y = cvt_pk_bf16(o[2], o[3]); w.z = cvt_pk_bf16(o[4], o[5]); w.w = cvt_pk_bf16(o[6], o[7]); *(PG8_GAS u32x4*)p = w; }
struct EpiAQkv {
    static constexpr bool PERM = true, AFTER_DRAIN = false;
    bf16_t* QKV; size_t sec_stride; const float* rstd; const float* gtab;
    __device__ __forceinline__ void operator()(const f32x4 (&acc)[2][2][4][2], const Unit& u, int wr, int wc, int fr, int fq) const {
        const int sec = u.pn >> 2, head = (u.pn & 3) * 4 + wc;
        bf16_t* dst = QKV + (size_t)sec * sec_stride + head * 64 + 8 * fq;
        const float* gp = gtab + sec * 64 + 8 * fq;
        const bool nrm = sec < 2;
        float rsv[2][4]; const float* rp = rstd + u.pm * BM + wr * 64 + fr;
#pragma unroll
        for (int ai = 0; ai < 2; ++ai)
#pragma unroll
            for (int m = 0; m < 4; ++m) rsv[ai][m] = *(const PG8_GAS float*)(rp + ai * HALF + m * 16);
        f32x4 g[2][2];
#pragma unroll
        for (int bj = 0; bj < 2; ++bj)
#pragma unroll
            for (int n = 0; n < 2; ++n) g[bj][n] = *(const PG8_GAS f32x4*)(gp + 32 * bj + 4 * n);
#pragma unroll
        for (int ai = 0; ai < 2; ++ai)
#pragma unroll
            for (int m = 0; m < 4; ++m) {
                const int row = u.pm * BM + ai * HALF + wr * 64 + m * 16 + fr;
                const float rs = rsv[ai][m];
                f32x4 v[2][2];
#pragma unroll
                for (int bj = 0; bj < 2; ++bj)
#pragma unroll
                    for (int n = 0; n < 2; ++n) v[bj][n] = acc[ai][bj][m][n] * rs;
                float s = 0.f;
#pragma unroll
                for (int bj = 0; bj < 2; ++bj)
#pragma unroll
                    for (int n = 0; n < 2; ++n) { const f32x4 x = v[bj][n]; s += (x[0] * x[0] + x[1] * x[1]) + (x[2] * x[2] + x[3] * x[3]); }
                s += __shfl_xor(s, 16); s += __shfl_xor(s, 32);
                const float sc = nrm ? __builtin_amdgcn_rsqf(s * (1.0f / 64.0f) + RMS_EPS) : 1.0f;
#pragma unroll
                for (int bj = 0; bj < 2; ++bj) { const f32x4 o0 = v[bj][0] * sc * g[bj][0], o1 = v[bj][1] * sc * g[bj][1];
                    u32x4 w; w.x = cvt_pk_bf16(o0[0], o0[1]); w.y = cvt_pk_bf16(o0[2], o0[3]); w.z = cvt_pk_bf16(o1[0], o1[1]); w.w = cvt_pk_bf16(o1[2], o1[3]);
                    *(PG8_GAS u32x4*)(dst + (size_t)row * 1024 + 32 * bj) = w; }
            }
    }
};
struct EpiBKvq {
    static constexpr bool PERM = true, AFTER_DRAIN = false;
    bf16_t *KB, *VB, *QB; const float* rstd; const float *kg, *qg  ; const unsigned* rcs  ; int tile_off; PG8_LAS float* xs;
    __device__ __forceinline__ void operator()(const f32x4 (&acc)[2][2][4][2], const Unit& u, int wr, int wc, int fr, int fq) const {
        const int T = u.pn + tile_off;
        float rsv[2][4]; const float* rp = rstd + u.pm * BM + wr * 64 + fr;
#pragma unroll
        for (int ai = 0; ai < 2; ++ai)
#pragma unroll
            for (int m = 0; m < 4; ++m) rsv[ai][m] = *(const PG8_GAS float*)(rp + ai * HALF + m * 16);
        if (T >= 4 && T < 8) {
            bf16_t* dst = VB + (T - 4) * 256 + 32 * wc + 8 * fq;
#pragma unroll
            for (int ai = 0; ai < 2; ++ai)
#pragma unroll
                for (int m = 0; m < 4; ++m) {
                    const int row = u.pm * BM + ai * HALF + wr * 64 + m * 16 + fr; const float rs = rsv[ai][m];
#pragma unroll
                    for (int bj = 0; bj < 2; ++bj) { float o[8];
#pragma unroll
                        for (int n = 0; n < 2; ++n)
#pragma unroll
                            for (int e = 0; e < 4; ++e) o[4 * n + e] = acc[ai][bj][m][n][e] * rs;
                        st16(dst + (size_t)row * 1024 + 128 * bj, o); }
                }
            return;
        }
        const bool isq = T >= 8; const int grp = isq ? ((T - 8) >> 2) : 0, head = (isq ? ((T - 8) & 3) : T) * 2 + (wc >> 1);
        const int d1 = 32 * (wc & 1) + 8 * fq;
        const float* gp = isq ? (qg + grp * 128) : kg;
        f32x4 g[2][2];
#pragma unroll
        for (int bj = 0; bj < 2; ++bj)
#pragma unroll
            for (int n = 0; n < 2; ++n) g[bj][n] = *(const PG8_GAS f32x4*)(gp + 64 * bj + d1 + 4 * n);
        const unsigned* rcp = rcs + (size_t)(u.pm * BM + wr * 64 + fr) * 64 + d1;
        u32x4 rn0 = *(const PG8_GAS u32x4*)(rcp), rn1 = *(const PG8_GAS u32x4*)(rcp + 4);
        float ss[2][4];
#pragma unroll
        for (int ai = 0; ai < 2; ++ai)
#pragma unroll
            for (int m = 0; m < 4; ++m) {
                const float rs = rsv[ai][m];
                float s = 0.f;
#pragma unroll
                for (int bj = 0; bj < 2; ++bj)
#pragma unroll
                    for (int n = 0; n < 2; ++n) { const f32x4 x = acc[ai][bj][m][n] * rs; s += (x[0] * x[0] + x[1] * x[1]) + (x[2] * x[2] + x[3] * x[3]); }
                s += __shfl_xor(s, 16); s += __shfl_xor(s, 32);
                ss[ai][m] = s;
                if (fq == 0) xs[(ai * HALF + wr * 64 + m * 16 + fr) * 4 + wc] = s;
            }
        asm volatile("s_waitcnt lgkmcnt(0)" ::: "memory"); __builtin_amdgcn_s_barrier(); asm volatile("" ::: "memory");
        bf16_t* dst = isq ? (QB + grp * 1024 + head * 128 + d1) : (KB + head * 128 + d1);
        const size_t pitch = isq ? 3072 : 1024;
#pragma unroll
        for (int ai = 0; ai < 2; ++ai)
#pragma unroll
            for (int m = 0; m < 4; ++m) {
                const int rl = ai * HALF + wr * 64 + m * 16 + fr, row = u.pm * BM + rl; const float rs = rsv[ai][m];
                const u32x4 rc0 = rn0, rc1 = rn1;
                { const int gi = ai * 4 + m + 1, an = (gi >> 2) & 1, mn = gi & 3; rn0 = *(const PG8_GAS u32x4*)(rcp + (size_t)(an * HALF + mn * 16) * 64); rn1 = *(const PG8_GAS u32x4*)(rcp + (size_t)(an * HALF + mn * 16) * 64 + 4); }
                const float tot = ss[ai][m] + xs[rl * 4 + (wc ^ 1)];
                const float sc = rs * __builtin_amdgcn_rsqf(tot * (1.0f / 128.0f) + RMS_EPS);
                float o1[8], o2[8];
#pragma unroll
                for (int n = 0; n < 2; ++n)
#pragma unroll
                    for (int e = 0; e < 4; ++e) { const int j = 4 * n + e;
                        const float y1 = acc[ai][0][m][n][e] * sc * g[0][n][e], y2 = acc[ai][1][m][n][e] * sc * g[1][n][e];
                        const unsigned cw = n ? rc1[e] : rc0[e];
                        const float c = (float)__builtin_bit_cast(_Float16, (unsigned short)(cw & 0xffffu)), sn = (float)__builtin_bit_cast(_Float16, (unsigned short)(cw >> 16));
                        o1[j] = y1 * c - y2 * sn; o2[j] = y2 * c + y1 * sn; }
                st16(dst + (size_t)row * pitch, o1); st16(dst + (size_t)row * pitch + 64, o2);
            }
        asm volatile("s_waitcnt lgkmcnt(0)" ::: "memory"); __builtin_amdgcn_s_barrier(); asm volatile("" ::: "memory");
    }
};
struct EpiResid {
    static constexpr bool PERM = true, AFTER_DRAIN = false;
    const float* B; float* H; float upd;
    __device__ __forceinline__ void operator()(const f32x4 (&acc)[2][2][4][2], const Unit& u, int wr, int wc, int fr, int fq) const {
        const size_t r0 = (size_t)(u.pm * BM + wr * 64 + fr) * 1024 + u.pn * BM + wc * 32 + 8 * fq;
        const float* bp = B + r0; float* hp = H + r0;
        f32x4 nx[2][2];
#pragma unroll
        for (int bj = 0; bj < 2; ++bj)
#pragma unroll
            for (int n = 0; n < 2; ++n) nx[bj][n] = *(const PG8_GAS f32x4*)(bp + bj * HALF + 4 * n);
#pragma unroll
        for (int ai = 0; ai < 2; ++ai)
#pragma unroll
            for (int m = 0; m < 4; ++m) { const size_t ro = (size_t)(ai * HALF + m * 16) * 1024;
                f32x4 cu[2][2];
#pragma unroll
                for (int bj = 0; bj < 2; ++bj)
#pragma unroll
                    for (int n = 0; n < 2; ++n) cu[bj][n] = nx[bj][n];
                { const int gi = ai * 4 + m + 1, an = (gi >> 2) & 1, mn = gi & 3; const size_t rn = (size_t)(an * HALF + mn * 16) * 1024;
#pragma unroll
                  for (int bj = 0; bj < 2; ++bj)
#pragma unroll
                      for (int n = 0; n < 2; ++n) nx[bj][n] = *(const PG8_GAS f32x4*)(bp + rn + bj * HALF + 4 * n); }
#pragma unroll
                for (int bj = 0; bj < 2; ++bj)
#pragma unroll
                    for (int n = 0; n < 2; ++n) *(PG8_GAS f32x4*)(hp + ro + bj * HALF + 4 * n) = cu[bj][n] + acc[ai][bj][m][n] * upd; }
    }
};

template <class Epi, class Sched, bool ALIGN_EPI = false, bool SP2 = false>
__device__ __forceinline__ void gemm_phase(PG8_LAS unsigned char* lds, const Gemm g, const Sched& S, const Epi& E) {
    const int tid = tid_fresh(), wid = __builtin_amdgcn_readfirstlane(tid >> 6), lane = tid & 63, wr = wid >> 2, wc = wid & 3, fr = lane & 15, fq = lane >> 4;
    const int K = g.K, nt = K / BK;
    unsigned voffA[2], voffB[2];
#pragma unroll
    for (int i = 0; i < 2; ++i) { int R, C; stage_rc(tid * 16 + i * 8192, R, C); const int Rb = Epi::PERM ? ((R & ~31) + perm32(R & 31)) : R;
        voffA[i] = (unsigned)(R * K + C) * 2u; voffB[i] = (unsigned)(Rb * K + C) * 2u; }
    const size_t kstep = (size_t)(BK * 2);
    const size_t hstep = (size_t)HALF * K * 2;
    const size_t tstep = 2 * hstep;
    const unsigned ldsw = (unsigned)wid * 1024u;
    const int aoff = lds_byte(wr * 64 + fr, fq * 8), boff = lds_byte(wc * 32 + fr, fq * 8);
#define PG8_SA(b, h) (((b) * 2 + (h)) * HTB)
#define PG8_SB(b, h) ((4 + (b) * 2 + (h)) * HTB)
#define PG8_STAGE(bufoff, gbase, voff) do { _Pragma("unroll") for (int _i = 0; _i < 2; ++_i) \
        __builtin_amdgcn_global_load_lds((const unsigned*)((const char*)(gbase) + (voff)[_i]), (PG8_LAS unsigned*)(lds + (bufoff) + ldsw + _i * 8192), 16, 0, 0); } while (0)
#define PG8_LDA(dst, b, h) do { _Pragma("unroll") for (int m = 0; m < 4; ++m) _Pragma("unroll") for (int k = 0; k < 2; ++k) dst[m][k] = *(const PG8_LAS bf16x8*)(lds + PG8_SA(b, h) + aoff + m * 2048 + k * 1024); } while (0)
#define PG8_LDB(dst, b, h) do { _Pragma("unroll") for (int n = 0; n < 2; ++n) _Pragma("unroll") for (int k = 0; k < 2; ++k) dst[n][k] = *(const PG8_LAS bf16x8*)(lds + PG8_SB(b, h) + boff + n * 2048 + k * 1024); } while (0)
#define PG8_MMA(ai, bj, At, Bt) do { __builtin_amdgcn_s_setprio(1); _Pragma("unroll") for (int m = 0; m < 4; ++m) _Pragma("unroll") for (int n = 0; n < 2; ++n) _Pragma("unroll") for (int k = 0; k < 2; ++k) \
        acc[ai][bj][m][n] = __builtin_amdgcn_mfma_f32_16x16x32_bf16(Bt[n][k], At[m][k], acc[ai][bj][m][n], 0, 0, 0); __builtin_amdgcn_s_setprio(0); } while (0)
#define PG8_WAIT_V(n) asm volatile("s_waitcnt vmcnt(" #n ")" ::: "memory")
#define PG8_WAIT_L(n) asm volatile("s_waitcnt lgkmcnt(" #n ")" ::: "memory")
#define PG8_BAR __builtin_amdgcn_s_barrier()
#define PG8_SCHED __builtin_amdgcn_sched_barrier(0)
    Unit cur, nxt; int ui = 0;
    if (!S.next(0, cur)) return;
    f32x4 acc[2][2][4][2];
#pragma unroll
    for (int a = 0; a < 2; ++a)
#pragma unroll
        for (int b = 0; b < 2; ++b)
#pragma unroll
            for (int m = 0; m < 4; ++m)
#pragma unroll
                for (int n = 0; n < 2; ++n) acc[a][b][m][n] = (f32x4){0.f, 0.f, 0.f, 0.f};
    bf16x8 At[4][2], B0[2][2], B1[2][2];
    const char* cA = (const char*)g.A + (size_t)cur.pm * tstep; const char* cB = (const char*)g.Bt + (size_t)cur.pn * tstep;
    S.a_ready(cur);
    if constexpr (SP2) {
        PG8_STAGE(PG8_SB(0, 0), cB, voffB); PG8_STAGE(PG8_SB(0, 1), cB + hstep, voffB); PG8_STAGE(PG8_SA(0, 0), cA, voffA); PG8_STAGE(PG8_SA(0, 1), cA + hstep, voffA);
        if (wr == 1) PG8_BAR;
        PG8_WAIT_V(2); PG8_BAR;
        PG8_STAGE(PG8_SB(1, 0), cB + kstep, voffB); PG8_STAGE(PG8_SA(1, 0), cA + kstep, voffA); PG8_STAGE(PG8_SB(1, 1), cB + hstep + kstep, voffB);
        PG8_WAIT_V(6); PG8_BAR;
    } else {
        PG8_STAGE(PG8_SB(0, 0), cB, voffB); PG8_STAGE(PG8_SA(0, 0), cA, voffA); PG8_STAGE(PG8_SB(0, 1), cB + hstep, voffB); PG8_STAGE(PG8_SA(0, 1), cA + hstep, voffA);
        if (wr == 1) PG8_BAR;
        PG8_WAIT_V(4); PG8_BAR;
        PG8_STAGE(PG8_SB(1, 0), cB + kstep, voffB); PG8_STAGE(PG8_SA(1, 0), cA + kstep, voffA); PG8_STAGE(PG8_SB(1, 1), cB + hstep + kstep, voffB);
        PG8_WAIT_V(6); PG8_BAR;
    }
    for (;;) {
        const bool has_next = S.next(ui + 1, nxt);
        const char* nA = has_next ? (const char*)g.A + (size_t)nxt.pm * tstep : cA; const char* nB = has_next ? (const char*)g.Bt + (size_t)nxt.pn * tstep : cB;
        for (int t = 0; t < nt; t += 2) {
            const bool last = (t == nt - 2);
            const char* a1 = cA + (size_t)(t + 1) * kstep;
            const char* a2 = last ? nA : cA + (size_t)(t + 2) * kstep; const char* b2 = last ? nB : cB + (size_t)(t + 2) * kstep;
            const char* a3 = a2 + kstep; const char* b3 = b2 + kstep;
            if (last && has_next) S.a_ready(nxt);
            if constexpr (SP2) {
            PG8_LDB(B0, 0, 0); PG8_LDB(B1, 0, 1); PG8_SCHED; PG8_LDA(At, 0, 0); PG8_STAGE(PG8_SA(1, 1), a1 + hstep, voffA);
            PG8_WAIT_V(8); PG8_WAIT_L(0); PG8_BAR; PG8_MMA(0, 0, At, B0); PG8_MMA(0, 1, At, B1); PG8_BAR; PG8_SCHED;
            PG8_LDA(At, 0, 1); PG8_STAGE(PG8_SB(0, 0), b2, voffB); PG8_STAGE(PG8_SB(0, 1), b2 + hstep, voffB); PG8_STAGE(PG8_SA(0, 0), a2, voffA);
            PG8_WAIT_V(8); PG8_WAIT_L(0); PG8_BAR; PG8_MMA(1, 0, At, B0); PG8_MMA(1, 1, At, B1); PG8_BAR; PG8_SCHED;
            PG8_LDB(B0, 1, 0); PG8_LDB(B1, 1, 1); PG8_SCHED; PG8_LDA(At, 1, 0); PG8_STAGE(PG8_SA(0, 1), a2 + hstep, voffA);
            PG8_WAIT_V(8); PG8_WAIT_L(0); PG8_BAR; PG8_MMA(0, 0, At, B0); PG8_MMA(0, 1, At, B1); PG8_BAR; PG8_SCHED;
            PG8_LDA(At, 1, 1); PG8_STAGE(PG8_SB(1, 0), b3, voffB); PG8_STAGE(PG8_SB(1, 1), b3 + hstep, voffB); PG8_STAGE(PG8_SA(1, 0), a3, voffA);
            PG8_WAIT_V(8); PG8_WAIT_L(0); PG8_BAR; PG8_MMA(1, 0, At, B0); PG8_MMA(1, 1, At, B1); PG8_BAR; PG8_SCHED;
            } else {
            PG8_LDB(B0, 0, 0); PG8_SCHED; PG8_LDA(At, 0, 0); PG8_STAGE(PG8_SA(1, 1), a1 + hstep, voffA);
            PG8_WAIT_L(8); PG8_BAR; PG8_WAIT_L(0); PG8_MMA(0, 0, At, B0); PG8_BAR; PG8_SCHED;
            PG8_LDB(B1, 0, 1); PG8_STAGE(PG8_SB(0, 0), b2, voffB);
            PG8_BAR; PG8_WAIT_L(0); PG8_MMA(0, 1, At, B1); PG8_BAR;
            PG8_LDA(At, 0, 1); PG8_STAGE(PG8_SA(0, 0), a2, voffA);
            PG8_BAR; PG8_WAIT_L(0); PG8_MMA(1, 0, At, B0); PG8_BAR; PG8_SCHED;
            PG8_STAGE(PG8_SB(0, 1), b2 + hstep, voffB);
            PG8_WAIT_V(6); PG8_BAR; PG8_MMA(1, 1, At, B1); PG8_BAR;
            PG8_LDB(B0, 1, 0); PG8_SCHED; PG8_LDA(At, 1, 0); PG8_STAGE(PG8_SA(0, 1), a2 + hstep, voffA);
            PG8_WAIT_L(8); PG8_BAR; PG8_WAIT_L(0); PG8_MMA(0, 0, At, B0); PG8_BAR; PG8_SCHED;
            PG8_LDB(B1, 1, 1); PG8_STAGE(PG8_SB(1, 0), b3, voffB);
            PG8_BAR; PG8_WAIT_L(0); PG8_MMA(0, 1, At, B1); PG8_BAR;
            PG8_LDA(At, 1, 1); PG8_STAGE(PG8_SA(1, 0), a3, voffA);
            PG8_BAR; PG8_WAIT_L(0); PG8_MMA(1, 0, At, B0); PG8_BAR; PG8_SCHED;
            PG8_STAGE(PG8_SB(1, 1), b3 + hstep, voffB);
            PG8_WAIT_V(6); PG8_BAR; PG8_MMA(1, 1, At, B1); PG8_BAR;
            }
        }
        if constexpr (ALIGN_EPI) { if (wr == 0) PG8_BAR; }
        if constexpr (!Epi::AFTER_DRAIN) { E(acc, cur, wr, wc, fr, fq); S.done(cur); }
        if (!has_next) break;
#pragma unroll
        for (int a = 0; a < 2; ++a)
#pragma unroll
            for (int b = 0; b < 2; ++b)
#pragma unroll
                for (int m = 0; m < 4; ++m)
#pragma unroll
                    for (int n = 0; n < 2; ++n) acc[a][b][m][n] = (f32x4){0.f, 0.f, 0.f, 0.f};
        cur = nxt; cA = nA; cB = nB; ++ui;
        if constexpr (ALIGN_EPI) { if (wr == 1) PG8_BAR; }
    }
    PG8_WAIT_V(0);
    if constexpr (!ALIGN_EPI) { if (wr == 0) PG8_BAR; }
    PG8_BAR;
    if constexpr (Epi::AFTER_DRAIN) { E.fused(acc, cur, wr, wc, fr, fq, lds, wid, lane); S.done(cur); }
#undef PG8_SA
#undef PG8_SB
#undef PG8_STAGE
#undef PG8_LDA
#undef PG8_LDB
#undef PG8_MMA
#undef PG8_WAIT_V
#undef PG8_WAIT_L
#undef PG8_BAR
#undef PG8_SCHED
}
}

#ifndef PG8_SP2
#define PG8_SP2 true
#endif
#ifndef PG8_ALIGN
#define PG8_ALIGN true
#endif

namespace attn_body {
using bf16=__hip_bfloat16;
using bf16x8=__attribute__((ext_vector_type(8)))short;
using s16x4=__attribute__((ext_vector_type(4)))short;
using f32x16=__attribute__((ext_vector_type(16)))float;
using u32x4=__attribute__((ext_vector_type(4)))unsigned;
constexpr int BATCH=2,NHEAD=16,SEQ=8192,D=64,DM=NHEAD*D;
constexpr int NW=8,QBLK=32,QB=QBLK*NW,KVBLK=64,NQB=SEQ/QB;
constexpr int ATTN_PITCH=DM, ATTN_UNIT_ROWS=QB;
__device__ __forceinline__ int crow(int r,int hi){return (r&3)+8*(r>>2)+4*hi;}
#define SBAR() __builtin_amdgcn_sched_barrier(0)
__device__ __forceinline__ void cmask(f32x16&p0,f32x16&p1,int jb,int qrel,int hi){
  const float NEG=-INFINITY; int kb=64*jb+4*hi;
  #pragma unroll
  for(int r=0;r<16;++r){int kv=kb+(r&3)+8*(r>>2); if(kv>qrel)p0[r]=NEG; if(kv+32>qrel)p1[r]=NEG;}
}

constexpr int NSLOT=3, SLOTB=8192;
constexpr int LDS_K=0, LDS_V=NSLOT*SLOTB, LDS_WS=2*NSLOT*SLOTB, LDS_OST=LDS_WS+NW*64*4, LDS_BYTES=LDS_OST+NW*4096;
constexpr float C2=0.125f*1.4426950408889634f;
__device__ __forceinline__ void glds16(const void*gsrc,unsigned lds_dst){unsigned keep;
  asm volatile("s_mov_b32 %0, m0\n\ts_mov_b32 m0, %2\n\ts_nop 0\n\tglobal_load_lds_dwordx4 %1, off\n\ts_mov_b32 m0, %0":"=&s"(keep):"v"(gsrc),"s"(lds_dst):"memory");}
__device__ __forceinline__ float max3f(float a,float b,float c){float r;asm("v_max3_f32 %0, %1, %2, %3":"=v"(r):"v"(a),"v"(b),"v"(c));return r;}
__device__ __forceinline__ float max2f(float a,float b){float r;asm("v_max_f32_e32 %0, %1, %2":"=v"(r):"v"(a),"v"(b));return r;}
__device__ __forceinline__ float fadd_s(float a,float b){float r;asm("v_add_f32_e32 %0, %1, %2":"=v"(r):"v"(a),"v"(b));return r;}
__device__ __forceinline__ float fsub_s(float a,float b){float r;asm("v_sub_f32_e32 %0, %1, %2":"=v"(r):"v"(a),"v"(b));return r;}
typedef float f32x2_t __attribute__((ext_vector_type(2))); typedef __bf16 bf16x2_t __attribute__((ext_vector_type(2)));
__device__ __forceinline__ unsigned cvtpk_s(float lo,float hi){f32x2_t v={lo,hi};bf16x2_t b=__builtin_convertvector(v,bf16x2_t);return __builtin_bit_cast(unsigned,b);}
#define WAIT_BAR(N) asm volatile("s_waitcnt vmcnt(" #N ") lgkmcnt(0)\n\ts_barrier":::"memory")

__device__ __forceinline__ void qkt(f32x16&p0,f32x16&p1,const char*Kslot,const bf16x8*qr,const f32x16&negm,int r32,int hi,s16x4 ka0,s16x4 ka1,s16x4 qa){
  const char*kb=Kslot+hi*1024+r32*16;
  #pragma unroll
  for(int d0=0;d0<4;++d0){
    const bf16x8 b0=*reinterpret_cast<const bf16x8*>(kb+d0*2048);
    const bf16x8 b1=*reinterpret_cast<const bf16x8*>(kb+d0*2048+512);
    if(d0==0){p0=__builtin_amdgcn_mfma_f32_32x32x16_bf16(b0,qr[0],negm,0,0,0);p1=__builtin_amdgcn_mfma_f32_32x32x16_bf16(b1,qr[0],negm,0,0,0);}
    else{p0=__builtin_amdgcn_mfma_f32_32x32x16_bf16(b0,qr[d0],p0,0,0,0);p1=__builtin_amdgcn_mfma_f32_32x32x16_bf16(b1,qr[d0],p1,0,0,0);}}
  p0=__builtin_amdgcn_mfma_f32_32x32x8bf16_1k(ka0,qa,p0,0,0,0);p1=__builtin_amdgcn_mfma_f32_32x32x8bf16_1k(ka1,qa,p1,0,0,0);
}
typedef __attribute__((address_space(3))) const char* lds_cptr;
typedef short v4i16_t __attribute__((ext_vector_type(4)));
__device__ __forceinline__ void kload8(bf16x8*kf,lds_cptr kp){
  kf[0]=*(const __attribute__((address_space(3))) bf16x8*)(kp);      kf[1]=*(const __attribute__((address_space(3))) bf16x8*)(kp+512);
  kf[2]=*(const __attribute__((address_space(3))) bf16x8*)(kp+2048); kf[3]=*(const __attribute__((address_space(3))) bf16x8*)(kp+2560);
  kf[4]=*(const __attribute__((address_space(3))) bf16x8*)(kp+4096); kf[5]=*(const __attribute__((address_space(3))) bf16x8*)(kp+4608);
  kf[6]=*(const __attribute__((address_space(3))) bf16x8*)(kp+6144); kf[7]=*(const __attribute__((address_space(3))) bf16x8*)(kp+6656);
}
__device__ __forceinline__ void kload2(bf16x8*kf,lds_cptr kp,int j){ kf[2*j]=*(const __attribute__((address_space(3))) bf16x8*)(kp+j*2048); kf[2*j+1]=*(const __attribute__((address_space(3))) bf16x8*)(kp+j*2048+512); }
__device__ __forceinline__ s16x4 vtr(lds_cptr p){ return __builtin_bit_cast(s16x4,__builtin_amdgcn_ds_read_tr16_b64_v4i16((__attribute__((address_space(3))) v4i16_t*)p)); }
__device__ __forceinline__ float rowmax(const f32x16&p0,const f32x16&p1){
  float a=max3f(p0[0],p0[1],p1[0]),b=max3f(p0[2],p0[3],p1[1]);a=max3f(a,p1[2],p1[3]);
  #pragma unroll
  for(int r=4;r<16;r+=4){a=max3f(a,p0[r],p0[r+1]);b=max3f(b,p0[r+2],p0[r+3]);a=max3f(a,p1[r],p1[r+1]);b=max3f(b,p1[r+2],p1[r+3]);}
  const float m=max2f(a,b);
  auto rr=__builtin_amdgcn_permlane32_swap(__float_as_uint(m),__float_as_uint(m),false,false);
  return max2f(__uint_as_float(rr[0]),__uint_as_float(rr[1]));
}
__device__ __forceinline__ void pv(f32x16*o,int vb,bf16x8 pa0,bf16x8 pa1,bf16x8 pa2,bf16x8 pa3){
  #pragma unroll
  for(int d0=0;d0<2;++d0){s16x4 lo[4],hi[4];
    #pragma unroll
    for(int ks=0;ks<4;++ks){
      asm volatile("ds_read_b64_tr_b16 %0,%1 offset:%c2":"=&v"(lo[ks]):"v"(vb),"i"(d0*4096+ks*1024):"memory");
      asm volatile("ds_read_b64_tr_b16 %0,%1 offset:%c2":"=&v"(hi[ks]):"v"(vb),"i"(d0*4096+ks*1024+512):"memory");}
    asm volatile("s_waitcnt lgkmcnt(0)":::"memory");SBAR();
    #define PK(k) (bf16x8){lo[k][0],lo[k][1],lo[k][2],lo[k][3],hi[k][0],hi[k][1],hi[k][2],hi[k][3]}
    o[d0]=__builtin_amdgcn_mfma_f32_32x32x16_bf16(pa0,PK(0),o[d0],0,0,0);
    o[d0]=__builtin_amdgcn_mfma_f32_32x32x16_bf16(pa1,PK(1),o[d0],0,0,0);
    o[d0]=__builtin_amdgcn_mfma_f32_32x32x16_bf16(pa2,PK(2),o[d0],0,0,0);
    o[d0]=__builtin_amdgcn_mfma_f32_32x32x16_bf16(pa3,PK(3),o[d0],0,0,0);
    #undef PK
  }
}

#ifndef ATTN_STORE16
#define ATTN_STORE16(p,v) (*(u32x4*)(p)=(v))
#endif
template<int THRL> __device__ __forceinline__ void attn_unit(int b,int h,int qb,int t0,const bf16*Q,const bf16*__restrict__ K,const bf16*__restrict__ V,bf16*O,char*shm){
  const int tid=tid_fresh(),lane=tid&63,r32=lane&31,hi=lane>>5; const int wid=__builtin_amdgcn_readfirstlane(tid>>6);
  const long rowbase=(long)b*SEQ; const int q0=qb*QB;
  const bf16*Qw=Q+(rowbase+q0+wid*QBLK)*DM+h*D;
  const bf16*Kh=K+(rowbase+(long)t0*KVBLK)*DM+h*D,*Vh=V+(rowbase+(long)t0*KVBLK)*DM+h*D;
  const unsigned lds0=(unsigned)(uintptr_t)shm;
  float*wsf=(float*)(shm+LDS_WS)+wid*64;
  const bf16*ksrc=Kh+(long)lane*DM+wid*8;
  const bf16*vsrc=Vh+(long)(16*(wid&3)+(lane>>2))*DM+(wid>>2)*32+(lane&3)*8;
  const unsigned kdst=lds0+LDS_K+wid*1024, vdst=lds0+LDS_V+wid*1024;
  #define DMA_K(t,slot) glds16(ksrc+(long)(t)*KVBLK*DM,(unsigned)__builtin_amdgcn_readfirstlane(kdst+(slot)))
  #define DMA_V(t,slot) glds16(vsrc+(long)(t)*KVBLK*DM,(unsigned)__builtin_amdgcn_readfirstlane(vdst+(slot)))
  const int vb0=(int)(lds0+LDS_V)+((lane>>4)&1)*32+(lane&3)*8+(4*hi+((lane&15)>>2))*64;
  const char*Kbase=shm+LDS_K; bf16x8 kf[8];
  const lds_cptr shm3=(lds_cptr)shm; const lds_cptr kp0=shm3+LDS_K+hi*1024+r32*16; const lds_cptr vp0=shm3+LDS_V+((lane>>4)&1)*32+(lane&3)*8+(4*hi+((lane&15)>>2))*64;
  const int NT=(q0+QB)/KVBLK-t0;
  DMA_K(0,0);DMA_V(0,0);DMA_K(1,SLOTB);
  bf16x8 qr[4];
  #pragma unroll
  for(int d0=0;d0<4;++d0)qr[d0]=*reinterpret_cast<const bf16x8*>(&Qw[(long)r32*DM+d0*16+hi*8]);
  typedef __attribute__((address_space(3))) unsigned long long lds_u64;
  const lds_u64* const ctab=(const lds_u64*)(__attribute__((address_space(3))) char*)(shm+LDS_BYTES);
  float mhat; { const float h1_=__uint_as_float((unsigned)ctab[q0-t0*KVBLK+wid*QBLK+r32]<<16), a0_=h1_+48.0f; mhat=__uint_as_float((__float_as_uint(a0_)+0x7fffu+((__float_as_uint(a0_)>>16)&1u))&0xffff0000u);
    if(h1_>=8192.0f) mhat=h1_; }
  float l_reg=0.f;f32x16 o[2];o[0]=f32x16{};o[1]=f32x16{};const f32x16 negm=f32x16{};
  typedef short s16x4k __attribute__((ext_vector_type(4))); typedef unsigned u32x2k __attribute__((ext_vector_type(2)));
  u32x2k qaw=(u32x2k){hi==0?0x3F803F80u:0u,0u};
  #define SETQA() do{ qaw[1]=(hi==0)?(0x3F80u|(((__float_as_uint(mhat)>>16)^0x8000u)<<16)):0u; }while(0)
  #define QAUG __builtin_bit_cast(s16x4k,qaw)
  #define MFA8(a_,b_,c_) __builtin_amdgcn_mfma_f32_32x32x8bf16_1k(a_,b_,c_,0,0,0)
  #define RNDBF(x_) __uint_as_float((__float_as_uint(x_)+0x7fffu+((__float_as_uint(x_)>>16)&1u))&0xffff0000u)
  SETQA();
  #define KAUG(t_,A0,A1) do{ const lds_u64* cp_=ctab+(t_)*KVBLK+r32; const unsigned long long w0_=cp_[0],w1_=cp_[32]; \
    A0=__builtin_bit_cast(s16x4k,w0_); A1=__builtin_bit_cast(s16x4k,w1_); }while(0)
  const int qrel=wid*QBLK+r32;
  #define CMASK(P0,P1,t) do{int jb_=(t)-(NT-4); if(jb_>=0)cmask(P0,P1,jb_,qrel,hi);}while(0)
  bool resc=false;
  #define START(P0,P1) do{ const float rm=rowmax(P0,P1); resc=false; \
    if(__builtin_expect(__any(rm>(float)THRL),0)){ const float rn_=mhat+__builtin_fmaxf(rm,0.f); const float mn_=RNDBF(rn_); const float dl=mn_-mhat; mhat=mn_; SETQA(); \
      _Pragma("unroll") for(int r=0;r<16;++r){P0[r]-=dl;P1[r]-=dl;} \
      } \
    _Pragma("unroll") for(int r=0;r<16;++r)P0[r]=__builtin_amdgcn_exp2f(P0[r]); }while(0)
  #define RESC() do{ if(resc){ asm volatile("s_waitcnt lgkmcnt(0)":::"memory"); \
      _Pragma("unroll") for(int d_=0;d_<2;++d_) _Pragma("unroll") for(int r=0;r<16;++r)o[d_][r]*=wsf[crow(r,hi)]; } }while(0)
  f32x16 pA0,pA1,pB0,pB1;
  int sl_prev=0,sl_cur=0,sl_next=SLOTB;
  #define ROT() do{sl_prev=sl_cur;sl_cur=sl_next;sl_next=(sl_next==(NSLOT-1)*SLOTB)?0:sl_next+SLOTB;}while(0)
  DMA_K(2,2*SLOTB);
  WAIT_BAR(3);
  { s16x4k ka0_,ka1_; KAUG(0,ka0_,ka1_); qkt(pA0,pA1,Kbase,qr,negm,r32,hi,ka0_,ka1_,QAUG); } asm volatile("s_nop 15\n\ts_nop 7":"+v"(pA0),"+v"(pA1));CMASK(pA0,pA1,0);
  START(pA0,pA1);
  _Pragma("unroll") for(int r=0;r<16;++r)pA1[r]=__builtin_amdgcn_exp2f(pA1[r]);
  WAIT_BAR(0);
  DMA_K(3,0);DMA_V(1,SLOTB);
  ROT();
  kload8(kf,kp0+sl_cur);
  WAIT_BAR(2);
  s16x4 vlo[8],vhi[8]; u32x4 pw0,pw1,pw2,pw3;
  #define PKW(P,B) cvtpk_s(P[B],P[B+1])
  #define PAF(k) __builtin_bit_cast(bf16x8,pw##k)
  #define VFR(i) (bf16x8){vlo[i][0],vlo[i][1],vlo[i][2],vlo[i][3],vhi[i][0],vhi[i][1],vhi[i][2],vhi[i][3]}
  #define PIN(x) asm volatile("":"+v"(x))
  #define MX3(a,b,c) __builtin_fmaxf(__builtin_fmaxf((a),(b)),(c))
  #define GAPA(MF,A0,A1,A2,A3,W0,W1,PW) do{ MF; sacc+=A0; sacc+=A1; sacc+=A2; sacc+=A3; PIN(sacc); W0; W1; PIN(PW); SBAR(); }while(0)
  #define EX(v) __builtin_amdgcn_exp2f(v)
  #define GAPB(MF,X,B) do{ MF; X[B]=EX(X[B]); X[B+1]=EX(X[B+1]); X[B+2]=EX(X[B+2]); X[B+3]=EX(X[B+3]); PIN(X); SBAR(); }while(0)
  #define VRD(i) do{ vlo[i]=vtr(vp_+(((i)>>2)*4096+((i)&3)*1024)); vhi[i]=vtr(vp_+(((i)>>2)*4096+((i)&3)*1024+512)); }while(0)
  #define KRD(G,j) do{ if(G){ kload2(kf,kp0+sl_next,j); SBAR(); } }while(0)
  #define STEP(C0,C1,P0,P1,t,GK,GV,GL) do{ SBAR(); \
    const lds_cptr vp_=vp0+sl_prev; s16x4k ka0_,ka1_; \
    VRD(0); SBAR(); float sacc=(P0[0]+P0[1]); \
    GAPA(C0=__builtin_amdgcn_mfma_f32_32x32x16_bf16(kf[0],qr[0],negm,0,0,0), P0[2],P0[3],P0[4],P0[5],     pw0[0]=PKW(P0,0), pw0[1]=PKW(P0,2), pw0); \
    VRD(4); SBAR(); GAPA(C1=__builtin_amdgcn_mfma_f32_32x32x16_bf16(kf[1],qr[0],negm,0,0,0), P0[6],P0[7],P0[8],P0[9],     pw0[2]=PKW(P0,4), pw0[3]=PKW(P0,6), pw0); \
    VRD(1); SBAR(); GAPA(C0=__builtin_amdgcn_mfma_f32_32x32x16_bf16(kf[2],qr[1],C0,0,0,0),   P0[10],P0[11],P0[12],P0[13], pw1[0]=PKW(P0,8), pw1[1]=PKW(P0,10), pw1); \
    VRD(5); SBAR(); GAPA(C1=__builtin_amdgcn_mfma_f32_32x32x16_bf16(kf[3],qr[1],C1,0,0,0),   P0[14],P0[15],P1[0],P1[1],   pw1[2]=PKW(P0,12),pw1[3]=PKW(P0,14), pw1); \
    VRD(2); SBAR(); GAPA(C0=__builtin_amdgcn_mfma_f32_32x32x16_bf16(kf[4],qr[2],C0,0,0,0),   P1[2],P1[3],P1[4],P1[5],     pw2[0]=PKW(P1,0), pw2[1]=PKW(P1,2), pw2); \
    VRD(6); SBAR(); GAPA(C1=__builtin_amdgcn_mfma_f32_32x32x16_bf16(kf[5],qr[2],C1,0,0,0),   P1[6],P1[7],P1[8],P1[9],     pw2[2]=PKW(P1,4), pw2[3]=PKW(P1,6), pw2); \
    VRD(3); SBAR(); GAPA(C0=__builtin_amdgcn_mfma_f32_32x32x16_bf16(kf[6],qr[3],C0,0,0,0),   P1[10],P1[11],P1[12],P1[13], pw3[0]=PKW(P1,8), pw3[1]=PKW(P1,10), pw3); \
    VRD(7); KAUG(t,ka0_,ka1_); SBAR(); GAPA(C1=__builtin_amdgcn_mfma_f32_32x32x16_bf16(kf[7],qr[3],C1,0,0,0),   P1[14],P1[15],0.f,0.f,       pw3[2]=PKW(P1,12),pw3[3]=PKW(P1,14), pw3); \
    C0=MFA8(ka0_,QAUG,C0); C1=MFA8(ka1_,QAUG,C1); \
    l_reg+=sacc; \
    if(GK){DMA_K((t)+3,sl_cur);} if(GV){DMA_V((t)+1,sl_next);} \
    CMASK(C0,C1,t); \
    { float a=MX3(C0[0],C0[1],C1[0]),b=MX3(C0[2],C0[3],C1[1]); a=MX3(a,C1[2],C1[3]); \
      _Pragma("unroll") for(int r=4;r<16;r+=4){a=MX3(a,C0[r],C0[r+1]);b=MX3(b,C0[r+2],C0[r+3]);a=MX3(a,C1[r],C1[r+1]);b=MX3(b,C1[r+2],C1[r+3]);} \
      float rm=__builtin_fmaxf(a,b); { auto rr=__builtin_amdgcn_permlane32_swap(__float_as_uint(rm),__float_as_uint(rm),false,false); rm=__builtin_fmaxf(__uint_as_float(rr[0]),__uint_as_float(rr[1])); } \
      resc=false; \
      if(__builtin_expect(__any(rm>(float)THRL),0)){ const float rn_=mhat+__builtin_fmaxf(rm,0.f); const float mn_=RNDBF(rn_); const float dl=mn_-mhat; mhat=mn_; SETQA(); \
        _Pragma("unroll") for(int r=0;r<16;++r){C0[r]-=dl;C1[r]-=dl;} \
        const float f=__builtin_amdgcn_exp2f(-dl); l_reg*=f; if(hi==0)wsf[r32]=f; resc=true; } } \
    SBAR(); \
    GAPB(o[0]=__builtin_amdgcn_mfma_f32_32x32x16_bf16(PAF(0),VFR(0),o[0],0,0,0), C0,0); \
    GAPB(o[1]=__builtin_amdgcn_mfma_f32_32x32x16_bf16(PAF(0),VFR(4),o[1],0,0,0), C0,4); \
    KRD(GL,0); GAPB(o[0]=__builtin_amdgcn_mfma_f32_32x32x16_bf16(PAF(1),VFR(1),o[0],0,0,0), C0,8); \
    KRD(GL,1); GAPB(o[1]=__builtin_amdgcn_mfma_f32_32x32x16_bf16(PAF(1),VFR(5),o[1],0,0,0), C0,12); \
    KRD(GL,2); GAPB(o[0]=__builtin_amdgcn_mfma_f32_32x32x16_bf16(PAF(2),VFR(2),o[0],0,0,0), C1,0); \
    KRD(GL,3); GAPB(o[1]=__builtin_amdgcn_mfma_f32_32x32x16_bf16(PAF(2),VFR(6),o[1],0,0,0), C1,4); \
    GAPB(o[0]=__builtin_amdgcn_mfma_f32_32x32x16_bf16(PAF(3),VFR(3),o[0],0,0,0), C1,8); \
    GAPB(o[1]=__builtin_amdgcn_mfma_f32_32x32x16_bf16(PAF(3),VFR(7),o[1],0,0,0), C1,12); \
    }while(0)
  int t=1;
  #undef CMASK
  #define CMASK(P0,P1,t) do{}while(0)
  for(;t+5<NT;t+=2){
    STEP(pB0,pB1,pA0,pA1,t,true,true,true);     WAIT_BAR(2); RESC(); ROT();
    STEP(pA0,pA1,pB0,pB1,t+1,true,true,true);   WAIT_BAR(2); RESC(); ROT();
  }
  #undef CMASK
  #define CMASK(P0,P1,t) do{int jb_=(t)-(NT-4); if(jb_>=0)cmask(P0,P1,jb_,qrel,hi);}while(0)
  #define ENDW(tt) do{ if((tt)+3<NT){WAIT_BAR(2);} else if((tt)+2<NT){WAIT_BAR(1);} else {WAIT_BAR(0);} }while(0)
  for(;t+1<NT;t+=2){
    STEP(pB0,pB1,pA0,pA1,t,(t+3<NT),(t+1<NT),(t+1<NT));       ENDW(t);   RESC(); ROT();
    STEP(pA0,pA1,pB0,pB1,t+1,(t+4<NT),(t+2<NT),(t+2<NT));     ENDW(t+1); RESC(); ROT();
  }
  STEP(pB0,pB1,pA0,pA1,NT-1,false,false,false); RESC();
  { float sacc=pB0[0]+pB0[1]; _Pragma("unroll") for(int r=2;r<16;++r)sacc+=pB0[r]; _Pragma("unroll") for(int r=0;r<16;++r)sacc+=pB1[r]; l_reg+=sacc;
    pw0=(u32x4){PKW(pB0,0),PKW(pB0,2),PKW(pB0,4),PKW(pB0,6)};pw1=(u32x4){PKW(pB0,8),PKW(pB0,10),PKW(pB0,12),PKW(pB0,14)};pw2=(u32x4){PKW(pB1,0),PKW(pB1,2),PKW(pB1,4),PKW(pB1,6)};pw3=(u32x4){PKW(pB1,8),PKW(pB1,10),PKW(pB1,12),PKW(pB1,14)};
    SBAR(); pv(o,vb0+sl_cur,PAF(0),PAF(1),PAF(2),PAF(3)); }
  #undef PKW
  #undef PAF
  #undef VFR
  #undef PIN
  #undef MX3
  #undef GAPA
  #undef GAPB
  #undef EX
  #undef VRD
  #undef KRD
  #undef STEP
  #undef ENDW
  {auto rr=__builtin_amdgcn_permlane32_swap(__float_as_uint(l_reg),__float_as_uint(l_reg),false,false);l_reg=__uint_as_float(rr[0])+__uint_as_float(rr[1]);}
  if(hi==0)wsf[32+r32]=l_reg;asm volatile("s_waitcnt lgkmcnt(0)":::"memory");
  float rli[16];
  #pragma unroll
  for(int r=0;r<16;++r)rli[r]=__builtin_amdgcn_rcpf(wsf[32+crow(r,hi)]);
  bf16*Ow=O+(rowbase+q0+wid*QBLK)*DM+h*D;
  { bf16*stg=(bf16*)(shm+LDS_OST)+wid*2048;
    #pragma unroll
    for(int r=0;r<16;++r){const int orow=crow(r,hi);
      #pragma unroll
      for(int d0=0;d0<2;++d0)stg[orow*64+d0*32+r32]=__float2bfloat16(o[d0][r]*rli[r]);}
    asm volatile("s_waitcnt lgkmcnt(0)":::"memory");
    #pragma unroll
    for(int i=0;i<4;++i){const int row=i*8+(lane>>3),ch=lane&7; const u32x4 v=*(const u32x4*)(stg+row*64+ch*8); ATTN_STORE16(Ow+(long)row*DM+ch*8,v);} }
  asm volatile("s_waitcnt lgkmcnt(0)\n\ts_barrier":::"memory");
  #undef KAUG
  #undef SETQA
  #undef QAUG
  #undef RNDBF
  #undef MFA8
  #undef DMA_K
  #undef DMA_V
  #undef CMASK
  #undef START
  #undef RESC
  #undef ROT
}
constexpr int ATTN_LDS_BYTES=LDS_BYTES+SEQ*8+16+4096;
struct AttnTensors { const bf16* Q; const bf16* K; const bf16* V; bf16* O; const unsigned long long* CAUG; };
struct AttnUnit { int bh; int qb; };
struct StaticOrder {
  int vcu;
  __device__ __forceinline__ explicit StaticOrder(int grid,int block):vcu((block%8)*(grid/8)+block/8){}
  __device__ __forceinline__ bool next(int i,AttnUnit&u)const{ if(i>=4)return false; const int s=vcu&7; u.bh=vcu>>3; u.qb=(i==0)?s:(i==1)?15-s:(i==2)?16+s:31-s; return true; }
  __device__ __forceinline__ void a_ready(const AttnUnit&)const{}
  __device__ __forceinline__ void done(const AttnUnit&)const{}
};
__device__ __forceinline__ unsigned f2bf_rne(float f){unsigned u=__float_as_uint(f);return (u+0x7fffu+((u>>16)&1u))>>16;}
__device__ __forceinline__ float caug_val(unsigned long long w){ return (__uint_as_float((unsigned)w<<16)+__uint_as_float((unsigned)w&0xffff0000u))+__uint_as_float((unsigned)(w>>32)<<16); }
constexpr float SKIP_TH=72.0f;
__device__ __forceinline__ void fox_scan(char*lds,const float*__restrict__ lf,unsigned long long*__restrict__ tab,int*__restrict__ nsk){
  typedef __attribute__((address_space(3))) double lds_f64;
  lds_f64* sums=(lds_f64*)(__attribute__((address_space(3))) char*)lds;
  const int tid=tid_fresh(); double acc=0.0;
  #pragma unroll
  for(int i=0;i<16;++i)acc+=(double)lf[tid*16+i];
  double xs=acc;
  { const int lane=tid&63;
    #pragma unroll
    for(int o=1;o<64;o<<=1){ const double y=__shfl_up(xs,o); if(lane>=o) xs+=y; }
    if(lane==63) sums[tid>>6]=xs; }
  __syncthreads();
  double run=xs-acc; for(int i=0;i<(tid>>6);++i)run+=sums[i];
  #pragma unroll 1
  for(int i=0;i<16;++i){ run+=(double)lf[tid*16+i]; const float nv=(float)(run*-1.4426950408889634);
    const unsigned h1=f2bf_rne(nv); const float r1=nv-__uint_as_float(h1<<16); const unsigned h2=f2bf_rne(r1); const float r2=r1-__uint_as_float(h2<<16); const unsigned h3=f2bf_rne(r2);
    const unsigned long long wv=(unsigned long long)(h1|(h2<<16))|((unsigned long long)(h3|0x3F800000u)<<32); tab[tid*16+i]=wv;
    if(i==15&&(tid&3)==3) ((__attribute__((address_space(3))) float*)(lds+4096))[tid>>2]=caug_val(wv);
    if(i==0&&(tid&15)==0) ((__attribute__((address_space(3))) float*)(lds+4096+512))[tid>>4]=caug_val(wv); }
  __syncthreads();
  if(tid<SEQ/QB){ const __attribute__((address_space(3))) float* te=(const __attribute__((address_space(3))) float*)(lds+4096); const float lim=te[128+tid]-SKIP_TH; const int lastt=(tid*QB+QB)/KVBLK-4;
    int lo=0,hi=lastt>0?lastt:0; while(lo<hi){ const int mid=(lo+hi)>>1; if(te[mid]<lim) lo=mid+1; else hi=mid; } nsk[tid]=lo; }
  __syncthreads();
}
template<int THRL=8> __device__ __forceinline__ void attn_phase_dyn(char*lds,const AttnTensors&T,unsigned*ctr,int first,int nfirst,const int*nsk){
  typedef __attribute__((address_space(3))) unsigned long long lds_u64; typedef __attribute__((address_space(3))) int lds_i32;
  lds_i32* slotw=(lds_i32*)(__attribute__((address_space(3))) char*)(lds+LDS_BYTES+SEQ*8);
  lds_u64* tab=(lds_u64*)(__attribute__((address_space(3))) char*)(lds+LDS_BYTES);
  lds_i32* nskl=slotw+4;
  for(int i=tid_fresh();i<BATCH*NHEAD*NQB;i+=NW*64) nskl[i]=nsk[i];
  for(int it=0;;++it){
    const int tid=tid_fresh();
    if(tid==0){ slotw[0]=(it==0&&first>=0)?first:nfirst+(int)__hip_atomic_fetch_add(ctr,1u,__ATOMIC_RELAXED,__HIP_MEMORY_SCOPE_AGENT); }
    __syncthreads();
    const int slot=__builtin_amdgcn_readfirstlane(slotw[0]);
    if(slot>=BATCH*NHEAD*NQB) break;
    const int qb=NQB-1-(slot>>5), bh=slot&31, q0=qb*QB, NTF=(q0+QB)/KVBLK;
    const unsigned long long* cg=T.CAUG+(long)bh*SEQ;
    const int nskip=__builtin_amdgcn_readfirstlane(nskl[bh*NQB+qb]);
    const int t0=nskip&~1;
    for(int i=tid;i<(NTF-t0)*KVBLK;i+=NW*64) tab[i]=cg[t0*KVBLK+i];
    __syncthreads();
    attn_unit<THRL>(bh/NHEAD,bh%NHEAD,qb,t0,T.Q,T.K,T.V,T.O,lds);
  }
}
#undef SBAR
#undef WAIT_BAR
}

namespace swa {
constexpr int D = 128; constexpr float THR = 8.f; constexpr bool WSKIP = true;
constexpr float SCALE = 0.08838834764831845f;
constexpr int NW = 8, QBLK = 32, KVBLK = 64, QB = NW * QBLK;
constexpr int SHM_V = KVBLK * D * 2, SHM_K = KVBLK * D * 2;
constexpr int LDS_BYTES = 2 * SHM_V + 2 * SHM_K + NW * 64 * 4;

using bf16 = __hip_bfloat16;
typedef short bf16x8 __attribute__((ext_vector_type(8)));
typedef short s16x4 __attribute__((ext_vector_type(4)));
typedef float f32x16 __attribute__((ext_vector_type(16)));
typedef float f32x4 __attribute__((ext_vector_type(4)));
typedef unsigned u32x4 __attribute__((ext_vector_type(4)));
template <class A, class Bt> struct same_t { static constexpr bool v = false; };
template <class A> struct same_t<A, A> { static constexpr bool v = true; };

#define KSWZ(row, colB) ((row) * 256 + ((colB) ^ (((row) & 7) << 4)))
#define SBAR() __builtin_amdgcn_sched_barrier(0)
__device__ __forceinline__ int v_st(int k, int c) { const int kk = (k & ~0xC) | ((k & 4) << 1) | ((k & 8) >> 1); return ((kk >> 3) * 4 + (c >> 5)) * 512 + ((kk & 7) * 32 + (c & 31)) * 2; }
__device__ __forceinline__ int v_rd_base(int lane) { return ((lane & 3) << 3) | (((lane >> 2) & 3) << 6) | (((lane >> 4) & 1) << 5) | (((lane >> 5) & 1) << 8); }
constexpr int v_rd_off(int d0, int ks, int half) { return d0 * 512 + ks * 4096 + half * 2048; }
__device__ __forceinline__ int crow(int r, int hi) { return (r & 3) + 8 * (r >> 2) + 4 * hi; }
__device__ __forceinline__ unsigned cvtpk(float lo, float hi) {
    unsigned r; asm volatile("v_cvt_pk_bf16_f32 %0, %1, %2" : "=v"(r) : "v"(lo), "v"(hi)); return r;
}
__device__ __forceinline__ bf16x8 pack8(f32x4 a, f32x4 b) {
    u32x4 w = {cvtpk(a[0], a[1]), cvtpk(a[2], a[3]), cvtpk(b[0], b[1]), cvtpk(b[2], b[3])};
    return *reinterpret_cast<bf16x8*>(&w);
}
template <class T> __device__ __forceinline__ bf16x8 load8(const T* p) {
    if constexpr (same_t<T, float>::v) { return pack8(*(const f32x4*)p, *(const f32x4*)(p + 4)); }
    else { return *reinterpret_cast<const bf16x8*>(p); }
}
__device__ __forceinline__ void mask_tile(f32x16& p0, f32x16& p1, int dq, unsigned W) {
    const float NEG = -__builtin_inff();
#pragma unroll
    for (int r = 0; r < 16; ++r) {
        const int c = (r & 3) + 8 * (r >> 2);
        if ((unsigned)(dq - c) >= W) p0[r] = NEG;
        if ((unsigned)(dq - c - 32) >= W) p1[r] = NEG;
    }
}
__device__ __forceinline__ void partialSM(f32x16& p0, f32x16& p1, float& m_reg, float& mn, float& alpha) {
    float pmax = p0[0]; for (int r = 1; r < 16; ++r) pmax = fmaxf(pmax, p0[r]); for (int r = 0; r < 16; ++r) pmax = fmaxf(pmax, p1[r]);
    { auto rr = __builtin_amdgcn_permlane32_swap(__float_as_uint(pmax), __float_as_uint(pmax), false, false);
      pmax = fmaxf(__uint_as_float(rr[0]), __uint_as_float(rr[1])); }
    constexpr float C2 = 1.4426950408889634f * SCALE;
    if (__builtin_expect(__all((pmax - m_reg) * SCALE <= THR), 1)) { mn = m_reg; alpha = 1.f; }
    else { mn = fmaxf(m_reg, pmax); alpha = __builtin_amdgcn_exp2f((m_reg - mn) * C2); m_reg = mn; }
    const float mnL = -mn * C2;
    for (int r = 0; r < 16; ++r) p0[r] = fmaf(p0[r], C2, mnL); for (int r = 0; r < 16; ++r) p1[r] = fmaf(p1[r], C2, mnL);
    for (int r = 0; r < 16; ++r) p0[r] = __builtin_amdgcn_exp2f(p0[r]);
}
__device__ __forceinline__ void finishSM(f32x16& p0, f32x16& p1, float alpha, float& l_reg, bf16x8& pa0, bf16x8& pa1, bf16x8& pa2, bf16x8& pa3) {
    for (int r = 0; r < 16; ++r) p1[r] = __builtin_amdgcn_exp2f(p1[r]);
    float ps = 0; for (int r = 0; r < 16; ++r) ps += p0[r]; for (int r = 0; r < 16; ++r) ps += p1[r];
    { auto rr = __builtin_amdgcn_permlane32_swap(__float_as_uint(ps), __float_as_uint(ps), false, false);
      ps = __uint_as_float(rr[0]) + __uint_as_float(rr[1]); }
    l_reg = l_reg * alpha + ps;
#define PK4(P, B_, OUT) do { unsigned a0 = cvtpk(P[B_+0], P[B_+1]), a1 = cvtpk(P[B_+2], P[B_+3]);                          \
        unsigned b0 = cvtpk(P[B_+4], P[B_+5]), b1 = cvtpk(P[B_+6], P[B_+7]);                                             \
        auto r0 = __builtin_amdgcn_permlane32_swap(a0, b0, false, false); auto r1 = __builtin_amdgcn_permlane32_swap(a1, b1, false, false); \
        u32x4 w = {r0[0], r1[0], r0[1], r1[1]}; OUT = *reinterpret_cast<bf16x8*>(&w); } while (0)
    PK4(p0, 0, pa0); PK4(p0, 8, pa1); PK4(p1, 0, pa2); PK4(p1, 8, pa3);
#undef PK4
}
template <int KB, bool SK>
__device__ __forceinline__ void qkt(f32x16& p0, f32x16& p1, const char* K_lds, int r32, int hi, const bf16x8* qr, bool act) {
    if (SK && !act) { const float NEG = -__builtin_inff();
#pragma unroll
        for (int r = 0; r < 16; ++r) { p0[r] = NEG; p1[r] = NEG; } return; }
    p0 = f32x16{}; p1 = f32x16{};
    const char* kb[4];
#pragma unroll
    for (int dd = 0; dd < 4; ++dd) kb[dd] = K_lds + KB * SHM_K + KSWZ(r32, (dd * 16 + hi * 8) * 2);
#pragma unroll
    for (int d0 = 0; d0 < 8; ++d0) { const char* a = kb[d0 & 3] + (d0 >> 2) * 128;
        bf16x8 b0 = *reinterpret_cast<const bf16x8*>(a);
        bf16x8 b1 = *reinterpret_cast<const bf16x8*>(a + 32 * 256);
        p0 = __builtin_amdgcn_mfma_f32_32x32x16_bf16(b0, qr[d0], p0, 0, 0, 0);
        p1 = __builtin_amdgcn_mfma_f32_32x32x16_bf16(b1, qr[d0], p1, 0, 0, 0); }
}
template <int VB, bool SK>
__device__ __forceinline__ void pv_tile(f32x16* o, int vb0, bf16x8 pa0, bf16x8 pa1, bf16x8 pa2, bf16x8 pa3, bool act) {
    if (SK && !act) return;
#define TRRD(dst, off) asm volatile("ds_read_b64_tr_b16 %0, %1 offset:%2" : "=&v"(dst) : "v"(vb0), "i"(off) : "memory")
#define PV_D0(d0) do { s16x4 l0, l1, l2, l3, h0, h1, h2, h3; constexpr int b_ = VB * SHM_V + v_rd_off(d0, 0, 0);     \
        TRRD(l0, b_); TRRD(h0, b_ + 2048); TRRD(l1, b_ + 4096); TRRD(h1, b_ + 6144); TRRD(l2, b_ + 8192); TRRD(h2, b_ + 10240); TRRD(l3, b_ + 12288); TRRD(h3, b_ + 14336); \
        asm volatile("s_waitcnt lgkmcnt(0)" ::: "memory"); SBAR();                 \
        o[d0] = __builtin_amdgcn_mfma_f32_32x32x16_bf16(pa0, (bf16x8){l0[0], l0[1], l0[2], l0[3], h0[0], h0[1], h0[2], h0[3]}, o[d0], 0, 0, 0);   \
        o[d0] = __builtin_amdgcn_mfma_f32_32x32x16_bf16(pa1, (bf16x8){l1[0], l1[1], l1[2], l1[3], h1[0], h1[1], h1[2], h1[3]}, o[d0], 0, 0, 0);   \
        o[d0] = __builtin_amdgcn_mfma_f32_32x32x16_bf16(pa2, (bf16x8){l2[0], l2[1], l2[2], l2[3], h2[0], h2[1], h2[2], h2[3]}, o[d0], 0, 0, 0);   \
        o[d0] = __builtin_amdgcn_mfma_f32_32x32x16_bf16(pa3, (bf16x8){l3[0], l3[1], l3[2], l3[3], h3[0], h3[1], h3[2], h3[3]}, o[d0], 0, 0, 0); } while (0)
    PV_D0(0); PV_D0(1); PV_D0(2); PV_D0(3);
#undef PV_D0
#undef TRRD
}

template <class TIn, class TOut> struct BlockRef { const TIn* Q; const TIn* K; const TIn* V; TOut* O; int P0; int qp, kp, op; float* L; int lp; };
template <class TIn> struct Seam {
    bf16x8 qr[8];
    bf16x8 st_v0, st_v1, st_k0, st_k1; f32x4 sf0, sf1, sf2, sf3;
    f32x4 tq[16];
};
__device__ __forceinline__ int swa_jlo(int P0, int W) { const int lowk = P0 - W + 1; return lowk > 0 ? lowk / KVBLK : 0; }
#define ROW(p, k0, rr) ((p) + (size_t)((k0) + (rr)) * D + sc)
#define VMW() asm volatile("s_waitcnt vmcnt(0)" ::: "memory")
#define VMWN(n) asm volatile("s_waitcnt vmcnt(%0)" :: "i"(n) : "memory")
#define ROWP(p, k0, rr, pt) ((const TIn*)((const char*)(p) + (unsigned)((((k0) + (rr)) * (pt) + sc) * 2)))
#define SLOAD_H(Kp, Vp, k0, pt) do { S.st_v0 = load8<TIn>(ROWP(Vp, k0, sr, pt)); S.st_v1 = load8<TIn>(ROWP(Vp, k0, 32 + sr, pt));              \
                         S.st_k0 = load8<TIn>(ROWP(Kp, k0, sr, pt)); S.st_k1 = load8<TIn>(ROWP(Kp, k0, 32 + sr, pt)); } while (0)
#define SWRITE_HK(bf) do { *(bf16x8*)(K_lds + (bf) * SHM_K + kws) = S.st_k0; *(bf16x8*)(K_lds + (bf) * SHM_K + kws + 32 * 256) = S.st_k1; } while (0)
#define SWRITE_HV(bf) do { *(bf16x8*)(V_lds + (bf) * SHM_V + vst0) = S.st_v0; *(bf16x8*)(V_lds + (bf) * SHM_V + vst1) = S.st_v1; } while (0)
#define SWRITE_H(bf) do { SWRITE_HV(bf); SWRITE_HK(bf); } while (0)
#define SLOAD_F(p, k0) do { S.sf0 = *(const f32x4*)ROW(p, k0, sr); S.sf1 = *(const f32x4*)(ROW(p, k0, sr) + 4);                \
                            S.sf2 = *(const f32x4*)ROW(p, k0, 32 + sr); S.sf3 = *(const f32x4*)(ROW(p, k0, 32 + sr) + 4); } while (0)
#define SWRITE_KF(bf) do { *(bf16x8*)(K_lds + (bf) * SHM_K + kws) = pack8(S.sf0, S.sf1); *(bf16x8*)(K_lds + (bf) * SHM_K + kws + 32 * 256) = pack8(S.sf2, S.sf3); } while (0)
#define SWRITE_VF(bf) do { *(bf16x8*)(V_lds + (bf) * SHM_V + vst0) = pack8(S.sf0, S.sf1); *(bf16x8*)(V_lds + (bf) * SHM_V + vst1) = pack8(S.sf2, S.sf3); } while (0)
template <class TIn, class TOut>
__device__ __forceinline__ void causal_swa_prime(const BlockRef<TIn, TOut>& cur, int W, char* lds, Seam<TIn>& S) {
    constexpr bool F32 = same_t<TIn, float>::v;
    const int tid = tid_fresh(), wid = __builtin_amdgcn_readfirstlane(tid >> 6), lane = tid & 63, r32 = lane & 31, hi = lane >> 5;
    const int sr = tid >> 4, sc = (tid & 15) * 8, kws = KSWZ(sr, sc * 2); char* K_lds = lds + 2 * SHM_V;
    const int kb0 = swa_jlo(cur.P0, W) * KVBLK;
    for (int d0 = 0; d0 < 8; ++d0) S.qr[d0] = load8<TIn>((const TIn*)((const char*)cur.Q + (unsigned)(((wid * QBLK + r32) * cur.qp + hi * 8) * 2) + d0 * 32));
    if constexpr (F32) { SLOAD_F((const float*)cur.K, kb0); VMW(); SWRITE_KF(0); SBAR(); SLOAD_F((const float*)cur.V, kb0); }
    else { SLOAD_H(cur.K, cur.V, kb0, cur.kp); VMW(); SWRITE_HK(0); }
    __syncthreads();
}
template <class TIn, class TOut>
__device__ __forceinline__ void causal_swa_block(const BlockRef<TIn, TOut>& cur, const BlockRef<TIn, TOut>& nxt, int skv, int W, char* lds, Seam<TIn>& S) {
    constexpr bool F32 = same_t<TIn, float>::v;
    const int tid = tid_fresh(), wid = __builtin_amdgcn_readfirstlane(tid >> 6), lane = tid & 63, r32 = lane & 31, hi = lane >> 5;
    const int j_lo = swa_jlo(cur.P0, W);
    int j_hi = (cur.P0 + QB - 1) / KVBLK + 1; if (j_hi > skv / KVBLK) j_hi = skv / KVBLK;
    const int NT = j_hi - j_lo;
    const int kbn = swa_jlo(nxt.P0, W) * KVBLK;
    const int qlo = cur.P0 + wid * QBLK, qm = qlo + r32 - 4 * hi;
    char* V_lds = lds; char* K_lds = lds + 2 * SHM_V;
    float* ws = (float*)(lds + 2 * SHM_V + 2 * SHM_K) + wid * 64; float* li_l = ws, * al_l = ws + 32;
    float m_reg = -1e30f, l_reg = 0; f32x16 o[4] = {};
    const int sr = tid >> 4, sc = (tid & 15) * 8, vst0 = v_st(sr, sc), vst1 = v_st(32 + sr, sc), kws = KSWZ(sr, sc * 2);
    const int vb0 = (int)(uintptr_t)V_lds + v_rd_base(lane);
    const TIn* Kh = cur.K; const TIn* Vh = cur.V;
#define RESC(a) do { if (__any((a) < 1.f)) { if (hi == 0) al_l[r32] = (a); asm volatile("s_waitcnt lgkmcnt(0)" ::: "memory");              \
                     for (int d_ = 0; d_ < 4; ++d_) for (int r = 0; r < 16; ++r) o[d_][r] *= al_l[crow(r, hi)]; } } while (0)
#define KBASE(t) ((j_lo + (t)) * KVBLK)
#define ACT(t) (KBASE(t) <= qlo + QBLK - 1 && KBASE(t) + KVBLK - 1 >= qlo - W + 1)
#define MASKT(P0_, P1_, t) do { const int kb_ = KBASE(t); if ((!SK || ACT(t)) && (kb_ + KVBLK - 1 > qlo || kb_ <= qlo + QBLK - 1 - W)) mask_tile(P0_, P1_, qm - kb_, (unsigned)W); } while (0)
    constexpr int NQL = F32 ? 16 : 8;
    constexpr bool SK = WSKIP && !F32;
#define SEAM_K0() do { VMWN(NQL); if constexpr (F32) { SWRITE_KF(0); SBAR(); SLOAD_F((const float*)nxt.V, kbn); } else { SWRITE_HK(0); } SBAR(); } while (0)
    f32x16 pA0, pA1, pB0, pB1; float mnA, mnB, alA, alB; bf16x8 pa0, pa1, pa2, pa3;
    if constexpr (F32) { VMW(); SWRITE_VF(0); SBAR(); } else { SWRITE_HV(0); SBAR(); }
    if (NT > 1) { if constexpr (F32) SLOAD_F((const float*)Kh, KBASE(1)); else SLOAD_H(Kh, Vh, KBASE(1), cur.kp); }
    SBAR(); qkt<0, SK>(pA0, pA1, K_lds, r32, hi, S.qr, ACT(0));
    if constexpr (F32) { if (NT > 1) { VMW(); SWRITE_KF(1); SBAR(); SLOAD_F((const float*)Vh, KBASE(1)); } }
    MASKT(pA0, pA1, 0); partialSM(pA0, pA1, m_reg, mnA, alA);
    if (NT > 1) { VMW(); if constexpr (F32) { SWRITE_VF(1); SBAR(); if (NT > 2) SLOAD_F((const float*)Kh, KBASE(2)); } else SWRITE_H(1); }
    __syncthreads();
#define HALF_STEP(PX0, PX1, mnX, alX, PY0, PY1, alY, t, KB, VB, SB) do {                                                      \
        if constexpr (!F32) { if ((t) + 1 < NT) SLOAD_H(Kh, Vh, KBASE((t) + 1), cur.kp); }     \
        SBAR(); qkt<KB, SK>(PX0, PX1, K_lds, r32, hi, S.qr, ACT(t));                                             \
        finishSM(PY0, PY1, alY, l_reg, pa0, pa1, pa2, pa3); SBAR();                                                           \
        if constexpr (F32) { if ((t) + 1 < NT) { VMW(); SWRITE_KF(SB); SBAR(); SLOAD_F((const float*)Vh, KBASE((t) + 1)); SBAR(); } }  \
        pv_tile<VB, SK>(o, vb0, pa0, pa1, pa2, pa3, ACT((t) - 1)); MASKT(PX0, PX1, (t)); partialSM(PX0, PX1, m_reg, mnX, alX);                                        \
        if constexpr (F32) __syncthreads(); else asm volatile("s_waitcnt lgkmcnt(0)\n\ts_barrier" ::: "memory");     \
        if ((t) + 1 < NT) { VMW(); if constexpr (F32) { SWRITE_VF(SB); SBAR(); if ((t) + 2 < NT) SLOAD_F((const float*)Kh, KBASE((t) + 2)); } \
                            else { SWRITE_H(SB); } }                                                                          \
        RESC(alX); if constexpr (F32) __syncthreads(); else asm volatile("s_waitcnt lgkmcnt(0)\n\ts_barrier" ::: "memory"); } while (0)
    for (int t = 1; t + 1 < NT; t += 2) {
        HALF_STEP(pB0, pB1, mnB, alB, pA0, pA1, alA, t, 1, 0, 0);
        HALF_STEP(pA0, pA1, mnA, alA, pB0, pB1, alB, t + 1, 0, 1, 1);
    }
    const bool even = (NT & 1) == 0;
    if constexpr (!F32) SLOAD_H(nxt.K, nxt.V, kbn, nxt.kp);
    if (even) { SBAR(); qkt<1, SK>(pB0, pB1, K_lds, r32, hi, S.qr, ACT(NT - 1)); SBAR(); }
#define QROW(e) (nxt.Q + (size_t)(wid * QBLK + r32) * D + ((e) >> 1) * 16 + hi * 8 + ((e) & 1) * 4)
    if constexpr (F32) { SLOAD_F((const float*)nxt.K, kbn); SBAR();
#pragma unroll
        for (int e = 0; e < 8; ++e) S.tq[e] = *(const f32x4*)QROW(e); }
    else { SBAR();
#pragma unroll
        for (int d0 = 0; d0 < 8; ++d0) S.qr[d0] = load8<TIn>((const TIn*)((const char*)nxt.Q + (unsigned)(((wid * QBLK + r32) * nxt.qp + hi * 8) * 2) + d0 * 32)); }
    SBAR();
    finishSM(pA0, pA1, alA, l_reg, pa0, pa1, pa2, pa3); SBAR();
    if constexpr (F32) {
#pragma unroll
        for (int e = 8; e < 16; ++e) S.tq[e] = *(const f32x4*)QROW(e); SBAR(); }
#undef QROW
    pv_tile<0, SK>(o, vb0, pa0, pa1, pa2, pa3, ACT(even ? NT - 2 : NT - 1));
    if (even) { MASKT(pB0, pB1, NT - 1); partialSM(pB0, pB1, m_reg, mnB, alB); __syncthreads(); RESC(alB);
        finishSM(pB0, pB1, alB, l_reg, pa0, pa1, pa2, pa3); SBAR(); pv_tile<1, SK>(o, vb0, pa0, pa1, pa2, pa3, ACT(NT - 1)); }
    SBAR(); SEAM_K0();
    if (hi == 0) { li_l[r32] = l_reg; if (cur.L) cur.L[(unsigned)((wid * QBLK + r32) * cur.lp)] = m_reg * SCALE + logf(l_reg); }
    asm volatile("s_waitcnt lgkmcnt(0)" ::: "memory");
    float rli[16];
#pragma unroll
    for (int r = 0; r < 16; ++r) rli[r] = __builtin_amdgcn_rcpf(li_l[crow(r, hi)]);
    TOut* Ow = cur.O + (unsigned)(wid * QBLK * cur.op); const int opitch = cur.op;
    if constexpr (same_t<TOut, float>::v) {
#pragma unroll
        for (int r = 0; r < 16; ++r) { const int orow = crow(r, hi);
#pragma unroll
            for (int d0 = 0; d0 < 4; ++d0) Ow[(unsigned)(orow * opitch + d0 * 32 + r32)] = o[d0][r] * rli[r]; }
    } else {
        char* ost = lds + LDS_BYTES + wid * (32 * 272);
#pragma unroll
        for (int r = 0; r < 16; ++r) { const int orow = crow(r, hi);
#pragma unroll
            for (int d0 = 0; d0 < 4; ++d0) { const float v = o[d0][r] * rli[r]; *(unsigned short*)(ost + orow * 272 + (d0 * 32 + r32) * 2) = (unsigned short)(cvtpk(v, v) & 0xffffu); } }
        asm volatile("s_waitcnt lgkmcnt(0)" ::: "memory");
#pragma unroll
        for (int i = 0; i < 8; ++i) { const int ch = i * 64 + lane, orow = ch >> 4, c16 = ch & 15;
            *(u32x4*)(Ow + (unsigned)(orow * opitch + c16 * 8)) = *(const u32x4*)(ost + orow * 272 + c16 * 16); }
    }
    if constexpr (F32) {
#pragma unroll
        for (int d0 = 0; d0 < 8; ++d0) S.qr[d0] = pack8(S.tq[2 * d0], S.tq[2 * d0 + 1]); }
    if constexpr (F32) __syncthreads(); else asm volatile("s_waitcnt lgkmcnt(0)\n\ts_barrier" ::: "memory");
#undef RESC
#undef KBASE
#undef ACT
#undef MASKT
#undef SEAM_K0
#undef HALF_STEP
}
#undef ROW
#undef VMW
#undef VMWN
#undef SLOAD_H
#undef SWRITE_HK
#undef SWRITE_HV
#undef SWRITE_H
#undef SLOAD_F
#undef SWRITE_KF
#undef SWRITE_VF

#undef ROWP
#undef KSWZ
#undef SBAR
}

constexpr int NWAVES = 8;
constexpr int BATCH = 2, SEQ = 8192, DM = 1024, TOK = BATCH * SEQ;
constexpr int AH = 16, AHD = 64;
constexpr int BH = 8, BHD = 128, BG = 3;
constexpr int NE = 16, FF = 256, NCLS = 24, MROWS = 72, MRP = 80;
constexpr int NA = 2, NB = 2, NL = 4;
constexpr int WIN_LD = 3 * DM + AH;
constexpr float LOG2E = 1.4426950408889634f;

constexpr size_t MiB = 1u << 20;
constexpr size_t WS_CTL = 0, CTL_ZERO_BYTES = 1 * MiB;
constexpr size_t WS_RSTD = 1 * MiB;
constexpr size_t WS_GA = 1 * MiB + 256 * 1024, WS_GB = 1 * MiB + 512 * 1024;
constexpr size_t WS_LOGF = 2 * MiB;
constexpr size_t WS_CL = 3 * MiB;
constexpr size_t WS_CAUG = 4 * MiB;
constexpr size_t WS_ROPEC = 6 * MiB;
constexpr size_t WS_GAL = 10 * MiB, WS_GBL = 12 * MiB;
constexpr size_t WS_WF = 14 * MiB;
constexpr size_t WS_WR = 14 * MiB + 512 * 1024;
constexpr size_t WS_WFF = 15 * MiB + 640 * 1024;
constexpr size_t WS_WRF = 15 * MiB + 64 * 1024;
constexpr size_t WS_GTAB = 15 * MiB;
constexpr size_t WS_LSE = 16 * MiB;
constexpr size_t WS_LIST = 18 * MiB;
constexpr size_t WS_WIN = 20 * MiB;
constexpr size_t WS_WOA = 32 * MiB;
constexpr size_t WS_WKVQ0 = 36 * MiB;
constexpr size_t WS_WQ1 = 46 * MiB;
constexpr size_t WS_WOB = 52 * MiB;
constexpr size_t WS_WGU = 56 * MiB;
constexpr size_t WS_WD = 88 * MiB;
constexpr size_t WS_HB = 104 * MiB;
constexpr size_t WS_KB = 136 * MiB, WS_VB = 168 * MiB;
constexpr size_t WS_QB = 200 * MiB;
constexpr size_t WS_HLO = 296 * MiB;
constexpr size_t WS_END = 328 * MiB;
constexpr int CW_CNT2 = 32768;
constexpr int CW_BAR = 4096, CW_CNT = 16384, CW_AQ = 20480;

constexpr int RING_OFF = 0, RING_BYTES = 131072;
constexpr int XS_OFF = 131072;
constexpr int LDS_BYTES = 163840;
constexpr int MISC_OFF = LDS_BYTES - 256;
static_assert(attn_body::ATTN_LDS_BYTES <= MISC_OFF, "attention LDS");

#define GAS __attribute__((address_space(1)))
#define LAS __attribute__((address_space(3)))
typedef unsigned short bf16;
typedef unsigned v4u __attribute__((ext_vector_type(4)));
typedef float f32x4 __attribute__((ext_vector_type(4)));
typedef short bf16x8 __attribute__((ext_vector_type(8)));
typedef GAS unsigned gu32;
#define RLX_AGENT __ATOMIC_RELAXED, __HIP_MEMORY_SCOPE_AGENT
#define LDS_WAIT() asm volatile("s_waitcnt lgkmcnt(0)" ::: "memory")
__device__ __forceinline__ unsigned f2bf(float f) { unsigned u = __builtin_bit_cast(unsigned, f); return (u + 0x7fffu + ((u >> 16) & 1u)) >> 16; }
__device__ __forceinline__ unsigned pk2(float lo, float hi) { return f2bf(lo) | (f2bf(hi) << 16); }
__device__ __forceinline__ float bf2f(unsigned b) { return __builtin_bit_cast(float, b << 16); }

#define XB_TMO      128
#define XB_XCNT(j)  (256  + 64 * (j))
#define XB_XSUB(j)  (1280 + 64 * (j))
#define XB_XGEN(j)  (2304 + 64 * (j))
#define XB_TOP      3328
#define XB_TOPGEN   3392
#define XCD_BAR_WORDS 3456
#define XB_SPIN_CAP (1u << 18)

__device__ __forceinline__ unsigned xb_ld(unsigned* p)              { return __hip_atomic_load(p, __ATOMIC_RELAXED, __HIP_MEMORY_SCOPE_AGENT); }
__device__ __forceinline__ unsigned xb_add(unsigned* p, unsigned v) { return __hip_atomic_fetch_add(p, v, __ATOMIC_RELAXED, __HIP_MEMORY_SCOPE_AGENT); }
__device__ __forceinline__ unsigned xb_xcc_id() { return (unsigned)__builtin_amdgcn_s_getreg((3 << 11) | 20) & 0xFu; }
#define XB_SPIN(cond, bar) do { unsigned _sp = 0; while (cond) { __builtin_amdgcn_s_sleep(1); \
    if ((++_sp & 255u) == 0u) { if (xb_ld(&(bar)[XB_TMO])) break; if (_sp > XB_SPIN_CAP) { atomicAdd(&(bar)[XB_TMO], 1u); break; } } } } while (0)

struct XcdBarrier {
    unsigned* bar; unsigned x;
    volatile LAS unsigned* st;
};

__device__ __forceinline__ XcdBarrier xcd_barrier_post(unsigned* bar, volatile LAS unsigned* st) {
    XcdBarrier b; b.bar = bar; b.x = xb_xcc_id(); b.st = st;
    if (threadIdx.x == 0) (void)xb_add(&bar[XB_XCNT(b.x)], 1u);
    return b;
}
__device__ __forceinline__ void xcd_barrier_complete(unsigned* bar, unsigned x, unsigned& nloc, unsigned& nx) {
    const unsigned G = gridDim.x * gridDim.y * gridDim.z;
    unsigned sum, cnt, mine, sp = 0u;
    for (;;) {
        sum = 0u; cnt = 0u; mine = 0u;
#pragma unroll
        for (unsigned j = 0; j < 16; ++j) { const unsigned c = xb_ld(&bar[XB_XCNT(j)]); sum += c; cnt += (c > 0u) ? 1u : 0u; mine = (j == x) ? c : mine; }
        if (sum == G) break;
        __builtin_amdgcn_s_sleep(1);
        if ((++sp & 255u) == 0u) { if (xb_ld(&bar[XB_TMO])) break; if (sp > XB_SPIN_CAP) { atomicAdd(&bar[XB_TMO], 1u); break; } }
    }
    nloc = mine > 0u ? mine : 1u; nx = cnt > 0u ? cnt : 1u;
}

__device__ __forceinline__ void xcd_barrier(const XcdBarrier& b) {
    asm volatile("s_waitcnt vmcnt(0)" ::: "memory");
    __syncthreads();
    if (threadIdx.x == 0) {
        unsigned* bar = b.bar;
        __builtin_amdgcn_s_waitcnt(0);
        unsigned nloc = b.st[0], nx = b.st[1];
        if (nloc == 0u) { xcd_barrier_complete(bar, b.x, nloc, nx); b.st[0] = nloc; b.st[1] = nx; }
        const unsigned old = xb_add(&bar[XB_XSUB(b.x)], 1u);
        const unsigned gen = old / nloc;
        if (old + 1u == (gen + 1u) * nloc) {
            __builtin_amdgcn_fence(__ATOMIC_RELEASE, "agent");
            asm volatile("s_waitcnt vmcnt(0)" ::: "memory");
            const unsigned og = xb_add(&bar[XB_TOP], 1u);
            const unsigned tg = og / nx;
            if (og + 1u == (tg + 1u) * nx) xb_add(&bar[XB_TOPGEN], 1u);
            else XB_SPIN(xb_ld(&bar[XB_TOPGEN]) == tg, bar);
            __builtin_amdgcn_fence(__ATOMIC_ACQUIRE, "agent");
            xb_add(&bar[XB_XGEN(b.x)], 1u);
            asm volatile("s_waitcnt vmcnt(0)" ::: "memory");
        } else {
            XB_SPIN(xb_ld(&bar[XB_XGEN(b.x)]) == gen, bar);
            __builtin_amdgcn_fence(__ATOMIC_ACQUIRE, "agent");
            asm volatile("s_waitcnt vmcnt(0)" ::: "memory");
        }
    }
    __syncthreads();
}

struct Args { const float* in[24]; float* out; unsigned char* ws; int ph_lo, ph_hi; };
typedef const __attribute__((address_space(4))) char* kptr_t;
struct KA { kptr_t k;
    __device__ __forceinline__ const float* in(int i) const { return (const float*)(const GAS float*)*(const float* const __attribute__((address_space(4)))*)(k + 8 * i); }
    __device__ __forceinline__ float* out() const { return (float*)(GAS float*)*(float* const __attribute__((address_space(4)))*)(k + 192); }
    __device__ __forceinline__ unsigned char* ws() const { return (unsigned char*)(GAS unsigned char*)*(unsigned char* const __attribute__((address_space(4)))*)(k + 200); } };
static_assert(sizeof(Args) == 216 && __builtin_offsetof(Args, out) == 192 && __builtin_offsetof(Args, ws) == 200, "Args layout");
struct Frame { LAS unsigned char* lds; int tid, lane, wave, vcu, G; };

__device__ __forceinline__ float wave_sum(float v) {
#pragma unroll
    for (int o = 1; o < 64; o <<= 1) v += __shfl_xor(v, o);
    return v;
}
struct TrD { const float* src; const float* gain; bf16* dst; int ld, mode, dK, n0, drow0, k0, up; };
__device__ __forceinline__ int map64(int n)  { return (n & ~255) + 128 * ((n >> 5) & 1) + 32 * ((n >> 6) & 3) + (n & 31); }
__device__ __forceinline__ int map128(int n) { return (n & ~255) + 128 * ((n >> 6) & 1) + 64 * ((n >> 7) & 1) + (n & 63); }
__device__ __forceinline__ void tr_load(const TrD& d, f32x4 (&rg)[8], int lane) {
    const int r = lane >> 3, c4 = lane & 7;
#pragma unroll
    for (int i = 0; i < 8; ++i) { const int kk = 8 * i + r; f32x4 v = *(const GAS f32x4*)(d.src + (size_t)(d.k0 + kk) * d.ld + d.n0 + 4 * c4);
        const float g = d.gain ? *(const GAS float*)(d.gain + d.k0 + kk) : 1.0f; rg[i] = v * g; }
}
__device__ __forceinline__ void tr_store(const TrD& d, const f32x4 (&rg)[8], LAS float* scr, int lane) {
    { const int r = lane >> 3, c4 = lane & 7;
#pragma unroll
      for (int i = 0; i < 8; ++i) { LAS float* p = scr + (8 * i + r) * 33 + 4 * c4; p[0] = rg[i].x; p[1] = rg[i].y; p[2] = rg[i].z; p[3] = rg[i].w; } }
    LDS_WAIT(); asm volatile("" ::: "memory");
    const int c = lane & 7;
#pragma unroll
    for (int j = 0; j < 4; ++j) { const int n = (lane >> 3) + 8 * j; const LAS float* s = scr + (8 * c) * 33 + n;
        v4u o; o.x = pk2(s[0 * 33], s[1 * 33]); o.y = pk2(s[2 * 33], s[3 * 33]); o.z = pk2(s[4 * 33], s[5 * 33]); o.w = pk2(s[6 * 33], s[7 * 33]);
        size_t pos;
        if (d.mode == 0) pos = (size_t)(d.drow0 + n) * d.dK + d.k0 + 8 * c;
        else { const int f = d.n0 + n, k8 = (d.k0 >> 3) + c, ks = k8 >> 2, fq = k8 & 3, fr = f & 15;
            if (d.mode == 1) { const int w = f >> 5, cb = 2 * d.up + ((f >> 4) & 1); pos = ((size_t)((w * 32 + ks) * 4 + cb) * 64 + fq * 16 + fr) * 8; }
            else { const int p = f >> 9, w = (f >> 6) & 7, c5 = f & 31, cb = 2 * ((f >> 5) & 1) + ((c5 >> 2) & 1), fm = 4 * (c5 >> 3) + (c5 & 3), KS = d.mode == 2 ? 8 : 32;
                pos = ((size_t)(((p * 8 + w) * KS + ks) * 4 + cb) * 64 + fq * 16 + fm) * 8; } }
        *(GAS v4u*)(d.dst + pos) = o; }
    LDS_WAIT(); asm volatile("" ::: "memory");
}
__device__ __forceinline__ TrD tr_decode_moe(const KA a, unsigned char* ws, int l, int it);
__device__ __forceinline__ TrD tr_decode_moe(const KA a, unsigned char* ws, int l, int it) {
    TrD d; const int slot = l & 1; d.dK = 0; d.drow0 = 0;
    if (it < 4096) {
        const int e = it >> 8, r = it & 255, up = r >> 7, q = r & 127, kb = q >> 3, nb = q & 7;
        d.src = a.in(up ? 21 : 20) + ((size_t)(l * NE + e)) * DM * FF; d.ld = FF; d.gain = a.in(15) + (size_t)l * DM;
        d.dst = (bf16*)(ws + WS_WGU) + ((size_t)(slot * NE + e)) * 512 * DM; d.mode = 1; d.n0 = 32 * nb; d.up = up; d.k0 = 64 * kb;
    } else {
        const int r0 = it - 4096, e = r0 >> 7, q = r0 & 127, kb = q >> 5, nb = q & 31;
        d.src = a.in(22) + ((size_t)(l * NE + e)) * FF * DM; d.ld = DM; d.gain = nullptr;
        d.dst = (bf16*)(ws + WS_WD) + ((size_t)(slot * NE + e)) * DM * FF; d.mode = 2; d.n0 = 32 * nb; d.up = 0; d.k0 = 64 * kb;
    }
    return d;
}
constexpr int TR_I_WIN = 16 * 96, TR_I_WO = 16 * 32, TR_I_KV = 16 * 64, TR_I_Q = 16 * 96, TR_I_MOE = 6144;
constexpr int TR_NITEMS = 2 * TR_I_WIN + 2 * TR_I_WO + TR_I_KV + 2 * TR_I_Q + 2 * TR_I_WO + 2 * TR_I_MOE;
__device__ __forceinline__ TrD tr_decode_main(const KA a, unsigned char* ws, int it) {
    TrD d; d.mode = 0; d.dK = DM; d.up = 0; int r = it;
    if (r < 2 * TR_I_WIN) { const int l = r / TR_I_WIN; r -= l * TR_I_WIN; const int kb = r / 96, nb = r % 96, n0 = 32 * nb;
        d.src = a.in(3) + (size_t)l * DM * WIN_LD; d.ld = WIN_LD; d.gain = a.in(2) + l * DM; d.dst = (bf16*)(ws + WS_WIN) + (size_t)l * 3072 * DM; d.n0 = n0; d.drow0 = map64(n0); d.k0 = 64 * kb; return d; }
    r -= 2 * TR_I_WIN;
    if (r < 2 * TR_I_WO) { const int l = r / TR_I_WO; r -= l * TR_I_WO; const int kb = r / 32, nb = r % 32;
        d.src = a.in(7) + (size_t)l * DM * DM; d.ld = DM; d.gain = nullptr; d.dst = (bf16*)(ws + WS_WOA) + (size_t)l * DM * DM; d.n0 = 32 * nb; d.drow0 = 32 * nb; d.k0 = 64 * kb; d.mode = 3; return d; }
    r -= 2 * TR_I_WO;
    if (r < TR_I_KV) { const int kb = r / 64, nb = r % 64, n0 = 32 * nb;
        d.src = a.in(9); d.ld = 2 * DM; d.gain = a.in(8); d.dst = (bf16*)(ws + WS_WKVQ0); d.n0 = n0; d.drow0 = n0 < DM ? map128(n0) : n0; d.k0 = 64 * kb; return d; }
    r -= TR_I_KV;
    if (r < 2 * TR_I_Q) { const int j = r / TR_I_Q; r -= j * TR_I_Q; const int kb = r / 96, nb = r % 96, n0 = 32 * nb;
        d.src = a.in(12) + (size_t)j * DM * 3072; d.ld = 3072; d.gain = a.in(11) + j * DM; d.dst = j == 0 ? (bf16*)(ws + WS_WKVQ0) + (size_t)2048 * DM : (bf16*)(ws + WS_WQ1); d.n0 = n0; d.drow0 = map128(n0); d.k0 = 64 * kb; return d; }
    r -= 2 * TR_I_Q;
    if (r < 2 * TR_I_WO) { const int j = r / TR_I_WO; r -= j * TR_I_WO; const int kb = r / 32, nb = r % 32;
        d.src = a.in(14) + (size_t)j * DM * DM; d.ld = DM; d.gain = nullptr; d.dst = (bf16*)(ws + WS_WOB) + (size_t)j * DM * DM; d.n0 = 32 * nb; d.drow0 = 32 * nb; d.k0 = 64 * kb; d.mode = 3; return d; }
    r -= 2 * TR_I_WO;
    { const int l = r / TR_I_MOE; return tr_decode_moe(a, ws, l, r - l * TR_I_MOE); }
}
template <bool MAIN> __device__ __forceinline__ void tr_run(const KA a, unsigned char* ws, int layer, int nitems, int gw, int NGW, LAS float* scr, int lane) {
    int it = gw; if (it >= nitems) return;
    TrD d = MAIN ? tr_decode_main(a, ws, it) : tr_decode_moe(a, ws, layer, it);
    f32x4 rg[8]; tr_load(d, rg, lane);
    for (;;) {
        const int itn = it + NGW; const bool more = itn < nitems;
        TrD dn = d; f32x4 rn[8];
        if (more) { dn = MAIN ? tr_decode_main(a, ws, itn) : tr_decode_moe(a, ws, layer, itn); tr_load(dn, rn, lane); }
        tr_store(d, rg, scr, lane);
        if (!more) break;
        d = dn; it = itn;
#pragma unroll
        for (int i = 0; i < 8; ++i) rg[i] = rn[i];
    }
}
constexpr int CW_CQ = 24576;
__device__ __forceinline__ void conv_drain(const KA a, unsigned char* ws, Frame& F, unsigned* cctr, bool main, int layer, int lo, int hi) {
    volatile LAS int* cw = (volatile LAS int*)(F.lds + MISC_OFF) + 16;
    LAS float* scr = (LAS float*)(F.lds + RING_OFF + F.wave * 16384);
    const int nb = (hi - lo + 127) >> 7;
    for (;;) {
        __syncthreads();
        if (F.tid == 0) cw[0] = (int)__hip_atomic_fetch_add(cctr, 1u, RLX_AGENT);
        __syncthreads();
        const int b = __builtin_amdgcn_readfirstlane(cw[0]);
        if (b >= nb) break;
        const int base = lo + b * 128, end = (base + 128 < hi) ? base + 128 : hi;
        int it = base + F.wave; if (it >= end) continue;
        TrD d0 = main ? tr_decode_main(a, ws, it) : tr_decode_moe(a, ws, layer, it);
        f32x4 r0[8], r1[8]; tr_load(d0, r0, F.lane);
        bool h1 = it + 8 < end; TrD d1 = d0;
        if (h1) { d1 = main ? tr_decode_main(a, ws, it + 8) : tr_decode_moe(a, ws, layer, it + 8); tr_load(d1, r1, F.lane); }
        for (;;) {
            const int it2 = it + 16; const bool h2 = h1 && it2 < end;
            TrD d2 = d1; f32x4 r2[8];
            if (h2) { d2 = main ? tr_decode_main(a, ws, it2) : tr_decode_moe(a, ws, layer, it2); tr_load(d2, r2, F.lane); }
            tr_store(d0, r0, scr, F.lane);
            if (!h1) break;
            d0 = d1; d1 = d2; h1 = h2; it += 8;
#pragma unroll
            for (int i = 0; i < 8; ++i) { r0[i] = r1[i]; r1[i] = r2[i]; }
        }
    }
    __syncthreads();
}
__device__ __forceinline__ void sincos_f64(double a, float& c, float& s) {
    const double q = __builtin_rint(a * 0.63661977236758134308);
    const double r = __builtin_fma(-q, 6.123233995736766036e-17, __builtin_fma(-q, 1.5707963267948966192, a));
    const double r2 = r * r;
    double sp = -1.0 / 39916800.0; sp = sp * r2 + 1.0 / 362880.0; sp = sp * r2 - 1.0 / 5040.0; sp = sp * r2 + 1.0 / 120.0; sp = sp * r2 - 1.0 / 6.0; sp = sp * r2 * r + r;
    double cp = 1.0 / 479001600.0; cp = cp * r2 - 1.0 / 3628800.0; cp = cp * r2 + 1.0 / 40320.0; cp = cp * r2 - 1.0 / 720.0; cp = cp * r2 + 1.0 / 24.0; cp = cp * r2 - 0.5; cp = cp * r2 + 1.0;
    const int qi = (int)((long long)q & 3);
    const double cs = (qi == 0) ? cp : (qi == 1) ? -sp : (qi == 2) ? -cp : sp;
    const double sn = (qi == 0) ? sp : (qi == 1) ? cp : (qi == 2) ? -sp : -cp;
    c = (float)cs; s = (float)sn;
}
__device__ __forceinline__ void p_prologue(const KA a, Frame& F) {
    unsigned char* ws = a.ws(); asm volatile("" : "+s"(ws)); ASSUME_GLOBAL(ws);
    LAS float* scr = (LAS float*)(F.lds + RING_OFF + F.wave * 16384);
    const int gw = F.vcu * NWAVES + F.wave, NGW = F.G * NWAVES;
    tr_run<true>(a, ws, 0, TR_I_WIN, gw, NGW, scr, F.lane);
    const int gt = (F.vcu * NWAVES + F.wave) * 64 + F.lane, NGT = NGW * 64;
    for (int i = gt; i < 2 * 16 * DM; i += NGT) { const int l = i / (16 * DM), v = (i / DM) % 16, k = i % DM;
        ((float*)(ws + WS_WF))[i] = a.in(3)[(size_t)l * DM * WIN_LD + (size_t)k * WIN_LD + 3 * DM + v] * a.in(2)[l * DM + k]; }
    for (int i = gt; i < 4 * 20 * DM; i += NGT) { const int l = i / (20 * DM), v = (i / DM) % 20, k = i % DM;
        const float w = v < 4 ? a.in(16)[(size_t)l * DM * 4 + k * 4 + v] : a.in(18)[(size_t)l * DM * 16 + k * 16 + (v - 4)];
        ((float*)(ws + WS_WR))[i] = w * a.in(15)[l * DM + k]; }
    for (int i = gt; i < 4 * 4 * 8 * 2 * 2 * 64; i += NGT) {
        const int lane = i & 63, hl = (i >> 6) & 1, qb = (i >> 7) & 1, w = (i >> 8) & 7, p = (i >> 11) & 3, l = i >> 13;
        const int q = qb * 16 + (lane & 15), fq = lane >> 4; unsigned pk[4];
#pragma unroll
        for (int e2 = 0; e2 < 4; ++e2) { float v[2];
#pragma unroll
            for (int h2 = 0; h2 < 2; ++h2) { const int e = 2 * e2 + h2, k = 256 * p + 32 * w + 8 * fq + e;
                float wv = 0.f;
                if (q < 20) wv = (q < 4 ? a.in(16)[(size_t)l * DM * 4 + k * 4 + q] : a.in(18)[(size_t)l * DM * 16 + k * 16 + (q - 4)]) * a.in(15)[l * DM + k];
                const float hi = bf2f(pk2(wv, 0.f) & 0xffffu); v[h2] = hl ? (wv - hi) : wv; }
            pk[e2] = pk2(v[0], v[1]); }
        *(GAS v4u*)((GAS char*)(ws + WS_WRF) + (size_t)i * 16) = (v4u){pk[0], pk[1], pk[2], pk[3]}; }
    for (int i = gt; i < 2 * 8 * 2 * 2 * 64; i += NGT) {
        const int lane = i & 63, hl = (i >> 6) & 1, s2 = (i >> 7) & 1, w = (i >> 8) & 7, p = (i >> 11) & 1;
        const int hh = lane & 15, fq = lane >> 4; unsigned pk[4];
#pragma unroll
        for (int e2 = 0; e2 < 4; ++e2) { float v[2];
#pragma unroll
            for (int h2 = 0; h2 < 2; ++h2) { const int e = 2 * e2 + h2, k = 512 * p + 64 * w + 32 * s2 + 8 * fq + e;
                const float wv = a.in(3)[(size_t)1 * DM * WIN_LD + (size_t)k * WIN_LD + 3 * DM + hh] * a.in(2)[1 * DM + k];
                const float hi = bf2f(pk2(wv, 0.f) & 0xffffu); v[h2] = hl ? (wv - hi) : wv; }
            pk[e2] = pk2(v[0], v[1]); }
        *(GAS v4u*)((GAS char*)(ws + WS_WFF) + (size_t)i * 16) = (v4u){pk[0], pk[1], pk[2], pk[3]}; }
    for (int i = gt; i < 2 * 192; i += NGT) { const int l = i / 192, sec = (i / 64) % 3, dd = i % 64;
        ((float*)(ws + WS_GTAB))[i] = sec == 0 ? a.in(5)[l * AHD + dd] * (0.125f * LOG2E) : (sec == 1 ? a.in(6)[l * AHD + dd] : 1.0f); }
    const int* pos = (const int*)a.in(1);
    for (int i = gt; i < TOK * 64; i += NGT) { const int m = i >> 6, f = i & 63;
        const float invf = powf(10000.0f, -(float)f / 64.0f);
        const float ang = (float)pos[m] * invf;
        float c, s; sincos_f64((double)ang, c, s);
        ((unsigned*)(ws + WS_ROPEC))[i] = (unsigned)__builtin_bit_cast(unsigned short, (_Float16)c) | ((unsigned)__builtin_bit_cast(unsigned short, (_Float16)s) << 16); }
}

template <int N, int O> struct RedTree {
    static __device__ __forceinline__ void run(float (&v)[80], int lane, int& base) {
        if constexpr (O >= 1) {
            if constexpr (N % 2 == 0) {
                const bool up = (lane & O) != 0;
#pragma unroll
                for (int i = 0; i < N / 2; ++i) { const float keep = up ? v[i + N / 2] : v[i], send = up ? v[i] : v[i + N / 2]; v[i] = keep + __shfl_xor(send, O); }
                if (up) base += N / 2;
                RedTree<N / 2, O / 2>::run(v, lane, base);
            } else {
#pragma unroll
                for (int i = 0; i < N; ++i) v[i] += __shfl_xor(v[i], O);
                RedTree<N, O / 2>::run(v, lane, base);
            }
        }
    }
};
template <int MODE> __device__ __forceinline__ void p_rowpass(const KA a, Frame& F, int layer, bool dry = false, const float* Hsrc = nullptr, bool raw_wf = false) {
    unsigned char* ws = a.ws(); asm volatile("" : "+s"(ws)); ASSUME_GLOBAL(ws);
    constexpr int NV = MODE == 1 ? 16 : (MODE == 2 ? 20 : 0), NT = MODE == 2 ? 2 : 4, NVAL = NT * NV;
    constexpr int NFIN = MODE == 2 ? 5 : 1;
    LAS float* wl = (LAS float*)(F.lds + RING_OFF);
    LAS float* red = (LAS float*)(F.lds + RING_OFF + 96 * 1024) + F.wave * 96;
    if (NV) {
        if (MODE == 1 && raw_wf) {
            const float* win = a.in(3) + (size_t)layer * DM * WIN_LD + 3 * DM; const float* gn = a.in(2) + layer * DM;
            for (int i = F.tid; i < 16 * DM; i += NWAVES * 64) { const int k = i >> 4, v = i & 15; wl[v * DM + k] = *(const GAS float*)(win + (size_t)k * WIN_LD + v) * *(const GAS float*)(gn + k); }
        } else {
        const float* wsrc = MODE == 1 ? (const float*)(ws + WS_WF) + (size_t)layer * 16 * DM : (const float*)(ws + WS_WR) + (size_t)layer * 20 * DM;
        for (int i = F.tid; i < NV * DM / 4; i += NWAVES * 64) ((LAS f32x4*)wl)[i] = ((const f32x4*)wsrc)[i];
        }
        __syncthreads();
    }
    const int gw = F.vcu * NWAVES + F.wave, NGW = F.G * NWAVES;
    const float* H = Hsrc ? Hsrc : a.out(); float* rstd = (float*)(ws + WS_RSTD); bf16* hb = (bf16*)(ws + WS_HB);
    for (int m0 = NT * gw; m0 < TOK; m0 += NT * NGW) {
        f32x4 v[NT][4]; float rs[4] = {0.f, 0.f, 0.f, 0.f};
#pragma unroll
        for (int r = 0; r < NT; ++r) { const f32x4* xr = (const f32x4*)(H + (size_t)(m0 + r) * DM) + F.lane;
#pragma unroll
            for (int j = 0; j < 4; ++j) v[r][j] = xr[64 * j]; }
#pragma unroll
        for (int r = 0; r < NT; ++r) { float s = 0.f;
#pragma unroll
            for (int j = 0; j < 4; ++j) s += (v[r][j].x * v[r][j].x + v[r][j].y * v[r][j].y) + (v[r][j].z * v[r][j].z + v[r][j].w * v[r][j].w);
            rs[r] = 1.0f / sqrtf(wave_sum(s) * (1.0f / DM) + 1e-6f);
            unsigned long long* o8 = (unsigned long long*)(hb + (size_t)(m0 + r) * DM) + F.lane;
#pragma unroll
            for (int j = 0; j < 4; ++j) o8[64 * j] = (unsigned long long)pk2(v[r][j].x, v[r][j].y) | ((unsigned long long)pk2(v[r][j].z, v[r][j].w) << 32); }
        if (F.lane < NT) rstd[m0 + F.lane] = F.lane == 0 ? rs[0] : (F.lane == 1 ? rs[1] : (F.lane == 2 ? rs[2] : rs[3]));
        if (NV) {
            float pv[80];
#pragma unroll
            for (int q = 0; q < NV; ++q) {
                f32x4 w[4];
#pragma unroll
                for (int j = 0; j < 4; ++j) w[j] = ((const LAS f32x4*)(wl + q * DM))[F.lane + 64 * j];
#pragma unroll
                for (int r = 0; r < NT; ++r) { float p = 0.f;
#pragma unroll
                    for (int j = 0; j < 4; ++j) p += (v[r][j].x * w[j].x + v[r][j].y * w[j].y) + (v[r][j].z * w[j].z + v[r][j].w * w[j].w);
                    pv[r * NV + q] = p; }
            }
            int base = 0;
            RedTree<NVAL, 32>::run(pv, F.lane, base);
            if (MODE == 1) {
                const int r = base >> 4, hh = base & 15; const float rsr = r == 0 ? rs[0] : (r == 1 ? rs[1] : (r == 2 ? rs[2] : rs[3]));
                const float z = pv[0] * rsr + a.in(4)[layer * AH + hh]; const float ls = fminf(z, 0.f) - __logf(1.0f + __expf(-fabsf(z)));
                const int m = m0 + r, b = m / SEQ, sidx = m % SEQ; ((float*)(ws + WS_LOGF))[(size_t)(b * AH + hh) * SEQ + sidx] = ls;
            } else if (MODE == 2) {
#pragma unroll
                for (int i = 0; i < NFIN; ++i) red[base + i] = pv[i];
                LDS_WAIT(); asm volatile("" ::: "memory");
                if (F.lane < NT) {
                    const int m = m0 + F.lane; const float rsr = F.lane == 0 ? rs[0] : (F.lane == 1 ? rs[1] : (F.lane == 2 ? rs[2] : rs[3]));
                    float d[20];
#pragma unroll
                    for (int q = 0; q < 20; ++q) d[q] = red[F.lane * 20 + q] * rsr;
                    const float* gb = a.in(17) + layer * 4;
                    float lg[4];
#pragma unroll
                    for (int q = 0; q < 4; ++q) lg[q] = d[q] + gb[q];
                    int gi = 0; float gm = lg[0];
#pragma unroll
                    for (int q = 1; q < 4; ++q) if (lg[q] > gm) { gm = lg[q]; gi = q; }
                    float gs = 0.f;
#pragma unroll
                    for (int q = 0; q < 4; ++q) gs += expf(lg[q] - gm);
                    const float gp = 1.0f / gs;
                    const float* ebp = a.in(19) + layer * 16;
                    float el[4];
#pragma unroll
                    for (int q = 0; q < 4; ++q) { float t = 0.f;
#pragma unroll
                        for (int g2 = 0; g2 < 4; ++g2) if (g2 == gi) t = d[4 + 4 * g2 + q] + ebp[4 * g2 + q];
                        el[q] = t; }
                    int i1 = 0; float v1 = el[0];
#pragma unroll
                    for (int q = 1; q < 4; ++q) if (el[q] > v1) { v1 = el[q]; i1 = q; }
                    int i2 = -1; float v2 = 0.f;
#pragma unroll
                    for (int q = 0; q < 4; ++q) if (q != i1 && (i2 < 0 || el[q] > v2)) { v2 = el[q]; i2 = q; }
                    const float e2 = expf(v2 - v1), g1 = gp / (1.0f + e2), g2v = gp * e2 / (1.0f + e2);
                    const int lo = i1 < i2 ? i1 : i2, hi = i1 < i2 ? i2 : i1;
                    const int pidx = (lo == 0) ? (hi - 1) : (lo == 1 ? hi + 1 : 5);
                    const int cls = gi * 6 + pidx;
                    if (!dry) {
                        const unsigned p = __hip_atomic_fetch_add((unsigned*)(ws + WS_CTL) + CW_CNT + layer * 64 + cls, 1u, RLX_AGENT);
                        ((int*)(ws + WS_LIST))[(size_t)cls * TOK + p] = m;
                        ((float*)(ws + WS_GA))[m] = (i1 < i2) ? g1 : g2v;
                        ((float*)(ws + WS_GB))[m] = (i1 < i2) ? g2v : g1;
                    }
                }
                LDS_WAIT(); asm volatile("" ::: "memory");
            }
        }
    }
    __syncthreads();
}

__device__ __forceinline__ void p_rowpass0(const KA a, Frame& F) {
    unsigned char* ws = a.ws(); asm volatile("" : "+s"(ws)); ASSUME_GLOBAL(ws);
    LAS unsigned char* fl = F.lds + RING_OFF;
    { const float* win = a.in(3) + 3 * DM; const float* gn = a.in(2);
      f32x4 wv[8]; float gv[8];
#pragma unroll
      for (int it = 0; it < 8; ++it) { const int idx = F.tid + NWAVES * 64 * it, k = idx >> 2, v4 = (idx & 3) * 4; wv[it] = *(const GAS f32x4*)(win + (size_t)k * WIN_LD + v4); gv[it] = *(const GAS float*)(gn + k); }
#pragma unroll
      for (int it = 0; it < 8; ++it) { const int idx = F.tid + NWAVES * 64 * it, k = idx >> 2, v4 = (idx & 3) * 4; const int c = k >> 5, fq = (k >> 3) & 3, e = k & 7;
#pragma unroll
          for (int j = 0; j < 4; ++j) { const float w = wv[it][j] * gv[it]; const unsigned hi = pk2(w, 0.f) & 0xffffu; const unsigned lo = pk2(w - bf2f(hi), 0.f) & 0xffffu;
              const int lane = fq * 16 + v4 + j;
              *(LAS unsigned short*)(fl + ((c * 2 + 0) * 64 + lane) * 16 + e * 2) = (unsigned short)hi; *(LAS unsigned short*)(fl + ((c * 2 + 1) * 64 + lane) * 16 + e * 2) = (unsigned short)lo; } } }
    __syncthreads();
    const int gw = F.vcu * NWAVES + F.wave, NGW = F.G * NWAVES;
    const float* X = a.in(0); float* rstd = (float*)(ws + WS_RSTD); bf16* hb = (bf16*)(ws + WS_HB);
    const int n = F.lane & 15, fq = F.lane >> 4;
    for (int t0 = 8 * gw; t0 < TOK; t0 += 8 * NGW) {
        const int tok = t0 + (n & 7);
        const GAS char* xp = (const GAS char*)(X + (size_t)tok * DM + 8 * fq); GAS char* hp = (GAS char*)(hb + (size_t)tok * DM + 8 * fq);
        f32x4 facc = (f32x4){0.f, 0.f, 0.f, 0.f}; float ssq = 0.f;
#pragma unroll 1
        for (int half = 0; half < 2; ++half) {
            f32x4 xv[16][2];
#pragma unroll
            for (int c = 0; c < 16; ++c) { xv[c][0] = *(const GAS f32x4*)(xp + ((half * 16 + c) * 32) * 4); xv[c][1] = *(const GAS f32x4*)(xp + ((half * 16 + c) * 32 + 4) * 4); }
#pragma unroll
            for (int c = 0; c < 16; ++c) { const f32x4 x0 = xv[c][0], x1 = xv[c][1];
                ssq += ((x0.x * x0.x + x0.y * x0.y) + (x0.z * x0.z + x0.w * x0.w)) + ((x1.x * x1.x + x1.y * x1.y) + (x1.z * x1.z + x1.w * x1.w));
                const unsigned h0 = pk2(x0.x, x0.y), h1 = pk2(x0.z, x0.w), h2 = pk2(x1.x, x1.y), h3 = pk2(x1.z, x1.w);
                if (n < 8) *(GAS v4u*)(hp + ((half * 16 + c) * 32) * 2) = (v4u){h0, h1, h2, h3};
                const unsigned l0 = pk2(x0.x - bf2f(h0 & 0xffffu), x0.y - bf2f(h0 >> 16)), l1 = pk2(x0.z - bf2f(h1 & 0xffffu), x0.w - bf2f(h1 >> 16)),
                               l2 = pk2(x1.x - bf2f(h2 & 0xffffu), x1.y - bf2f(h2 >> 16)), l3 = pk2(x1.z - bf2f(h3 & 0xffffu), x1.w - bf2f(h3 >> 16));
                const bf16x8 hh = __builtin_bit_cast(bf16x8, (v4u){h0, h1, h2, h3}), ll = __builtin_bit_cast(bf16x8, (v4u){l0, l1, l2, l3});
                const bf16x8 whi = *(const LAS bf16x8*)(fl + (((half * 16 + c) * 2 + 0) * 64 + F.lane) * 16), wlo = *(const LAS bf16x8*)(fl + (((half * 16 + c) * 2 + 1) * 64 + F.lane) * 16);
                facc = __builtin_amdgcn_mfma_f32_16x16x32_bf16(whi, hh, facc, 0, 0, 0);
                facc = __builtin_amdgcn_mfma_f32_16x16x32_bf16(wlo, hh, facc, 0, 0, 0);
                facc = __builtin_amdgcn_mfma_f32_16x16x32_bf16(whi, ll, facc, 0, 0, 0); }
        }
        ssq += __shfl_xor(ssq, 16); ssq += __shfl_xor(ssq, 32);
        const float rs = 1.0f / sqrtf(ssq * (1.0f / DM) + 1e-6f);
        if (n < 8) { if (fq == 0) rstd[tok] = rs;
            const int b = tok / SEQ, sidx = tok % SEQ;
#pragma unroll
            for (int j = 0; j < 4; ++j) { const int hh_ = 4 * fq + j; const float z = facc[j] * rs + a.in(4)[hh_]; const float ls = fminf(z, 0.f) - __logf(1.0f + __expf(-fabsf(z)));
                ((float*)(ws + WS_LOGF))[(size_t)(b * AH + hh_) * SEQ + sidx] = ls; } }
    }
    __syncthreads();
}

__device__ __forceinline__ swa::BlockRef<swa::bf16, swa::bf16> b_unit_ref(unsigned char* ws, int id, bool dry) {
    const int g = id >> 9, r0 = id & 511, bh = r0 >> 5, r1 = r0 & 31;
    const int dl = (g == 0) ? 1 : (g == 1 ? 4 : 16), nq = 32 / dl, res = r1 / nq, qb = r1 % nq;
    const int b = bh >> 3, h = bh & 7;
    const size_t tok0 = (size_t)b * SEQ + res;
    swa::BlockRef<swa::bf16, swa::bf16> R;
    swa::bf16* qbase = (swa::bf16*)(ws + WS_QB) + tok0 * 3072 + g * 1024 + h * 128;
    R.Q = qbase + (size_t)qb * 256 * dl * 3072; R.O = qbase + (size_t)qb * 256 * dl * 3072; R.qp = dl * 3072; R.op = dl * 3072;
    R.K = (const swa::bf16*)(ws + WS_KB) + tok0 * 1024 + h * 128; R.V = (const swa::bf16*)(ws + WS_VB) + tok0 * 1024 + h * 128; R.kp = dl * 1024;
    R.L = (float*)(ws + WS_LSE) + (tok0 + (size_t)qb * 256 * dl) * 24 + g * 8 + h; R.lp = dl * 24;
    R.P0 = qb * 256;
    if (dry) { R.O = (swa::bf16*)(ws + WS_HB) + tok0 * 1024 + h * 128 + (size_t)qb * 256 * dl * 1024; R.op = dl * 1024; R.L = nullptr; }
    return R;
}
__device__ __forceinline__ void p_battn(const KA a, Frame& F, bool dry) {
    unsigned char* ws = a.ws(); asm volatile("" : "+s"(ws)); ASSUME_GLOBAL(ws); char* lds = (char*)(F.lds + RING_OFF);
    constexpr int NUNITS = 3 * 512;
    const int bid0 = bid_fresh();
    const bool xdeal = gridDim.x == 256; const int vc = (bid0 & 7) * 32 + (bid0 >> 3), xj = vc & 31, xb = (vc >> 5) * 2; int it = 0;
#define B_PAIR(it_) (xj + 32 * ((it_) >> 1))
#define B_UNIT_ID(it_) (xdeal ? ((((B_PAIR(it_)) / 16) % 3) * 512 + (xb + (B_PAIR(it_)) / 48) * 32 + 2 * ((B_PAIR(it_)) % 16) + ((it_) & 1)) : (bid0 + (it_) * (int)gridDim.x))
    int id = B_UNIT_ID(0);
    if (id >= NUNITS) return;
    typedef swa::BlockRef<swa::bf16, swa::bf16> Ref;
    Ref cur = b_unit_ref(ws, id, dry);
    swa::Seam<swa::bf16> S;
    swa::causal_swa_prime<swa::bf16, swa::bf16>(cur, 129, lds, S);
    for (;;) {
        ++it; const int idn = (xdeal && it >= 6) ? NUNITS : B_UNIT_ID(it); const bool last = idn >= NUNITS;
        const Ref nxt = last ? cur : b_unit_ref(ws, idn, dry);
        const int dl = (id >> 9) == 0 ? 1 : ((id >> 9) == 1 ? 4 : 16);
        swa::causal_swa_block<swa::bf16, swa::bf16>(cur, nxt, SEQ / dl, 129, lds, S);
        if (last) break;
        cur = nxt; id = idn;
    }
#undef B_UNIT_ID
#undef B_PAIR
}
__device__ __forceinline__ void p_bmerge(const KA a, Frame& F) {
    unsigned char* ws = a.ws(); asm volatile("" : "+s"(ws)); ASSUME_GLOBAL(ws);
    const int gw = F.vcu * NWAVES + F.wave, NGW = F.G * NWAVES;
    const bf16* og = (const bf16*)(ws + WS_QB); const float* lse = (const float*)(ws + WS_LSE); bf16* o = (bf16*)(ws + WS_HB);
    for (int m = gw; m < TOK; m += NGW) {
        const int h = F.lane >> 3;
        const float l0 = lse[(size_t)m * 24 + h], l1 = lse[(size_t)m * 24 + 8 + h], l2 = lse[(size_t)m * 24 + 16 + h];
        const float mx = fmaxf(l0, fmaxf(l1, l2));
        const float e0 = expf(l0 - mx), e1 = expf(l1 - mx), e2 = expf(l2 - mx), inv = 1.0f / (e0 + e1 + e2);
        const float w0 = e0 * inv, w1 = e1 * inv, w2 = e2 * inv;
        float accv[16];
#pragma unroll
        for (int i = 0; i < 16; ++i) accv[i] = 0.f;
#pragma unroll
        for (int g = 0; g < 3; ++g) { const float w = g == 0 ? w0 : (g == 1 ? w1 : w2);
            const v4u* p = (const v4u*)(og + (size_t)m * 3072 + g * 1024 + F.lane * 16);
#pragma unroll
            for (int q = 0; q < 2; ++q) { const v4u x = p[q];
                const unsigned xs[4] = {x.x, x.y, x.z, x.w};
#pragma unroll
                for (int e = 0; e < 4; ++e) { accv[q * 8 + 2 * e] += w * bf2f(xs[e] & 0xffffu); accv[q * 8 + 2 * e + 1] += w * bf2f(xs[e] >> 16); } } }
        v4u* po = (v4u*)(o + (size_t)m * DM + F.lane * 16);
#pragma unroll
        for (int q = 0; q < 2; ++q) { v4u w; w.x = pk2(accv[q * 8 + 0], accv[q * 8 + 1]); w.y = pk2(accv[q * 8 + 2], accv[q * 8 + 3]); w.z = pk2(accv[q * 8 + 4], accv[q * 8 + 5]); w.w = pk2(accv[q * 8 + 6], accv[q * 8 + 7]); po[q] = w; }
    }
}

constexpr int MOE_APB = 2048 + 16;
constexpr int MOE_HP = 512 + 8;
constexpr int MOE_A_OFF = 0, MOE_H_OFF = 0;
constexpr int MOE_T_OFF = MROWS * MOE_APB;
constexpr int MOE_E_OFF = 90112;
static_assert(MOE_T_OFF + 3 * MRP * 4 + 768 <= MISC_OFF, "MoE LDS");
static_assert(MRP * MOE_HP * 2 <= MOE_E_OFF && MOE_E_OFF + 8192 + 16 * 81 * 8 <= MOE_T_OFF, "MoE LDS");
typedef float f32x4m __attribute__((ext_vector_type(4)));
__device__ __forceinline__ void p_moe(const KA a, Frame& F, int layer, float upd, bool fg) {
    unsigned char* ws = a.ws(); asm volatile("" : "+s"(ws)); ASSUME_GLOBAL(ws);
    LAS int* cl = (LAS int*)(F.lds + RING_OFF + MOE_T_OFF + 3 * MRP * 4);
    if (F.tid < NCLS * 8) cl[F.tid] = (int)__hip_atomic_load((const unsigned*)(ws + WS_CTL) + CW_CNT2 + layer * 8192 + F.tid * 32, RLX_AGENT);
    __syncthreads();
    for (int u = F.vcu; ; u += (int)gridDim.x) {
    int cls = -1, tile = 0, n_c = 0;
    { int accu = 0;
      for (int c = 0; c < NCLS; ++c) { int n = 0;
#pragma unroll
          for (int k = 0; k < 8; ++k) n += cl[c * 8 + k];
          const int nt = (n + MROWS - 1) / MROWS;
          if (cls < 0 && u < accu + nt) { cls = c; tile = u - accu; n_c = n; } accu += nt; } }
    if (cls < 0) break;
    const int nrow = (n_c - tile * MROWS) < MROWS ? (n_c - tile * MROWS) : MROWS;
    const int grp = cls / 6, pidx = cls % 6;
    const int elo = pidx < 3 ? 0 : (pidx < 5 ? 1 : 2), ehi = pidx < 3 ? pidx + 1 : (pidx < 5 ? pidx - 1 : 3);
    const int slot = layer & 1;
    const int ea = grp * 4 + elo, eb = grp * 4 + ehi;
    LAS unsigned char* Al = F.lds + RING_OFF + MOE_A_OFF; LAS bf16* Hl = (LAS bf16*)(F.lds + RING_OFF + MOE_H_OFF);
    LAS int* tokl = (LAS int*)(F.lds + RING_OFF + MOE_T_OFF); LAS float* gal = (LAS float*)(tokl + MRP); LAS float* gbl = gal + MRP;
    if (F.tid < MRP) { const bool ok = F.tid < nrow; int kk = 0, off = tile * MROWS + F.tid;
#pragma unroll
        for (int k = 0; k < 7; ++k) { const int nk = cl[cls * 8 + k]; const bool adv = (kk == k) && (off >= nk); off = adv ? off - nk : off; kk = adv ? kk + 1 : kk; }
        const size_t li = (size_t)cls * TOK + kk * 2048 + off;
        const int t = ok ? ((const int*)(ws + WS_LIST))[li] : 0;
        tokl[F.tid] = ok ? t : -1; gal[F.tid] = ok ? ((const float*)(ws + WS_GAL))[li] : 0.f; gbl[F.tid] = ok ? ((const float*)(ws + WS_GBL))[li] : 0.f; }
    __syncthreads();
    const bf16* hb = (const bf16*)(ws + WS_HB);
    const int fr = F.lane & 15, fq = F.lane >> 4, w = F.wave; const unsigned lb = (unsigned)F.lane * 16u;
    { const int tidm = tid_fresh(), c = tidm & 127, r0 = tidm >> 7;
      v4u greg[18];
#pragma unroll
      for (int i = 0; i < 18; ++i) { const int t = tokl[r0 + 4 * i]; greg[i] = *(const GAS v4u*)((const GAS char*)hb + ((size_t)(unsigned)((t >= 0 ? t : 0) * DM + c * 8)) * 2u); if (t < 0) greg[i] = (v4u){0u, 0u, 0u, 0u}; }
#pragma unroll
      for (int i = 0; i < 18; ++i) *(LAS v4u*)(Al + (r0 + 4 * i) * MOE_APB + c * 16) = greg[i]; }
    LDS_WAIT(); __builtin_amdgcn_s_barrier(); asm volatile("" ::: "memory");
    unsigned long long hq0[5][2];
#pragma unroll 1
    for (int xi = 0; xi < 2; ++xi) { const int x = xi ^ (tile & 1);
        const bf16* Wt = (const bf16*)(ws + WS_WGU) + ((size_t)(slot * NE + (x ? eb : ea))) * 512 * DM + (size_t)w * (32 * 4 * 64 * 8);
        f32x4m acc[5][4];
#pragma unroll
        for (int rb = 0; rb < 5; ++rb)
#pragma unroll
            for (int cb = 0; cb < 4; ++cb) acc[rb][cb] = (f32x4m){0.f, 0.f, 0.f, 0.f};
        bf16x8 bfr[4][4];
#pragma unroll
        for (int r = 0; r < 3; ++r)
#pragma unroll
            for (int cb = 0; cb < 4; ++cb) bfr[r][cb] = *(const GAS bf16x8*)((const char*)(Wt + (r * 4 + cb) * 512) + lb);
        const int l1 = tid_fresh() & 63, fr1 = l1 & 15, fq1 = l1 >> 4;
        const LAS unsigned char* ap0 = Al + fr1 * MOE_APB + fq1 * 16;
        const LAS unsigned char* ap4 = Al + (64 + (fr1 < 8 ? fr1 : fr1 - 8)) * MOE_APB + fq1 * 16;
#pragma unroll 1
        for (int kc = 0; kc < 8; ++kc) {
#pragma unroll
            for (int j = 0; j < 4; ++j) {
                const int ks = kc * 4 + j, kn = (ks + 3 < 32) ? ks + 3 : 31;
#pragma unroll
                for (int cb = 0; cb < 4; ++cb) bfr[(j + 3) & 3][cb] = *(const GAS bf16x8*)((const char*)(Wt + (kn * 4 + cb) * 512) + lb);
                bf16x8 af[5];
#pragma unroll
                for (int rb = 0; rb < 4; ++rb) af[rb] = *(const LAS bf16x8*)(ap0 + rb * 16 * MOE_APB + ks * 64);
                af[4] = *(const LAS bf16x8*)(ap4 + ks * 64);
                __builtin_amdgcn_sched_barrier(0);
#pragma unroll
                for (int rb = 0; rb < 5; ++rb)
#pragma unroll
                    for (int cb = 0; cb < 4; ++cb) acc[rb][cb] = __builtin_amdgcn_mfma_f32_16x16x32_bf16(bfr[j][cb], af[rb], acc[rb][cb], 0, 0, 0);
                __builtin_amdgcn_sched_barrier(0);
            }
        }
        { const int l2 = tid_fresh() & 63, fr = l2 & 15, fq = l2 >> 4;
          if (xi == 1) { LDS_WAIT(); __builtin_amdgcn_s_barrier(); asm volatile("" ::: "memory"); }
#pragma unroll
        for (int rb = 0; rb < 5; ++rb) { const int row = rb * 16 + fr; const float gt = x ? gbl[row] : gal[row];
#pragma unroll
            for (int cb = 0; cb < 2; ++cb) { float hv[4];
#pragma unroll
                for (int j = 0; j < 4; ++j) { const float gv = acc[rb][cb][j], uv = acc[rb][cb + 2][j]; hv[j] = gv / (1.0f + __expf(-gv)) * uv * gt; }
                const unsigned long long pkd = (unsigned long long)pk2(hv[0], hv[1]) | ((unsigned long long)pk2(hv[2], hv[3]) << 32);
                if (xi == 0) hq0[rb][cb] = pkd;
                else { *(LAS unsigned long long*)(Hl + row * MOE_HP + x * 256 + 32 * w + 16 * cb + 4 * fq) = pkd;
                       *(LAS unsigned long long*)(Hl + row * MOE_HP + (x ^ 1) * 256 + 32 * w + 16 * cb + 4 * fq) = hq0[rb][cb]; } } }
        }
    }
    __syncthreads();
    float* H = a.out(); LAS float* ssl = (LAS float*)(F.lds + RING_OFF + MOE_E_OFF);
    LAS float* rsl = ssl + MRP * 16;
    LAS long long* fgl = (LAS long long*)(F.lds + RING_OFF + MOE_E_OFF + 8192);
    if (fg) { unsigned z_; asm volatile("v_mov_b32 %0, 0" : "=v"(z_)); const unsigned long long z64 = ((unsigned long long)z_ << 32) | z_;
        for (int i = F.tid; i < 16 * 81; i += NWAVES * 64) fgl[i] = (long long)z64; __syncthreads(); }
#pragma unroll 1
    for (int pi = 0; pi < 2; ++pi) { const int p = pi ^ ((tile >> 1) & 1);
        const bf16* WtA = (const bf16*)(ws + WS_WD) + ((size_t)(slot * NE + ea)) * DM * FF + (size_t)(p * 8 + w) * (8 * 4 * 64 * 8);
        const bf16* WtB = (const bf16*)(ws + WS_WD) + ((size_t)(slot * NE + eb)) * DM * FF + (size_t)(p * 8 + w) * (8 * 4 * 64 * 8);
        f32x4m acc[5][4];
#pragma unroll
        for (int rb = 0; rb < 5; ++rb)
#pragma unroll
            for (int cb = 0; cb < 4; ++cb) acc[rb][cb] = (f32x4m){0.f, 0.f, 0.f, 0.f};
        bf16x8 bfr[4][4];
#pragma unroll
        for (int r = 0; r < 3; ++r)
#pragma unroll
            for (int cb = 0; cb < 4; ++cb) bfr[r][cb] = *(const GAS bf16x8*)((const char*)(WtA + (r * 4 + cb) * 512) + lb);
        bf16x8 afn = *(const LAS bf16x8*)(Hl + fr * MOE_HP + fq * 8);
#pragma unroll 1
        for (int kc = 0; kc < 4; ++kc) {
#pragma unroll
            for (int j = 0; j < 4; ++j) {
                const int ks = kc * 4 + j, kn = (ks + 3 < 16) ? ks + 3 : 15;
                { const bf16* Wn = (kn < 8 ? WtA : WtB) + ((kn & 7) * 4) * 512;
#pragma unroll
                    for (int cb = 0; cb < 4; ++cb) bfr[(j + 3) & 3][cb] = *(const GAS bf16x8*)((const char*)(Wn + cb * 512) + lb); }
#pragma unroll
                for (int rb = 0; rb < 5; ++rb) { const bf16x8 af = afn; const int rn = (rb + 1) % 5, kq = ks + (rb == 4 ? 1 : 0);
                    afn = *(const LAS bf16x8*)(Hl + (rn * 16 + fr) * MOE_HP + (kq < 16 ? kq : 15) * 32 + fq * 8);
                    __builtin_amdgcn_sched_barrier(0);
#pragma unroll
                    for (int cb = 0; cb < 4; ++cb) acc[rb][cb] = __builtin_amdgcn_mfma_f32_16x16x32_bf16(bfr[j][cb], af, acc[rb][cb], 0, 0, 0);
                    __builtin_amdgcn_sched_barrier(0); }
            }
        }
        const int l3 = tid_fresh() & 63, fr3 = l3 & 15, fq3 = l3 >> 4;
        bf16* hbw = (bf16*)(ws + WS_HB);
        bf16x8 wff[2][2];
        if (fg) { const GAS char* fp = (const GAS char*)(ws + WS_WFF) + (size_t)((p * 8 + w) * 4) * 1024u + (unsigned)l3 * 16u;
#pragma unroll
            for (int s2 = 0; s2 < 2; ++s2)
#pragma unroll
                for (int hl = 0; hl < 2; ++hl) wff[s2][hl] = *(const GAS bf16x8*)(fp + (s2 * 2 + hl) * 1024); }
        unsigned php[8], plp[8]; int pt = -1;
#pragma unroll
        for (int i = 0; i < 8; ++i) { php[i] = 0u; plp[i] = 0u; }
#define MOE_FG(rb_, t_) do { f32x4m fa = (f32x4m){0.f, 0.f, 0.f, 0.f}; \
            _Pragma("unroll") for (int s2 = 0; s2 < 2; ++s2) { \
                const bf16x8 hh_ = __builtin_bit_cast(bf16x8, (v4u){php[4 * s2], php[4 * s2 + 1], php[4 * s2 + 2], php[4 * s2 + 3]}), ll_ = __builtin_bit_cast(bf16x8, (v4u){plp[4 * s2], plp[4 * s2 + 1], plp[4 * s2 + 2], plp[4 * s2 + 3]}); \
                fa = __builtin_amdgcn_mfma_f32_16x16x32_bf16(wff[s2][0], hh_, fa, 0, 0, 0); \
                fa = __builtin_amdgcn_mfma_f32_16x16x32_bf16(wff[s2][1], hh_, fa, 0, 0, 0); \
                fa = __builtin_amdgcn_mfma_f32_16x16x32_bf16(wff[s2][0], ll_, fa, 0, 0, 0); } \
            if ((t_) >= 0) { _Pragma("unroll") for (int j = 0; j < 4; ++j) { const long long fx = (long long)(fa[j] * 4294967296.0f); \
                (void)__hip_atomic_fetch_add(fgl + (4 * fq3 + j) * 81 + (rb_) * 16 + fr3, fx, __ATOMIC_RELAXED, __HIP_MEMORY_SCOPE_WORKGROUP); } } } while (0)
#pragma unroll
        for (int rb = 0; rb < 5; ++rb) { const int t = tokl[rb * 16 + fr3]; float ssq = 0.f;
            const size_t eo = (size_t)(t >= 0 ? t : 0) * DM + 512 * p + 64 * w + 8 * fq3;
            GAS f32x4* hp = (GAS f32x4*)(H + eo); GAS v4u* bp = (GAS v4u*)(hbw + eo); GAS v4u* lpw = (GAS v4u*)((bf16*)(ws + WS_HLO) + eo);
            f32x4 hv[4];
            { v4u hi2[2], lo2[2];
#pragma unroll
              for (int hs = 0; hs < 2; ++hs) { hi2[hs] = bp[4 * hs]; lo2[hs] = lpw[4 * hs]; }
#pragma unroll
              for (int hs = 0; hs < 2; ++hs) { const v4u hi_ = hi2[hs], lo_ = lo2[hs];
                  hv[2 * hs]     = (f32x4){bf2f(hi_.x & 0xffffu) + bf2f(lo_.x & 0xffffu), bf2f(hi_.x >> 16) + bf2f(lo_.x >> 16), bf2f(hi_.y & 0xffffu) + bf2f(lo_.y & 0xffffu), bf2f(hi_.y >> 16) + bf2f(lo_.y >> 16)};
                  hv[2 * hs + 1] = (f32x4){bf2f(hi_.z & 0xffffu) + bf2f(lo_.z & 0xffffu), bf2f(hi_.z >> 16) + bf2f(lo_.z >> 16), bf2f(hi_.w & 0xffffu) + bf2f(lo_.w & 0xffffu), bf2f(hi_.w >> 16) + bf2f(lo_.w >> 16)}; } }
            if (fg && rb > 0) MOE_FG(rb - 1, pt);
            unsigned hp8[8], lp8[8];
#pragma unroll
            for (int cb = 0; cb < 4; ++cb) { const int hi4 = 8 * (cb >> 1) + (cb & 1); const f32x4 hn = hv[cb] + acc[rb][cb] * upd; if (t >= 0 && layer + 1 >= NL) hp[hi4] = hn; ssq += (hn.x * hn.x + hn.y * hn.y) + (hn.z * hn.z + hn.w * hn.w);
                const unsigned h01 = pk2(hn.x, hn.y), h23 = pk2(hn.z, hn.w);
                hp8[2 * cb] = t >= 0 ? h01 : 0u; hp8[2 * cb + 1] = t >= 0 ? h23 : 0u;
                lp8[2 * cb] = t >= 0 ? pk2(hn.x - bf2f(h01 & 0xffffu), hn.y - bf2f(h01 >> 16)) : 0u; lp8[2 * cb + 1] = t >= 0 ? pk2(hn.z - bf2f(h23 & 0xffffu), hn.w - bf2f(h23 >> 16)) : 0u; }
            if (t >= 0 && layer + 1 < NL) { bp[0] = (v4u){hp8[0], hp8[1], hp8[2], hp8[3]}; bp[4] = (v4u){hp8[4], hp8[5], hp8[6], hp8[7]}; lpw[0] = (v4u){lp8[0], lp8[1], lp8[2], lp8[3]}; lpw[4] = (v4u){lp8[4], lp8[5], lp8[6], lp8[7]}; }
            if (t < 0) ssq = 0.f;
            ssq += __shfl_xor(ssq, 16); ssq += __shfl_xor(ssq, 32);
            if (fq3 == 0) ssl[(rb * 16 + fr3) * 16 + p * 8 + w] = ssq;
#pragma unroll
            for (int i = 0; i < 8; ++i) { php[i] = hp8[i]; plp[i] = lp8[i]; }
            pt = t; }
        if (fg) MOE_FG(4, pt);
#undef MOE_FG
    }
    __syncthreads();
    if (F.tid < MROWS) { const int t = tokl[F.tid]; float tot = 0.f;
#pragma unroll
        for (int i = 0; i < 16; ++i) tot += ssl[F.tid * 16 + i];
        const float rsn = 1.0f / sqrtf(tot * (1.0f / DM) + 1e-6f); rsl[F.tid] = rsn;
        if (t >= 0 && layer + 1 < NL) ((float*)(ws + WS_RSTD))[t] = rsn; }
    __syncthreads();
    if (fg) {
        for (int i = F.tid; i < MROWS * 16; i += NWAVES * 64) { const int r = i >> 4, hh = i & 15; const int t = tokl[r];
            if (t >= 0) { const float z = ((float)fgl[hh * 81 + r] * (1.0f / 4294967296.0f)) * rsl[r] + a.in(4)[1 * AH + hh];
                const float ls = fminf(z, 0.f) - __logf(1.0f + __expf(-fabsf(z)));
                const int b = t / SEQ, sidx = t % SEQ; ((float*)(ws + WS_LOGF))[(size_t)(b * AH + hh) * SEQ + sidx] = ls; } }
        __syncthreads(); }
    }
}

constexpr int OPR_ROWS = 64;
constexpr int OPR_A_OFF = 0, OPR_APB = 2048 + 16;
constexpr int OPR_P2_OFF = 0, OPR_S2_OFF = 40960;
constexpr int OPR_WQ_OFF = OPR_ROWS * OPR_APB;
static_assert(OPR_WQ_OFF + 8192 <= MISC_OFF, "OPR LDS");
__device__ __forceinline__ float opr_red4(const float (&v)[4], int fq) {
    const bool b0 = fq & 1, b1 = fq & 2;
    const float s0 = b0 ? v[0] : v[2], s1 = b0 ? v[1] : v[3], k0 = b0 ? v[2] : v[0], k1 = b0 ? v[3] : v[1];
    const float a0 = k0 + __shfl_xor(s0, 16), a1 = k1 + __shfl_xor(s1, 16);
    const float s = b1 ? a0 : a1, k = b1 ? a1 : a0;
    return k + __shfl_xor(s, 32);
}
struct OprCtx { const bf16* wt; LAS unsigned char* Al; const float* base; bf16* hlw; bf16* hbw; const bf16* wrf; int row0, rot, w; bool dry; };
#define OPR_KS(s_) (((((s_) >> 2) + C.rot) & 7) * 4 + ((s_) & 3))
template <bool K, bool EPI> __device__ __forceinline__ void opr_pass(const OprCtx& C, int p, f32x4m (&acc)[4][2], f32x4m (&hd)[4][2], bf16x8 (&bfr)[8][2], f32x4m (&racc)[4][2], bf16x8 (&wf)[2][2], float (&ssacc)[4]) {
    const int q = p - 1;
    const int tid = tid_fresh(), lane = tid & 63, fr = lane & 15, fq = lane >> 4;
    const unsigned lb = (unsigned)lane * 16u;
    const unsigned eoff = (unsigned)((C.row0 + fr) * DM + 32 * C.w + 8 * fq);
    const LAS unsigned char* ap0 = C.Al + fr * OPR_APB + fq * 16;
#pragma unroll
    for (int ks = 0; ks < (K ? 32 : 4); ++ks) {
        bf16x8 af[4];
        if (K) {
            { int sn = p * 32 + ks + 7; sn = sn < 127 ? sn : 127; const int pn = sn >> 5, kn = OPR_KS(sn & 31);
              const unsigned o = (unsigned)(((((pn >> 1) * 8 + 4 * (pn & 1) + (C.w >> 1)) * 32 + kn) * 4 + 2 * (C.w & 1))) * 1024u;
              const GAS char* wp = (const GAS char*)C.wt + o;
              bfr[(ks + 7) & 7][0] = *(const GAS bf16x8*)(wp + lb); bfr[(ks + 7) & 7][1] = *(const GAS bf16x8*)(wp + 1024 + lb); }
            { const LAS unsigned char* ap = ap0 + OPR_KS(ks) * 64;
#pragma unroll
              for (int rb = 0; rb < 4; ++rb) af[rb] = *(const LAS bf16x8*)(ap + rb * 16 * OPR_APB); }
        }
        __builtin_amdgcn_sched_barrier(0);
        if (K) {
#pragma unroll
            for (int rb = 0; rb < 4; ++rb)
#pragma unroll
                for (int cb = 0; cb < 2; ++cb) acc[rb][cb] = __builtin_amdgcn_mfma_f32_16x16x32_bf16(bfr[ks & 7][cb], af[rb], acc[rb][cb], 0, 0, 0);
        }
        if (EPI && ks < 4) {
            const int rb = ks; const unsigned off = eoff + (unsigned)(rb * 16 * DM + 256 * q);
            unsigned hp[4], lp[4];
#pragma unroll
            for (int cb = 0; cb < 2; ++cb) { const f32x4m hn = hd[rb][cb];
                const unsigned h01 = pk2(hn.x, hn.y), h23 = pk2(hn.z, hn.w);
                ssacc[rb] += (hn.x * hn.x + hn.y * hn.y) + (hn.z * hn.z + hn.w * hn.w);
                hp[2 * cb] = h01; hp[2 * cb + 1] = h23;
                lp[2 * cb] = pk2(hn.x - bf2f(h01 & 0xffffu), hn.y - bf2f(h01 >> 16)); lp[2 * cb + 1] = pk2(hn.z - bf2f(h23 & 0xffffu), hn.w - bf2f(h23 >> 16)); }
            if (!C.dry) { *(GAS v4u*)((GAS char*)C.hbw + (size_t)off * 2u) = (v4u){hp[0], hp[1], hp[2], hp[3]};
                          *(GAS v4u*)((GAS char*)C.hlw + (size_t)off * 2u) = (v4u){lp[0], lp[1], lp[2], lp[3]}; }
            const bf16x8 hh = __builtin_bit_cast(bf16x8, (v4u){hp[0], hp[1], hp[2], hp[3]}), ll = __builtin_bit_cast(bf16x8, (v4u){lp[0], lp[1], lp[2], lp[3]});
#pragma unroll
            for (int qb = 0; qb < 2; ++qb) {
                racc[rb][qb] = __builtin_amdgcn_mfma_f32_16x16x32_bf16(wf[qb][0], hh, racc[rb][qb], 0, 0, 0);
                racc[rb][qb] = __builtin_amdgcn_mfma_f32_16x16x32_bf16(wf[qb][1], hh, racc[rb][qb], 0, 0, 0);
                racc[rb][qb] = __builtin_amdgcn_mfma_f32_16x16x32_bf16(wf[qb][0], ll, racc[rb][qb], 0, 0, 0); }
        }
        if (K) {
            if (ks >= 4 && ks < 8) {
                const int rb = ks - 4; const unsigned bo = eoff + (unsigned)(rb * 16 * DM + 256 * p);
                if (C.base) { const GAS char* bp = (const GAS char*)C.base + (size_t)bo * 4u; hd[rb][0] = *(const GAS f32x4m*)bp; hd[rb][1] = *(const GAS f32x4m*)(bp + 16); }
                else { hd[rb][0] = *(const GAS f32x4m*)((const GAS char*)C.hbw + (size_t)bo * 2u); hd[rb][1] = *(const GAS f32x4m*)((const GAS char*)C.hlw + (size_t)bo * 2u); }
            } else if (ks == 28) {
                const GAS char* fp = (const GAS char*)C.wrf + (size_t)((p * 8 + C.w) * 4) * 1024u + lb;
#pragma unroll
                for (int qb = 0; qb < 2; ++qb)
#pragma unroll
                    for (int hl = 0; hl < 2; ++hl) wf[qb][hl] = *(const GAS bf16x8*)(fp + (qb * 2 + hl) * 1024);
            }
        }
        __builtin_amdgcn_sched_barrier(0);
    }
}
template <bool MERGE> __device__ __forceinline__ void p_opr(const KA a, Frame& F, int layer, const bf16* Wt_all, const float* base, bool dry) {
    unsigned char* ws = a.ws(); asm volatile("" : "+s"(ws)); ASSUME_GLOBAL(ws);
    OprCtx C;
    C.Al = F.lds + OPR_A_OFF;
    C.base = base; C.hlw = (bf16*)(ws + WS_HLO); C.hbw = (bf16*)(ws + WS_HB); C.wrf = (const bf16*)(ws + WS_WRF) + (size_t)layer * (4 * 8 * 4 * 512);
    C.w = F.wave; C.dry = dry; C.wt = Wt_all;
    LAS float* wql = (LAS float*)(F.lds + OPR_WQ_OFF);
    for (int u = bid_fresh(); u < TOK / OPR_ROWS; u += (int)gridDim.x) {
    C.row0 = u * OPR_ROWS; C.rot = ((u >> 3) * 3 + (u & 7)) & 7;
    if (MERGE) {
        const int t3 = tid_fresh(), r = t3 >> 3, hh = t3 & 7; const float* lp = (const float*)(ws + WS_LSE) + (size_t)(C.row0 + r) * 24 + hh;
        const float l0 = *(const GAS float*)lp, l1 = *(const GAS float*)(lp + 8), l2 = *(const GAS float*)(lp + 16);
        const float mx = fmaxf(l0, fmaxf(l1, l2)); const float e0 = expf(l0 - mx), e1 = expf(l1 - mx), e2 = expf(l2 - mx), inv = 1.0f / (e0 + e1 + e2);
        *(LAS f32x4*)(wql + (r * 8 + hh) * 4) = (f32x4){e0 * inv, e1 * inv, e2 * inv, 0.f};
        __syncthreads();
    }
    { const bf16* asrc = (const bf16*)(ws + WS_QB);
      const int c = F.tid & 127, r0 = F.tid >> 7;
      constexpr int NG = MERGE ? 3 : 1, NB = MERGE ? 2 : 1, PB = 16 / NB;
#pragma unroll 1
      for (int b = 0; b < NB; ++b) {
          v4u greg[PB][NG];
#pragma unroll
          for (int i = 0; i < PB; ++i)
#pragma unroll
              for (int g = 0; g < NG; ++g) greg[i][g] = *(const GAS v4u*)(asrc + (size_t)(C.row0 + r0 + 4 * (b * PB + i)) * (MERGE ? 3072 : 1024) + g * 1024 + c * 8);
#pragma unroll
          for (int i = 0; i < PB; ++i) { const int r = r0 + 4 * (b * PB + i); v4u o_;
              if (MERGE) { const f32x4 wq_ = *(const LAS f32x4*)(wql + (r * 8 + (c >> 4)) * 4);
                  const unsigned x0_[4] = {greg[i][0].x, greg[i][0].y, greg[i][0].z, greg[i][0].w}, x1_[4] = {greg[i][NG > 1 ? 1 : 0].x, greg[i][NG > 1 ? 1 : 0].y, greg[i][NG > 1 ? 1 : 0].z, greg[i][NG > 1 ? 1 : 0].w},
                                 x2_[4] = {greg[i][NG > 2 ? 2 : 0].x, greg[i][NG > 2 ? 2 : 0].y, greg[i][NG > 2 ? 2 : 0].z, greg[i][NG > 2 ? 2 : 0].w}; unsigned y_[4];
#pragma unroll
                  for (int e = 0; e < 4; ++e) { const float lo_ = wq_.x * bf2f(x0_[e] & 0xffffu) + wq_.y * bf2f(x1_[e] & 0xffffu) + wq_.z * bf2f(x2_[e] & 0xffffu),
                                                            hi_ = wq_.x * bf2f(x0_[e] >> 16) + wq_.y * bf2f(x1_[e] >> 16) + wq_.z * bf2f(x2_[e] >> 16); y_[e] = pk2(lo_, hi_); }
                  o_ = (v4u){y_[0], y_[1], y_[2], y_[3]}; } else o_ = greg[i][0];
              *(LAS v4u*)(C.Al + r * OPR_APB + c * 16) = o_; }
      } }
    __builtin_amdgcn_sched_barrier(0);
    f32x4m acc[4][2], hd[4][2], racc[4][2]; bf16x8 bfr[8][2], wf[2][2]; float ssacc[4] = {0.f, 0.f, 0.f, 0.f};
#pragma unroll
    for (int rb = 0; rb < 4; ++rb)
#pragma unroll
        for (int cb = 0; cb < 2; ++cb) { acc[rb][cb] = (f32x4m){0.f, 0.f, 0.f, 0.f}; hd[rb][cb] = (f32x4m){0.f, 0.f, 0.f, 0.f}; racc[rb][cb] = (f32x4m){0.f, 0.f, 0.f, 0.f}; }
#pragma unroll
    for (int qb = 0; qb < 2; ++qb)
#pragma unroll
        for (int hl = 0; hl < 2; ++hl) wf[qb][hl] = (bf16x8){0, 0, 0, 0, 0, 0, 0, 0};
#pragma unroll
    for (int s = 0; s < 7; ++s) { const unsigned o = (unsigned)((((C.w >> 1) * 32 + OPR_KS(s)) * 4 + 2 * (C.w & 1))) * 1024u; const unsigned lb = (unsigned)F.lane * 16u;
        bfr[s][0] = *(const GAS bf16x8*)((const GAS char*)Wt_all + o + lb); bfr[s][1] = *(const GAS bf16x8*)((const GAS char*)Wt_all + o + 1024 + lb); }
    LDS_WAIT(); __builtin_amdgcn_s_barrier(); asm volatile("" ::: "memory");
#define OPR_BOUNDARY() do { \
        if (C.base) { _Pragma("unroll") for (int rb = 0; rb < 4; ++rb) _Pragma("unroll") for (int cb = 0; cb < 2; ++cb) { hd[rb][cb] = acc[rb][cb] + hd[rb][cb]; acc[rb][cb] = (f32x4m){0.f, 0.f, 0.f, 0.f}; } } \
        else { _Pragma("unroll") for (int rb = 0; rb < 4; ++rb) { const v4u hi_ = __builtin_bit_cast(v4u, hd[rb][0]), lo_ = __builtin_bit_cast(v4u, hd[rb][1]); \
                 hd[rb][0] = acc[rb][0] + (f32x4m){bf2f(hi_.x & 0xffffu) + bf2f(lo_.x & 0xffffu), bf2f(hi_.x >> 16) + bf2f(lo_.x >> 16), bf2f(hi_.y & 0xffffu) + bf2f(lo_.y & 0xffffu), bf2f(hi_.y >> 16) + bf2f(lo_.y >> 16)}; \
                 hd[rb][1] = acc[rb][1] + (f32x4m){bf2f(hi_.z & 0xffffu) + bf2f(lo_.z & 0xffffu), bf2f(hi_.z >> 16) + bf2f(lo_.z >> 16), bf2f(hi_.w & 0xffffu) + bf2f(lo_.w & 0xffffu), bf2f(hi_.w >> 16) + bf2f(lo_.w >> 16)}; \
                 acc[rb][0] = (f32x4m){0.f, 0.f, 0.f, 0.f}; acc[rb][1] = (f32x4m){0.f, 0.f, 0.f, 0.f}; } } } while (0)
    opr_pass<true, false>(C, 0, acc, hd, bfr, racc, wf, ssacc);
    OPR_BOUNDARY();
#pragma unroll 1
    for (int p = 1; p < 4; ++p) { opr_pass<true, true>(C, p, acc, hd, bfr, racc, wf, ssacc); OPR_BOUNDARY(); }
    opr_pass<false, true>(C, 4, acc, hd, bfr, racc, wf, ssacc);
#undef OPR_BOUNDARY
    LDS_WAIT(); __builtin_amdgcn_s_barrier(); asm volatile("" ::: "memory");
    { const int l3 = tid_fresh() & 63, fr3 = l3 & 15, fq3 = l3 >> 4;
      LAS float* p2 = (LAS float*)(F.lds + OPR_P2_OFF) + (size_t)C.w * 64 * 20; LAS float* s2 = (LAS float*)(F.lds + OPR_S2_OFF) + C.w * 64;
#pragma unroll
      for (int rb = 0; rb < 4; ++rb) { *(LAS f32x4m*)(p2 + (rb * 16 + fr3) * 20 + 4 * fq3) = racc[rb][0]; if (fq3 == 0) *(LAS f32x4m*)(p2 + (rb * 16 + fr3) * 20 + 16) = racc[rb][1]; }
      const float t = opr_red4(ssacc, fq3); s2[(2 * (fq3 & 1) + (fq3 >> 1)) * 16 + fr3] = t; }
    LDS_WAIT(); __builtin_amdgcn_s_barrier(); asm volatile("" ::: "memory");
    if (F.tid < OPR_ROWS) { const int m = C.row0 + F.tid;
        const LAS float* p2 = (const LAS float*)(F.lds + OPR_P2_OFF) + F.tid * 20; const LAS float* s2 = (const LAS float*)(F.lds + OPR_S2_OFF) + F.tid;
        float tot = 0.f;
#pragma unroll
        for (int w8 = 0; w8 < 8; ++w8) tot += s2[w8 * 64];
        const float rsr = 1.0f / sqrtf(tot * (1.0f / DM) + 1e-6f);
        ((float*)(ws + WS_RSTD))[m] = rsr;
        float d[20];
#pragma unroll
        for (int q4 = 0; q4 < 5; ++q4) { f32x4m t4 = *(const LAS f32x4m*)(p2 + 4 * q4);
#pragma unroll
            for (int w8 = 1; w8 < 8; ++w8) t4 = t4 + *(const LAS f32x4m*)(p2 + w8 * 64 * 20 + 4 * q4);
            d[4 * q4] = t4.x * rsr; d[4 * q4 + 1] = t4.y * rsr; d[4 * q4 + 2] = t4.z * rsr; d[4 * q4 + 3] = t4.w * rsr; }
        const float* gb = a.in(17) + layer * 4;
        float lg[4];
#pragma unroll
        for (int q = 0; q < 4; ++q) lg[q] = d[q] + gb[q];
        int gi = 0; float gm = lg[0];
#pragma unroll
        for (int q = 1; q < 4; ++q) if (lg[q] > gm) { gm = lg[q]; gi = q; }
        float gs = 0.f;
#pragma unroll
        for (int q = 0; q < 4; ++q) gs += expf(lg[q] - gm);
        const float gp = 1.0f / gs;
        const float* ebp = a.in(19) + layer * 16;
        float el[4];
#pragma unroll
        for (int q = 0; q < 4; ++q) { float t = 0.f;
#pragma unroll
            for (int g2 = 0; g2 < 4; ++g2) if (g2 == gi) t = d[4 + 4 * g2 + q] + ebp[4 * g2 + q];
            el[q] = t; }
        int i1 = 0; float v1 = el[0];
#pragma unroll
        for (int q = 1; q < 4; ++q) if (el[q] > v1) { v1 = el[q]; i1 = q; }
        int i2 = -1; float v2 = 0.f;
#pragma unroll
        for (int q = 0; q < 4; ++q) if (q != i1 && (i2 < 0 || el[q] > v2)) { v2 = el[q]; i2 = q; }
        const float e2 = expf(v2 - v1), g1 = gp / (1.0f + e2), g2v = gp * e2 / (1.0f + e2);
        const int lo = i1 < i2 ? i1 : i2, hi = i1 < i2 ? i2 : i1;
        const int pidx = (lo == 0) ? (hi - 1) : (lo == 1 ? hi + 1 : 5);
        const int cls = gi * 6 + pidx;
        int rank = 0, mycnt = 0;
#pragma unroll 1
        for (int c = 0; c < NCLS; ++c) { const unsigned long long mk = __ballot(cls == c); if (cls == c) rank = __popcll(mk & ((1ull << F.tid) - 1ull)); if (F.tid == c) mycnt = __popcll(mk); }
        const int sub = u & 7;
        unsigned basev = 0u;
        if (!dry && F.tid < NCLS && mycnt > 0) basev = __hip_atomic_fetch_add((unsigned*)(ws + WS_CTL) + CW_CNT2 + layer * 8192 + (F.tid * 8 + sub) * 32, (unsigned)mycnt, RLX_AGENT);
        const unsigned pp = (unsigned)__shfl((int)basev, cls) + (unsigned)rank;
        if (!dry) {
            ((int*)(ws + WS_LIST))[(size_t)cls * TOK + sub * 2048 + pp] = m;
            ((float*)(ws + WS_GAL))[(size_t)cls * TOK + sub * 2048 + pp] = (i1 < i2) ? g1 : g2v;
            ((float*)(ws + WS_GBL))[(size_t)cls * TOK + sub * 2048 + pp] = (i1 < i2) ? g2v : g1;
        }
    }
    __syncthreads();
    }
#undef OPR_KS
}

__global__ void __launch_bounds__(NWAVES * 64, 2) fwd_kernel(Args args_unused_directly) {
    extern __shared__ __attribute__((aligned(16))) unsigned char lds[];
    Frame F;
    F.lds = (LAS unsigned char*)lds;
    F.tid = threadIdx.x; F.lane = F.tid & 63; F.wave = __builtin_amdgcn_readfirstlane(F.tid >> 6);
    F.G = gridDim.x; { const int bx = blockIdx.x; F.vcu = (F.G % 8 == 0) ? (bx % 8) * (F.G / 8) + bx / 8 : bx; }
    const kptr_t kbase = (kptr_t)__builtin_amdgcn_kernarg_segment_ptr();
    unsigned char* const ws0 = KA{kbase}.ws();
    volatile LAS unsigned* MISC = (volatile LAS unsigned*)(F.lds + MISC_OFF);
    if (F.tid < 64) MISC[F.tid] = 0u;
    __syncthreads();
    const int lo = *(const int __attribute__((address_space(4)))*)(kbase + 208), hi = *(const int __attribute__((address_space(4)))*)(kbase + 212);
    XcdBarrier bar; bar.bar = (unsigned*)(ws0 + WS_CTL) + CW_BAR; bar.x = 0; bar.st = nullptr;
    if (hi - lo > 1) bar = xcd_barrier_post((unsigned*)(ws0 + WS_CTL) + CW_BAR, MISC + 8);
    int pc = 0;
#ifndef PH_EN
#define PH_EN 0xFFFF
#endif
#ifndef REP_MASK
#define REP_MASK 0
#endif
#define RUN(id, ...) RUN_(id, 1, __VA_ARGS__)
#define RUN_(id, bar_, ...) do { if (((PH_EN >> (id)) & 1) && pc >= lo && pc < hi) { \
      for (int rep_ = ((REP_MASK >> (id)) & 1); rep_ >= 0; --rep_) { const bool dry = rep_ > 0; (void)dry; kptr_t kl_ = kbase; asm volatile("" : "+s"(kl_)); const KA args{kl_}; unsigned char* ws = args.ws(); asm volatile("" : "+s"(ws)); ASSUME_GLOBAL(ws); \
        F.tid = tid_fresh(); F.lane = F.tid & 63; F.wave = __builtin_amdgcn_readfirstlane(F.tid >> 6); { const int bx = bid_fresh(); F.vcu = (F.G % 8 == 0) ? (bx % 8) * (F.G / 8) + bx / 8 : bx; } \
        __VA_ARGS__; } } if ((bar_) && pc >= lo && pc + 1 < hi) xcd_barrier(bar); ++pc; } while (0)

    RUN_(0, 0, { p_prologue(args, F); __syncthreads(); });
    for (int l = 0; l < NL; ++l) {
        if (l < NA) {
            if (l == 0) RUN(1, p_rowpass0(args, F));
            RUN(2, {

                { const int bx = bid_fresh(); if (bx < BATCH * AH) attn_body::fox_scan((char*)lds + RING_OFF, (const float*)(ws + WS_LOGF) + (size_t)bx * SEQ, (unsigned long long*)(ws + WS_CAUG) + (size_t)bx * SEQ, (int*)(ws + WS_CL) + bx * 32); }
                pg8::Gemm g{(const pg8::bf16_t*)(ws + WS_HB), (const pg8::bf16_t*)(ws + WS_WIN) + (size_t)l * 3072 * DM, TOK, 3072, DM};
                pg8::StaticOrder S; S.init(TOK, 3072, F.G, bid_fresh());
                pg8::EpiAQkv E{(pg8::bf16_t*)(ws + WS_QB), (size_t)(16 * MiB), (const float*)(ws + WS_RSTD), (const float*)(ws + WS_GTAB) + l * 192};
                pg8::gemm_phase<pg8::EpiAQkv, pg8::StaticOrder, true, true>(F.lds + RING_OFF, g, S, E);
            });
            RUN(3, {
                const attn_body::AttnTensors AT{(const attn_body::bf16*)(ws + WS_QB), (const attn_body::bf16*)(ws + WS_QB + 32 * MiB), (const attn_body::bf16*)(ws + WS_QB + 64 * MiB),
                                                (attn_body::bf16*)(ws + (dry ? WS_KB : WS_QB)), (const unsigned long long*)(ws + WS_CAUG)};
                unsigned* cq = (unsigned*)(ws + WS_CTL) + CW_CQ + (l * 2 + (dry ? 1 : 0)) * 64;
                const bool cmain = l == 0; const int clo = cmain ? TR_I_WIN : 0, chi = cmain ? TR_NITEMS : 6144;
                _Pragma("unroll 1") for (int pass = 0; pass < 2; ++pass) {
                    if (pass == 1 || (F.vcu & 3) == 0) conv_drain(args, ws, F, cq, cmain, 2, clo, chi);
                    if (pass == 0) { const int G4 = F.G - ((F.G + 3) >> 2);
                        attn_body::attn_phase_dyn<8>((char*)lds + RING_OFF, AT, (unsigned*)(ws + WS_CTL) + CW_AQ + (l * 2 + (dry ? 1 : 0)) * 64, (F.vcu & 3) ? (F.vcu >> 2) * 3 + (F.vcu & 3) - 1 : -1, G4, (const int*)(ws + WS_CL)); __syncthreads(); }
                }
            });
            RUN(4, {
                p_opr<false>(args, F, l, (const bf16*)(ws + WS_WOA) + (size_t)l * DM * DM, l == 0 ? args.in(0) : (const float*)nullptr, dry);
            });
        } else {
            const int j = l - NA;
            RUN(6, {
                const int N = j == 0 ? 5120 : 3072;
                pg8::Gemm g{(const pg8::bf16_t*)(ws + WS_HB), j == 0 ? (const pg8::bf16_t*)(ws + WS_WKVQ0) : (const pg8::bf16_t*)(ws + WS_WQ1), TOK, N, DM};
                pg8::StaticOrder S; S.init(TOK, N, F.G, bid_fresh());
                pg8::EpiBKvq E{(pg8::bf16_t*)(ws + WS_KB), (pg8::bf16_t*)(ws + WS_VB), (pg8::bf16_t*)(ws + WS_QB), (const float*)(ws + WS_RSTD), args.in(10), args.in(13) + j * BG * BHD,
                               (const unsigned*)(ws + WS_ROPEC), j == 0 ? 0 : 8, (PG8_LAS float*)(F.lds + XS_OFF)};
                pg8::gemm_phase<pg8::EpiBKvq, pg8::StaticOrder, true, true>(F.lds + RING_OFF, g, S, E);
            });
            RUN(7, p_battn(args, F, dry));
            RUN(9, {
                if (l == 2) {
                    LAS float* scr = (LAS float*)(F.lds + RING_OFF + F.wave * 16384);
                    tr_run<false>(args, ws, 3, 6144, F.vcu * NWAVES + F.wave, F.G * NWAVES, scr, F.lane);
                    __syncthreads();
                }
                p_opr<true>(args, F, l, (const bf16*)(ws + WS_WOB) + (size_t)j * DM * DM, (const float*)nullptr, dry);
            });
        }
        RUN(11, p_moe(args, F, l, dry ? 0.f : 1.f, l + 1 < NA));
    }
#undef RUN
}
constexpr int N_PHASES = 1 + 1 + NA * 4 + NB * 4;

#ifndef MK_ONE_LAUNCH
#define MK_ONE_LAUNCH 1
#endif
extern "C" void kernel_launch(void* const* d_in, const int* in_sizes, int n_in, void* d_out, int out_size, void* d_ws, size_t ws_size, hipStream_t stream) {
    static int grid = 0;
    if (grid == 0) {
        if (n_in != 23 || out_size != TOK * DM || ws_size < WS_END) { fprintf(stderr, "kernel_launch: unexpected shapes (n_in %d, out %d, ws %zu)\n", n_in, out_size, ws_size); grid = -1; return; }
        int dev = 0, cus = 0;
        if (hipGetDevice(&dev) != hipSuccess || hipDeviceGetAttribute(&cus, hipDeviceAttributeMultiprocessorCount, dev) != hipSuccess) { grid = -1; return; }
        if (hipFuncSetAttribute((const void*)fwd_kernel, hipFuncAttributeMaxDynamicSharedMemorySize, LDS_BYTES) != hipSuccess) { fprintf(stderr, "kernel_launch: hipFuncSetAttribute failed\n"); grid = -1; return; }
        int per_cu = 0;
        if (hipOccupancyMaxActiveBlocksPerMultiprocessor(&per_cu, (const void*)fwd_kernel, NWAVES * 64, LDS_BYTES) != hipSuccess || per_cu < 1) fprintf(stderr, "kernel_launch: occupancy query says %d\n", per_cu);
        (void)hipGetLastError();
        grid = cus;
    }
    if (grid < 0) return;
    if (hipMemsetAsync((char*)d_ws + WS_CTL, 0, CTL_ZERO_BYTES, stream) != hipSuccess) return;
    Args a{};
    for (int i = 0; i < 23; ++i) a.in[i] = (const float*)d_in[i];
    a.in[23] = nullptr;
    a.out = (float*)d_out; a.ws = (unsigned char*)d_ws;
#if MK_ONE_LAUNCH
    a.ph_lo = 0; a.ph_hi = N_PHASES;
    hipLaunchKernelGGL(fwd_kernel, dim3(grid), dim3(NWAVES * 64), LDS_BYTES, stream, a);
#else
    for (int p = 0; p < N_PHASES; ++p) { a.ph_lo = p; a.ph_hi = p + 1;
        hipLaunchKernelGGL(fwd_kernel, dim3(grid), dim3(NWAVES * 64), LDS_BYTES, stream, a); }
#endif
}
```
